# Optimizing an MI355X kernel written in HIP

```python
import math
import jax, jax.numpy as jnp
from jax import lax
import numpy as np

D_MODEL = 1024
BATCH = 8
SEQ = 2048
DEPTH = 4
DEC_BATCH = 128
DEC_SEQ = 4
PAST_LEN = 16384
PAGE_SIZE = 128

N_MIXERS = 3
N_A = (DEPTH + 2) // 3
N_B = (DEPTH + 1) // 3
N_C = DEPTH // 3
EPS = 1e-6
CHUNK = 128
D_SGU = D_MODEL
HEADS_A = 8
HD_A = D_SGU // HEADS_A
D_RNN = D_MODEL
HEADS_B = 16
HD_B = D_RNN // HEADS_B
CONV_W = 4
LRU_C = 8.0
D_S5 = D_MODEL
GROUP_C = 16
G_C = D_S5 // GROUP_C
P_C = 64
D_FF = 4 * D_MODEL

kernel_name = "hybrid_sgu_rglru_s5_decoder_step"


def rmsnorm(x, g):
    xf = x.astype(jnp.float32)
    y = xf * lax.rsqrt(jnp.mean(xf * xf, axis=-1, keepdims=True) + EPS)
    return (y * g.astype(jnp.float32)).astype(x.dtype)


def chunk_sgu(h, w_in, sgu_g, w_s, b_s, w_out):
    bsz, T, _ = h.shape
    u, v = jnp.split(jax.nn.gelu(h @ w_in), 2, axis=-1)
    v = rmsnorm(v, sgu_g)
    L = min(T, CHUNK)
    nc = T // L
    mask = jnp.tril(jnp.ones((L, L), dtype=bool))
    w = jnp.where(mask, w_s[:, :L, :L], 0.0)
    vc = v.reshape(bsz, nc, L, HEADS_A, HD_A)
    mixed = jnp.einsum('gts,bcsgd->bctgd', w, vc) + b_s[:, :L].T[None, None, :, :, None]
    y = u * mixed.reshape(bsz, T, D_SGU)
    return y @ w_out, v


def rglru_block(h, conv_buf, h0, w_in, conv_w, conv_b, w_a, b_a, w_x, b_x, lam, w_out):
    bsz, T, _ = h.shape
    gate, xb = jnp.split(h @ w_in, 2, axis=-1)
    gate = jax.nn.gelu(gate)
    x_ext = jnp.concatenate([conv_buf.astype(xb.dtype), xb], axis=1)
    xc = conv_b + sum(x_ext[:, k:k + T] * conv_w[k] for k in range(CONV_W))
    new_buf = x_ext[:, T:]
    xh = xc.reshape(bsz, T, HEADS_B, HD_B)
    r = jax.nn.sigmoid(jnp.einsum('bthi,hij->bthj', xh, w_a).reshape(bsz, T, D_RNN) + b_a)
    i = jax.nn.sigmoid(jnp.einsum('bthi,hij->bthj', xh, w_x).reshape(bsz, T, D_RNN) + b_x)
    log_a = -LRU_C * r.astype(jnp.float32) * jax.nn.softplus(-lam.astype(jnp.float32))
    a = jnp.exp(log_a)
    mult = jnp.sqrt(jnp.maximum(-jnp.expm1(2.0 * log_a), 0.0))
    bx = mult * (i * xc).astype(jnp.float32)
    bx = bx.at[:, 0].add(a[:, 0] * h0.astype(jnp.float32))

    def comb(left, right):
        a1, b1 = left
        a2, b2 = right
        return a1 * a2, a2 * b1 + b2

    _, hs = lax.associative_scan(comb, (a, bx), axis=1)
    y = (hs.astype(h.dtype) * gate) @ w_out
    return y, new_buf, hs[:, -1].astype(h0.dtype)


def s5_block(h, s_re, s_im, w_in, lam_re, lam_im, log_dt, b_re, b_im, c_re, c_im, d_skip, w_glu):
    f32 = jnp.float32
    bsz, T, _ = h.shape
    u = h @ w_in
    dt = jnp.exp(log_dt.astype(f32))[:, None]
    lr, li = lam_re.astype(f32), lam_im.astype(f32)
    mag = jnp.exp(lr * dt)
    ab_re, ab_im = mag * jnp.cos(li * dt), mag * jnp.sin(li * dt)
    zr, zi = ab_re - 1.0, ab_im
    den = lr * lr + li * li
    q_re = (zr * lr + zi * li) / den
    q_im = (zi * lr - zr * li) / den
    br, bi = b_re.astype(f32), b_im.astype(f32)
    bb_re = q_re[..., None] * br - q_im[..., None] * bi
    bb_im = q_re[..., None] * bi + q_im[..., None] * br
    cr, ci = c_re.astype(f32), c_im.astype(f32)
    L = min(T, CHUNK)
    nc = T // L
    uc = u.astype(f32).reshape(bsz, nc, L, G_C, GROUP_C).transpose(1, 0, 2, 3, 4)

    def comb(left, right):
        ar1, ai1, br1, bi1 = left
        ar2, ai2, br2, bi2 = right
        return (ar1 * ar2 - ai1 * ai2, ar1 * ai2 + ai1 * ar2,
                ar2 * br1 - ai2 * bi1 + br2, ar2 * bi1 + ai2 * br1 + bi2)

    def step(carry, u_blk):
        x_re, x_im = carry
        bu_re = jnp.einsum('blgh,gph->blgp', u_blk, bb_re)
        bu_im = jnp.einsum('blgh,gph->blgp', u_blk, bb_im)
        bu_re = bu_re.at[:, 0].add(ab_re * x_re - ab_im * x_im)
        bu_im = bu_im.at[:, 0].add(ab_re * x_im + ab_im * x_re)
        a_re = jnp.broadcast_to(ab_re, bu_re.shape)
        a_im = jnp.broadcast_to(ab_im, bu_im.shape)
        _, _, xs_re, xs_im = lax.associative_scan(comb, (a_re, a_im, bu_re, bu_im), axis=1)
        y = jnp.einsum('blgp,ghp->blgh', xs_re, cr) - jnp.einsum('blgp,ghp->blgh', xs_im, ci)
        return (xs_re[:, -1], xs_im[:, -1]), y

    (fr, fi), ys = lax.scan(step, (s_re.astype(f32), s_im.astype(f32)), uc)
    y = ys.transpose(1, 0, 2, 3, 4).reshape(bsz, T, D_S5) + d_skip.astype(f32) * u.astype(f32)
    g = jax.nn.gelu(y).astype(h.dtype)
    o_a, o_b = jnp.split(g @ w_glu, 2, axis=-1)
    return o_a * jax.nn.sigmoid(o_b), fr.astype(s_re.dtype), fi.astype(s_im.dtype)


def sqrelu_ffn(h, w1, w2):
    return jnp.square(jax.nn.relu(h @ w1)) @ w2


def trunk(x, conv0, h0, sre0, sim0, p, keep_chunk_v):
    vs, convs, hs, sres, sims = [], [], [], [], []
    for layer in range(DEPTH):
        j = layer // N_MIXERS
        kind = layer % N_MIXERS
        h = rmsnorm(x, p['norm_mix'][layer])
        if kind == 0:
            out, v = chunk_sgu(h, p['w_in_a'][j], p['sgu_g'][j], p['w_s'][j], p['b_s'][j], p['w_out_a'][j])
            if keep_chunk_v:
                vs.append(v)
        elif kind == 1:
            out, cb, hl = rglru_block(h, conv0[j], h0[j], p['w_in_b'][j], p['conv_w'][j], p['conv_b'][j],
                                      p['w_a'][j], p['b_a'][j], p['w_x'][j], p['b_x'][j], p['lam'][j],
                                      p['w_out_b'][j])
            convs.append(cb)
            hs.append(hl)
        else:
            out, fr, fi = s5_block(h, sre0[j], sim0[j], p['w_in_c'][j], p['lam_re'][j], p['lam_im'][j],
                                   p['log_dt'][j], p['b_re'][j], p['b_im'][j], p['c_re'][j], p['c_im'][j],
                                   p['d_skip'][j], p['w_glu'][j])
            sres.append(fr)
            sims.append(fi)
        x = x + out.astype(x.dtype)
        x = x + sqrelu_ffn(rmsnorm(x, p['norm_ffn'][layer]), p['w_ff1'][layer], p['w_ff2'][layer]).astype(x.dtype)
    v_out = jnp.stack(vs) if keep_chunk_v else None
    return rmsnorm(x, p['norm_f']), v_out, jnp.stack(convs), jnp.stack(hs), jnp.stack(sres), jnp.stack(sims)


def setup_inputs(seed: int = 0) -> dict:
    key = jax.random.key(seed)
    ks = list(jax.random.split(key, 40))
    f32 = jnp.float32

    def nrm(idx, shape, scale):
        return jax.random.normal(ks[idx], shape, f32) * scale

    u_lam = jax.random.uniform(ks[20], (N_B, D_RNN), f32, minval=0.9, maxval=0.999)
    s_lam = u_lam ** (1.0 / LRU_C)
    lam = jnp.log(s_lam) - jnp.log1p(-s_lam)
    lam_im = jnp.broadcast_to(jnp.pi * jnp.arange(P_C, dtype=f32), (N_C, G_C, P_C)) + nrm(25, (N_C, G_C, P_C), 0.01)
    log_dt = jax.random.uniform(ks[26], (N_C, G_C), f32, minval=math.log(1e-3), maxval=math.log(1e-1))
    return {
        'x_prompt': nrm(0, (BATCH, SEQ, D_MODEL), 1.0),
        'x_sample': nrm(1, (DEC_BATCH, DEC_SEQ, D_MODEL), 1.0),
        'state_rglru_conv': nrm(2, (N_B, DEC_BATCH, CONV_W - 1, D_RNN), 1.0),
        'state_rglru_h': nrm(3, (N_B, DEC_BATCH, D_RNN), 0.5),
        'state_s5_re': nrm(4, (N_C, DEC_BATCH, G_C, P_C), 0.5),
        'state_s5_im': nrm(5, (N_C, DEC_BATCH, G_C, P_C), 0.5),
        'norm_mix': 1.0 + nrm(6, (DEPTH, D_MODEL), 0.01),
        'norm_ffn': 1.0 + nrm(7, (DEPTH, D_MODEL), 0.01),
        'norm_f': 1.0 + nrm(8, (D_MODEL,), 0.01),
        'w_ff1': nrm(9, (DEPTH, D_MODEL, D_FF), D_MODEL ** -0.5),
        'w_ff2': nrm(10, (DEPTH, D_FF, D_MODEL), D_FF ** -0.5),
        'w_in_a': nrm(11, (N_A, D_MODEL, 2 * D_SGU), D_MODEL ** -0.5),
        'sgu_g': 1.0 + nrm(12, (N_A, D_SGU), 0.01),
        'w_s': nrm(13, (N_A, HEADS_A, CHUNK, CHUNK), CHUNK ** -0.5),
        'b_s': 1.0 + nrm(14, (N_A, HEADS_A, CHUNK), 0.01),
        'w_out_a': nrm(15, (N_A, D_SGU, D_MODEL), D_SGU ** -0.5),
        'w_in_b': nrm(16, (N_B, D_MODEL, 2 * D_RNN), D_MODEL ** -0.5),
        'conv_w': nrm(17, (N_B, CONV_W, D_RNN), CONV_W ** -0.5),
        'conv_b': nrm(18, (N_B, D_RNN), 0.01),
        'w_a': nrm(19, (N_B, HEADS_B, HD_B, HD_B), HD_B ** -0.5),
        'b_a': nrm(21, (N_B, D_RNN), 0.01),
        'w_x': nrm(22, (N_B, HEADS_B, HD_B, HD_B), HD_B ** -0.5),
        'b_x': nrm(23, (N_B, D_RNN), 0.01),
        'lam': lam,
        'w_out_b': nrm(24, (N_B, D_RNN, D_MODEL), D_RNN ** -0.5),
        'w_in_c': nrm(27, (N_C, D_MODEL, D_S5), D_MODEL ** -0.5),
        'lam_re': -0.5 + nrm(28, (N_C, G_C, P_C), 0.01),
        'lam_im': lam_im,
        'log_dt': log_dt,
        'b_re': nrm(29, (N_C, G_C, P_C, GROUP_C), (2.0 * GROUP_C) ** -0.5),
        'b_im': nrm(30, (N_C, G_C, P_C, GROUP_C), (2.0 * GROUP_C) ** -0.5),
        'c_re': nrm(31, (N_C, G_C, GROUP_C, P_C), (2.0 * P_C) ** -0.5),
        'c_im': nrm(32, (N_C, G_C, GROUP_C, P_C), (2.0 * P_C) ** -0.5),
        'd_skip': nrm(33, (N_C, D_S5), 0.5),
        'w_glu': nrm(34, (N_C, D_S5, 2 * D_MODEL), D_S5 ** -0.5),
    }


def reference(x_prompt, x_sample, state_rglru_conv, state_rglru_h, state_s5_re, state_s5_im,
              norm_mix, norm_ffn, norm_f, w_ff1, w_ff2,
              w_in_a, sgu_g, w_s, b_s, w_out_a,
              w_in_b, conv_w, conv_b, w_a, b_a, w_x, b_x, lam, w_out_b,
              w_in_c, lam_re, lam_im, log_dt, b_re, b_im, c_re, c_im, d_skip, w_glu):
    p = dict(norm_mix=norm_mix, norm_ffn=norm_ffn, norm_f=norm_f, w_ff1=w_ff1, w_ff2=w_ff2,
             w_in_a=w_in_a, sgu_g=sgu_g, w_s=w_s, b_s=b_s, w_out_a=w_out_a,
             w_in_b=w_in_b, conv_w=conv_w, conv_b=conv_b, w_a=w_a, b_a=b_a, w_x=w_x, b_x=b_x,
             lam=lam, w_out_b=w_out_b,
             w_in_c=w_in_c, lam_re=lam_re, lam_im=lam_im, log_dt=log_dt, b_re=b_re, b_im=b_im,
             c_re=c_re, c_im=c_im, d_skip=d_skip, w_glu=w_glu)
    bp = x_prompt.shape[0]
    dt_s = state_rglru_h.dtype
    conv0_p = jnp.zeros((N_B, bp, CONV_W - 1, D_RNN), dt_s)
    h0_p = jnp.zeros((N_B, bp, D_RNN), dt_s)
    sre0_p = jnp.zeros((N_C, bp, G_C, P_C), state_s5_re.dtype)
    sim0_p = jnp.zeros((N_C, bp, G_C, P_C), state_s5_im.dtype)
    y_prompt, _, conv_p, h_p, sre_p, sim_p = trunk(x_prompt, conv0_p, h0_p, sre0_p, sim0_p, p, False)
    y_sample, v_s, conv_s, h_s, sre_s, sim_s = trunk(x_sample, state_rglru_conv, state_rglru_h,
                                                    state_s5_re, state_s5_im, p, True)
    return (y_prompt, y_sample, v_s, conv_p, h_p, conv_s, h_s, sre_p, sim_p, sre_s, sim_s)
```

```cpp
#include <hip/hip_runtime.h>
#include <cstdio>
#include <cstdint>

constexpr int MP = 16384, MS = 512, M = MP + MS, D = 1024, FF = 4096;
constexpr int SEQ = 2048, BATCH = 8, DEC_BATCH = 128, DEC_SEQ = 4;
constexpr float EPS = 1e-6f;
typedef unsigned short bf16;

__device__ __forceinline__ unsigned f2bf(float f) { unsigned u = __builtin_bit_cast(unsigned, f); return (u + 0x7fffu + ((u >> 16) & 1u)) >> 16; }
__device__ __forceinline__ float bf2f(unsigned short h) { return __builtin_bit_cast(float, (unsigned)h << 16); }
__device__ __forceinline__ float gelu_tanh(float x) { const float u = 0.7978845608028654f * (x + 0.044715f * x * x * x); return 0.5f * x * (1.f + tanhf(u)); }
__device__ __forceinline__ float sigmoidf_(float x) { return 1.f / (1.f + expf(-x)); }
__device__ __forceinline__ float wave_sum(float v) {
#pragma unroll
    for (int o = 1; o < 64; o <<= 1) v += __shfl_xor(v, o);
    return v;
}

constexpr size_t O_YP = 0, O_YS = (size_t)MP * D, O_VS = O_YS + (size_t)MS * D, O_CONVP = O_VS + 2 * (size_t)MS * D, O_HP = O_CONVP + 8 * 3 * 1024,
                 O_CONVS = O_HP + 8 * 1024, O_HS = O_CONVS + 128 * 3 * 1024, O_SREP = O_HS + 128 * 1024, O_SIMP = O_SREP + 8 * 4096, O_SRES = O_SIMP + 8 * 4096,
                 O_SIMS = O_SRES + 128 * 4096, O_END = O_SIMS + 128 * 4096;

constexpr size_t MiB = 1u << 20;
constexpr size_t WS_XN = 1 * MiB;
constexpr size_t WS_T = 34 * MiB;
constexpr size_t WS_MISC = 166 * MiB;
constexpr size_t WS_RSV = WS_MISC;
constexpr size_t WS_S5AB = WS_MISC + 1 * MiB;
constexpr size_t WS_S5BB = WS_MISC + 2 * MiB;
constexpr size_t WS_HST = WS_MISC + 3 * MiB;
constexpr size_t WS_S5ST = WS_MISC + 4 * MiB;
constexpr size_t WS_CHA = WS_MISC + 8 * MiB;
constexpr size_t WS_CHB = WS_MISC + 12 * MiB;
constexpr size_t WS_XSR = WS_MISC + 16 * MiB;
constexpr size_t WS_XSI = WS_MISC + 32 * MiB;

__global__ void k_copy_x(const float* __restrict__ xp, const float* __restrict__ xs, float* __restrict__ X) {
    const size_t i = (size_t)blockIdx.x * 256 + threadIdx.x; const size_t np = (size_t)MP * D / 4;
    if (i < (size_t)M * D / 4) ((float4*)X)[i] = i < np ? ((const float4*)xp)[i] : ((const float4*)xs)[i - np];
}
__global__ void k_rmsnorm_bf16(const float* __restrict__ X, const float* __restrict__ g, bf16* __restrict__ XN) {
    const int row = blockIdx.x * 4 + (threadIdx.x >> 6), lane = threadIdx.x & 63; if (row >= M) return;
    const float* x = X + (size_t)row * D; float v[16]; float s = 0.f;
#pragma unroll
    for (int j = 0; j < 16; ++j) { v[j] = x[lane + 64 * j]; s += v[j] * v[j]; }
    s = wave_sum(s); const float rs = rsqrtf(s * (1.f / D) + EPS);
#pragma unroll
    for (int j = 0; j < 16; ++j) XN[(size_t)row * D + lane + 64 * j] = (bf16)f2bf(v[j] * rs * g[lane + 64 * j]);
}
__global__ void k_rmsnorm_final(float* __restrict__ X, const float* __restrict__ g) {
    const int row = blockIdx.x * 4 + (threadIdx.x >> 6), lane = threadIdx.x & 63; if (row >= M) return;
    float* x = X + (size_t)row * D; float v[16]; float s = 0.f;
#pragma unroll
    for (int j = 0; j < 16; ++j) { v[j] = x[lane + 64 * j]; s += v[j] * v[j]; }
    s = wave_sum(s); const float rs = rsqrtf(s * (1.f / D) + EPS);
#pragma unroll
    for (int j = 0; j < 16; ++j) x[lane + 64 * j] = v[j] * rs * g[lane + 64 * j];
}

enum { EPI_GELU_BF16 = 0, EPI_SQRELU_BF16 = 1, EPI_RESID = 2, EPI_RGLRU = 3, EPI_F32 = 4 };
struct EpiP { bf16* ob; float* of; int ldo; int pad; };
template <int EPI>
__global__ void __launch_bounds__(256) k_gemm_naive(const bf16* __restrict__ A, int lda, const float* __restrict__ W, int ldw, int K, EpiP P) {
    __shared__ __attribute__((aligned(16))) float As[16][64 + 4]; __shared__ __attribute__((aligned(16))) float Ws[16][128];
    const int tid = threadIdx.x, ty = tid >> 5, tx = tid & 31; const int m0 = blockIdx.y * 64, n0 = blockIdx.x * 128;
    float acc[8][4];
#pragma unroll
    for (int i = 0; i < 8; ++i)
#pragma unroll
        for (int j = 0; j < 4; ++j) acc[i][j] = 0.f;
    for (int k0 = 0; k0 < K; k0 += 16) {
        { const int m = tid >> 2, kq = (tid & 3) * 4; const bf16* ap = A + (size_t)(m0 + m) * lda + k0 + kq;
          const unsigned long long w = *(const unsigned long long*)ap;
          As[kq + 0][m] = bf2f((unsigned short)(w & 0xffff)); As[kq + 1][m] = bf2f((unsigned short)((w >> 16) & 0xffff));
          As[kq + 2][m] = bf2f((unsigned short)((w >> 32) & 0xffff)); As[kq + 3][m] = bf2f((unsigned short)(w >> 48)); }
#pragma unroll
        for (int h = 0; h < 2; ++h) { const int kk = (tid >> 5) + 8 * h, c4 = (tid & 31) * 4;
          *(float4*)&Ws[kk][c4] = *(const float4*)(W + (size_t)(k0 + kk) * ldw + n0 + c4); }
        __syncthreads();
#pragma unroll
        for (int k = 0; k < 16; ++k) {
            const float4 a0 = *(const float4*)&As[k][ty * 8], a1 = *(const float4*)&As[k][ty * 8 + 4], w = *(const float4*)&Ws[k][tx * 4];
            const float a[8] = {a0.x, a0.y, a0.z, a0.w, a1.x, a1.y, a1.z, a1.w}; const float ww[4] = {w.x, w.y, w.z, w.w};
#pragma unroll
            for (int i = 0; i < 8; ++i)
#pragma unroll
                for (int j = 0; j < 4; ++j) acc[i][j] += a[i] * ww[j];
        }
        __syncthreads();
    }
#pragma unroll
    for (int i = 0; i < 8; ++i)
#pragma unroll
        for (int j = 0; j < 4; ++j) {
            const int row = m0 + ty * 8 + i, col = n0 + tx * 4 + j; const float v = acc[i][j];
            if (EPI == EPI_GELU_BF16) P.ob[(size_t)row * P.ldo + col] = (bf16)f2bf(gelu_tanh(v));
            else if (EPI == EPI_SQRELU_BF16) { const float r = v > 0.f ? v : 0.f; P.ob[(size_t)row * P.ldo + col] = (bf16)f2bf(r * r); }
            else if (EPI == EPI_RESID) P.of[(size_t)row * P.ldo + col] += v;
            else if (EPI == EPI_RGLRU) { if (col < 1024) P.ob[(size_t)row * 1024 + col] = (bf16)f2bf(gelu_tanh(v)); else P.of[(size_t)row * 1024 + col - 1024] = v; }
            else P.of[(size_t)row * P.ldo + col] = v;
        }
}

__global__ void k_vstat(const bf16* __restrict__ UV, const float* __restrict__ sg, float* __restrict__ rsv, float* __restrict__ vs_out) {
    const int row = blockIdx.x * 4 + (threadIdx.x >> 6), lane = threadIdx.x & 63; if (row >= M) return;
    const bf16* v = UV + (size_t)row * 2048 + 1024; float x[16]; float s = 0.f;
#pragma unroll
    for (int j = 0; j < 16; ++j) { x[j] = bf2f(v[lane + 64 * j]); s += x[j] * x[j]; }
    s = wave_sum(s); const float rs = rsqrtf(s * (1.f / 1024) + EPS);
    if (lane == 0) rsv[row] = rs;
    if (row >= MP) {
#pragma unroll
        for (int j = 0; j < 16; ++j) vs_out[(size_t)(row - MP) * 1024 + lane + 64 * j] = x[j] * rs * sg[lane + 64 * j];
    }
}
__global__ void k_sgu_mix(const bf16* __restrict__ UV, const float* __restrict__ rsv, const float* __restrict__ sg, const float* __restrict__ ws_, const float* __restrict__ bs_, bf16* __restrict__ Y) {
    const int row = blockIdx.x, tl = row < MP ? (row & 127) : ((row - MP) & 3), base = row - tl;
    for (int d = threadIdx.x; d < 1024; d += 256) {
        const int g = d >> 7; const float* w = ws_ + ((size_t)g * 128 + tl) * 128; float s = 0.f;
        for (int sl = 0; sl <= tl; ++sl) s += w[sl] * bf2f(UV[(size_t)(base + sl) * 2048 + 1024 + d]) * rsv[base + sl];
        const float mixed = s * sg[d] + bs_[g * 128 + tl];
        Y[(size_t)row * 1024 + d] = (bf16)f2bf(bf2f(UV[(size_t)row * 2048 + d]) * mixed);
    }
}

__global__ void k_rglru_gates(const float* __restrict__ XB, const float* __restrict__ cstate  , const float* __restrict__ cw, const float* __restrict__ cb,
                              const float* __restrict__ wa, const float* __restrict__ ba, const float* __restrict__ wx, const float* __restrict__ bxb, const float* __restrict__ lam,
                              float* __restrict__ Ac, float* __restrict__ Bc, int base, int T, int t0, int tc) {
    const int j = threadIdx.x + 256 * (blockIdx.x & 3), st = blockIdx.x >> 2, s = st / tc, tt = st % tc, t = t0 + tt;
    const int h = j >> 6, jj = j & 63; float rp = 0.f, ip = 0.f, xcj = 0.f;
    for (int i = 0; i < 64; ++i) {
        const int c = h * 64 + i; float xc = cb[c];
#pragma unroll
        for (int k = 0; k < 4; ++k) { const int tau = t + k - 3; const float xe = tau >= 0 ? XB[(size_t)(base + s * T + tau) * 1024 + c] : (cstate ? cstate[((size_t)s * 3 + (tau + 3)) * 1024 + c] : 0.f); xc += xe * cw[k * 1024 + c]; }
        rp += xc * wa[((size_t)h * 64 + i) * 64 + jj]; ip += xc * wx[((size_t)h * 64 + i) * 64 + jj]; if (i == jj) xcj = xc;
    }
    const float r = sigmoidf_(rp + ba[j]), ig = sigmoidf_(ip + bxb[j]);
    const float sp = log1pf(expf(-lam[j]));
    const float log_a = -8.0f * r * sp, a = expf(log_a), mult = sqrtf(fmaxf(-expm1f(2.f * log_a), 0.f));
    Ac[((size_t)s * tc + tt) * 1024 + j] = a; Bc[((size_t)s * tc + tt) * 1024 + j] = mult * (ig * xcj);
}
__global__ void k_rglru_scan(const float* __restrict__ Ac, const float* __restrict__ Bc, float* __restrict__ hst, const float* __restrict__ hinit, int first, const bf16* __restrict__ G, bf16* __restrict__ Y, int base, int T, int t0, int tc) {
    const int idx = blockIdx.x * 256 + threadIdx.x, s = idx >> 10, j = idx & 1023;
    float h = first ? (hinit ? hinit[(size_t)s * 1024 + j] : 0.f) : hst[(size_t)s * 1024 + j];
    for (int tt = 0; tt < tc; ++tt) { const size_t ci = ((size_t)s * tc + tt) * 1024 + j; h = Ac[ci] * h + Bc[ci]; const size_t row = (size_t)base + (size_t)s * T + t0 + tt;
        Y[row * 1024 + j] = (bf16)f2bf(h * bf2f(G[row * 1024 + j])); }
    hst[(size_t)s * 1024 + j] = h;
}
__global__ void k_rglru_out(const float* __restrict__ XB, const float* __restrict__ hst, float* __restrict__ conv_out, float* __restrict__ h_out, int base, int T, int nseq) {
    const int idx = blockIdx.x * 256 + threadIdx.x; if (idx >= nseq * 1024) return; const int s = idx >> 10, j = idx & 1023;
    h_out[idx] = hst[idx];
    for (int r = 0; r < 3; ++r) conv_out[((size_t)s * 3 + r) * 1024 + j] = XB[(size_t)(base + s * T + T - 3 + r) * 1024 + j];
}

__global__ void k_s5_prep(const float* __restrict__ lre, const float* __restrict__ lim, const float* __restrict__ ldt, const float* __restrict__ bre, const float* __restrict__ bim, float* __restrict__ AB, float* __restrict__ BB) {
    const int idx = blockIdx.x * 256 + threadIdx.x; if (idx >= 4096) return; const int g = idx >> 6;
    const float dt = expf(ldt[g]), lr = lre[idx], li = lim[idx], mag = expf(lr * dt), ar = mag * cosf(li * dt), ai = mag * sinf(li * dt);
    AB[idx * 2] = ar; AB[idx * 2 + 1] = ai;
    const float zr = ar - 1.f, zi = ai, den = lr * lr + li * li, qr = (zr * lr + zi * li) / den, qi = (zi * lr - zr * li) / den;
    for (int h = 0; h < 16; ++h) { const float br = bre[(size_t)idx * 16 + h], bi = bim[(size_t)idx * 16 + h]; BB[((size_t)idx * 16 + h) * 2] = qr * br - qi * bi; BB[((size_t)idx * 16 + h) * 2 + 1] = qr * bi + qi * br; }
}
__global__ void k_s5_scan(const float* __restrict__ U, const float* __restrict__ AB, const float* __restrict__ BB, float* __restrict__ st  , const float* __restrict__ ire, const float* __restrict__ iim, int first,
                          float* __restrict__ XR, float* __restrict__ XI, int base, int T, int t0, int tc, int nseq) {
    const int idx = blockIdx.x * 256 + threadIdx.x, s = idx >> 12, gp = idx & 4095, g = gp >> 6;
    float xr = first ? (ire ? ire[(size_t)s * 4096 + gp] : 0.f) : st[(size_t)s * 4096 + gp];
    float xi = first ? (iim ? iim[(size_t)s * 4096 + gp] : 0.f) : st[(size_t)(nseq + s) * 4096 + gp];
    const float ar = AB[gp * 2], ai = AB[gp * 2 + 1]; float br[16], bi[16];
#pragma unroll
    for (int h = 0; h < 16; ++h) { br[h] = BB[((size_t)gp * 16 + h) * 2]; bi[h] = BB[((size_t)gp * 16 + h) * 2 + 1]; }
    for (int tt = 0; tt < tc; ++tt) {
        const float* u = U + (size_t)(base + s * T + t0 + tt) * 1024 + g * 16; float bur = 0.f, bui = 0.f;
#pragma unroll
        for (int h = 0; h < 16; ++h) { bur += u[h] * br[h]; bui += u[h] * bi[h]; }
        const float nr = ar * xr - ai * xi + bur, ni = ar * xi + ai * xr + bui; xr = nr; xi = ni;
        XR[((size_t)s * tc + tt) * 4096 + gp] = xr; XI[((size_t)s * tc + tt) * 4096 + gp] = xi;
    }
    st[(size_t)s * 4096 + gp] = xr; st[(size_t)(nseq + s) * 4096 + gp] = xi;
}
__global__ void k_s5_proj(const float* __restrict__ XR, const float* __restrict__ XI, const float* __restrict__ cre, const float* __restrict__ cim, const float* __restrict__ dsk, const float* __restrict__ U, bf16* __restrict__ Gs, int base, int T, int t0, int tc) {
    const int ch = threadIdx.x + 256 * (blockIdx.x & 3), st = blockIdx.x >> 2, s = st / tc, tt = st % tc, g = ch >> 4, h = ch & 15;
    const float* xr = XR + ((size_t)s * tc + tt) * 4096 + g * 64; const float* xi = XI + ((size_t)s * tc + tt) * 4096 + g * 64;
    const float* cr = cre + ((size_t)g * 16 + h) * 64; const float* ci = cim + ((size_t)g * 16 + h) * 64; float y = 0.f;
    for (int p = 0; p < 64; ++p) y += xr[p] * cr[p] - xi[p] * ci[p];
    const size_t row = (size_t)base + (size_t)s * T + t0 + tt; y += dsk[ch] * U[row * 1024 + ch];
    Gs[row * 1024 + ch] = (bf16)f2bf(gelu_tanh(y));
}
__global__ void k_s5_out(const float* __restrict__ st, float* __restrict__ ore, float* __restrict__ oim, int nseq) {
    const int idx = blockIdx.x * 256 + threadIdx.x; if (idx >= nseq * 4096) return; ore[idx] = st[idx]; oim[idx] = st[(size_t)nseq * 4096 + idx];
}
__global__ void k_glu(const float* __restrict__ O, float* __restrict__ X) {
    const size_t i = (size_t)blockIdx.x * 256 + threadIdx.x; if (i >= (size_t)M * 1024) return; const size_t row = i >> 10, c = i & 1023;
    X[i] += O[row * 2048 + c] * sigmoidf_(O[row * 2048 + 1024 + c]);
}

extern "C" void kernel_launch(void* const* d_in, const int* in_sizes, int n_in, void* d_out, int out_size, void* d_ws, size_t ws_size, hipStream_t stream) {
    const float* in[35]; for (int i = 0; i < 35; ++i) in[i] = (const float*)d_in[i];
    float* out = (float*)d_out; unsigned char* ws = (unsigned char*)d_ws; float* X = out;
    bf16* XN = (bf16*)(ws + WS_XN); unsigned char* T = ws + WS_T;
    float* rsv = (float*)(ws + WS_RSV); float* AB = (float*)(ws + WS_S5AB); float* BB = (float*)(ws + WS_S5BB); float* hst = (float*)(ws + WS_HST); float* s5st = (float*)(ws + WS_S5ST);
    float* chA = (float*)(ws + WS_CHA); float* chB = (float*)(ws + WS_CHB); float* XSR = (float*)(ws + WS_XSR); float* XSI = (float*)(ws + WS_XSI);
    k_copy_x<<<(M * D / 4 + 255) / 256, 256, 0, stream>>>(in[0], in[1], X);
    for (int l = 0; l < 4; ++l) {
        const int kind = l % 3, j = l / 3;
        k_rmsnorm_bf16<<<M / 4, 256, 0, stream>>>(X, in[6] + l * D, XN);
        if (kind == 0) {
            bf16* UV = (bf16*)T;
            k_gemm_naive<EPI_GELU_BF16><<<dim3(2048 / 128, M / 64), 256, 0, stream>>>(XN, D, in[11] + (size_t)j * D * 2048, 2048, D, EpiP{UV, nullptr, 2048});
            k_vstat<<<M / 4, 256, 0, stream>>>(UV, in[12] + j * 1024, rsv, out + O_VS + (size_t)j * MS * 1024);
            k_sgu_mix<<<M, 256, 0, stream>>>(UV, rsv, in[12] + j * 1024, in[13] + (size_t)j * 8 * 128 * 128, in[14] + j * 8 * 128, XN);
            k_gemm_naive<EPI_RESID><<<dim3(D / 128, M / 64), 256, 0, stream>>>(XN, D, in[15] + (size_t)j * D * D, D, D, EpiP{nullptr, X, D});
        } else if (kind == 1) {
            bf16* G = (bf16*)T; float* XB = (float*)(T + 33 * MiB);
            k_gemm_naive<EPI_RGLRU><<<dim3(2048 / 128, M / 64), 256, 0, stream>>>(XN, D, in[16], 2048, D, EpiP{G, XB, 1024});
            for (int grp = 0; grp < 2; ++grp) {
                const int base = grp ? MP : 0, Tq = grp ? 4 : 2048, nseq = grp ? 128 : 8, tc = grp ? 4 : 128;
                for (int t0 = 0; t0 < Tq; t0 += tc) {
                    k_rglru_gates<<<nseq * tc * 4, 256, 0, stream>>>(XB, grp ? in[2] : nullptr, in[17], in[18], in[19], in[20], in[21], in[22], in[23], chA, chB, base, Tq, t0, tc);
                    k_rglru_scan<<<nseq * 1024 / 256, 256, 0, stream>>>(chA, chB, hst, grp ? in[3] : nullptr, t0 == 0, G, XN, base, Tq, t0, tc);
                }
                k_rglru_out<<<nseq * 1024 / 256, 256, 0, stream>>>(XB, hst, out + (grp ? O_CONVS : O_CONVP), out + (grp ? O_HS : O_HP), base, Tq, nseq);
            }
            k_gemm_naive<EPI_RESID><<<dim3(D / 128, M / 64), 256, 0, stream>>>(XN, D, in[24], D, D, EpiP{nullptr, X, D});
        } else {
            float* U = (float*)T;
            k_gemm_naive<EPI_F32><<<dim3(D / 128, M / 64), 256, 0, stream>>>(XN, D, in[25], D, D, EpiP{nullptr, U, D});
            k_s5_prep<<<16, 256, 0, stream>>>(in[26], in[27], in[28], in[29], in[30], AB, BB);
            for (int grp = 0; grp < 2; ++grp) {
                const int base = grp ? MP : 0, Tq = grp ? 4 : 2048, nseq = grp ? 128 : 8, tc = grp ? 4 : 128;
                for (int t0 = 0; t0 < Tq; t0 += tc) {
                    k_s5_scan<<<nseq * 4096 / 256, 256, 0, stream>>>(U, AB, BB, s5st, grp ? in[4] : nullptr, grp ? in[5] : nullptr, t0 == 0, XSR, XSI, base, Tq, t0, tc, nseq);
                    k_s5_proj<<<nseq * tc * 4, 256, 0, stream>>>(XSR, XSI, in[31], in[32], in[33], U, XN, base, Tq, t0, tc);
                }
                k_s5_out<<<nseq * 4096 / 256, 256, 0, stream>>>(s5st, out + (grp ? O_SRES : O_SREP), out + (grp ? O_SIMS : O_SIMP), nseq);
            }
            float* O = (float*)T;
            k_gemm_naive<EPI_F32><<<dim3(2048 / 128, M / 64), 256, 0, stream>>>(XN, D, in[34], 2048, D, EpiP{nullptr, O, 2048});
            k_glu<<<(M * 1024 + 255) / 256, 256, 0, stream>>>(O, X);
        }
        k_rmsnorm_bf16<<<M / 4, 256, 0, stream>>>(X, in[7] + l * D, XN);
        bf16* H = (bf16*)T;
        k_gemm_naive<EPI_SQRELU_BF16><<<dim3(FF / 128, M / 64), 256, 0, stream>>>(XN, D, in[9] + (size_t)l * D * FF, FF, D, EpiP{H, nullptr, FF});
        k_gemm_naive<EPI_RESID><<<dim3(D / 128, M / 64), 256, 0, stream>>>(H, FF, in[10] + (size_t)l * FF * D, D, FF, EpiP{nullptr, X, D});
    }
    k_rmsnorm_final<<<M / 4, 256, 0, stream>>>(X, in[8]);
}
```

```cpp
#include <hip/hip_runtime.h>
#include <cstdio>
#include <cstdint>

constexpr int MP = 16384, MS = 512, M = MP + MS, D = 1024, FF = 4096;
constexpr float EPS = 1e-6f;

constexpr size_t O_YP = 0, O_YS = (size_t)MP * D, O_VS = O_YS + (size_t)MS * D, O_CONVP = O_VS + 2 * (size_t)MS * D, O_HP = O_CONVP + 8 * 3 * 1024,
                 O_CONVS = O_HP + 8 * 1024, O_HS = O_CONVS + 128 * 3 * 1024, O_SREP = O_HS + 128 * 1024, O_SIMP = O_SREP + 8 * 4096, O_SRES = O_SIMP + 8 * 4096,
                 O_SIMS = O_SRES + 128 * 4096, O_END = O_SIMS + 128 * 4096;

constexpr size_t MiB = 1u << 20;
constexpr size_t WS_CTL = 0, CTL_ZERO_BYTES = 64 * 1024;
constexpr size_t WS_XN = 1 * MiB;
constexpr size_t WS_T = 34 * MiB;
constexpr size_t WS_RSV = 128 * 1024;
constexpr size_t WS_WM = 166 * MiB;
constexpr size_t WS_RGT = 167 * MiB;
constexpr size_t WS_S5T = 168 * MiB;
constexpr size_t WS_S5AB = 170 * MiB;
constexpr size_t WS_S5BB = 170 * MiB + 512 * 1024;
constexpr size_t WS_HST = 171 * MiB;
constexpr size_t WS_S5ST = 172 * MiB;
constexpr size_t WS_CHA = 176 * MiB;
constexpr size_t WS_CHB = 180 * MiB;
constexpr size_t WS_XSR = 184 * MiB;
constexpr size_t WS_XSI = 200 * MiB;
constexpr size_t WS_W_INA = 216 * MiB, WS_W_OUTA = 224 * MiB, WS_W_INB = 228 * MiB, WS_W_OUTB = 232 * MiB, WS_W_INC = 234 * MiB, WS_W_GLU = 236 * MiB,
                 WS_W_FF1 = 240 * MiB, WS_W_FF2 = 248 * MiB, WS_END = 256 * MiB;
constexpr int CW_BAR = 4096;

#define GAS __attribute__((address_space(1)))
#define LAS __attribute__((address_space(3)))
typedef unsigned short bf16;
typedef unsigned v4u __attribute__((ext_vector_type(4)));
typedef float f32x4 __attribute__((ext_vector_type(4)));
typedef short bf16x8 __attribute__((ext_vector_type(8)));
typedef GAS unsigned gu32;
typedef GAS unsigned long long gu64;
#define RLX_AGENT __ATOMIC_RELAXED, __HIP_MEMORY_SCOPE_AGENT
#define LDS_WAIT() asm volatile("s_waitcnt lgkmcnt(0)" ::: "memory")
#define VM_WAIT() asm volatile("s_waitcnt vmcnt(0)" ::: "memory")
__device__ __forceinline__ unsigned long long rt() { return __builtin_amdgcn_s_memrealtime(); }
__device__ __forceinline__ unsigned f2bf(float f) { unsigned u = __builtin_bit_cast(unsigned, f); return (u + 0x7fffu + ((u >> 16) & 1u)) >> 16; }
__device__ __forceinline__ unsigned pk2(float lo, float hi) { return f2bf(lo) | (f2bf(hi) << 16); }

#define XB_TMO      128
#define XB_XCNT(j)  (256  + 64 * (j))
#define XB_XSUB(j)  (1280 + 64 * (j))
#define XB_XGEN(j)  (2304 + 64 * (j))
#define XB_TOP      3328
#define XB_TOPGEN   3392
#define XCD_BAR_WORDS 3456
#define XB_SPIN_CAP (1u << 18)

__device__ __forceinline__ unsigned xb_ld(unsigned* p)              { return __hip_atomic_load(p, __ATOMIC_RELAXED, __HIP_MEMORY_SCOPE_AGENT); }
__device__ __forceinline__ unsigned xb_add(unsigned* p, unsigned v) { return __hip_atomic_fetch_add(p, v, __ATOMIC_RELAXED, __HIP_MEMORY_SCOPE_AGENT); }
__device__ __forceinline__ unsigned xb_xcc_id() { return (unsigned)__builtin_amdgcn_s_getreg((3 << 11) | 20) & 0xFu; }
#define XB_SPIN(cond, bar) do { unsigned _sp = 0; while (cond) { __builtin_amdgcn_s_sleep(1); \
    if ((++_sp & 255u) == 0u) { if (xb_ld(&(bar)[XB_TMO])) break; if (_sp > XB_SPIN_CAP) { atomicAdd(&(bar)[XB_TMO], 1u); break; } } } } while (0)

struct XcdBarrier {
    unsigned* bar; unsigned x;
    volatile LAS unsigned* st;
};

__device__ __forceinline__ XcdBarrier xcd_barrier_post(unsigned* bar, volatile LAS unsigned* st) {
    XcdBarrier b; b.bar = bar; b.x = xb_xcc_id(); b.st = st;
    if (threadIdx.x == 0) (void)xb_add(&bar[XB_XCNT(b.x)], 1u);
    return b;
}
__device__ __forceinline__ void xcd_barrier_complete(unsigned* bar, unsigned x, unsigned& nloc, unsigned& nx) {
    const unsigned G = gridDim.x * gridDim.y * gridDim.z;
    unsigned sum, cnt, mine, sp = 0u;
    for (;;) {
        sum = 0u; cnt = 0u; mine = 0u;
#pragma unroll
        for (unsigned j = 0; j < 16; ++j) { const unsigned c = xb_ld(&bar[XB_XCNT(j)]); sum += c; cnt += (c > 0u) ? 1u : 0u; mine = (j == x) ? c : mine; }
        if (sum == G) break;
        __builtin_amdgcn_s_sleep(1);
        if ((++sp & 255u) == 0u) { if (xb_ld(&bar[XB_TMO])) break; if (sp > XB_SPIN_CAP) { atomicAdd(&bar[XB_TMO], 1u); break; } }
    }
    nloc = mine > 0u ? mine : 1u; nx = cnt > 0u ? cnt : 1u;
}

__device__ __forceinline__ void xcd_barrier(const XcdBarrier& b) {
    asm volatile("s_waitcnt vmcnt(0)" ::: "memory");
    __syncthreads();
    if (threadIdx.x == 0) {
        unsigned* bar = b.bar;
        __builtin_amdgcn_s_waitcnt(0);
        unsigned nloc = b.st[0], nx = b.st[1];
        if (nloc == 0u) { xcd_barrier_complete(bar, b.x, nloc, nx); b.st[0] = nloc; b.st[1] = nx; }
        const unsigned old = xb_add(&bar[XB_XSUB(b.x)], 1u);
        const unsigned gen = old / nloc;
        if (old + 1u == (gen + 1u) * nloc) {
            __builtin_amdgcn_fence(__ATOMIC_RELEASE, "agent");
            asm volatile("s_waitcnt vmcnt(0)" ::: "memory");
            const unsigned og = xb_add(&bar[XB_TOP], 1u);
            const unsigned tg = og / nx;
            if (og + 1u == (tg + 1u) * nx) xb_add(&bar[XB_TOPGEN], 1u);
            else XB_SPIN(xb_ld(&bar[XB_TOPGEN]) == tg, bar);
            __builtin_amdgcn_fence(__ATOMIC_ACQUIRE, "agent");
            xb_add(&bar[XB_XGEN(b.x)], 1u);
            asm volatile("s_waitcnt vmcnt(0)" ::: "memory");
        } else {
            XB_SPIN(xb_ld(&bar[XB_XGEN(b.x)]) == gen, bar);
            __builtin_amdgcn_fence(__ATOMIC_ACQUIRE, "agent");
            asm volatile("s_waitcnt vmcnt(0)" ::: "memory");
        }
    }
    __syncthreads();
}
namespace pg8 {
#define PG8_LAS __attribute__((address_space(3)))
typedef unsigned short bf16_t;
typedef short bf16x8 __attribute__((ext_vector_type(8)));
typedef float f32x4 __attribute__((ext_vector_type(4)));
typedef unsigned u32x4 __attribute__((ext_vector_type(4)));
constexpr int BM = 256, BK = 64, HALF = 128, HTB = HALF * BK * 2  , STAGE_BYTES = 8 * HTB, NXCD = 8, WGM = 8;

__host__ __device__ __forceinline__ int lds_byte(int r, int c) { const int st = (r >> 4) * 2 + (c >> 5), rr = r & 15, cc = c & 31, ob = rr * 64 + cc * 2; return st * 1024 + (ob ^ (((ob >> 9) & 1) << 5)); }
__host__ __device__ __forceinline__ void stage_rc(int b, int& R, int& C) { const int st = b / 1024, sb = b % 1024, swz = sb ^ (((sb >> 9) & 1) << 5); R = (st >> 1) * 16 + swz / 64; C = (st & 1) * 32 + (swz % 64) / 2; }
__host__ __device__ __forceinline__ int perm32(int rho) { const int n = rho >> 4, i = rho & 15; return 8 * (i >> 2) + 4 * n + (i & 3); }

struct Unit { int pm, pn; };
struct Gemm { const bf16_t* A; const bf16_t* Bt; int M, N, K; };

struct StaticOrder {
    int nM, nN, nwg, G, c;
    __host__ __device__ void init(int M, int N, int G_, int c_) { nM = M / BM; nN = N / BM; nwg = nM * nN; G = G_; c = c_; }
    __host__ __device__ bool next(int i, Unit& u) const {
        const long L = (long)i * G + c; if (L >= nwg) return false;
        int wgid = (int)L; { const int q = nwg / NXCD, r = nwg % NXCD, xcd = wgid % NXCD, off = wgid / NXCD; wgid = (xcd < r ? xcd * (q + 1) : r * (q + 1) + (xcd - r) * q) + off; }
        const int nig = WGM * nN, gid = wgid / nig, fm = gid * WGM, gsz = (nM - fm) < WGM ? (nM - fm) : WGM;
        u.pm = fm + ((wgid % nig) % gsz); u.pn = (wgid % nig) / gsz; return true;
    }
    __device__ __forceinline__ void a_ready(const Unit&) const {}
    __device__ __forceinline__ void done(const Unit&) const {}
};

template <class Epi, class Sched, bool ALIGN_EPI = false, bool SP2 = false>
__device__ __forceinline__ void gemm_phase(PG8_LAS unsigned char* lds, const Gemm g, const Sched& S, const Epi& E, const int tid_in) {
    const int tid = tid_in, wid = __builtin_amdgcn_readfirstlane(tid >> 6), lane = tid & 63, wr = wid >> 2, wc = wid & 3, fr = lane & 15, fq = lane >> 4;
    const int K = g.K, nt = K / BK;
    unsigned voffA[2], voffB[2];
#pragma unroll
    for (int i = 0; i < 2; ++i) { int R, C; stage_rc(tid * 16 + i * 8192, R, C); const int Rb = Epi::PERM ? ((R & ~31) + perm32(R & 31)) : R;
        voffA[i] = (unsigned)(R * K + C) * 2u; voffB[i] = (unsigned)(Rb * K + C) * 2u; }
    const size_t kstep = (size_t)(BK * 2);
    const size_t hstep = (size_t)HALF * K * 2;
    const size_t tstep = 2 * hstep;
    const unsigned ldsw = (unsigned)wid * 1024u;
    const int aoff = lds_byte(wr * 64 + fr, fq * 8), boff = lds_byte(wc * 32 + fr, fq * 8);
#define PG8_SA(b, h) (((b) * 2 + (h)) * HTB)
#define PG8_SB(b, h) ((4 + (b) * 2 + (h)) * HTB)
#define PG8_STAGE(bufoff, gbase, voff) do { _Pragma("unroll") for (int _i = 0; _i < 2; ++_i) \
        __builtin_amdgcn_global_load_lds((const unsigned*)((const char*)(gbase) + (voff)[_i]), (PG8_LAS unsigned*)(lds + (bufoff) + ldsw + _i * 8192), 16, 0, 0); } while (0)
#define PG8_LDA(dst, b, h) do { _Pragma("unroll") for (int m = 0; m < 4; ++m) _Pragma("unroll") for (int k = 0; k < 2; ++k) dst[m][k] = *(const PG8_LAS bf16x8*)(lds + PG8_SA(b, h) + aoff + m * 2048 + k * 1024); } while (0)
#define PG8_LDB(dst, b, h) do { _Pragma("unroll") for (int n = 0; n < 2; ++n) _Pragma("unroll") for (int k = 0; k < 2; ++k) dst[n][k] = *(const PG8_LAS bf16x8*)(lds + PG8_SB(b, h) + boff + n * 2048 + k * 1024); } while (0)
#define PG8_MMA(ai, bj, At, Bt) do { __builtin_amdgcn_s_setprio(1); _Pragma("unroll") for (int m = 0; m < 4; ++m) _Pragma("unroll") for (int n = 0; n < 2; ++n) _Pragma("unroll") for (int k = 0; k < 2; ++k) \
        acc[ai][bj][m][n] = __builtin_amdgcn_mfma_f32_16x16x32_bf16(Bt[n][k], At[m][k], acc[ai][bj][m][n], 0, 0, 0); __builtin_amdgcn_s_setprio(0); } while (0)
#define PG8_WAIT_V(n) asm volatile("s_waitcnt vmcnt(" #n ")" ::: "memory")
#define PG8_WAIT_L(n) asm volatile("s_waitcnt lgkmcnt(" #n ")" ::: "memory")
#define PG8_BAR __builtin_amdgcn_s_barrier()
#define PG8_SCHED __builtin_amdgcn_sched_barrier(0)
    Unit cur, nxt; int ui = 0;
    if (!S.next(0, cur)) return;
    f32x4 acc[2][2][4][2];
#pragma unroll
    for (int a = 0; a < 2; ++a)
#pragma unroll
        for (int b = 0; b < 2; ++b)
#pragma unroll
            for (int m = 0; m < 4; ++m)
#pragma unroll
                for (int n = 0; n < 2; ++n) acc[a][b][m][n] = (f32x4){0.f, 0.f, 0.f, 0.f};
    bf16x8 At[4][2], B0[2][2], B1[2][2];
    const char* cA = (const char*)g.A + (size_t)cur.pm * tstep; const char* cB = (const char*)g.Bt + (size_t)cur.pn * tstep;
    S.a_ready(cur);
    if constexpr (SP2) {
        PG8_STAGE(PG8_SB(0, 0), cB, voffB); PG8_STAGE(PG8_SB(0, 1), cB + hstep, voffB); PG8_STAGE(PG8_SA(0, 0), cA, voffA); PG8_STAGE(PG8_SA(0, 1), cA + hstep, voffA);
        if (wr == 1) PG8_BAR;
        PG8_WAIT_V(2); PG8_BAR;
        PG8_STAGE(PG8_SB(1, 0), cB + kstep, voffB); PG8_STAGE(PG8_SA(1, 0), cA + kstep, voffA); PG8_STAGE(PG8_SB(1, 1), cB + hstep + kstep, voffB);
        PG8_WAIT_V(6); PG8_BAR;
    } else {
        PG8_STAGE(PG8_SB(0, 0), cB, voffB); PG8_STAGE(PG8_SA(0, 0), cA, voffA); PG8_STAGE(PG8_SB(0, 1), cB + hstep, voffB); PG8_STAGE(PG8_SA(0, 1), cA + hstep, voffA);
        if (wr == 1) PG8_BAR;
        PG8_WAIT_V(4); PG8_BAR;
        PG8_STAGE(PG8_SB(1, 0), cB + kstep, voffB); PG8_STAGE(PG8_SA(1, 0), cA + kstep, voffA); PG8_STAGE(PG8_SB(1, 1), cB + hstep + kstep, voffB);
        PG8_WAIT_V(6); PG8_BAR;
    }
    for (;;) {
        const bool has_next = S.next(ui + 1, nxt);
        const char* nA = has_next ? (const char*)g.A + (size_t)nxt.pm * tstep : cA; const char* nB = has_next ? (const char*)g.Bt + (size_t)nxt.pn * tstep : cB;
        for (int t = 0; t < nt; t += 2) {
            const bool last = (t == nt - 2);
            const char* a1 = cA + (size_t)(t + 1) * kstep;
            const char* a2 = last ? nA : cA + (size_t)(t + 2) * kstep; const char* b2 = last ? nB : cB + (size_t)(t + 2) * kstep;
            const char* a3 = a2 + kstep; const char* b3 = b2 + kstep;
            if (last && has_next) S.a_ready(nxt);
            if constexpr (SP2) {
            PG8_LDB(B0, 0, 0); PG8_LDB(B1, 0, 1); PG8_SCHED; PG8_LDA(At, 0, 0); PG8_STAGE(PG8_SA(1, 1), a1 + hstep, voffA);
            PG8_WAIT_V(8); PG8_WAIT_L(0); PG8_BAR; PG8_MMA(0, 0, At, B0); PG8_MMA(0, 1, At, B1); PG8_BAR; PG8_SCHED;
            PG8_LDA(At, 0, 1); PG8_STAGE(PG8_SB(0, 0), b2, voffB); PG8_STAGE(PG8_SB(0, 1), b2 + hstep, voffB); PG8_STAGE(PG8_SA(0, 0), a2, voffA);
            PG8_WAIT_V(8); PG8_WAIT_L(0); PG8_BAR; PG8_MMA(1, 0, At, B0); PG8_MMA(1, 1, At, B1); PG8_BAR; PG8_SCHED;
            PG8_LDB(B0, 1, 0); PG8_LDB(B1, 1, 1); PG8_SCHED; PG8_LDA(At, 1, 0); PG8_STAGE(PG8_SA(0, 1), a2 + hstep, voffA);
            PG8_WAIT_V(8); PG8_WAIT_L(0); PG8_BAR; PG8_MMA(0, 0, At, B0); PG8_MMA(0, 1, At, B1); PG8_BAR; PG8_SCHED;
            PG8_LDA(At, 1, 1); PG8_STAGE(PG8_SB(1, 0), b3, voffB); PG8_STAGE(PG8_SB(1, 1), b3 + hstep, voffB); PG8_STAGE(PG8_SA(1, 0), a3, voffA);
            PG8_WAIT_V(8); PG8_WAIT_L(0); PG8_BAR; PG8_MMA(1, 0, At, B0); PG8_MMA(1, 1, At, B1); PG8_BAR; PG8_SCHED;
            } else {
            PG8_LDB(B0, 0, 0); PG8_SCHED; PG8_LDA(At, 0, 0); PG8_STAGE(PG8_SA(1, 1), a1 + hstep, voffA);
            PG8_WAIT_L(8); PG8_BAR; PG8_WAIT_L(0); PG8_MMA(0, 0, At, B0); PG8_BAR; PG8_SCHED;
            PG8_LDB(B1, 0, 1); PG8_STAGE(PG8_SB(0, 0), b2, voffB);
            PG8_BAR; PG8_WAIT_L(0); PG8_MMA(0, 1, At, B1); PG8_BAR;
            PG8_LDA(At, 0, 1); PG8_STAGE(PG8_SA(0, 0), a2, voffA);
            PG8_BAR; PG8_WAIT_L(0); PG8_MMA(1, 0, At, B0); PG8_BAR; PG8_SCHED;
            PG8_STAGE(PG8_SB(0, 1), b2 + hstep, voffB);
            PG8_WAIT_V(6); PG8_BAR; PG8_MMA(1, 1, At, B1); PG8_BAR;
            PG8_LDB(B0, 1, 0); PG8_SCHED; PG8_LDA(At, 1, 0); PG8_STAGE(PG8_SA(0, 1), a2 + hstep, voffA);
            PG8_WAIT_L(8); PG8_BAR; PG8_WAIT_L(0); PG8_MMA(0, 0, At, B0); PG8_BAR; PG8_SCHED;
            PG8_LDB(B1, 1, 1); PG8_STAGE(PG8_SB(1, 0), b3, voffB);
            PG8_BAR; PG8_WAIT_L(0); PG8_MMA(0, 1, At, B1); PG8_BAR;
            PG8_LDA(At, 1, 1); PG8_STAGE(PG8_SA(1, 0), a3, voffA);
            PG8_BAR; PG8_WAIT_L(0); PG8_MMA(1, 0, At, B0); PG8_BAR; PG8_SCHED;
            PG8_STAGE(PG8_SB(1, 1), b3 + hstep, voffB);
            PG8_WAIT_V(6); PG8_BAR; PG8_MMA(1, 1, At, B1); PG8_BAR;
            }
        }
        if constexpr (ALIGN_EPI) { if (wr == 0) PG8_BAR; }
        if constexpr (!Epi::AFTER_DRAIN) { E(acc, cur, wr, wc, fr, fq); S.done(cur); }
        if (!has_next) break;
#pragma unroll
        for (int a = 0; a < 2; ++a)
#pragma unroll
            for (int b = 0; b < 2; ++b)
#pragma unroll
                for (int m = 0; m < 4; ++m)
#pragma unroll
                    for (int n = 0; n < 2; ++n) acc[a][b][m][n] = (f32x4){0.f, 0.f, 0.f, 0.f};
        cur = nxt; cA = nA; cB = nB; ++ui;
        if constexpr (ALIGN_EPI) { if (wr == 1) PG8_BAR; }
    }
    PG8_WAIT_V(0);
    if constexpr (!ALIGN_EPI) { if (wr == 0) PG8_BAR; }
    PG8_BAR;
    if constexpr (Epi::AFTER_DRAIN) { E.fused(acc, cur, wr, wc, fr, fq, lds, wid, lane); S.done(cur); }
#undef PG8_SA
#undef PG8_SB
#undef PG8_STAGE
#undef PG8_LDA
#undef PG8_LDB
#undef PG8_MMA
#undef PG8_WAIT_V
#undef PG8_WAIT_L
#undef PG8_BAR
#undef PG8_SCHED
}
}
__device__ __forceinline__ float bf2f(unsigned short h) { return __builtin_bit_cast(float, (unsigned)h << 16); }
__device__ __forceinline__ float gelu_tanh(float x) { const float u = 0.7978845608028654f * (x + 0.044715f * x * x * x); return 0.5f * x * (1.f + tanhf(u)); }
__device__ __forceinline__ float sigmoidf_(float x) { return 1.f / (1.f + expf(-x)); }
__device__ __forceinline__ float wave_sum(float v) {
#pragma unroll
    for (int o = 1; o < 64; o <<= 1) v += __shfl_xor(v, o);
    return v;
}
__device__ __forceinline__ unsigned cvt_pk_bf16(float lo, float hi) { unsigned r; asm volatile("v_cvt_pk_bf16_f32 %0, %1, %2" : "=v"(r) : "v"(lo), "v"(hi)); return r; }
__device__ __forceinline__ float gelu_fast(float x) { const float u = x * (0.7978845608028654f + 0.035677408136300125f * x * x); return x * __builtin_amdgcn_rcpf(1.f + __builtin_amdgcn_exp2f(-2.8853900817779268f * u)); }
__device__ __forceinline__ float sigmoid_fast(float x) { return __builtin_amdgcn_rcpf(1.f + __builtin_amdgcn_exp2f(-1.4426950408889634f * x)); }
enum { ACT_GELU = 0, ACT_SQRELU = 1 };
typedef unsigned u32x2 __attribute__((ext_vector_type(2)));
template <int ACT> struct FActBf16 { bf16* O; int ldc;
    __device__ __forceinline__ void apply4(int row, int col, f32x4 v) const {
        float r[4];
#pragma unroll
        for (int i = 0; i < 4; ++i) { if (ACT == ACT_GELU) r[i] = gelu_fast(v[i]); else { const float t = fmaxf(v[i], 0.f); r[i] = t * t; } }
        u32x2 w; w.x = cvt_pk_bf16(r[0], r[1]); w.y = cvt_pk_bf16(r[2], r[3]); *(u32x2*)(O + (size_t)row * ldc + col) = w; } };
struct FResid { float* X;
    __device__ __forceinline__ void apply4(int row, int col, f32x4 v) const { f32x4* p = (f32x4*)(X + (size_t)row * D + col); *p = *p + v; } };
struct FRglru { bf16* G; float* XB;
    __device__ __forceinline__ void apply4(int row, int col, f32x4 v) const {
        if (col < 1024) { u32x2 w; w.x = cvt_pk_bf16(gelu_fast(v[0]), gelu_fast(v[1])); w.y = cvt_pk_bf16(gelu_fast(v[2]), gelu_fast(v[3])); *(u32x2*)(G + (size_t)row * 1024 + col) = w; }
        else *(f32x4*)(XB + (size_t)row * 1024 + col - 1024) = v; } };
struct FF32 { float* O; int ldc;
    __device__ __forceinline__ void apply4(int row, int col, f32x4 v) const { *(f32x4*)(O + (size_t)row * ldc + col) = v; } };
struct FGlu { float* X;
    __device__ __forceinline__ void apply_pair(int row, int col, f32x4 a, f32x4 b) const { f32x4* p = (f32x4*)(X + (size_t)row * D + col); f32x4 x = *p;
#pragma unroll
        for (int i = 0; i < 4; ++i) x[i] += a[i] * sigmoid_fast(b[i]);
        *p = x; } };

template <class F> struct EpiRow4 { static constexpr bool PERM = false, AFTER_DRAIN = false; F f;
    __device__ __forceinline__ void operator()(const pg8::f32x4 (&acc)[2][2][4][2], const pg8::Unit& u, int wr, int wc, int fr, int fq) const {
#pragma unroll
        for (int ai = 0; ai < 2; ++ai)
#pragma unroll
            for (int m = 0; m < 4; ++m) { const int row = u.pm * 256 + ai * 128 + wr * 64 + m * 16 + fr;
#pragma unroll
                for (int bj = 0; bj < 2; ++bj)
#pragma unroll
                    for (int n = 0; n < 2; ++n) f.apply4(row, u.pn * 256 + bj * 128 + wc * 32 + n * 16 + 4 * fq, acc[ai][bj][m][n]);
                asm volatile("" ::: "memory"); } } };
template <class F> struct EpiPair4 { static constexpr bool PERM = false, AFTER_DRAIN = false; F f;
    __device__ __forceinline__ void operator()(const pg8::f32x4 (&acc)[2][2][4][2], const pg8::Unit& u, int wr, int wc, int fr, int fq) const {
#pragma unroll
        for (int ai = 0; ai < 2; ++ai)
#pragma unroll
            for (int m = 0; m < 4; ++m) { const int row = u.pm * 256 + ai * 128 + wr * 64 + m * 16 + fr;
#pragma unroll
                for (int n = 0; n < 2; ++n) f.apply_pair(row, u.pn * 128 + wc * 32 + n * 16 + 4 * fq, acc[ai][0][m][n], acc[ai][1][m][n]);
                asm volatile("" ::: "memory"); } } };

constexpr int NWAVES = 8;
constexpr int RING_BYTES = 131072, LDSCTL_OFF = RING_BYTES, MISC_OFF = LDSCTL_OFF + 320, LDS_BYTES = 147456;
constexpr int PTAB_OFF = LDSCTL_OFF + 1024;
struct Frame { LAS unsigned char* lds; int tid, lane, wave, vcu, G, bx; };
__device__ __forceinline__ const float* inp(const Frame& F, int i) {
    const volatile LAS unsigned* t = (const volatile LAS unsigned*)(F.lds + PTAB_OFF) + 2 * i;
    const unsigned lo = __builtin_amdgcn_readfirstlane(t[0]), hi = __builtin_amdgcn_readfirstlane(t[1]);
    return (const float*)(((unsigned long long)hi << 32) | lo);
}

template <int NT, class F>
__device__ __forceinline__ void small_gemm(const Frame& Fr, const bf16* A, const bf16* WT, int K, const F& f) {
    const int piece = Fr.vcu, rb = piece & 7, cb = piece >> 3, rt = Fr.wave & 3, chh = Fr.wave >> 2, fr = Fr.lane & 15, fq = Fr.lane >> 4;
    const int m0 = MP + rb * 64 + rt * 16, n0 = (cb * 2 + chh) * NT * 16;
    const bf16* ap = A + (size_t)(m0 + fr) * K + 8 * fq; const bf16* bp = WT + (size_t)(n0 + fr) * K + 8 * fq;
    f32x4 acc[NT];
#pragma unroll
    for (int t = 0; t < NT; ++t) acc[t] = (f32x4){0.f, 0.f, 0.f, 0.f};
#pragma unroll 4
    for (int k0 = 0; k0 < K; k0 += 32) {
        const bf16x8 a = *(const bf16x8*)(ap + k0);
#pragma unroll
        for (int t = 0; t < NT; ++t) { const bf16x8 b = *(const bf16x8*)(bp + (size_t)t * 16 * K + k0); acc[t] = __builtin_amdgcn_mfma_f32_16x16x32_bf16(b, a, acc[t], 0, 0, 0); }
    }
#pragma unroll
    for (int t = 0; t < NT; ++t) f.apply4(m0 + fr, n0 + t * 16 + 4 * fq, acc[t]);
}
__device__ __forceinline__ void small_gemm_glu(const Frame& Fr, const bf16* A, const bf16* WT, int K, const FGlu& f) {
    const int piece = Fr.vcu, rb = piece & 7, cb = piece >> 3, rt = Fr.wave & 3, chh = Fr.wave >> 2, fr = Fr.lane & 15, fq = Fr.lane >> 4;
    const int m0 = MP + rb * 64 + rt * 16, c0 = cb * 32 + chh * 16, ra = 256 * (c0 >> 7) + (c0 & 127);
    const bf16* ap = A + (size_t)(m0 + fr) * K + 8 * fq; const bf16* bpa = WT + (size_t)(ra + fr) * K + 8 * fq; const bf16* bpb = bpa + (size_t)128 * K;
    f32x4 acca = (f32x4){0.f, 0.f, 0.f, 0.f}, accb = acca;
#pragma unroll 4
    for (int k0 = 0; k0 < K; k0 += 32) {
        const bf16x8 a = *(const bf16x8*)(ap + k0), ba = *(const bf16x8*)(bpa + k0), bb = *(const bf16x8*)(bpb + k0);
        acca = __builtin_amdgcn_mfma_f32_16x16x32_bf16(ba, a, acca, 0, 0, 0); accb = __builtin_amdgcn_mfma_f32_16x16x32_bf16(bb, a, accb, 0, 0, 0);
    }
    f.apply_pair(m0 + fr, c0 + 4 * fq, acca, accb);
}

__device__ __forceinline__ void transpose_item(const float* W, int K, int N, bf16* WT, int drow0, LAS float* scr, int k0, int n0, int lane) {
#pragma unroll 8
    for (int i = 0; i < 32; ++i) { const int kk = 2 * i + (lane >> 5); scr[kk * 33 + (lane & 31)] = W[(size_t)(k0 + kk) * N + n0 + (lane & 31)]; }
    LDS_WAIT(); asm volatile("" ::: "memory");
    const int c = lane & 7;
#pragma unroll
    for (int j = 0; j < 4; ++j) { const int n = (lane >> 3) + 8 * j; const LAS float* s = scr + (8 * c) * 33 + n;
        v4u o; o.x = cvt_pk_bf16(s[0 * 33], s[1 * 33]); o.y = cvt_pk_bf16(s[2 * 33], s[3 * 33]); o.z = cvt_pk_bf16(s[4 * 33], s[5 * 33]); o.w = cvt_pk_bf16(s[6 * 33], s[7 * 33]);
        *(GAS v4u*)(WT + (size_t)(drow0 + n) * K + k0 + 8 * c) = o; }
    LDS_WAIT(); asm volatile("" ::: "memory");
}
__device__ __forceinline__ bool conv_job(const Frame& F, int& it, const float* W, int K, int N, bf16* WT, bool glu) {
    const int nblk = N / 32, nit = (K / 64) * nblk;
    if (it >= nit) { it -= nit; return false; }
    const int kb = it / nblk, nb = it % nblk, n0 = 32 * nb; int drow0 = n0;
    if (glu) { const int bj = n0 >> 10, r = n0 & 1023; drow0 = 256 * (r >> 7) + 128 * bj + (r & 127); }
    transpose_item(W, K, N, WT, drow0, (LAS float*)(F.lds + F.wave * 16384), 64 * kb, n0, F.lane);
    return true;
}

struct Args { const float* in[35]; float* out; unsigned char* ws; int ph_lo, ph_hi; };

__device__ __forceinline__ void norm_rows(const Frame& F, const float* X, const float* g, bf16* XN) {
    const int gw = F.vcu * NWAVES + F.wave, NGW = F.G * NWAVES;
    f32x4 gv[4];
#pragma unroll
    for (int j = 0; j < 4; ++j) gv[j] = ((const f32x4*)g)[F.lane + 64 * j];
    for (int row = gw; row < M; row += NGW) {
        const f32x4* xr = (const f32x4*)(X + (size_t)row * D) + F.lane; f32x4 v[4]; float s = 0.f;
#pragma unroll
        for (int j = 0; j < 4; ++j) { v[j] = xr[64 * j]; s += (v[j].x * v[j].x + v[j].y * v[j].y) + (v[j].z * v[j].z + v[j].w * v[j].w); }
        const float rs = rsqrtf(wave_sum(s) * (1.f / D) + EPS);
        u32x2* o = (u32x2*)(XN + (size_t)row * D) + F.lane;
#pragma unroll
        for (int j = 0; j < 4; ++j) { u32x2 w; w.x = cvt_pk_bf16(v[j].x * rs * gv[j].x, v[j].y * rs * gv[j].y); w.y = cvt_pk_bf16(v[j].z * rs * gv[j].z, v[j].w * rs * gv[j].w); o[64 * j] = w; }
    }
}
__device__ __forceinline__ void norm_final(const Frame& F, float* X, const float* g) {
    const int gw = F.vcu * NWAVES + F.wave, NGW = F.G * NWAVES;
    f32x4 gv[4];
#pragma unroll
    for (int j = 0; j < 4; ++j) gv[j] = ((const f32x4*)g)[F.lane + 64 * j];
    for (int row = gw; row < M; row += NGW) {
        f32x4* xr = (f32x4*)(X + (size_t)row * D) + F.lane; f32x4 v[4]; float s = 0.f;
#pragma unroll
        for (int j = 0; j < 4; ++j) { v[j] = xr[64 * j]; s += (v[j].x * v[j].x + v[j].y * v[j].y) + (v[j].z * v[j].z + v[j].w * v[j].w); }
        const float rs = rsqrtf(wave_sum(s) * (1.f / D) + EPS);
#pragma unroll
        for (int j = 0; j < 4; ++j) xr[64 * j] = v[j] * rs * gv[j];
    }
}

template <class Epi> __device__ __forceinline__ void big_gemm(const Frame& F, const bf16* A, const bf16* WT, int N, int K, const Epi& E) {
    pg8::Gemm g{A, WT, MP, N, K}; pg8::StaticOrder S; S.init(MP, N, F.G, F.bx);
    pg8::gemm_phase<Epi, pg8::StaticOrder, true, true>(F.lds, g, S, E, F.tid);
}

__device__ __forceinline__ float bflo(unsigned u) { return __builtin_bit_cast(float, u << 16); }
__device__ __forceinline__ float bfhi(unsigned u) { return __builtin_bit_cast(float, u & 0xffff0000u); }
__device__ __forceinline__ void vstat_phase(const Frame& F, const bf16* UV, const float* sg, float* rsv, float* vs_out) {
    const int gw = F.vcu * NWAVES + F.wave, NGW = F.G * NWAVES;
    for (int row = gw; row < M; row += NGW) {
        const v4u* vp = (const v4u*)(UV + (size_t)row * 2048 + 1024) + F.lane;
        const v4u a = vp[0], b = vp[64]; float x[16];
        x[0] = bflo(a.x); x[1] = bfhi(a.x); x[2] = bflo(a.y); x[3] = bfhi(a.y); x[4] = bflo(a.z); x[5] = bfhi(a.z); x[6] = bflo(a.w); x[7] = bfhi(a.w);
        x[8] = bflo(b.x); x[9] = bfhi(b.x); x[10] = bflo(b.y); x[11] = bfhi(b.y); x[12] = bflo(b.z); x[13] = bfhi(b.z); x[14] = bflo(b.w); x[15] = bfhi(b.w);
        float s = 0.f;
#pragma unroll
        for (int i = 0; i < 16; ++i) s += x[i] * x[i];
        const float rs = rsqrtf(wave_sum(s) * (1.f / 1024) + EPS);
        if (F.lane == 0) rsv[row] = rs;
        if (row >= MP) {
            float* o = vs_out + (size_t)(row - MP) * 1024;
#pragma unroll
            for (int hf = 0; hf < 2; ++hf) { const int c0 = hf * 512 + F.lane * 8; const f32x4 g0 = *(const f32x4*)(sg + c0), g1 = *(const f32x4*)(sg + c0 + 4);
                *(f32x4*)(o + c0) = (f32x4){x[hf * 8 + 0] * rs * g0.x, x[hf * 8 + 1] * rs * g0.y, x[hf * 8 + 2] * rs * g0.z, x[hf * 8 + 3] * rs * g0.w};
                *(f32x4*)(o + c0 + 4) = (f32x4){x[hf * 8 + 4] * rs * g1.x, x[hf * 8 + 5] * rs * g1.y, x[hf * 8 + 6] * rs * g1.z, x[hf * 8 + 7] * rs * g1.w}; }
        }
    }
}
constexpr int VS_STRIDE = 264;
__device__ __forceinline__ void sgu_mix_phase(const Frame& F, const bf16* UV, const float* rsv, const float* sg, const bf16* Wm, const float* bs, const float* wsf, bf16* Y) {
    LAS unsigned char* Vs = F.lds; const int fr = F.lane & 15, fq = F.lane >> 4;
    for (int u = F.vcu; u < 1024; u += F.G) {
        const int g = u & 7, r0 = (u >> 3) * 128;
#pragma unroll
        for (int i = 0; i < 4; ++i) { const int id = F.tid + 512 * i, row = id >> 4, ch = id & 15;
            const v4u raw = *(const v4u*)(UV + (size_t)(r0 + row) * 2048 + 1024 + g * 128 + ch * 8); const float rs = rsv[r0 + row];
            const f32x4 g0 = *(const f32x4*)(sg + g * 128 + ch * 8), g1 = *(const f32x4*)(sg + g * 128 + ch * 8 + 4);
            u32x2 w0, w1; w0.x = cvt_pk_bf16(bflo(raw.x) * rs * g0.x, bfhi(raw.x) * rs * g0.y); w0.y = cvt_pk_bf16(bflo(raw.y) * rs * g0.z, bfhi(raw.y) * rs * g0.w);
            w1.x = cvt_pk_bf16(bflo(raw.z) * rs * g1.x, bfhi(raw.z) * rs * g1.y); w1.y = cvt_pk_bf16(bflo(raw.w) * rs * g1.z, bfhi(raw.w) * rs * g1.w);
            *(LAS u32x2*)(Vs + row * VS_STRIDE + ch * 16) = w0; *(LAS u32x2*)(Vs + row * VS_STRIDE + ch * 16 + 8) = w1; }
        __syncthreads();
        bf16x8 af[4];
#pragma unroll
        for (int kk = 0; kk < 4; ++kk)
#pragma unroll
            for (int j = 0; j < 8; ++j) af[kk][j] = (short)*(const LAS unsigned short*)(Vs + (32 * kk + 8 * fq + j) * VS_STRIDE + (16 * F.wave + fr) * 2);
        f32x4 acc[8]; const bf16* wg = Wm + (size_t)g * 128 * 128;
#pragma unroll
        for (int n = 0; n < 8; ++n) { acc[n] = (f32x4){0.f, 0.f, 0.f, 0.f};
#pragma unroll
            for (int kk = 0; kk <= n / 2; ++kk) { const bf16x8 b = *(const bf16x8*)(wg + (size_t)(16 * n + fr) * 128 + 32 * kk + 8 * fq); acc[n] = __builtin_amdgcn_mfma_f32_16x16x32_bf16(af[kk], b, acc[n], 0, 0, 0); } }
#pragma unroll
        for (int n = 0; n < 8; ++n) { const int t = 16 * n + fr, row = r0 + t, col = g * 128 + 16 * F.wave + 4 * fq; const float bb = bs[g * 128 + t];
            const u32x2 uu = *(const u32x2*)(UV + (size_t)row * 2048 + col);
            u32x2 w; w.x = cvt_pk_bf16(bflo(uu.x) * (acc[n][0] + bb), bfhi(uu.x) * (acc[n][1] + bb)); w.y = cvt_pk_bf16(bflo(uu.y) * (acc[n][2] + bb), bfhi(uu.y) * (acc[n][3] + bb));
            *(u32x2*)(Y + (size_t)row * 1024 + col) = w; }
        __syncthreads();
    }
    for (int it = F.vcu * 512 + F.tid; it < 128 * 256; it += F.G * 512) {
        const int b = it >> 8, d = (it & 255) * 4, gh = d >> 7, rowb = MP + b * 4; const f32x4 gg = *(const f32x4*)(sg + d);
        float v[4][4], uu[4][4];
#pragma unroll
        for (int s = 0; s < 4; ++s) { const u32x2 rv = *(const u32x2*)(UV + (size_t)(rowb + s) * 2048 + 1024 + d), ru = *(const u32x2*)(UV + (size_t)(rowb + s) * 2048 + d); const float rs = rsv[rowb + s];
            v[s][0] = bflo(rv.x) * rs; v[s][1] = bfhi(rv.x) * rs; v[s][2] = bflo(rv.y) * rs; v[s][3] = bfhi(rv.y) * rs;
            uu[s][0] = bflo(ru.x); uu[s][1] = bfhi(ru.x); uu[s][2] = bflo(ru.y); uu[s][3] = bfhi(ru.y); }
#pragma unroll
        for (int t = 0; t < 4; ++t) { float m[4] = {0.f, 0.f, 0.f, 0.f};
#pragma unroll
            for (int s = 0; s <= t; ++s) { const float w = wsf[((size_t)gh * 128 + t) * 128 + s];
#pragma unroll
                for (int e = 0; e < 4; ++e) m[e] += w * v[s][e]; }
            const float bb = bs[gh * 128 + t];
            u32x2 w; w.x = cvt_pk_bf16(uu[t][0] * (m[0] * gg.x + bb), uu[t][1] * (m[1] * gg.y + bb)); w.y = cvt_pk_bf16(uu[t][2] * (m[2] * gg.z + bb), uu[t][3] * (m[3] * gg.w + bb));
            *(u32x2*)(Y + (size_t)(rowb + t) * 1024 + d) = w; }
    }
}
constexpr size_t RGT_W = 0, RGT_BA = 512 * 1024, RGT_BX = RGT_BA + 4096, RGT_NSP = RGT_BX + 4096;
__device__ __forceinline__ int rg_jch(int m, int r) { return 8 * (r >> 2) + 4 * (m & 1) + (r & 3) + 32 * (m >> 1); }
__device__ __forceinline__ void rglru_tables(const Frame& F, const float* wa, const float* wx, const float* ba, const float* bx, const float* lam, unsigned char* tab) {
    bf16* W = (bf16*)(tab + RGT_W);
    for (int i = F.vcu * 512 + F.tid; i < 16 * 2 * 4 * 2 * 64 * 8; i += F.G * 512) {
        const int e = i & 7, lane = (i >> 3) & 63, ks = (i >> 9) & 1, m = (i >> 10) & 3, type = (i >> 12) & 1, h = i >> 13, fr = lane & 15, fq = lane >> 4;
        const float* w = type ? wx : wa; const float v = w[((size_t)h * 64 + 32 * ks + 8 * fq + e) * 64 + rg_jch(m, fr)];
        W[i] = (bf16)(cvt_pk_bf16(v, 0.f) & 0xffffu);
    }
    for (int c = F.vcu * 512 + F.tid; c < 1024; c += F.G * 512) {
        ((float*)(tab + RGT_BA))[c] = ba[c]; ((float*)(tab + RGT_BX))[c] = bx[c]; ((float*)(tab + RGT_NSP))[c] = -8.0f * log1pf(expf(-lam[c]));
    }
}
template <int CTRL> __device__ __forceinline__ float dpp_f(float old, float src) {
    return __builtin_bit_cast(float, __builtin_amdgcn_update_dpp(__builtin_bit_cast(int, old), __builtin_bit_cast(int, src), CTRL, 0xf, 0xf, false)); }
constexpr int RG_XC_STRIDE = 68, RG_XC_BYTES = 128 * RG_XC_STRIDE * 4, RG_TOT_OFF = 2 * RG_XC_BYTES, RG_CARRY_OFF = RG_TOT_OFF + 2 * 2 * 8 * 64 * 4;
template <int D_, bool SAMPLE> __device__ __forceinline__ void ks_step(float (&a)[16], float (&b)[16], int tt) {
#pragma unroll
    for (int i = 0; i < 16; ++i) {
        float as = dpp_f<0x110 + D_>(1.0f, a[i]), bs = dpp_f<0x110 + D_>(0.0f, b[i]);
        if (SAMPLE) { const bool ok = tt >= D_; as = ok ? as : 1.0f; bs = ok ? bs : 0.0f; }
        b[i] = a[i] * bs + b[i]; a[i] = a[i] * as;
    }
}
template <bool SAMPLE>
__device__ __forceinline__ void rglru_unit(const Frame& F, int unit, const float* XB, const bf16* G, bf16* Y, const float* cw, const float* cb, const unsigned char* tab,
                                           const float* cstate, const float* hstate, float* conv_out, float* h_out) {
    const int fr = F.lane & 15, fq = F.lane >> 4, w = F.wave;
    int h, b0, rowbase, nchunk;
    if (SAMPLE) { h = unit >> 2; b0 = (unit & 3) * 32; rowbase = MP + b0 * 4; nchunk = 1; }
    else { b0 = unit >> 4; h = unit & 15; rowbase = b0 * 2048; nchunk = 16; }
    LAS float* XC = (LAS float*)F.lds; LAS float* TOT = (LAS float*)(F.lds + RG_TOT_OFF); LAS float* CARRY = (LAS float*)(F.lds + RG_CARRY_OFF);
    const int chq = F.tid & 15, rsub = F.tid >> 4, cA = h * 64 + 4 * chq;
    f32x4 cwv[4];
#pragma unroll
    for (int k = 0; k < 4; ++k) cwv[k] = *(const f32x4*)(cw + k * 1024 + cA);
    const f32x4 cbv = *(const f32x4*)(cb + cA);
    bf16x8 Af[2][4][2];
#pragma unroll
    for (int ty = 0; ty < 2; ++ty)
#pragma unroll
        for (int m = 0; m < 4; ++m)
#pragma unroll
            for (int ks = 0; ks < 2; ++ks) Af[ty][m][ks] = *(const bf16x8*)((const bf16*)(tab + RGT_W) + ((((size_t)(h * 2 + ty) * 4 + m) * 2 + ks) * 64 + F.lane) * 8);
    for (int c = 0; c < nchunk; ++c) {
        const int buf = c & 1, c0 = c * 128;
#pragma unroll
        for (int i = 0; i < 4; ++i) { const int r = rsub + 32 * i; f32x4 acc = cbv;
#pragma unroll
            for (int k = 0; k < 4; ++k) { f32x4 xe;
                if (SAMPLE) { const int bi = r >> 2, tau = (r & 3) + k - 3;
                    xe = tau >= 0 ? *(const f32x4*)(XB + (size_t)(rowbase + bi * 4 + tau) * 1024 + cA) : *(const f32x4*)(cstate + ((size_t)(b0 + bi) * 3 + (tau + 3)) * 1024 + cA); }
                else { const int tau = c0 + r + k - 3; xe = tau >= 0 ? *(const f32x4*)(XB + (size_t)(rowbase + tau) * 1024 + cA) : (f32x4){0.f, 0.f, 0.f, 0.f}; }
                acc = acc + cwv[k] * xe; }
            *(LAS f32x4*)(XC + (size_t)buf * (128 * RG_XC_STRIDE) + r * RG_XC_STRIDE + 4 * chq) = acc; }
        __syncthreads();
        const int trow = 16 * w + fr;
        float xc[16];
        { const LAS float* xp = XC + (size_t)buf * (128 * RG_XC_STRIDE) + trow * RG_XC_STRIDE + 8 * fq;
          const f32x4 x0 = *(const LAS f32x4*)(xp), x1 = *(const LAS f32x4*)(xp + 4), x2 = *(const LAS f32x4*)(xp + 32), x3 = *(const LAS f32x4*)(xp + 36);
          xc[0] = x0.x; xc[1] = x0.y; xc[2] = x0.z; xc[3] = x0.w; xc[4] = x1.x; xc[5] = x1.y; xc[6] = x1.z; xc[7] = x1.w;
          xc[8] = x2.x; xc[9] = x2.y; xc[10] = x2.z; xc[11] = x2.w; xc[12] = x3.x; xc[13] = x3.y; xc[14] = x3.z; xc[15] = x3.w; }
        bf16x8 bf0, bf1;
        { v4u p0, p1; p0.x = cvt_pk_bf16(xc[0], xc[1]); p0.y = cvt_pk_bf16(xc[2], xc[3]); p0.z = cvt_pk_bf16(xc[4], xc[5]); p0.w = cvt_pk_bf16(xc[6], xc[7]);
          p1.x = cvt_pk_bf16(xc[8], xc[9]); p1.y = cvt_pk_bf16(xc[10], xc[11]); p1.z = cvt_pk_bf16(xc[12], xc[13]); p1.w = cvt_pk_bf16(xc[14], xc[15]);
          bf0 = __builtin_bit_cast(bf16x8, p0); bf1 = __builtin_bit_cast(bf16x8, p1); }
        float av[16], bv[16];
#pragma unroll
        for (int m = 0; m < 4; ++m) {
            f32x4 ra = (f32x4){0.f, 0.f, 0.f, 0.f}, rx = ra;
            ra = __builtin_amdgcn_mfma_f32_16x16x32_bf16(Af[0][m][0], bf0, ra, 0, 0, 0); ra = __builtin_amdgcn_mfma_f32_16x16x32_bf16(Af[0][m][1], bf1, ra, 0, 0, 0);
            rx = __builtin_amdgcn_mfma_f32_16x16x32_bf16(Af[1][m][0], bf0, rx, 0, 0, 0); rx = __builtin_amdgcn_mfma_f32_16x16x32_bf16(Af[1][m][1], bf1, rx, 0, 0, 0);
            const int cg = h * 64 + 8 * fq + 4 * (m & 1) + 32 * (m >> 1);
            const f32x4 ba4 = *(const f32x4*)((const float*)(tab + RGT_BA) + cg), bx4 = *(const f32x4*)((const float*)(tab + RGT_BX) + cg), ns4 = *(const f32x4*)((const float*)(tab + RGT_NSP) + cg);
#pragma unroll
            for (int r = 0; r < 4; ++r) { const float rg = sigmoid_fast(ra[r] + ba4[r]), ig = sigmoid_fast(rx[r] + bx4[r]);
                const float la = ns4[r] * rg, a = __builtin_amdgcn_exp2f(1.4426950408889634f * la), mult = __builtin_amdgcn_sqrtf(fmaxf(1.f - a * a, 0.f));
                av[4 * m + r] = a; bv[4 * m + r] = mult * ig * xc[4 * m + r]; }
        }
        const int tt = fr & 3;
        if (SAMPLE) {
            const int bi = (16 * w + fr) >> 2;
#pragma unroll
            for (int m = 0; m < 4; ++m) { const int cg = h * 64 + 8 * fq + 4 * (m & 1) + 32 * (m >> 1); const f32x4 h0 = *(const f32x4*)(hstate + (size_t)(b0 + bi) * 1024 + cg);
#pragma unroll
                for (int r = 0; r < 4; ++r) if (tt == 0) bv[4 * m + r] += av[4 * m + r] * h0[r]; }
            ks_step<1, true>(av, bv, tt); ks_step<2, true>(av, bv, tt);
        } else {
            ks_step<1, false>(av, bv, tt); ks_step<2, false>(av, bv, tt); ks_step<4, false>(av, bv, tt); ks_step<8, false>(av, bv, tt);
            if (fr == 15) { LAS float* ta = TOT + ((size_t)(buf * 2 + 0) * 8 + w) * 64 + fq * 16; LAS float* th = TOT + ((size_t)(buf * 2 + 1) * 8 + w) * 64 + fq * 16;
#pragma unroll
                for (int i = 0; i < 16; i += 4) { *(LAS f32x4*)(ta + i) = (f32x4){av[i], av[i + 1], av[i + 2], av[i + 3]}; *(LAS f32x4*)(th + i) = (f32x4){bv[i], bv[i + 1], bv[i + 2], bv[i + 3]}; } }
            __syncthreads();
            float ch[16];
            if (c == 0) {
#pragma unroll
                for (int i = 0; i < 16; ++i) ch[i] = 0.f;
            } else {
#pragma unroll
                for (int i = 0; i < 16; i += 4) { const f32x4 t = *(const LAS f32x4*)(CARRY + buf * 64 + fq * 16 + i); ch[i] = t.x; ch[i + 1] = t.y; ch[i + 2] = t.z; ch[i + 3] = t.w; }
            }
            for (int v = 0; v < w; ++v) { const LAS float* ta = TOT + ((size_t)(buf * 2 + 0) * 8 + v) * 64 + fq * 16; const LAS float* th = TOT + ((size_t)(buf * 2 + 1) * 8 + v) * 64 + fq * 16;
#pragma unroll
                for (int i = 0; i < 16; i += 4) { const f32x4 A4 = *(const LAS f32x4*)(ta + i), H4 = *(const LAS f32x4*)(th + i);
                    ch[i] = A4.x * ch[i] + H4.x; ch[i + 1] = A4.y * ch[i + 1] + H4.y; ch[i + 2] = A4.z * ch[i + 2] + H4.z; ch[i + 3] = A4.w * ch[i + 3] + H4.w; } }
#pragma unroll
            for (int i = 0; i < 16; ++i) bv[i] = bv[i] + av[i] * ch[i];
            if (w == 7 && fr == 15) {
#pragma unroll
                for (int i = 0; i < 16; i += 4) *(LAS f32x4*)(CARRY + (buf ^ 1) * 64 + fq * 16 + i) = (f32x4){bv[i], bv[i + 1], bv[i + 2], bv[i + 3]}; }
        }
        { const size_t row = (size_t)rowbase + c0 + trow; const size_t o0 = row * 1024 + h * 64 + 8 * fq;
          const v4u g0 = *(const v4u*)(G + o0), g1 = *(const v4u*)(G + o0 + 32); v4u y0, y1;
          y0.x = cvt_pk_bf16(bv[0] * bflo(g0.x), bv[1] * bfhi(g0.x)); y0.y = cvt_pk_bf16(bv[2] * bflo(g0.y), bv[3] * bfhi(g0.y)); y0.z = cvt_pk_bf16(bv[4] * bflo(g0.z), bv[5] * bfhi(g0.z)); y0.w = cvt_pk_bf16(bv[6] * bflo(g0.w), bv[7] * bfhi(g0.w));
          y1.x = cvt_pk_bf16(bv[8] * bflo(g1.x), bv[9] * bfhi(g1.x)); y1.y = cvt_pk_bf16(bv[10] * bflo(g1.y), bv[11] * bfhi(g1.y)); y1.z = cvt_pk_bf16(bv[12] * bflo(g1.z), bv[13] * bfhi(g1.z)); y1.w = cvt_pk_bf16(bv[14] * bflo(g1.w), bv[15] * bfhi(g1.w));
          *(v4u*)(Y + o0) = y0; *(v4u*)(Y + o0 + 32) = y1; }
        if (SAMPLE) {
            if (tt == 3) { const int bi = (16 * w + fr) >> 2; float* ho = h_out + (size_t)(b0 + bi) * 1024 + h * 64 + 8 * fq;
                *(f32x4*)(ho) = (f32x4){bv[0], bv[1], bv[2], bv[3]}; *(f32x4*)(ho + 4) = (f32x4){bv[4], bv[5], bv[6], bv[7]};
                *(f32x4*)(ho + 32) = (f32x4){bv[8], bv[9], bv[10], bv[11]}; *(f32x4*)(ho + 36) = (f32x4){bv[12], bv[13], bv[14], bv[15]}; }
        } else if (c == nchunk - 1 && w == 7 && fr == 15) { float* ho = h_out + (size_t)b0 * 1024 + h * 64 + 8 * fq;
            *(f32x4*)(ho) = (f32x4){bv[0], bv[1], bv[2], bv[3]}; *(f32x4*)(ho + 4) = (f32x4){bv[4], bv[5], bv[6], bv[7]};
            *(f32x4*)(ho + 32) = (f32x4){bv[8], bv[9], bv[10], bv[11]}; *(f32x4*)(ho + 36) = (f32x4){bv[12], bv[13], bv[14], bv[15]}; }
    }
    if (SAMPLE) { for (int i = F.tid; i < 32 * 3 * 64; i += 512) { const int cc = i & 63, r = (i >> 6) % 3, bi = i / 192;
            conv_out[((size_t)(b0 + bi) * 3 + r) * 1024 + h * 64 + cc] = XB[(size_t)(rowbase + bi * 4 + 1 + r) * 1024 + h * 64 + cc]; } }
    else if (F.tid < 192) { const int cc = F.tid & 63, r = F.tid >> 6; conv_out[((size_t)b0 * 3 + r) * 1024 + h * 64 + cc] = XB[(size_t)(rowbase + 2045 + r) * 1024 + h * 64 + cc]; }
    __syncthreads();
}
__device__ __forceinline__ void rglru_phase(const Frame& F, const float* XB, const bf16* G, bf16* Y, const float* cw, const float* cb, const unsigned char* tab, const float* cstate, const float* hstate, float* out) {
    for (int unit = F.vcu; unit < 192; unit += F.G) {
        if (unit < 128) rglru_unit<false>(F, unit, XB, G, Y, cw, cb, tab, nullptr, nullptr, out + O_CONVP, out + O_HP);
        else rglru_unit<true>(F, unit - 128, XB, G, Y, cw, cb, tab, cstate, hstate, out + O_CONVS, out + O_HS);
    }
}
constexpr size_t S5T_AP = 0, S5T_BF = 128 * 1024, S5T_CF = S5T_BF + 1024 * 1024;
__device__ __forceinline__ void s5_disc(const float* lre, const float* lim, const float* ldt, int g, int p, float& ar, float& ai, float& qr, float& qi) {
    const float dt = expf(ldt[g]), lr = lre[g * 64 + p], li = lim[g * 64 + p], mag = expf(lr * dt); ar = mag * cosf(li * dt); ai = mag * sinf(li * dt);
    const float zr = ar - 1.f, zi = ai, den = lr * lr + li * li; qr = (zr * lr + zi * li) / den; qi = (zi * lr - zr * li) / den;
}
__device__ __forceinline__ void s5_tables(const Frame& F, const float* lre, const float* lim, const float* ldt, const float* bre, const float* bim, const float* cre, const float* cim, unsigned char* tab) {
    for (int i = F.vcu * 512 + F.tid; i < 4096; i += F.G * 512) { float ar, ai, qr, qi; s5_disc(lre, lim, ldt, i >> 6, i & 63, ar, ai, qr, qi);
        float* o = (float*)(tab + S5T_AP) + (size_t)i * 8; o[0] = ar; o[1] = ai;
        float r2 = ar * ar - ai * ai, i2 = 2.f * ar * ai; o[2] = r2; o[3] = i2; float r4 = r2 * r2 - i2 * i2, i4 = 2.f * r2 * i2; o[4] = r4; o[5] = i4; o[6] = r4 * r4 - i4 * i4; o[7] = 2.f * r4 * i4; }
    for (int i = F.vcu * 512 + F.tid; i < 64 * 4 * 4 * 64 * 8; i += F.G * 512) {
        const int e = i & 7, lane = (i >> 3) & 63, kind = (i >> 9) & 3, w = (i >> 11) & 3, g = i >> 13, fr = lane & 15, fq = lane >> 4, h = (8 * fq + e) & 15, p = 16 * w + fr;
        float ar, ai, qr, qi; s5_disc(lre, lim, ldt, g, p, ar, ai, qr, qi);
        const float br = bre[((size_t)g * 64 + p) * 16 + h], bi = bim[((size_t)g * 64 + p) * 16 + h]; const float v = (kind & 2) ? (qr * bi + qi * br) : (qr * br - qi * bi);
        const unsigned hi = cvt_pk_bf16(v, 0.f) & 0xffffu; const float vh = __builtin_bit_cast(float, hi << 16);
        ((bf16*)(tab + S5T_BF))[i] = (kind & 1) ? (bf16)(cvt_pk_bf16(v - vh, 0.f) & 0xffffu) : (bf16)hi;
    }
    for (int i = F.vcu * 512 + F.tid; i < 64 * 4 * 64 * 8; i += F.G * 512) {
        const int e = i & 7, lane = (i >> 3) & 63, w = (i >> 9) & 3, g = i >> 11, fr = lane & 15, fq = lane >> 4, p = 16 * w + 4 * fq + (e & 3);
        const float v = e < 4 ? cre[((size_t)g * 16 + fr) * 64 + p] : -cim[((size_t)g * 16 + fr) * 64 + p];
        ((bf16*)(tab + S5T_CF))[i] = (bf16)(cvt_pk_bf16(v, 0.f) & 0xffffu);
    }
}
template <int D_, bool SAMPLE> __device__ __forceinline__ void s5_ks(float (&xr)[4], float (&xi)[4], const float (&ap)[4][8], int pi, int tt) {
#pragma unroll
    for (int s = 0; s < 4; ++s) {
        float sr = dpp_f<0x110 + D_>(0.0f, xr[s]), si = dpp_f<0x110 + D_>(0.0f, xi[s]);
        if (SAMPLE) { const bool ok = tt >= D_; sr = ok ? sr : 0.f; si = ok ? si : 0.f; }
        const float ar = ap[s][2 * pi], ai = ap[s][2 * pi + 1];
        xr[s] = xr[s] + ar * sr - ai * si; xi[s] = xi[s] + ar * si + ai * sr;
    }
}
template <bool SAMPLE>
__device__ __forceinline__ void s5_pass(const Frame& F, int unit, const float* U, bf16* Gs, const float* dsk, const unsigned char* tab, const float* sre, const float* sim, float* ore, float* oim) {
    const int fr = F.lane & 15, fq = F.lane >> 4, wq = F.wave & 3, usel = F.wave >> 2, tt = fr & 3;
    int g, rowbase, ntile, bidx;
    if (SAMPLE) { g = unit >> 5; bidx = (unit & 31) * 4; rowbase = MP + bidx * 4; ntile = 1; }
    else { bidx = unit >> 6; g = unit & 63; rowbase = bidx * 2048; ntile = 128; }
    LAS f32x4* YP = (LAS f32x4*)F.lds;
    float ap[4][8];
#pragma unroll
    for (int s = 0; s < 4; ++s) { const f32x4* a4 = (const f32x4*)((const float*)(tab + S5T_AP) + ((size_t)g * 64 + 16 * wq + 4 * fq + s) * 8); const f32x4 lo = a4[0], hi = a4[1];
        ap[s][0] = lo.x; ap[s][1] = lo.y; ap[s][2] = lo.z; ap[s][3] = lo.w; ap[s][4] = hi.x; ap[s][5] = hi.y; ap[s][6] = hi.z; ap[s][7] = hi.w; }
    bf16x8 Bf[4];
#pragma unroll
    for (int k = 0; k < 4; ++k) Bf[k] = *(const bf16x8*)((const bf16*)(tab + S5T_BF) + ((((size_t)g * 4 + wq) * 4 + k) * 64 + F.lane) * 8);
    const bf16x8 Cf = *(const bf16x8*)((const bf16*)(tab + S5T_CF) + (((size_t)g * 4 + wq) * 64 + F.lane) * 8);
    float xr[4] = {0.f, 0.f, 0.f, 0.f}, xi[4] = {0.f, 0.f, 0.f, 0.f};
    for (int t0 = 0; t0 < ntile; t0 += 8) {
        f32x4 yp[8];
#pragma unroll
        for (int tl = 0; tl < 8; ++tl) {
            if (SAMPLE && tl > 0) { yp[tl] = (f32x4){0.f, 0.f, 0.f, 0.f}; continue; }
            const size_t row = (size_t)rowbase + (size_t)(t0 + tl) * 16 + fr;
            const f32x4 u0 = *(const f32x4*)(U + row * 1024 + g * 16 + 8 * (fq & 1)), u1 = *(const f32x4*)(U + row * 1024 + g * 16 + 8 * (fq & 1) + 4);
            v4u hw, lw; hw.x = cvt_pk_bf16(u0.x, u0.y); hw.y = cvt_pk_bf16(u0.z, u0.w); hw.z = cvt_pk_bf16(u1.x, u1.y); hw.w = cvt_pk_bf16(u1.z, u1.w);
            lw.x = cvt_pk_bf16(u0.x - bflo(hw.x), u0.y - bfhi(hw.x)); lw.y = cvt_pk_bf16(u0.z - bflo(hw.y), u0.w - bfhi(hw.y));
            lw.z = cvt_pk_bf16(u1.x - bflo(hw.z), u1.y - bfhi(hw.z)); lw.w = cvt_pk_bf16(u1.z - bflo(hw.w), u1.w - bfhi(hw.w));
            const v4u bw = fq >= 2 ? lw : hw; const bf16x8 Bop = __builtin_bit_cast(bf16x8, bw);
            f32x4 br = (f32x4){0.f, 0.f, 0.f, 0.f}, bi = br;
            br = __builtin_amdgcn_mfma_f32_16x16x32_bf16(Bf[0], Bop, br, 0, 0, 0); br = __builtin_amdgcn_mfma_f32_16x16x32_bf16(Bf[1], Bop, br, 0, 0, 0);
            bi = __builtin_amdgcn_mfma_f32_16x16x32_bf16(Bf[2], Bop, bi, 0, 0, 0); bi = __builtin_amdgcn_mfma_f32_16x16x32_bf16(Bf[3], Bop, bi, 0, 0, 0);
            float nr[4], ni[4];
            if (SAMPLE) {
                const int bi_ = fr >> 2; const size_t so = ((size_t)(bidx + bi_) * 64 + g) * 64 + 16 * wq + 4 * fq; const f32x4 s_r = *(const f32x4*)(sre + so), s_i = *(const f32x4*)(sim + so);
#pragma unroll
                for (int s = 0; s < 4; ++s) { const float a_r = ap[s][0], a_i = ap[s][1]; const float cr_ = tt == 0 ? s_r[s] : 0.f, ci_ = tt == 0 ? s_i[s] : 0.f;
                    nr[s] = br[s] + a_r * cr_ - a_i * ci_; ni[s] = bi[s] + a_r * ci_ + a_i * cr_; }
            } else {
#pragma unroll
                for (int s = 0; s < 4; ++s) { const float a_r = ap[s][0], a_i = ap[s][1]; float cr_ = dpp_f<0x121>(0.f, xr[s]), ci_ = dpp_f<0x121>(0.f, xi[s]);
                    cr_ = fr == 0 ? cr_ : 0.f; ci_ = fr == 0 ? ci_ : 0.f;
                    nr[s] = br[s] + a_r * cr_ - a_i * ci_; ni[s] = bi[s] + a_r * ci_ + a_i * cr_; }
            }
#pragma unroll
            for (int s = 0; s < 4; ++s) { xr[s] = nr[s]; xi[s] = ni[s]; }
            s5_ks<1, SAMPLE>(xr, xi, ap, 0, tt); s5_ks<2, SAMPLE>(xr, xi, ap, 1, tt);
            if (!SAMPLE) { s5_ks<4, false>(xr, xi, ap, 2, tt); s5_ks<8, false>(xr, xi, ap, 3, tt); }
            v4u xw; xw.x = cvt_pk_bf16(xr[0], xr[1]); xw.y = cvt_pk_bf16(xr[2], xr[3]); xw.z = cvt_pk_bf16(xi[0], xi[1]); xw.w = cvt_pk_bf16(xi[2], xi[3]);
            yp[tl] = __builtin_amdgcn_mfma_f32_16x16x32_bf16(Cf, __builtin_bit_cast(bf16x8, xw), (f32x4){0.f, 0.f, 0.f, 0.f}, 0, 0, 0);
        }
#pragma unroll
        for (int tl = 0; tl < (SAMPLE ? 1 : 8); ++tl) YP[((usel * 4 + wq) * 8 + tl) * 64 + F.lane] = yp[tl];
        __syncthreads();
#pragma unroll
        for (int k = 0; k < 2; ++k) { const int tl = 2 * wq + k; if (SAMPLE && tl > 0) continue;
            f32x4 y = YP[((usel * 4 + 0) * 8 + tl) * 64 + F.lane] + YP[((usel * 4 + 1) * 8 + tl) * 64 + F.lane] + YP[((usel * 4 + 2) * 8 + tl) * 64 + F.lane] + YP[((usel * 4 + 3) * 8 + tl) * 64 + F.lane];
            const size_t row = (size_t)rowbase + (size_t)(t0 + tl) * 16 + fr; const int ch = g * 16 + 4 * fq;
            const f32x4 u4 = *(const f32x4*)(U + row * 1024 + ch), d4 = *(const f32x4*)(dsk + ch); y = y + d4 * u4;
            u32x2 o; o.x = cvt_pk_bf16(gelu_fast(y.x), gelu_fast(y.y)); o.y = cvt_pk_bf16(gelu_fast(y.z), gelu_fast(y.w)); *(u32x2*)(Gs + row * 1024 + ch) = o; }
        __syncthreads();
    }
    if (SAMPLE) { if (tt == 3) { const size_t so = ((size_t)(bidx + (fr >> 2)) * 64 + g) * 64 + 16 * wq + 4 * fq; *(f32x4*)(ore + so) = (f32x4){xr[0], xr[1], xr[2], xr[3]}; *(f32x4*)(oim + so) = (f32x4){xi[0], xi[1], xi[2], xi[3]}; } }
    else if (fr == 15) { const size_t so = ((size_t)bidx * 64 + g) * 64 + 16 * wq + 4 * fq; *(f32x4*)(ore + so) = (f32x4){xr[0], xr[1], xr[2], xr[3]}; *(f32x4*)(oim + so) = (f32x4){xi[0], xi[1], xi[2], xi[3]}; }
}
__device__ __forceinline__ void s5_phase(const Frame& F, const float* U, bf16* Gs, const float* dsk, const unsigned char* tab, const float* sre, const float* sim, float* out) {
    const int usel = F.wave >> 2;
    for (int u0 = F.vcu; u0 < 256; u0 += F.G) s5_pass<false>(F, u0 * 2 + usel, U, Gs, dsk, tab, nullptr, nullptr, out + O_SREP, out + O_SIMP);
    for (int u0 = F.vcu; u0 < 1024; u0 += F.G) s5_pass<true>(F, u0 * 2 + usel, U, Gs, dsk, tab, sre, sim, out + O_SRES, out + O_SIMS);
}
constexpr int PH_FINAL = 33, PH_END = 34;
enum { ST_NORM1 = 0, ST_GIN = 1, ST_MIXA = 2, ST_MIXB = 3, ST_GOUT = 4, ST_NORM2 = 5, ST_FF1 = 6, ST_FF2 = 7 };

__global__ void __launch_bounds__(NWAVES * 64, 2) mk(Args a) {
    extern __shared__ __attribute__((aligned(16))) unsigned char lds_raw[];
    Frame F; F.lds = (LAS unsigned char*)lds_raw; F.tid = threadIdx.x; F.lane = F.tid & 63; F.wave = __builtin_amdgcn_readfirstlane(F.tid >> 6);
    F.G = gridDim.x; F.bx = blockIdx.x; F.vcu = (F.bx % 8) * (F.G / 8) + F.bx / 8;
    volatile LAS unsigned* MISC = (volatile LAS unsigned*)(F.lds + MISC_OFF);
    for (int u = F.tid; u < (LDS_BYTES - LDSCTL_OFF) / 4; u += NWAVES * 64) ((LAS unsigned*)(F.lds + LDSCTL_OFF))[u] = 0u;
    __syncthreads();
    if (F.tid == 0) { LAS unsigned long long* pt = (LAS unsigned long long*)(F.lds + PTAB_OFF);
#pragma unroll
        for (int i = 0; i < 35; ++i) pt[i] = (unsigned long long)a.in[i]; }
    __syncthreads();
    unsigned char* ws = a.ws; float* X = a.out;
    bf16* XN = (bf16*)(ws + WS_XN); unsigned char* T = ws + WS_T;
    const bool multi = (a.ph_hi - a.ph_lo) > 1;
    XcdBarrier bar; bar.bar = (unsigned*)(ws + WS_CTL) + CW_BAR; bar.x = 0; bar.st = nullptr;
    if (multi) bar = xcd_barrier_post((unsigned*)(ws + WS_CTL) + CW_BAR, MISC + 8);

    for (int ph = a.ph_lo; ph < a.ph_hi; ++ph) {
        { int t_ = threadIdx.x, b_ = blockIdx.x; asm volatile("" : "+v"(t_)); asm volatile("" : "+s"(b_));
          F.tid = t_; F.lane = t_ & 63; F.wave = __builtin_amdgcn_readfirstlane(t_ >> 6); F.bx = b_; F.vcu = (b_ % 8) * (F.G / 8) + b_ / 8; }
        if (ph == 0) {
            { const f32x4* xp = (const f32x4*)inp(F, 0); const f32x4* xs = (const f32x4*)inp(F, 1); f32x4* xo = (f32x4*)X; const size_t np = (size_t)MP * D / 4, nt = (size_t)M * D / 4;
              for (size_t i = (size_t)F.vcu * 512 + F.tid; i < nt; i += (size_t)F.G * 512) xo[i] = i < np ? xp[i] : xs[i - np]; }
            { const float* wsf = inp(F, 13); bf16* wm = (bf16*)(ws + WS_WM);
              for (int i = F.vcu * 512 + F.tid; i < 2 * 8 * 128 * 128; i += F.G * 512) { const int s_ = i & 127, t_ = (i >> 7) & 127; wm[i] = s_ <= t_ ? (bf16)(cvt_pk_bf16(wsf[i], 0.f) & 0xffffu) : (bf16)0; } }
            s5_tables(F, inp(F, 26), inp(F, 27), inp(F, 28), inp(F, 29), inp(F, 30), inp(F, 31), inp(F, 32), ws + WS_S5T);
            rglru_tables(F, inp(F, 19), inp(F, 21), inp(F, 20), inp(F, 22), inp(F, 23), ws + WS_RGT);
            const int gw = F.vcu * NWAVES + F.wave, NGW = F.G * NWAVES;
            for (int it0 = gw; it0 < 6144; it0 += NGW) { int it = it0;
                if (conv_job(F, it, inp(F, 11), D, 2048, (bf16*)(ws + WS_W_INA), false)) continue;
                if (conv_job(F, it, inp(F, 11) + (size_t)D * 2048, D, 2048, (bf16*)(ws + WS_W_INA + 4 * MiB), false)) continue;
                if (conv_job(F, it, inp(F, 15), D, D, (bf16*)(ws + WS_W_OUTA), false)) continue;
                if (conv_job(F, it, inp(F, 15) + (size_t)D * D, D, D, (bf16*)(ws + WS_W_OUTA + 2 * MiB), false)) continue;
                if (conv_job(F, it, inp(F, 16), D, 2048, (bf16*)(ws + WS_W_INB), false)) continue;
                if (conv_job(F, it, inp(F, 24), D, D, (bf16*)(ws + WS_W_OUTB), false)) continue;
                if (conv_job(F, it, inp(F, 25), D, D, (bf16*)(ws + WS_W_INC), false)) continue;
                conv_job(F, it, inp(F, 34), D, 2048, (bf16*)(ws + WS_W_GLU), true);
            }
        } else if (ph == PH_FINAL) {
            norm_final(F, X, inp(F, 8));
        } else {
            const int l = (ph - 1) >> 3, st = (ph - 1) & 7, kind = l % 3, j = l / 3;
            if (st == ST_NORM1) norm_rows(F, X, inp(F, 6) + l * D, XN);
            else if (st == ST_GIN) {
                if (kind == 0) { const bf16* W = (const bf16*)(ws + WS_W_INA + (size_t)j * 4 * MiB); EpiRow4<FActBf16<ACT_GELU>> E{{(bf16*)T, 2048}};
                    big_gemm(F, XN, W, 2048, D, E); small_gemm<2>(F, XN, W, D, E.f); }
                else if (kind == 1) { const bf16* W = (const bf16*)(ws + WS_W_INB); EpiRow4<FRglru> E{{(bf16*)T, (float*)(T + 33 * MiB)}};
                    big_gemm(F, XN, W, 2048, D, E); small_gemm<2>(F, XN, W, D, E.f); }
                else { const bf16* W = (const bf16*)(ws + WS_W_INC); EpiRow4<FF32> E{{(float*)T, D}};
                    big_gemm(F, XN, W, D, D, E); small_gemm<1>(F, XN, W, D, E.f); }
            } else if (st == ST_MIXA) {
                if (kind == 2) s5_phase(F, (const float*)T, XN, inp(F, 33), ws + WS_S5T, inp(F, 4), inp(F, 5), X);
                if (kind == 1) rglru_phase(F, (const float*)(T + 33 * MiB), (const bf16*)T, XN, inp(F, 17), inp(F, 18), ws + WS_RGT, inp(F, 2), inp(F, 3), X);
                if (kind == 0) vstat_phase(F, (const bf16*)T, inp(F, 12) + j * 1024, (float*)(ws + WS_RSV), X + O_VS + (size_t)j * MS * 1024);
            } else if (st == ST_MIXB) {
                if (kind == 0) sgu_mix_phase(F, (const bf16*)T, (const float*)(ws + WS_RSV), inp(F, 12) + j * 1024, (const bf16*)(ws + WS_WM) + (size_t)j * 8 * 128 * 128, inp(F, 14) + j * 8 * 128, inp(F, 13) + (size_t)j * 8 * 128 * 128, XN);
            } else if (st == ST_GOUT) {
                if (kind == 2) { const bf16* W = (const bf16*)(ws + WS_W_GLU); EpiPair4<FGlu> E{{X}};
                    big_gemm(F, XN, W, 2048, D, E); small_gemm_glu(F, XN, W, D, E.f); }
                else { const bf16* W = kind == 0 ? (const bf16*)(ws + WS_W_OUTA + (size_t)j * 2 * MiB) : (const bf16*)(ws + WS_W_OUTB); EpiRow4<FResid> E{{X}};
                    big_gemm(F, XN, W, D, D, E); small_gemm<1>(F, XN, W, D, E.f); }
            } else if (st == ST_NORM2) {
                norm_rows(F, X, inp(F, 7) + l * D, XN);
                const int gw = F.vcu * NWAVES + F.wave, NGW = F.G * NWAVES;
                for (int it0 = gw; it0 < 4096; it0 += NGW) { int it = it0;
                    if (conv_job(F, it, inp(F, 9) + (size_t)l * D * FF, D, FF, (bf16*)(ws + WS_W_FF1), false)) continue;
                    conv_job(F, it, inp(F, 10) + (size_t)l * FF * D, FF, D, (bf16*)(ws + WS_W_FF2), false);
                }
            } else if (st == ST_FF1) {
                const bf16* W = (const bf16*)(ws + WS_W_FF1); EpiRow4<FActBf16<ACT_SQRELU>> E{{(bf16*)T, FF}};
                big_gemm(F, XN, W, FF, D, E); small_gemm<4>(F, XN, W, D, E.f);
            } else if (st == ST_FF2) {
                const bf16* W = (const bf16*)(ws + WS_W_FF2); EpiRow4<FResid> E{{X}};
                big_gemm(F, (const bf16*)T, W, D, FF, E); small_gemm<1>(F, (const bf16*)T, W, FF, E.f);
            }
        }
        { const int st_ = (ph - 1) & 7, kind_ = ((ph - 1) >> 3) % 3;
          const bool empty = ph > 0 && ph < PH_FINAL && st_ == ST_MIXB && kind_ != 0;
          if (ph + 1 < a.ph_hi && !empty) xcd_barrier(bar); }
    }
}

static void launch_mk(const Args& base, int lo, int hi, hipStream_t stream) {
    Args a = base; a.ph_lo = lo; a.ph_hi = hi;
    hipLaunchKernelGGL(mk, dim3(256), dim3(NWAVES * 64), LDS_BYTES, stream, a);
}

extern "C" void kernel_launch(void* const* d_in, const int* in_sizes, int n_in, void* d_out, int out_size, void* d_ws, size_t ws_size, hipStream_t stream) {
    static int inited = 0;
    if (!inited) {
        if (n_in != 35 || out_size != (int)O_END || ws_size < WS_END) { fprintf(stderr, "kernel_launch: unexpected sizes n_in %d out %d ws %zu\n", n_in, out_size, ws_size); }
        if (hipFuncSetAttribute((const void*)mk, hipFuncAttributeMaxDynamicSharedMemorySize, LDS_BYTES) != hipSuccess) fprintf(stderr, "kernel_launch: hipFuncSetAttribute failed\n");
        (void)hipGetLastError(); inited = 1;
    }
    (void)hipMemsetAsync((unsigned char*)d_ws + WS_CTL, 0, CTL_ZERO_BYTES, stream);
    Args base{}; for (int i = 0; i < 35; ++i) base.in[i] = (const float*)d_in[i]; base.out = (float*)d_out; base.ws = (unsigned char*)d_ws;
    launch_mk(base, 0, PH_END, stream);
}
```

```cpp
#include <hip/hip_runtime.h>
#include <cstdio>
#include <cstdint>

constexpr int MP = 16384, MS = 512, M = MP + MS, D = 1024, FF = 4096;
constexpr float EPS = 1e-6f;

constexpr size_t O_YP = 0, O_YS = (size_t)MP * D, O_VS = O_YS + (size_t)MS * D, O_CONVP = O_VS + 2 * (size_t)MS * D, O_HP = O_CONVP + 8 * 3 * 1024,
                 O_CONVS = O_HP + 8 * 1024, O_HS = O_CONVS + 128 * 3 * 1024, O_SREP = O_HS + 128 * 1024, O_SIMP = O_SREP + 8 * 4096, O_SRES = O_SIMP + 8 * 4096,
                 O_SIMS = O_SRES + 128 * 4096, O_END = O_SIMS + 128 * 4096;

constexpr size_t MiB = 1u << 20;
constexpr size_t WS_CTL = 0, CTL_ZERO_BYTES = 64 * 1024;
constexpr size_t WS_XN = 1 * MiB;
constexpr size_t WS_T = 34 * MiB;
constexpr size_t WS_RSV = 128 * 1024;
constexpr size_t WS_WM = 166 * MiB;
constexpr size_t WS_RGT = 167 * MiB;
constexpr size_t WS_S5T = 168 * MiB;
constexpr size_t WS_S5AB = 170 * MiB;
constexpr size_t WS_S5BB = 170 * MiB + 512 * 1024;
constexpr size_t WS_HST = 171 * MiB;
constexpr size_t WS_S5ST = 172 * MiB;
constexpr size_t WS_CHA = 176 * MiB;
constexpr size_t WS_CHB = 180 * MiB;
constexpr size_t WS_XSR = 184 * MiB;
constexpr size_t WS_XSI = 200 * MiB;
constexpr size_t WS_W_INA = 216 * MiB, WS_W_OUTA = 224 * MiB, WS_W_INB = 228 * MiB, WS_W_OUTB = 232 * MiB, WS_W_INC = 234 * MiB, WS_W_GLU = 236 * MiB,
                 WS_W_FF1 = 240 * MiB, WS_W_FF2 = 248 * MiB, WS_END = 256 * MiB;
constexpr int CW_BAR = 4096;

#define GAS __attribute__((address_space(1)))
#define LAS __attribute__((address_space(3)))
typedef unsigned short bf16;
typedef unsigned v4u __attribute__((ext_vector_type(4)));
typedef float f32x4 __attribute__((ext_vector_type(4)));
typedef short bf16x8 __attribute__((ext_vector_type(8)));
typedef GAS unsigned gu32;
typedef GAS unsigned long long gu64;
#define RLX_AGENT __ATOMIC_RELAXED, __HIP_MEMORY_SCOPE_AGENT
#define LDS_WAIT() asm volatile("s_waitcnt lgkmcnt(0)" ::: "memory")
#define VM_WAIT() asm volatile("s_waitcnt vmcnt(0)" ::: "memory")
__device__ __forceinline__ unsigned long long rt() { return __builtin_amdgcn_s_memrealtime(); }
__device__ __forceinline__ unsigned f2bf(float f) { unsigned u = __builtin_bit_cast(unsigned, f); return (u + 0x7fffu + ((u >> 16) & 1u)) >> 16; }
__device__ __forceinline__ unsigned pk2(float lo, float hi) { return f2bf(lo) | (f2bf(hi) << 16); }

#define XB_TMO      128
#define XB_XCNT(j)  (256  + 64 * (j))
#define XB_XSUB(j)  (1280 + 64 * (j))
#define XB_XGEN(j)  (2304 + 64 * (j))
#define XB_TOP      3328
#define XB_TOPGEN   3392
#define XCD_BAR_WORDS 3456
#define XB_SPIN_CAP (1u << 18)

__device__ __forceinline__ unsigned xb_ld(unsigned* p)              { return __hip_atomic_load(p, __ATOMIC_RELAXED, __HIP_MEMORY_SCOPE_AGENT); }
__device__ __forceinline__ unsigned xb_add(unsigned* p, unsigned v) { return __hip_atomic_fetch_add(p, v, __ATOMIC_RELAXED, __HIP_MEMORY_SCOPE_AGENT); }
__device__ __forceinline__ unsigned xb_xcc_id() { return (unsigned)__builtin_amdgcn_s_getreg((3 << 11) | 20) & 0xFu; }
#define XB_SPIN(cond, bar) do { unsigned _sp = 0; while (cond) { __builtin_amdgcn_s_sleep(1); \
    if ((++_sp & 255u) == 0u) { if (xb_ld(&(bar)[XB_TMO])) break; if (_sp > XB_SPIN_CAP) { atomicAdd(&(bar)[XB_TMO], 1u); break; } } } } while (0)

struct XcdBarrier {
    unsigned* bar; unsigned x;
    volatile LAS unsigned* st;
};

__device__ __forceinline__ XcdBarrier xcd_barrier_post(unsigned* bar, volatile LAS unsigned* st) {
    XcdBarrier b; b.bar = bar; b.x = xb_xcc_id(); b.st = st;
    if (threadIdx.x == 0) (void)xb_add(&bar[XB_XCNT(b.x)], 1u);
    return b;
}
__device__ __forceinline__ void xcd_barrier_complete(unsigned* bar, unsigned x, unsigned& nloc, unsigned& nx) {
    const unsigned G = gridDim.x * gridDim.y * gridDim.z;
    unsigned sum, cnt, mine, sp = 0u;
    for (;;) {
        sum = 0u; cnt = 0u; mine = 0u;
#pragma unroll
        for (unsigned j = 0; j < 16; ++j) { const unsigned c = xb_ld(&bar[XB_XCNT(j)]); sum += c; cnt += (c > 0u) ? 1u : 0u; mine = (j == x) ? c : mine; }
        if (sum == G) break;
        __builtin_amdgcn_s_sleep(1);
        if ((++sp & 255u) == 0u) { if (xb_ld(&bar[XB_TMO])) break; if (sp > XB_SPIN_CAP) { atomicAdd(&bar[XB_TMO], 1u); break; } }
    }
    nloc = mine > 0u ? mine : 1u; nx = cnt > 0u ? cnt : 1u;
}

__device__ __forceinline__ void xcd_barrier(const XcdBarrier& b) {
    asm volatile("s_waitcnt vmcnt(0)" ::: "memory");
    __syncthreads();
    if (threadIdx.x == 0) {
        unsigned* bar = b.bar;
        __builtin_amdgcn_s_waitcnt(0);
        unsigned nloc = b.st[0], nx = b.st[1];
        if (nloc == 0u) { xcd_barrier_complete(bar, b.x, nloc, nx); b.st[0] = nloc; b.st[1] = nx; }
        const unsigned old = xb_add(&bar[XB_XSUB(b.x)], 1u);
        const unsigned gen = old / nloc;
        if (old + 1u == (gen + 1u) * nloc) {
            __builtin_amdgcn_fence(__ATOMIC_RELEASE, "agent");
            asm volatile("s_waitcnt vmcnt(0)" ::: "memory");
            const unsigned og = xb_add(&bar[XB_TOP], 1u);
            const unsigned tg = og / nx;
            if (og + 1u == (tg + 1u) * nx) xb_add(&bar[XB_TOPGEN], 1u);
            else XB_SPIN(xb_ld(&bar[XB_TOPGEN]) == tg, bar);
            __builtin_amdgcn_fence(__ATOMIC_ACQUIRE, "agent");
            xb_add(&bar[XB_XGEN(b.x)], 1u);
            asm volatile("s_waitcnt vmcnt(0)" ::: "memory");
        } else {
            XB_SPIN(xb_ld(&bar[XB_XGEN(b.x)]) == gen, bar);
            __builtin_amdgcn_fence(__ATOMIC_ACQUIRE, "agent");
            asm volatile("s_waitcnt vmcnt(0)" ::: "memory");
        }
    }
    __syncthreads();
}
namespace pg8 {
#define PG8_LAS __attribute__((address_space(3)))
typedef unsigned short bf16_t;
typedef short bf16x8 __attribute__((ext_vector_type(8)));
typedef float f32x4 __attribute__((ext_vector_type(4)));
typedef unsigned u32x4 __attribute__((ext_vector_type(4)));
constexpr int BM = 256, BK = 64, HALF = 128, HTB = HALF * BK * 2  , STAGE_BYTES = 8 * HTB, NXCD = 8, WGM = 8;

__host__ __device__ __forceinline__ int lds_byte(int r, int c) { const int st = (r >> 4) * 2 + (c >> 5), rr = r & 15, cc = c & 31, ob = rr * 64 + cc * 2; return st * 1024 + (ob ^ (((ob >> 9) & 1) << 5)); }
__host__ __device__ __forceinline__ void stage_rc(int b, int& R, int& C) { const int st = b / 1024, sb = b % 1024, swz = sb ^ (((sb >> 9) & 1) << 5); R = (st >> 1) * 16 + swz / 64; C = (st & 1) * 32 + (swz % 64) / 2; }
__host__ __device__ __forceinline__ int perm32(int rho) { const int n = rho >> 4, i = rho & 15; return 8 * (i >> 2) + 4 * n + (i & 3); }

struct Unit { int pm, pn; };
struct Gemm { const bf16_t* A; const bf16_t* Bt; int M, N, K; };

struct StaticOrder {
    int nM, nN, nwg, G, c;
    __host__ __device__ void init(int M, int N, int G_, int c_) { nM = M / BM; nN = N / BM; nwg = nM * nN; G = G_; c = c_; }
    __host__ __device__ bool next(int i, Unit& u) const {
        const long L = (long)i * G + c; if (L >= nwg) return false;
        int wgid = (int)L; { const int q = nwg / NXCD, r = nwg % NXCD, xcd = wgid % NXCD, off = wgid / NXCD; wgid = (xcd < r ? xcd * (q + 1) : r * (q + 1) + (xcd - r) * q) + off; }
        const int nig = WGM * nN, gid = wgid / nig, fm = gid * WGM, gsz = (nM - fm) < WGM ? (nM - fm) : WGM;
        u.pm = fm + ((wgid % nig) % gsz); u.pn = (wgid % nig) / gsz; return true;
    }
    __device__ __forceinline__ void a_ready(const Unit&) const {}
    __device__ __forceinline__ void done(const Unit&) const {}
};

template <class Epi, class Sched, bool ALIGN_EPI = false, bool SP2 = false>
__device__ __forceinline__ void gemm_phase(PG8_LAS unsigned char* lds, const Gemm g, const Sched& S, const Epi& E, const int tid_in) {
    const int tid = tid_in, wid = __builtin_amdgcn_readfirstlane(tid >> 6), lane = tid & 63, wr = wid >> 2, wc = wid & 3, fr = lane & 15, fq = lane >> 4;
    const int K = g.K, nt = K / BK;
    unsigned voffA[2], voffB[2];
#pragma unroll
    for (int i = 0; i < 2; ++i) { int R, C; stage_rc(tid * 16 + i * 8192, R, C); const int Rb = Epi::PERM ? ((R & ~31) + perm32(R & 31)) : R;
        voffA[i] = (unsigned)(R * K + C) * 2u; voffB[i] = (unsigned)(Rb * K + C) * 2u; }
    const size_t kstep = (size_t)(BK * 2);
    const size_t hstep = (size_t)HALF * K * 2;
    const size_t tstep = 2 * hstep;
    const unsigned ldsw = (unsigned)wid * 1024u;
    const int aoff = lds_byte(wr * 64 + fr, fq * 8), boff = lds_byte(wc * 32 + fr, fq * 8);
#define PG8_SA(b, h) (((b) * 2 + (h)) * HTB)
#define PG8_SB(b, h) ((4 + (b) * 2 + (h)) * HTB)
#define PG8_STAGE(bufoff, gbase, voff) do { _Pragma("unroll") for (int _i = 0; _i < 2; ++_i) \
        __builtin_amdgcn_global_load_lds((const unsigned*)((const char*)(gbase) + (voff)[_i]), (PG8_LAS unsigned*)(lds + (bufoff) + ldsw + _i * 8192), 16, 0, 0); } while (0)
#define PG8_LDA(dst, b, h) do { _Pragma("unroll") for (int m = 0; m < 4; ++m) _Pragma("unroll") for (int k = 0; k < 2; ++k) dst[m][k] = *(const PG8_LAS bf16x8*)(lds + PG8_SA(b, h) + aoff + m * 2048 + k * 1024); } while (0)
#define PG8_LDB(dst, b, h) do { _Pragma("unroll") for (int n = 0; n < 2; ++n) _Pragma("unroll") for (int k = 0; k < 2; ++k) dst[n][k] = *(const PG8_LAS bf16x8*)(lds + PG8_SB(b, h) + boff + n * 2048 + k * 1024); } while (0)
#define PG8_MMA(ai, bj, At, Bt) do { __builtin_amdgcn_s_setprio(1); _Pragma("unroll") for (int m = 0; m < 4; ++m) _Pragma("unroll") for (int n = 0; n < 2; ++n) _Pragma("unroll") for (int k = 0; k < 2; ++k) \
        acc[ai][bj][m][n] = __builtin_amdgcn_mfma_f32_16x16x32_bf16(Bt[n][k], At[m][k], acc[ai][bj][m][n], 0, 0, 0); __builtin_amdgcn_s_setprio(0); } while (0)
#define PG8_WAIT_V(n) asm volatile("s_waitcnt vmcnt(" #n ")" ::: "memory")
#define PG8_WAIT_L(n) asm volatile("s_waitcnt lgkmcnt(" #n ")" ::: "memory")
#define PG8_BAR __builtin_amdgcn_s_barrier()
#define PG8_SCHED __builtin_amdgcn_sched_barrier(0)
    Unit cur, nxt; int ui = 0;
    if (!S.next(0, cur)) return;
    E.first(lds, cur, tid);
    f32x4 acc[2][2][4][2];
#pragma unroll
    for (int a = 0; a < 2; ++a)
#pragma unroll
        for (int b = 0; b < 2; ++b)
#pragma unroll
            for (int m = 0; m < 4; ++m)
#pragma unroll
                for (int n = 0; n < 2; ++n) acc[a][b][m][n] = (f32x4){0.f, 0.f, 0.f, 0.f};
    bf16x8 At[4][2], B0[2][2], B1[2][2];
    const char* cA = (const char*)g.A + (size_t)cur.pm * tstep; const char* cB = (const char*)g.Bt + (size_t)cur.pn * tstep;
    S.a_ready(cur);
    if constexpr (SP2) {
        PG8_STAGE(PG8_SB(0, 0), cB, voffB); PG8_STAGE(PG8_SB(0, 1), cB + hstep, voffB); PG8_STAGE(PG8_SA(0, 0), cA, voffA); PG8_STAGE(PG8_SA(0, 1), cA + hstep, voffA);
        if (wr == 1) PG8_BAR;
        PG8_WAIT_V(2); PG8_BAR;
        PG8_STAGE(PG8_SB(1, 0), cB + kstep, voffB); PG8_STAGE(PG8_SA(1, 0), cA + kstep, voffA); PG8_STAGE(PG8_SB(1, 1), cB + hstep + kstep, voffB);
        PG8_WAIT_V(6); PG8_BAR;
    } else {
        PG8_STAGE(PG8_SB(0, 0), cB, voffB); PG8_STAGE(PG8_SA(0, 0), cA, voffA); PG8_STAGE(PG8_SB(0, 1), cB + hstep, voffB); PG8_STAGE(PG8_SA(0, 1), cA + hstep, voffA);
        if (wr == 1) PG8_BAR;
        PG8_WAIT_V(4); PG8_BAR;
        PG8_STAGE(PG8_SB(1, 0), cB + kstep, voffB); PG8_STAGE(PG8_SA(1, 0), cA + kstep, voffA); PG8_STAGE(PG8_SB(1, 1), cB + hstep + kstep, voffB);
        PG8_WAIT_V(6); PG8_BAR;
    }
    for (;;) {
        const bool has_next = S.next(ui + 1, nxt);
        const char* nA = has_next ? (const char*)g.A + (size_t)nxt.pm * tstep : cA; const char* nB = has_next ? (const char*)g.Bt + (size_t)nxt.pn * tstep : cB;
        for (int t = 0; t < nt; t += 2) {
            const bool last = (t == nt - 2);
            const char* a1 = cA + (size_t)(t + 1) * kstep;
            const char* a2 = last ? nA : cA + (size_t)(t + 2) * kstep; const char* b2 = last ? nB : cB + (size_t)(t + 2) * kstep;
            const char* a3 = a2 + kstep; const char* b3 = b2 + kstep;
            if (last && has_next) S.a_ready(nxt);
            if constexpr (SP2) {
            PG8_LDB(B0, 0, 0); PG8_LDB(B1, 0, 1); PG8_SCHED; PG8_LDA(At, 0, 0); PG8_STAGE(PG8_SA(1, 1), a1 + hstep, voffA);
            PG8_WAIT_V(8); PG8_WAIT_L(0); PG8_BAR; PG8_MMA(0, 0, At, B0); PG8_MMA(0, 1, At, B1); PG8_BAR; PG8_SCHED;
            PG8_LDA(At, 0, 1); PG8_STAGE(PG8_SB(0, 0), b2, voffB); PG8_STAGE(PG8_SB(0, 1), b2 + hstep, voffB); PG8_STAGE(PG8_SA(0, 0), a2, voffA);
            PG8_WAIT_V(8); PG8_WAIT_L(0); PG8_BAR; PG8_MMA(1, 0, At, B0); PG8_MMA(1, 1, At, B1); PG8_BAR; PG8_SCHED;
            PG8_LDB(B0, 1, 0); PG8_LDB(B1, 1, 1); PG8_SCHED; PG8_LDA(At, 1, 0); PG8_STAGE(PG8_SA(0, 1), a2 + hstep, voffA);
            PG8_WAIT_V(8); PG8_WAIT_L(0); PG8_BAR; PG8_MMA(0, 0, At, B0); PG8_MMA(0, 1, At, B1); PG8_BAR; PG8_SCHED;
            PG8_LDA(At, 1, 1); PG8_STAGE(PG8_SB(1, 0), b3, voffB); PG8_STAGE(PG8_SB(1, 1), b3 + hstep, voffB); PG8_STAGE(PG8_SA(1, 0), a3, voffA);
            PG8_WAIT_V(8); PG8_WAIT_L(0); PG8_BAR; PG8_MMA(1, 0, At, B0); PG8_MMA(1, 1, At, B1); PG8_BAR; PG8_SCHED;
            } else {
            PG8_LDB(B0, 0, 0); PG8_SCHED; PG8_LDA(At, 0, 0); PG8_STAGE(PG8_SA(1, 1), a1 + hstep, voffA);
            PG8_WAIT_L(8); PG8_BAR; PG8_WAIT_L(0); PG8_MMA(0, 0, At, B0); PG8_BAR; PG8_SCHED;
            PG8_LDB(B1, 0, 1); PG8_STAGE(PG8_SB(0, 0), b2, voffB);
            PG8_BAR; PG8_WAIT_L(0); PG8_MMA(0, 1, At, B1); PG8_BAR;
            PG8_LDA(At, 0, 1); PG8_STAGE(PG8_SA(0, 0), a2, voffA);
            PG8_BAR; PG8_WAIT_L(0); PG8_MMA(1, 0, At, B0); PG8_BAR; PG8_SCHED;
            PG8_STAGE(PG8_SB(0, 1), b2 + hstep, voffB);
            PG8_WAIT_V(6); PG8_BAR; PG8_MMA(1, 1, At, B1); PG8_BAR;
            PG8_LDB(B0, 1, 0); PG8_SCHED; PG8_LDA(At, 1, 0); PG8_STAGE(PG8_SA(0, 1), a2 + hstep, voffA);
            PG8_WAIT_L(8); PG8_BAR; PG8_WAIT_L(0); PG8_MMA(0, 0, At, B0); PG8_BAR; PG8_SCHED;
            PG8_LDB(B1, 1, 1); PG8_STAGE(PG8_SB(1, 0), b3, voffB);
            PG8_BAR; PG8_WAIT_L(0); PG8_MMA(0, 1, At, B1); PG8_BAR;
            PG8_LDA(At, 1, 1); PG8_STAGE(PG8_SA(1, 0), a3, voffA);
            PG8_BAR; PG8_WAIT_L(0); PG8_MMA(1, 0, At, B0); PG8_BAR; PG8_SCHED;
            PG8_STAGE(PG8_SB(1, 1), b3 + hstep, voffB);
            PG8_WAIT_V(6); PG8_BAR; PG8_MMA(1, 1, At, B1); PG8_BAR;
            }
        }
        if constexpr (ALIGN_EPI) { if (wr == 0) PG8_BAR; }
        if constexpr (!Epi::AFTER_DRAIN) { E(acc, cur, wr, wc, fr, fq, lds, nxt, has_next, ui, tid); S.done(cur); }
        if (!has_next) break;
#pragma unroll
        for (int a = 0; a < 2; ++a)
#pragma unroll
            for (int b = 0; b < 2; ++b)
#pragma unroll
                for (int m = 0; m < 4; ++m)
#pragma unroll
                    for (int n = 0; n < 2; ++n) acc[a][b][m][n] = (f32x4){0.f, 0.f, 0.f, 0.f};
        cur = nxt; cA = nA; cB = nB; ++ui;
        if constexpr (ALIGN_EPI) { if (wr == 1) PG8_BAR; }
    }
    PG8_WAIT_V(0);
    if constexpr (!ALIGN_EPI) { if (wr == 0) PG8_BAR; }
    PG8_BAR;
    if constexpr (Epi::AFTER_DRAIN) { E.fused(acc, cur, wr, wc, fr, fq, lds, wid, lane); S.done(cur); }
#undef PG8_SA
#undef PG8_SB
#undef PG8_STAGE
#undef PG8_LDA
#undef PG8_LDB
#undef PG8_MMA
#undef PG8_WAIT_V
#undef PG8_WAIT_L
#undef PG8_BAR
#undef PG8_SCHED
}
}
__device__ __forceinline__ float bf2f(unsigned short h) { return __builtin_bit_cast(float, (unsigned)h << 16); }
__device__ __forceinline__ float gelu_tanh(float x) { const float u = 0.7978845608028654f * (x + 0.044715f * x * x * x); return 0.5f * x * (1.f + tanhf(u)); }
__device__ __forceinline__ float sigmoidf_(float x) { return 1.f / (1.f + expf(-x)); }
template <int CTRL> __device__ __forceinline__ float dpp0(float src) { return __builtin_bit_cast(float, __builtin_amdgcn_update_dpp(0, __builtin_bit_cast(int, src), CTRL, 0xf, 0xf, true)); }
__device__ __forceinline__ float xor16f(float v) { return __shfl_xor(v, 16); }
__device__ __forceinline__ float sum32f(float v) { return v + __shfl_xor(v, 32); }
__device__ __forceinline__ float wave_sum(float v) {
#pragma unroll
    for (int o = 1; o < 64; o <<= 1) v += __shfl_xor(v, o);
    return v;
}
__device__ __forceinline__ unsigned cvt_pk_bf16(float lo, float hi) { unsigned r; asm volatile("v_cvt_pk_bf16_f32 %0, %1, %2" : "=v"(r) : "v"(lo), "v"(hi)); return r; }
__device__ __forceinline__ float gelu_fast(float x) { const float u = x * (0.7978845608028654f + 0.035677408136300125f * x * x); return x * __builtin_amdgcn_rcpf(1.f + __builtin_amdgcn_exp2f(-2.8853900817779268f * u)); }
__device__ __forceinline__ float sigmoid_fast(float x) { return __builtin_amdgcn_rcpf(1.f + __builtin_amdgcn_exp2f(-1.4426950408889634f * x)); }
enum { ACT_GELU = 0, ACT_SQRELU = 1 };
typedef unsigned u32x2 __attribute__((ext_vector_type(2)));
struct RowCtx { float rs, ss; };
constexpr int XS_P = 32, XS_S = 64, VS_P = 16, VS_S = 32;
template <int N4> __device__ __forceinline__ float sum_slots_n(const float* p) { f32x4 v[N4];
#pragma unroll
    for (int i = 0; i < N4; ++i) v[i] = ((const f32x4*)p)[i];
    float s = 0.f;
#pragma unroll
    for (int i = 0; i < N4; ++i) s += (v[i].x + v[i].y) + (v[i].z + v[i].w);
    return s; }
__device__ __forceinline__ float sum_slots(const float* p, int n4) { return n4 == 4 ? sum_slots_n<4>(p) : (n4 == 8 ? sum_slots_n<8>(p) : sum_slots_n<16>(p)); }
__device__ __forceinline__ float rs_x(const float* P, int nslot, int row) {
    const float s = row < MP ? sum_slots(P + (size_t)row * XS_P, nslot >> 2) : sum_slots(P + (size_t)MP * XS_P + (size_t)(row - MP) * XS_S, XS_S >> 2); return rsqrtf(s * (1.f / 1024.f) + EPS); }
__device__ __forceinline__ float rs_v(const float* P, int row) {
    const float s = row < MP ? sum_slots(P + (size_t)row * VS_P, VS_P >> 2) : sum_slots(P + (size_t)MP * VS_P + (size_t)(row - MP) * VS_S, VS_S >> 2); return rsqrtf(s * (1.f / 1024.f) + EPS); }
__device__ __forceinline__ float fq_sum(float ss) { ss += xor16f(ss); return sum32f(ss); }
__device__ __forceinline__ void xs_store(float* P, int row, int col, bool pair, float ss, int fq) {
    ss = fq_sum(ss); if (fq != 0) return;
    if (row < MP) P[(size_t)row * XS_P + (pair ? (col >> 5) : (((col >> 8) << 2) | ((col >> 5) & 3)))] = ss; else P[(size_t)MP * XS_P + (size_t)(row - MP) * XS_S + (col >> 4)] = ss; }
__device__ __forceinline__ void vs_store(float* P, int row, int col, float ss, int fq) {
    ss = fq_sum(ss); if (fq != 0) return; const int c = col - 1024;
    if (row < MP) P[(size_t)row * VS_P + (((c >> 8) << 2) | ((c >> 5) & 3))] = ss; else P[(size_t)MP * VS_P + (size_t)(row - MP) * VS_S + (c >> 5)] = ss; }
constexpr int RSTAB_OFF = 131072 + 2048;
__device__ __forceinline__ LAS float* rstab(LAS unsigned char* lds, int par) { return (LAS float*)(lds + RSTAB_OFF) + par * 256; }
template <int ACT> __device__ __forceinline__ float act_f(float x) { if (ACT == ACT_GELU) return gelu_fast(x); const float t = fmaxf(x, 0.f); return t * t; }

template <int ACT, bool VSTAT> struct FAct { bf16* O; int ldc; const float* S; int nslot; float* SV;
    __device__ __forceinline__ RowCtx begin(int row) const { return RowCtx{rs_x(S, nslot, row), 0.f}; }
    __device__ __forceinline__ float rs_row(int row) const { return rs_x(S, nslot, row); }
    __device__ __forceinline__ void apply8(RowCtx& c, int row, int col, f32x4 v0, f32x4 v1) const {
        float r[8];
#pragma unroll
        for (int i = 0; i < 4; ++i) { r[i] = act_f<ACT>(v0[i] * c.rs); r[4 + i] = act_f<ACT>(v1[i] * c.rs); }
        if (VSTAT && col >= 1024) {
#pragma unroll
            for (int i = 0; i < 8; ++i) c.ss += r[i] * r[i]; }
        v4u w; w.x = cvt_pk_bf16(r[0], r[1]); w.y = cvt_pk_bf16(r[2], r[3]); w.z = cvt_pk_bf16(r[4], r[5]); w.w = cvt_pk_bf16(r[6], r[7]); *(v4u*)(O + (size_t)row * ldc + col) = w; }
    __device__ __forceinline__ void apply4(RowCtx& c, int row, int col, f32x4 v) const {
        float r[4];
#pragma unroll
        for (int i = 0; i < 4; ++i) r[i] = act_f<ACT>(v[i] * c.rs);
        if (VSTAT && col >= 1024) c.ss += (r[0] * r[0] + r[1] * r[1]) + (r[2] * r[2] + r[3] * r[3]);
        u32x2 w; w.x = cvt_pk_bf16(r[0], r[1]); w.y = cvt_pk_bf16(r[2], r[3]); *(u32x2*)(O + (size_t)row * ldc + col) = w; }
    __device__ __forceinline__ void end(RowCtx& c, int row, int col, int fq) const { if (VSTAT && col >= 1024) vs_store(SV, row, col, c.ss, fq); } };
struct FRglru { bf16* G; float* XB; const float* S;
    __device__ __forceinline__ RowCtx begin(int row) const { return RowCtx{rs_x(S, 16, row), 0.f}; }
    __device__ __forceinline__ float rs_row(int row) const { return rs_x(S, 16, row); }
    __device__ __forceinline__ void apply8(RowCtx& c, int row, int col, f32x4 v0, f32x4 v1) const {
        if (col < 1024) { v4u w; w.x = cvt_pk_bf16(gelu_fast(v0[0] * c.rs), gelu_fast(v0[1] * c.rs)); w.y = cvt_pk_bf16(gelu_fast(v0[2] * c.rs), gelu_fast(v0[3] * c.rs));
            w.z = cvt_pk_bf16(gelu_fast(v1[0] * c.rs), gelu_fast(v1[1] * c.rs)); w.w = cvt_pk_bf16(gelu_fast(v1[2] * c.rs), gelu_fast(v1[3] * c.rs)); *(v4u*)(G + (size_t)row * 1024 + col) = w; }
        else { float* p = XB + (size_t)row * 1024 + col - 1024; *(f32x4*)p = v0 * c.rs; *(f32x4*)(p + 4) = v1 * c.rs; } }
    __device__ __forceinline__ void apply4(RowCtx& c, int row, int col, f32x4 v) const {
        if (col < 1024) { u32x2 w; w.x = cvt_pk_bf16(gelu_fast(v[0] * c.rs), gelu_fast(v[1] * c.rs)); w.y = cvt_pk_bf16(gelu_fast(v[2] * c.rs), gelu_fast(v[3] * c.rs)); *(u32x2*)(G + (size_t)row * 1024 + col) = w; }
        else *(f32x4*)(XB + (size_t)row * 1024 + col - 1024) = v * c.rs; }
    __device__ __forceinline__ void end(RowCtx&, int, int, int) const {} };
struct FF32 { float* O; int ldc; const float* S;
    __device__ __forceinline__ RowCtx begin(int row) const { return RowCtx{rs_x(S, 16, row), 0.f}; }
    __device__ __forceinline__ float rs_row(int row) const { return rs_x(S, 16, row); }
    __device__ __forceinline__ void apply8(RowCtx& c, int row, int col, f32x4 v0, f32x4 v1) const { float* p = O + (size_t)row * ldc + col; *(f32x4*)p = v0 * c.rs; *(f32x4*)(p + 4) = v1 * c.rs; }
    __device__ __forceinline__ void apply4(RowCtx& c, int row, int col, f32x4 v) const { *(f32x4*)(O + (size_t)row * ldc + col) = v * c.rs; }
    __device__ __forceinline__ void end(RowCtx&, int, int, int) const {} };
struct FResid { float* X; bf16* XB16; float* Sacc;
    __device__ __forceinline__ RowCtx begin(int) const { return RowCtx{0.f, 0.f}; }
    __device__ __forceinline__ void load8(int row, int col, f32x4& xa, f32x4& xb) const { const float* p = X + (size_t)row * D + col; xa = *(const f32x4*)p; xb = *(const f32x4*)(p + 4); }
    __device__ __forceinline__ void apply8x(RowCtx& c, int row, int col, f32x4 v0, f32x4 v1, f32x4 xa, f32x4 xb) const { float* p = X + (size_t)row * D + col;
        const f32x4 x0 = xa + v0, x1 = xb + v1; *(f32x4*)p = x0; *(f32x4*)(p + 4) = x1;
        c.ss += (x0[0] * x0[0] + x0[1] * x0[1]) + (x0[2] * x0[2] + x0[3] * x0[3]) + (x1[0] * x1[0] + x1[1] * x1[1]) + (x1[2] * x1[2] + x1[3] * x1[3]);
        v4u w; w.x = cvt_pk_bf16(x0[0], x0[1]); w.y = cvt_pk_bf16(x0[2], x0[3]); w.z = cvt_pk_bf16(x1[0], x1[1]); w.w = cvt_pk_bf16(x1[2], x1[3]); *(v4u*)(XB16 + (size_t)row * D + col) = w; }
    __device__ __forceinline__ void apply4(RowCtx& c, int row, int col, f32x4 v) const { float* p = X + (size_t)row * D + col; const f32x4 x0 = *(const f32x4*)p + v; *(f32x4*)p = x0;
        c.ss += (x0[0] * x0[0] + x0[1] * x0[1]) + (x0[2] * x0[2] + x0[3] * x0[3]);
        u32x2 w; w.x = cvt_pk_bf16(x0[0], x0[1]); w.y = cvt_pk_bf16(x0[2], x0[3]); *(u32x2*)(XB16 + (size_t)row * D + col) = w; }
    __device__ __forceinline__ void end(RowCtx& c, int row, int col, int fq) const { xs_store(Sacc, row, col, false, c.ss, fq); } };
struct FGlu { float* X; bf16* XB16; float* Sacc;
    __device__ __forceinline__ RowCtx begin(int) const { return RowCtx{0.f, 0.f}; }
    __device__ __forceinline__ void apply4_pair(RowCtx& c, int row, int col, f32x4 a, f32x4 b) const { float* p = X + (size_t)row * D + col; f32x4 x0 = *(const f32x4*)p;
#pragma unroll
        for (int i = 0; i < 4; ++i) x0[i] += a[i] * sigmoid_fast(b[i]);
        *(f32x4*)p = x0; c.ss += (x0[0] * x0[0] + x0[1] * x0[1]) + (x0[2] * x0[2] + x0[3] * x0[3]);
        u32x2 w; w.x = cvt_pk_bf16(x0[0], x0[1]); w.y = cvt_pk_bf16(x0[2], x0[3]); *(u32x2*)(XB16 + (size_t)row * D + col) = w; }
    __device__ __forceinline__ void load8(int row, int col, f32x4& xa, f32x4& xb) const { const float* p = X + (size_t)row * D + col; xa = *(const f32x4*)p; xb = *(const f32x4*)(p + 4); }
    __device__ __forceinline__ void apply8x_pair(RowCtx& c, int row, int col, f32x4 a0, f32x4 a1, f32x4 b0, f32x4 b1, f32x4 x0, f32x4 x1) const { float* p = X + (size_t)row * D + col;
#pragma unroll
        for (int i = 0; i < 4; ++i) { x0[i] += a0[i] * sigmoid_fast(b0[i]); x1[i] += a1[i] * sigmoid_fast(b1[i]); }
        *(f32x4*)p = x0; *(f32x4*)(p + 4) = x1;
        c.ss += (x0[0] * x0[0] + x0[1] * x0[1]) + (x0[2] * x0[2] + x0[3] * x0[3]) + (x1[0] * x1[0] + x1[1] * x1[1]) + (x1[2] * x1[2] + x1[3] * x1[3]);
        v4u w; w.x = cvt_pk_bf16(x0[0], x0[1]); w.y = cvt_pk_bf16(x0[2], x0[3]); w.z = cvt_pk_bf16(x1[0], x1[1]); w.w = cvt_pk_bf16(x1[2], x1[3]); *(v4u*)(XB16 + (size_t)row * D + col) = w; }
    __device__ __forceinline__ void end(RowCtx& c, int row, int col, int fq) const { xs_store(Sacc, row, col, true, c.ss, fq); } };

template <class F> struct EpiRow8 { static constexpr bool PERM = true, AFTER_DRAIN = false; F f;
    __device__ __forceinline__ void first(PG8_LAS unsigned char* lds, const pg8::Unit& u, int tid) const { if (tid < 256) rstab(lds, 0)[tid] = f.rs_row(u.pm * 256 + tid); }
    __device__ __forceinline__ void operator()(const pg8::f32x4 (&acc)[2][2][4][2], const pg8::Unit& u, int wr, int wc, int fr, int fq, PG8_LAS unsigned char* lds, const pg8::Unit& nxt, bool has_next, int ui, int tid) const {
        const LAS float* tab = rstab(lds, ui & 1);
        float nrs = 0.f; if (has_next && tid < 256) nrs = f.rs_row(nxt.pm * 256 + tid);
#pragma unroll
        for (int ai = 0; ai < 2; ++ai)
#pragma unroll
            for (int m = 0; m < 4; ++m) { const int rl = ai * 128 + wr * 64 + m * 16 + fr, row = u.pm * 256 + rl; RowCtx c = RowCtx{tab[rl], 0.f};
#pragma unroll
                for (int bj = 0; bj < 2; ++bj) f.apply8(c, row, u.pn * 256 + bj * 128 + wc * 32 + 8 * fq, acc[ai][bj][m][0], acc[ai][bj][m][1]);
                f.end(c, row, u.pn * 256 + wc * 32, fq); }
        if (has_next && tid < 256) rstab(lds, (ui + 1) & 1)[tid] = nrs; } };
template <class F> struct EpiResid8 { static constexpr bool PERM = true, AFTER_DRAIN = false; F f;
    __device__ __forceinline__ void first(PG8_LAS unsigned char*, const pg8::Unit&, int) const {}
    __device__ __forceinline__ void operator()(const pg8::f32x4 (&acc)[2][2][4][2], const pg8::Unit& u, int wr, int wc, int fr, int fq, PG8_LAS unsigned char*, const pg8::Unit&, bool, int, int) const {
#pragma unroll
        for (int ai = 0; ai < 2; ++ai)
#pragma unroll
            for (int mh = 0; mh < 2; ++mh) {
                f32x4 xo[2][2][2];
#pragma unroll
                for (int mm = 0; mm < 2; ++mm)
#pragma unroll
                    for (int bj = 0; bj < 2; ++bj) f.load8(u.pm * 256 + ai * 128 + wr * 64 + (2 * mh + mm) * 16 + fr, u.pn * 256 + bj * 128 + wc * 32 + 8 * fq, xo[mm][bj][0], xo[mm][bj][1]);
#pragma unroll
                for (int mm = 0; mm < 2; ++mm) { const int m = 2 * mh + mm, row = u.pm * 256 + ai * 128 + wr * 64 + m * 16 + fr; RowCtx c = f.begin(row);
#pragma unroll
                    for (int bj = 0; bj < 2; ++bj) f.apply8x(c, row, u.pn * 256 + bj * 128 + wc * 32 + 8 * fq, acc[ai][bj][m][0], acc[ai][bj][m][1], xo[mm][bj][0], xo[mm][bj][1]);
                    f.end(c, row, u.pn * 256 + wc * 32, fq); }
                asm volatile("" ::: "memory"); } } };
template <class F> struct EpiPair8 { static constexpr bool PERM = true, AFTER_DRAIN = false; F f;
    __device__ __forceinline__ void first(PG8_LAS unsigned char*, const pg8::Unit&, int) const {}
    __device__ __forceinline__ void operator()(const pg8::f32x4 (&acc)[2][2][4][2], const pg8::Unit& u, int wr, int wc, int fr, int fq, PG8_LAS unsigned char*, const pg8::Unit&, bool, int, int) const {
#pragma unroll
        for (int ai = 0; ai < 2; ++ai) {
            f32x4 xo[4][2];
#pragma unroll
            for (int m = 0; m < 4; ++m) f.load8(u.pm * 256 + ai * 128 + wr * 64 + m * 16 + fr, u.pn * 128 + wc * 32 + 8 * fq, xo[m][0], xo[m][1]);
#pragma unroll
            for (int m = 0; m < 4; ++m) { const int row = u.pm * 256 + ai * 128 + wr * 64 + m * 16 + fr; RowCtx c = f.begin(row);
                f.apply8x_pair(c, row, u.pn * 128 + wc * 32 + 8 * fq, acc[ai][0][m][0], acc[ai][0][m][1], acc[ai][1][m][0], acc[ai][1][m][1], xo[m][0], xo[m][1]);
                f.end(c, row, u.pn * 128 + wc * 32, fq); }
            asm volatile("" ::: "memory"); } } };

constexpr int NWAVES = 8;
constexpr int RING_BYTES = 131072, LDSCTL_OFF = RING_BYTES, MISC_OFF = LDSCTL_OFF + 320, LDS_BYTES = 147456;
constexpr int PTAB_OFF = LDSCTL_OFF + 1024;
struct Frame { LAS unsigned char* lds; int tid, lane, wave, vcu, G, bx; };
__device__ __forceinline__ const float* inp(const Frame& F, int i) {
    const volatile LAS unsigned* t = (const volatile LAS unsigned*)(F.lds + PTAB_OFF) + 2 * i;
    const unsigned lo = __builtin_amdgcn_readfirstlane(t[0]), hi = __builtin_amdgcn_readfirstlane(t[1]);
    return (const float*)(((unsigned long long)hi << 32) | lo);
}

template <int NT, class F>
__device__ __forceinline__ void small_gemm(const Frame& Fr, const bf16* A, const bf16* WT, int K, const F& f) {
    const int piece = Fr.vcu, rb = piece & 7, cb = piece >> 3, rt = Fr.wave & 3, chh = Fr.wave >> 2, fr = Fr.lane & 15, fq = Fr.lane >> 4;
    const int m0 = MP + rb * 64 + rt * 16, n0 = (cb * 2 + chh) * NT * 16;
    const bf16* ap = A + (size_t)(m0 + fr) * K + 8 * fq; const bf16* bp = WT + (size_t)(n0 + fr) * K + 8 * fq;
    f32x4 acc[NT];
#pragma unroll
    for (int t = 0; t < NT; ++t) acc[t] = (f32x4){0.f, 0.f, 0.f, 0.f};
#pragma unroll 8
    for (int k0 = 0; k0 < K; k0 += 32) {
        const bf16x8 a = *(const bf16x8*)(ap + k0);
#pragma unroll
        for (int t = 0; t < NT; ++t) { const bf16x8 b = *(const bf16x8*)(bp + (size_t)t * 16 * K + k0); acc[t] = __builtin_amdgcn_mfma_f32_16x16x32_bf16(b, a, acc[t], 0, 0, 0); }
    }
    RowCtx c = f.begin(m0 + fr);
#pragma unroll
    for (int t = 0; t < NT; ++t) f.apply4(c, m0 + fr, n0 + t * 16 + 4 * fq, acc[t]);
    f.end(c, m0 + fr, n0, fq);
}
__device__ __forceinline__ void small_gemm_glu(const Frame& Fr, const bf16* A, const bf16* WT, int K, const FGlu& f) {
    const int piece = Fr.vcu, rb = piece & 7, cb = piece >> 3, rt = Fr.wave & 3, chh = Fr.wave >> 2, fr = Fr.lane & 15, fq = Fr.lane >> 4;
    const int m0 = MP + rb * 64 + rt * 16, c0 = cb * 32 + chh * 16, ra = 256 * (c0 >> 7) + (c0 & 127);
    const bf16* ap = A + (size_t)(m0 + fr) * K + 8 * fq; const bf16* bpa = WT + (size_t)(ra + fr) * K + 8 * fq; const bf16* bpb = bpa + (size_t)128 * K;
    f32x4 acca = (f32x4){0.f, 0.f, 0.f, 0.f}, accb = acca;
#pragma unroll 8
    for (int k0 = 0; k0 < K; k0 += 32) {
        const bf16x8 a = *(const bf16x8*)(ap + k0), ba = *(const bf16x8*)(bpa + k0), bb = *(const bf16x8*)(bpb + k0);
        acca = __builtin_amdgcn_mfma_f32_16x16x32_bf16(ba, a, acca, 0, 0, 0); accb = __builtin_amdgcn_mfma_f32_16x16x32_bf16(bb, a, accb, 0, 0, 0);
    }
    RowCtx c = f.begin(m0 + fr); f.apply4_pair(c, m0 + fr, c0 + 4 * fq, acca, accb); f.end(c, m0 + fr, c0, fq);
}

__device__ __forceinline__ void transpose_item(const float* W, int K, int N, bf16* WT, int drow0, LAS float* scr, int k0, int n0, int lane, const float* gain) {
#pragma unroll 8
    for (int i = 0; i < 32; ++i) { const int kk = 2 * i + (lane >> 5); scr[kk * 33 + (lane & 31)] = W[(size_t)(k0 + kk) * N + n0 + (lane & 31)] * (gain ? gain[k0 + kk] : 1.f); }
    LDS_WAIT(); asm volatile("" ::: "memory");
    const int c = lane & 7;
#pragma unroll
    for (int j = 0; j < 4; ++j) { const int n = (lane >> 3) + 8 * j; const LAS float* s = scr + (8 * c) * 33 + n;
        v4u o; o.x = cvt_pk_bf16(s[0 * 33], s[1 * 33]); o.y = cvt_pk_bf16(s[2 * 33], s[3 * 33]); o.z = cvt_pk_bf16(s[4 * 33], s[5 * 33]); o.w = cvt_pk_bf16(s[6 * 33], s[7 * 33]);
        *(GAS v4u*)(WT + (size_t)(drow0 + n) * K + k0 + 8 * c) = o; }
    LDS_WAIT(); asm volatile("" ::: "memory");
}
__device__ __forceinline__ bool conv_job(const Frame& F, int& it, const float* W, int K, int N, bf16* WT, bool glu, const float* gain) {
    const int nblk = N / 32, nit = (K / 64) * nblk;
    if (it >= nit) { it -= nit; return false; }
    const int kb = it / nblk, nb = it % nblk, n0 = 32 * nb; int drow0 = n0;
    if (glu) { const int bj = n0 >> 10, r = n0 & 1023; drow0 = 256 * (r >> 7) + 128 * bj + (r & 127); }
    transpose_item(W, K, N, WT, drow0, (LAS float*)(F.lds + F.wave * 16384), 64 * kb, n0, F.lane, gain);
    return true;
}
__device__ __forceinline__ void ffn_conv(const Frame& F, int l, const float* w1, const float* w2, const float* gffn, unsigned char* ws) {
    const int gw = F.vcu * NWAVES + F.wave, NGW = F.G * NWAVES;
    for (int it0 = gw; it0 < 4096; it0 += NGW) { int it = it0;
        if (conv_job(F, it, w1 + (size_t)l * D * FF, D, FF, (bf16*)(ws + WS_W_FF1), false, gffn + l * D)) continue;
        conv_job(F, it, w2 + (size_t)l * FF * D, FF, D, (bf16*)(ws + WS_W_FF2), false, nullptr);
    }
}

struct Args { const float* in[35]; float* out; unsigned char* ws; int ph_lo, ph_hi; };

__device__ __forceinline__ void prologue_rows(const Frame& F, const float* xp, const float* xs, float* X, bf16* XB16, float* SX0) {
    const int gw = F.vcu * NWAVES + F.wave, NGW = F.G * NWAVES;
    for (int row = gw; row < M; row += NGW) {
        const f32x4* xr = (const f32x4*)(row < MP ? xp + (size_t)row * D : xs + (size_t)(row - MP) * D) + F.lane; f32x4 v[4]; float s = 0.f;
#pragma unroll
        for (int j = 0; j < 4; ++j) { v[j] = xr[64 * j]; s += (v[j].x * v[j].x + v[j].y * v[j].y) + (v[j].z * v[j].z + v[j].w * v[j].w); }
        s = wave_sum(s);
        if (row < MP) { if (F.lane < 16) SX0[(size_t)row * XS_P + F.lane] = F.lane == 0 ? s : 0.f; } else SX0[(size_t)MP * XS_P + (size_t)(row - MP) * XS_S + F.lane] = F.lane == 0 ? s : 0.f;
        f32x4* xo = (f32x4*)(X + (size_t)row * D) + F.lane; u32x2* o = (u32x2*)(XB16 + (size_t)row * D) + F.lane;
#pragma unroll
        for (int j = 0; j < 4; ++j) { xo[64 * j] = v[j]; u32x2 w; w.x = cvt_pk_bf16(v[j].x, v[j].y); w.y = cvt_pk_bf16(v[j].z, v[j].w); o[64 * j] = w; }
    }
}
__device__ __forceinline__ void norm_final(const Frame& F, float* X, const float* g) {
    const int gw = F.vcu * NWAVES + F.wave, NGW = F.G * NWAVES;
    f32x4 gv[4];
#pragma unroll
    for (int j = 0; j < 4; ++j) gv[j] = ((const f32x4*)g)[F.lane + 64 * j];
    for (int row = gw; row < M; row += NGW) {
        f32x4* xr = (f32x4*)(X + (size_t)row * D) + F.lane; f32x4 v[4]; float s = 0.f;
#pragma unroll
        for (int j = 0; j < 4; ++j) { v[j] = xr[64 * j]; s += (v[j].x * v[j].x + v[j].y * v[j].y) + (v[j].z * v[j].z + v[j].w * v[j].w); }
        const float rs = rsqrtf(wave_sum(s) * (1.f / D) + EPS);
#pragma unroll
        for (int j = 0; j < 4; ++j) xr[64 * j] = v[j] * rs * gv[j];
    }
}

template <class Epi> __device__ __forceinline__ void big_gemm(const Frame& F, const bf16* A, const bf16* WT, int N, int K, const Epi& E) {
    pg8::Gemm g{A, WT, MP, N, K}; pg8::StaticOrder S; S.init(MP, N, F.G, F.bx);
    pg8::gemm_phase<Epi, pg8::StaticOrder, true, true>(F.lds, g, S, E, F.tid);
}

__device__ __forceinline__ float bflo(unsigned u) { return __builtin_bit_cast(float, u << 16); }
__device__ __forceinline__ float bfhi(unsigned u) { return __builtin_bit_cast(float, u & 0xffff0000u); }
constexpr int VS_STRIDE = 264;
__device__ __forceinline__ void sgu_mix_phase(const Frame& F, const bf16* UV, const float* SV, const float* sg, const bf16* Wm, const float* bs, const float* wsf, bf16* Y, float* vs_out) {
    LAS unsigned char* Vs = F.lds; const int fr = F.lane & 15, fq = F.lane >> 4;
    for (int u = F.vcu; u < 1024; u += F.G) {
        const int g = u & 7, r0 = (u >> 3) * 128;
#pragma unroll
        for (int i = 0; i < 4; ++i) { const int id = F.tid + 512 * i, row = id >> 4, ch = id & 15;
            const v4u raw = *(const v4u*)(UV + (size_t)(r0 + row) * 2048 + 1024 + g * 128 + ch * 8); const float rs = rs_v(SV, r0 + row);
            const f32x4 g0 = *(const f32x4*)(sg + g * 128 + ch * 8), g1 = *(const f32x4*)(sg + g * 128 + ch * 8 + 4);
            u32x2 w0, w1; w0.x = cvt_pk_bf16(bflo(raw.x) * rs * g0.x, bfhi(raw.x) * rs * g0.y); w0.y = cvt_pk_bf16(bflo(raw.y) * rs * g0.z, bfhi(raw.y) * rs * g0.w);
            w1.x = cvt_pk_bf16(bflo(raw.z) * rs * g1.x, bfhi(raw.z) * rs * g1.y); w1.y = cvt_pk_bf16(bflo(raw.w) * rs * g1.z, bfhi(raw.w) * rs * g1.w);
            *(LAS u32x2*)(Vs + row * VS_STRIDE + ch * 16) = w0; *(LAS u32x2*)(Vs + row * VS_STRIDE + ch * 16 + 8) = w1; }
        __syncthreads();
        bf16x8 af[4];
#pragma unroll
        for (int kk = 0; kk < 4; ++kk)
#pragma unroll
            for (int j = 0; j < 8; ++j) af[kk][j] = (short)*(const LAS unsigned short*)(Vs + (32 * kk + 8 * fq + j) * VS_STRIDE + (16 * F.wave + fr) * 2);
        f32x4 acc[8]; const bf16* wg = Wm + (size_t)g * 128 * 128;
#pragma unroll
        for (int n = 0; n < 8; ++n) { acc[n] = (f32x4){0.f, 0.f, 0.f, 0.f};
#pragma unroll
            for (int kk = 0; kk <= n / 2; ++kk) { const bf16x8 b = *(const bf16x8*)(wg + (size_t)(16 * n + fr) * 128 + 32 * kk + 8 * fq); acc[n] = __builtin_amdgcn_mfma_f32_16x16x32_bf16(af[kk], b, acc[n], 0, 0, 0); } }
#pragma unroll
        for (int n = 0; n < 8; ++n) { const int t = 16 * n + fr, row = r0 + t, col = g * 128 + 16 * F.wave + 4 * fq; const float bb = bs[g * 128 + t];
            const u32x2 uu = *(const u32x2*)(UV + (size_t)row * 2048 + col);
            u32x2 w; w.x = cvt_pk_bf16(bflo(uu.x) * (acc[n][0] + bb), bfhi(uu.x) * (acc[n][1] + bb)); w.y = cvt_pk_bf16(bflo(uu.y) * (acc[n][2] + bb), bfhi(uu.y) * (acc[n][3] + bb));
            *(u32x2*)(Y + (size_t)row * 1024 + col) = w; }
        __syncthreads();
    }
    for (int it = F.vcu * 512 + F.tid; it < 128 * 256; it += F.G * 512) {
        const int b = it >> 8, d = (it & 255) * 4, gh = d >> 7, rowb = MP + b * 4; const f32x4 gg = *(const f32x4*)(sg + d);
        float v[4][4], uu[4][4];
#pragma unroll
        for (int s = 0; s < 4; ++s) { const u32x2 rv = *(const u32x2*)(UV + (size_t)(rowb + s) * 2048 + 1024 + d), ru = *(const u32x2*)(UV + (size_t)(rowb + s) * 2048 + d); const float rs = rs_v(SV, rowb + s);
            v[s][0] = bflo(rv.x) * rs; v[s][1] = bfhi(rv.x) * rs; v[s][2] = bflo(rv.y) * rs; v[s][3] = bfhi(rv.y) * rs;
            uu[s][0] = bflo(ru.x); uu[s][1] = bfhi(ru.x); uu[s][2] = bflo(ru.y); uu[s][3] = bfhi(ru.y);
            *(f32x4*)(vs_out + (size_t)(b * 4 + s) * 1024 + d) = (f32x4){v[s][0] * gg.x, v[s][1] * gg.y, v[s][2] * gg.z, v[s][3] * gg.w}; }
#pragma unroll
        for (int t = 0; t < 4; ++t) { float m[4] = {0.f, 0.f, 0.f, 0.f};
#pragma unroll
            for (int s = 0; s <= t; ++s) { const float w = wsf[((size_t)gh * 128 + t) * 128 + s];
#pragma unroll
                for (int e = 0; e < 4; ++e) m[e] += w * v[s][e]; }
            const float bb = bs[gh * 128 + t];
            u32x2 w; w.x = cvt_pk_bf16(uu[t][0] * (m[0] * gg.x + bb), uu[t][1] * (m[1] * gg.y + bb)); w.y = cvt_pk_bf16(uu[t][2] * (m[2] * gg.z + bb), uu[t][3] * (m[3] * gg.w + bb));
            *(u32x2*)(Y + (size_t)(rowb + t) * 1024 + d) = w; }
    }
}
constexpr size_t RGT_W = 0, RGT_BA = 512 * 1024, RGT_BX = RGT_BA + 4096, RGT_NSP = RGT_BX + 4096;
__device__ __forceinline__ int rg_jch(int m, int r) { return 8 * (r >> 2) + 4 * (m & 1) + (r & 3) + 32 * (m >> 1); }
__device__ __forceinline__ void rglru_tables(const Frame& F, const float* wa, const float* wx, const float* ba, const float* bx, const float* lam, unsigned char* tab) {
    bf16* W = (bf16*)(tab + RGT_W);
    for (int i = F.vcu * 512 + F.tid; i < 16 * 2 * 4 * 2 * 64 * 8; i += F.G * 512) {
        const int e = i & 7, lane = (i >> 3) & 63, ks = (i >> 9) & 1, m = (i >> 10) & 3, type = (i >> 12) & 1, h = i >> 13, fr = lane & 15, fq = lane >> 4;
        const float* w = type ? wx : wa; const float v = w[((size_t)h * 64 + 32 * ks + 8 * fq + e) * 64 + rg_jch(m, fr)];
        W[i] = (bf16)(cvt_pk_bf16(v, 0.f) & 0xffffu);
    }
    for (int c = F.vcu * 512 + F.tid; c < 1024; c += F.G * 512) {
        ((float*)(tab + RGT_BA))[c] = ba[c]; ((float*)(tab + RGT_BX))[c] = bx[c]; ((float*)(tab + RGT_NSP))[c] = -8.0f * log1pf(expf(-lam[c]));
    }
}
template <int CTRL> __device__ __forceinline__ float dpp_f(float old, float src) {
    return __builtin_bit_cast(float, __builtin_amdgcn_update_dpp(__builtin_bit_cast(int, old), __builtin_bit_cast(int, src), CTRL, 0xf, 0xf, false)); }
template <int CTRL> __device__ __forceinline__ float dpp_z(float src) {
    return __builtin_bit_cast(float, __builtin_amdgcn_update_dpp(0, __builtin_bit_cast(int, src), CTRL, 0xf, 0xf, true)); }
constexpr int RG_XC_STRIDE = 68, RG_XC_BYTES = 128 * RG_XC_STRIDE * 4, RG_TOT_OFF = 2 * RG_XC_BYTES, RG_CARRY_OFF = RG_TOT_OFF + 2 * 2 * 8 * 64 * 4;
template <int D_, bool SAMPLE> __device__ __forceinline__ void ks_step(float (&a)[16], float (&b)[16], int tt) {
#pragma unroll
    for (int i = 0; i < 16; ++i) {
        float as = dpp_f<0x110 + D_>(1.0f, a[i]), bs = dpp_z<0x110 + D_>(b[i]);
        if (SAMPLE) { const bool ok = tt >= D_; as = ok ? as : 1.0f; bs = ok ? bs : 0.0f; }
        b[i] = a[i] * bs + b[i]; a[i] = a[i] * as;
    }
}
template <bool SAMPLE>
__device__ __forceinline__ void rglru_unit(const Frame& F, int unit, const float* XB, const bf16* G, bf16* Y, const float* cw, const float* cb, const unsigned char* tab,
                                           const float* cstate, const float* hstate, float* conv_out, float* h_out) {
    const int fr = F.lane & 15, fq = F.lane >> 4, w = F.wave;
    int h, b0, rowbase, nchunk;
    if (SAMPLE) { h = unit >> 2; b0 = (unit & 3) * 32; rowbase = MP + b0 * 4; nchunk = 1; }
    else { b0 = unit >> 4; h = unit & 15; rowbase = b0 * 2048; nchunk = 16; }
    LAS float* XC = (LAS float*)F.lds; LAS float* TOT = (LAS float*)(F.lds + RG_TOT_OFF); LAS float* CARRY = (LAS float*)(F.lds + RG_CARRY_OFF);
    const int chq = F.tid & 15, rsub = F.tid >> 4, cA = h * 64 + 4 * chq;
    bf16x8 Af[2][4][2];
#pragma unroll
    for (int ty = 0; ty < 2; ++ty)
#pragma unroll
        for (int m = 0; m < 4; ++m)
#pragma unroll
            for (int ks = 0; ks < 2; ++ks) Af[ty][m][ks] = *(const bf16x8*)((const bf16*)(tab + RGT_W) + ((((size_t)(h * 2 + ty) * 4 + m) * 2 + ks) * 64 + F.lane) * 8);
    for (int c = 0; c < nchunk; ++c) {
        const int buf = c & 1, c0 = c * 128;
        const float* cw_ = cw; const float* cb_ = cb; asm volatile("" : "+s"(cw_)); asm volatile("" : "+s"(cb_));
        f32x4 cwv[4];
#pragma unroll
        for (int k = 0; k < 4; ++k) cwv[k] = *(const f32x4*)(cw_ + k * 1024 + cA);
        const f32x4 cbv = *(const f32x4*)(cb_ + cA);
#pragma unroll
        for (int i = 0; i < 4; ++i) { const int r = rsub + 32 * i; f32x4 acc = cbv;
#pragma unroll
            for (int k = 0; k < 4; ++k) { f32x4 xe;
                if (SAMPLE) { const int bi = r >> 2, tau = (r & 3) + k - 3;
                    xe = tau >= 0 ? *(const f32x4*)(XB + (size_t)(rowbase + bi * 4 + tau) * 1024 + cA) : *(const f32x4*)(cstate + ((size_t)(b0 + bi) * 3 + (tau + 3)) * 1024 + cA); }
                else { const int tau = c0 + r + k - 3; xe = tau >= 0 ? *(const f32x4*)(XB + (size_t)(rowbase + tau) * 1024 + cA) : (f32x4){0.f, 0.f, 0.f, 0.f}; }
                acc = acc + cwv[k] * xe; }
            *(LAS f32x4*)(XC + (size_t)buf * (128 * RG_XC_STRIDE) + r * RG_XC_STRIDE + 4 * chq) = acc; }
        __syncthreads();
        const int trow = 16 * w + fr;
        float xc[16];
        { const LAS float* xp = XC + (size_t)buf * (128 * RG_XC_STRIDE) + trow * RG_XC_STRIDE + 8 * fq;
          const f32x4 x0 = *(const LAS f32x4*)(xp), x1 = *(const LAS f32x4*)(xp + 4), x2 = *(const LAS f32x4*)(xp + 32), x3 = *(const LAS f32x4*)(xp + 36);
          xc[0] = x0.x; xc[1] = x0.y; xc[2] = x0.z; xc[3] = x0.w; xc[4] = x1.x; xc[5] = x1.y; xc[6] = x1.z; xc[7] = x1.w;
          xc[8] = x2.x; xc[9] = x2.y; xc[10] = x2.z; xc[11] = x2.w; xc[12] = x3.x; xc[13] = x3.y; xc[14] = x3.z; xc[15] = x3.w; }
        bf16x8 bf0, bf1;
        { v4u p0, p1; p0.x = cvt_pk_bf16(xc[0], xc[1]); p0.y = cvt_pk_bf16(xc[2], xc[3]); p0.z = cvt_pk_bf16(xc[4], xc[5]); p0.w = cvt_pk_bf16(xc[6], xc[7]);
          p1.x = cvt_pk_bf16(xc[8], xc[9]); p1.y = cvt_pk_bf16(xc[10], xc[11]); p1.z = cvt_pk_bf16(xc[12], xc[13]); p1.w = cvt_pk_bf16(xc[14], xc[15]);
          bf0 = __builtin_bit_cast(bf16x8, p0); bf1 = __builtin_bit_cast(bf16x8, p1); }
        float av[16], bv[16];
#pragma unroll
        for (int m = 0; m < 4; ++m) {
            f32x4 ra = (f32x4){0.f, 0.f, 0.f, 0.f}, rx = ra;
            ra = __builtin_amdgcn_mfma_f32_16x16x32_bf16(Af[0][m][0], bf0, ra, 0, 0, 0); ra = __builtin_amdgcn_mfma_f32_16x16x32_bf16(Af[0][m][1], bf1, ra, 0, 0, 0);
            rx = __builtin_amdgcn_mfma_f32_16x16x32_bf16(Af[1][m][0], bf0, rx, 0, 0, 0); rx = __builtin_amdgcn_mfma_f32_16x16x32_bf16(Af[1][m][1], bf1, rx, 0, 0, 0);
            const int cg = h * 64 + 8 * fq + 4 * (m & 1) + 32 * (m >> 1);
            const f32x4 ba4 = *(const f32x4*)((const float*)(tab + RGT_BA) + cg), bx4 = *(const f32x4*)((const float*)(tab + RGT_BX) + cg), ns4 = *(const f32x4*)((const float*)(tab + RGT_NSP) + cg);
#pragma unroll
            for (int r = 0; r < 4; ++r) { const float rg = sigmoid_fast(ra[r] + ba4[r]), ig = sigmoid_fast(rx[r] + bx4[r]);
                const float la = ns4[r] * rg, a = __builtin_amdgcn_exp2f(1.4426950408889634f * la), mult = __builtin_amdgcn_sqrtf(fmaxf(1.f - a * a, 0.f));
                av[4 * m + r] = a; bv[4 * m + r] = mult * ig * xc[4 * m + r]; }
        }
        const int tt = fr & 3;
        if (SAMPLE) {
            const int bi = (16 * w + fr) >> 2;
#pragma unroll
            for (int m = 0; m < 4; ++m) { const int cg = h * 64 + 8 * fq + 4 * (m & 1) + 32 * (m >> 1); const f32x4 h0 = *(const f32x4*)(hstate + (size_t)(b0 + bi) * 1024 + cg);
#pragma unroll
                for (int r = 0; r < 4; ++r) if (tt == 0) bv[4 * m + r] += av[4 * m + r] * h0[r]; }
            ks_step<1, true>(av, bv, tt); ks_step<2, true>(av, bv, tt);
        } else {
            ks_step<1, false>(av, bv, tt); ks_step<2, false>(av, bv, tt); ks_step<4, false>(av, bv, tt); ks_step<8, false>(av, bv, tt);
            if (fr == 15) { LAS float* ta = TOT + ((size_t)(buf * 2 + 0) * 8 + w) * 64 + fq * 16; LAS float* th = TOT + ((size_t)(buf * 2 + 1) * 8 + w) * 64 + fq * 16;
#pragma unroll
                for (int i = 0; i < 16; i += 4) { *(LAS f32x4*)(ta + i) = (f32x4){av[i], av[i + 1], av[i + 2], av[i + 3]}; *(LAS f32x4*)(th + i) = (f32x4){bv[i], bv[i + 1], bv[i + 2], bv[i + 3]}; } }
            __syncthreads();
            float ch[16];
            if (c == 0) {
#pragma unroll
                for (int i = 0; i < 16; ++i) ch[i] = 0.f;
            } else {
#pragma unroll
                for (int i = 0; i < 16; i += 4) { const f32x4 t = *(const LAS f32x4*)(CARRY + buf * 64 + fq * 16 + i); ch[i] = t.x; ch[i + 1] = t.y; ch[i + 2] = t.z; ch[i + 3] = t.w; }
            }
            for (int v = 0; v < w; ++v) { const LAS float* ta = TOT + ((size_t)(buf * 2 + 0) * 8 + v) * 64 + fq * 16; const LAS float* th = TOT + ((size_t)(buf * 2 + 1) * 8 + v) * 64 + fq * 16;
#pragma unroll
                for (int i = 0; i < 16; i += 4) { const f32x4 A4 = *(const LAS f32x4*)(ta + i), H4 = *(const LAS f32x4*)(th + i);
                    ch[i] = A4.x * ch[i] + H4.x; ch[i + 1] = A4.y * ch[i + 1] + H4.y; ch[i + 2] = A4.z * ch[i + 2] + H4.z; ch[i + 3] = A4.w * ch[i + 3] + H4.w; } }
#pragma unroll
            for (int i = 0; i < 16; ++i) bv[i] = bv[i] + av[i] * ch[i];
            if (w == 7 && fr == 15) {
#pragma unroll
                for (int i = 0; i < 16; i += 4) *(LAS f32x4*)(CARRY + (buf ^ 1) * 64 + fq * 16 + i) = (f32x4){bv[i], bv[i + 1], bv[i + 2], bv[i + 3]}; }
        }
        { const size_t row = (size_t)rowbase + c0 + trow; const size_t o0 = row * 1024 + h * 64 + 8 * fq;
          const v4u g0 = *(const v4u*)(G + o0), g1 = *(const v4u*)(G + o0 + 32); v4u y0, y1;
          y0.x = cvt_pk_bf16(bv[0] * bflo(g0.x), bv[1] * bfhi(g0.x)); y0.y = cvt_pk_bf16(bv[2] * bflo(g0.y), bv[3] * bfhi(g0.y)); y0.z = cvt_pk_bf16(bv[4] * bflo(g0.z), bv[5] * bfhi(g0.z)); y0.w = cvt_pk_bf16(bv[6] * bflo(g0.w), bv[7] * bfhi(g0.w));
          y1.x = cvt_pk_bf16(bv[8] * bflo(g1.x), bv[9] * bfhi(g1.x)); y1.y = cvt_pk_bf16(bv[10] * bflo(g1.y), bv[11] * bfhi(g1.y)); y1.z = cvt_pk_bf16(bv[12] * bflo(g1.z), bv[13] * bfhi(g1.z)); y1.w = cvt_pk_bf16(bv[14] * bflo(g1.w), bv[15] * bfhi(g1.w));
          *(v4u*)(Y + o0) = y0; *(v4u*)(Y + o0 + 32) = y1; }
        if (SAMPLE) {
            if (tt == 3) { const int bi = (16 * w + fr) >> 2; float* ho = h_out + (size_t)(b0 + bi) * 1024 + h * 64 + 8 * fq;
                *(f32x4*)(ho) = (f32x4){bv[0], bv[1], bv[2], bv[3]}; *(f32x4*)(ho + 4) = (f32x4){bv[4], bv[5], bv[6], bv[7]};
                *(f32x4*)(ho + 32) = (f32x4){bv[8], bv[9], bv[10], bv[11]}; *(f32x4*)(ho + 36) = (f32x4){bv[12], bv[13], bv[14], bv[15]}; }
        } else if (c == nchunk - 1 && w == 7 && fr == 15) { float* ho = h_out + (size_t)b0 * 1024 + h * 64 + 8 * fq;
            *(f32x4*)(ho) = (f32x4){bv[0], bv[1], bv[2], bv[3]}; *(f32x4*)(ho + 4) = (f32x4){bv[4], bv[5], bv[6], bv[7]};
            *(f32x4*)(ho + 32) = (f32x4){bv[8], bv[9], bv[10], bv[11]}; *(f32x4*)(ho + 36) = (f32x4){bv[12], bv[13], bv[14], bv[15]}; }
    }
    if (SAMPLE) { for (int i = F.tid; i < 32 * 3 * 64; i += 512) { const int cc = i & 63, r = (i >> 6) % 3, bi = i / 192;
            conv_out[((size_t)(b0 + bi) * 3 + r) * 1024 + h * 64 + cc] = XB[(size_t)(rowbase + bi * 4 + 1 + r) * 1024 + h * 64 + cc]; } }
    else if (F.tid < 192) { const int cc = F.tid & 63, r = F.tid >> 6; conv_out[((size_t)b0 * 3 + r) * 1024 + h * 64 + cc] = XB[(size_t)(rowbase + 2045 + r) * 1024 + h * 64 + cc]; }
    __syncthreads();
}
__device__ __forceinline__ void rglru_phase(const Frame& F, const float* XB, const bf16* G, bf16* Y, const float* cw, const float* cb, const unsigned char* tab, const float* cstate, const float* hstate, float* out) {
    for (int unit = F.vcu; unit < 192; unit += F.G) {
        if (unit < 128) rglru_unit<false>(F, unit, XB, G, Y, cw, cb, tab, nullptr, nullptr, out + O_CONVP, out + O_HP);
        else rglru_unit<true>(F, unit - 128, XB, G, Y, cw, cb, tab, cstate, hstate, out + O_CONVS, out + O_HS);
    }
}
constexpr size_t S5T_AP = 0, S5T_BF = 128 * 1024, S5T_CF = S5T_BF + 1024 * 1024;
__device__ __forceinline__ void s5_disc(const float* lre, const float* lim, const float* ldt, int g, int p, float& ar, float& ai, float& qr, float& qi) {
    const float dt = expf(ldt[g]), lr = lre[g * 64 + p], li = lim[g * 64 + p], mag = expf(lr * dt); ar = mag * cosf(li * dt); ai = mag * sinf(li * dt);
    const float zr = ar - 1.f, zi = ai, den = lr * lr + li * li; qr = (zr * lr + zi * li) / den; qi = (zi * lr - zr * li) / den;
}
__device__ __forceinline__ void s5_tables(const Frame& F, const float* lre, const float* lim, const float* ldt, const float* bre, const float* bim, const float* cre, const float* cim, unsigned char* tab) {
    for (int i = F.vcu * 512 + F.tid; i < 4096; i += F.G * 512) { float ar, ai, qr, qi; s5_disc(lre, lim, ldt, i >> 6, i & 63, ar, ai, qr, qi);
        float* o = (float*)(tab + S5T_AP) + (size_t)i * 8; o[0] = ar; o[1] = ai;
        float r2 = ar * ar - ai * ai, i2 = 2.f * ar * ai; o[2] = r2; o[3] = i2; float r4 = r2 * r2 - i2 * i2, i4 = 2.f * r2 * i2; o[4] = r4; o[5] = i4; o[6] = r4 * r4 - i4 * i4; o[7] = 2.f * r4 * i4; }
    for (int i = F.vcu * 512 + F.tid; i < 64 * 4 * 4 * 64 * 8; i += F.G * 512) {
        const int e = i & 7, lane = (i >> 3) & 63, kind = (i >> 9) & 3, w = (i >> 11) & 3, g = i >> 13, fr = lane & 15, fq = lane >> 4, h = (8 * fq + e) & 15, p = 16 * w + fr;
        float ar, ai, qr, qi; s5_disc(lre, lim, ldt, g, p, ar, ai, qr, qi);
        const float br = bre[((size_t)g * 64 + p) * 16 + h], bi = bim[((size_t)g * 64 + p) * 16 + h]; const float v = (kind & 1) ? (qr * bi + qi * br) : (qr * br - qi * bi);
        ((bf16*)(tab + S5T_BF))[i] = (kind < 2 && fq < 2) ? (bf16)(cvt_pk_bf16(v, 0.f) & 0xffffu) : (bf16)0;
    }
    for (int i = F.vcu * 512 + F.tid; i < 64 * 4 * 64 * 8; i += F.G * 512) {
        const int e = i & 7, lane = (i >> 3) & 63, w = (i >> 9) & 3, g = i >> 11, fr = lane & 15, fq = lane >> 4, p = 16 * w + 4 * fq + (e & 3);
        const float v = e < 4 ? cre[((size_t)g * 16 + fr) * 64 + p] : -cim[((size_t)g * 16 + fr) * 64 + p];
        ((bf16*)(tab + S5T_CF))[i] = (bf16)(cvt_pk_bf16(v, 0.f) & 0xffffu);
    }
}
typedef float f32x2 __attribute__((ext_vector_type(2)));
template <int D_, bool SAMPLE> __device__ __forceinline__ void s5_ks(f32x2 (&x)[4], const float (&ap)[4][8], int pi, int tt) {
    f32x2 sh[4];
#pragma unroll
    for (int s = 0; s < 4; ++s) { sh[s].x = dpp_z<0x110 + D_>(x[s].x); sh[s].y = dpp_z<0x110 + D_>(x[s].y); }
    if (SAMPLE) { const bool ok = tt >= D_;
#pragma unroll
        for (int s = 0; s < 4; ++s) { sh[s].x = ok ? sh[s].x : 0.f; sh[s].y = ok ? sh[s].y : 0.f; } }
#pragma unroll
    for (int s = 0; s < 4; ++s) { const float ar = ap[s][2 * pi], ai = ap[s][2 * pi + 1];
        x[s] = (f32x2){ar, ar} * sh[s] + x[s]; x[s] = (f32x2){-ai, ai} * __builtin_shufflevector(sh[s], sh[s], 1, 0) + x[s]; }
}
template <bool SAMPLE>
__device__ __forceinline__ void s5_pass(const Frame& F, int unit, const float* U, bf16* Gs, const float* dsk, const unsigned char* tab, const float* sre, const float* sim, float* ore, float* oim) {
    const int fr = F.lane & 15, fq = F.lane >> 4, wq = F.wave & 3, usel = F.wave >> 2, tt = fr & 3;
    int g, rowbase, ntile, bidx;
    if (SAMPLE) { g = unit >> 5; bidx = (unit & 31) * 4; rowbase = MP + bidx * 4; ntile = 1; }
    else { bidx = unit >> 6; g = unit & 63; rowbase = bidx * 2048; ntile = 128; }
    LAS f32x4* YP = (LAS f32x4*)F.lds;
    float ap[4][8];
#pragma unroll
    for (int s = 0; s < 4; ++s) { const f32x4* a4 = (const f32x4*)((const float*)(tab + S5T_AP) + ((size_t)g * 64 + 16 * wq + 4 * fq + s) * 8); const f32x4 lo = a4[0], hi = a4[1];
        ap[s][0] = lo.x; ap[s][1] = lo.y; ap[s][2] = lo.z; ap[s][3] = lo.w; ap[s][4] = hi.x; ap[s][5] = hi.y; ap[s][6] = hi.z; ap[s][7] = hi.w; }
    bf16x8 Bf[2];
#pragma unroll
    for (int k = 0; k < 2; ++k) Bf[k] = *(const bf16x8*)((const bf16*)(tab + S5T_BF) + ((((size_t)g * 4 + wq) * 4 + k) * 64 + F.lane) * 8);
    const bf16x8 Cf = *(const bf16x8*)((const bf16*)(tab + S5T_CF) + (((size_t)g * 4 + wq) * 64 + F.lane) * 8);
    f32x2 x[4];
#pragma unroll
    for (int s = 0; s < 4; ++s) x[s] = (f32x2){0.f, 0.f};
    f32x4 ua[8], ub[8];
#pragma unroll
    for (int tl = 0; tl < (SAMPLE ? 1 : 8); ++tl) { const GAS float* up = (const GAS float*)U + ((size_t)rowbase + (size_t)tl * 16 + fr) * 1024 + g * 16 + 8 * (fq & 1);
        ua[tl] = *(const GAS f32x4*)up; ub[tl] = *(const GAS f32x4*)(up + 4); }
    for (int t0 = 0; t0 < ntile; t0 += 8) {
#pragma unroll
        for (int tl = 0; tl < 8; ++tl) {
            if (SAMPLE && tl > 0) continue;
            const f32x4 u0 = ua[tl], u1 = ub[tl];
            v4u bw; bw.x = cvt_pk_bf16(u0.x, u0.y); bw.y = cvt_pk_bf16(u0.z, u0.w); bw.z = cvt_pk_bf16(u1.x, u1.y); bw.w = cvt_pk_bf16(u1.z, u1.w);
            const bf16x8 Bop = __builtin_bit_cast(bf16x8, bw);
            f32x4 br = __builtin_amdgcn_mfma_f32_16x16x32_bf16(Bf[0], Bop, (f32x4){0.f, 0.f, 0.f, 0.f}, 0, 0, 0);
            f32x4 bi = __builtin_amdgcn_mfma_f32_16x16x32_bf16(Bf[1], Bop, (f32x4){0.f, 0.f, 0.f, 0.f}, 0, 0, 0);
            f32x2 cin[4];
            if (SAMPLE) {
                const int bi_ = fr >> 2; const size_t so = ((size_t)(bidx + bi_) * 64 + g) * 64 + 16 * wq + 4 * fq; const f32x4 s_r = *(const f32x4*)(sre + so), s_i = *(const f32x4*)(sim + so);
#pragma unroll
                for (int s = 0; s < 4; ++s) cin[s] = tt == 0 ? (f32x2){s_r[s], s_i[s]} : (f32x2){0.f, 0.f};
            } else {
#pragma unroll
                for (int s = 0; s < 4; ++s) { cin[s].x = dpp_z<0x121>(x[s].x); cin[s].y = dpp_z<0x121>(x[s].y); }
#pragma unroll
                for (int s = 0; s < 4; ++s) cin[s] = fr == 0 ? cin[s] : (f32x2){0.f, 0.f};
            }
#pragma unroll
            for (int s = 0; s < 4; ++s) { const float a_r = ap[s][0], a_i = ap[s][1];
                f32x2 n = (f32x2){br[s], bi[s]}; n = (f32x2){a_r, a_r} * cin[s] + n; n = (f32x2){-a_i, a_i} * __builtin_shufflevector(cin[s], cin[s], 1, 0) + n; x[s] = n; }
            s5_ks<1, SAMPLE>(x, ap, 0, tt); s5_ks<2, SAMPLE>(x, ap, 1, tt);
            if (!SAMPLE) { s5_ks<4, false>(x, ap, 2, tt); s5_ks<8, false>(x, ap, 3, tt); }
            v4u xw; xw.x = cvt_pk_bf16(x[0].x, x[1].x); xw.y = cvt_pk_bf16(x[2].x, x[3].x); xw.z = cvt_pk_bf16(x[0].y, x[1].y); xw.w = cvt_pk_bf16(x[2].y, x[3].y);
            YP[((usel * 4 + wq) * 8 + tl) * 64 + F.lane] = __builtin_amdgcn_mfma_f32_16x16x32_bf16(Cf, __builtin_bit_cast(bf16x8, xw), (f32x4){0.f, 0.f, 0.f, 0.f}, 0, 0, 0);
        }
        if (!SAMPLE && t0 + 8 < ntile) {
#pragma unroll
            for (int tl = 0; tl < 8; ++tl) { const GAS float* up = (const GAS float*)U + ((size_t)rowbase + (size_t)(t0 + 8 + tl) * 16 + fr) * 1024 + g * 16 + 8 * (fq & 1);
                ua[tl] = *(const GAS f32x4*)up; ub[tl] = *(const GAS f32x4*)(up + 4); } }
        __syncthreads();
#pragma unroll
        for (int k = 0; k < 2; ++k) { const int tl = 2 * wq + k; if (SAMPLE && tl > 0) continue;
            f32x4 y = YP[((usel * 4 + 0) * 8 + tl) * 64 + F.lane] + YP[((usel * 4 + 1) * 8 + tl) * 64 + F.lane] + YP[((usel * 4 + 2) * 8 + tl) * 64 + F.lane] + YP[((usel * 4 + 3) * 8 + tl) * 64 + F.lane];
            const size_t row = (size_t)rowbase + (size_t)(t0 + tl) * 16 + fr; const int ch = g * 16 + 4 * fq;
            const f32x4 u4 = *(const f32x4*)(U + row * 1024 + ch), d4 = *(const f32x4*)(dsk + ch); y = y + d4 * u4;
            u32x2 o; o.x = cvt_pk_bf16(gelu_fast(y.x), gelu_fast(y.y)); o.y = cvt_pk_bf16(gelu_fast(y.z), gelu_fast(y.w)); *(u32x2*)(Gs + row * 1024 + ch) = o; }
        __syncthreads();
    }
    if (SAMPLE) { if (tt == 3) { const size_t so = ((size_t)(bidx + (fr >> 2)) * 64 + g) * 64 + 16 * wq + 4 * fq; *(f32x4*)(ore + so) = (f32x4){x[0].x, x[1].x, x[2].x, x[3].x}; *(f32x4*)(oim + so) = (f32x4){x[0].y, x[1].y, x[2].y, x[3].y}; } }
    else if (fr == 15) { const size_t so = ((size_t)bidx * 64 + g) * 64 + 16 * wq + 4 * fq; *(f32x4*)(ore + so) = (f32x4){x[0].x, x[1].x, x[2].x, x[3].x}; *(f32x4*)(oim + so) = (f32x4){x[0].y, x[1].y, x[2].y, x[3].y}; }
}
__device__ __forceinline__ void s5_phase(const Frame& F, const float* U, bf16* Gs, const float* dsk, const unsigned char* tab, const float* sre, const float* sim, float* out) {
    const int usel = F.wave >> 2;
    for (int u0 = F.vcu; u0 < 256; u0 += F.G) s5_pass<false>(F, u0 * 2 + usel, U, Gs, dsk, tab, nullptr, nullptr, out + O_SREP, out + O_SIMP);
    for (int u0 = F.vcu; u0 < 1024; u0 += F.G) s5_pass<true>(F, u0 * 2 + usel, U, Gs, dsk, tab, sre, sim, out + O_SRES, out + O_SIMS);
}
constexpr int PH_FINAL = 21, PH_END = 22;
enum { ST_GIN = 0, ST_MIX = 1, ST_GOUT = 2, ST_FF1 = 3, ST_FF2 = 4 };
constexpr size_t WS_SX0 = 172 * MiB, WS_SX1 = 175 * MiB, WS_SV = 178 * MiB;
constexpr size_t T_Y = 99 * MiB;

__global__ void __launch_bounds__(NWAVES * 64, 2) mk(Args a) {
    extern __shared__ __attribute__((aligned(16))) unsigned char lds_raw[];
    Frame F; F.lds = (LAS unsigned char*)lds_raw; F.tid = threadIdx.x; F.lane = F.tid & 63; F.wave = __builtin_amdgcn_readfirstlane(F.tid >> 6);
    F.G = gridDim.x; F.bx = blockIdx.x; F.vcu = (F.bx % 8) * (F.G / 8) + F.bx / 8;
    volatile LAS unsigned* MISC = (volatile LAS unsigned*)(F.lds + MISC_OFF);
    for (int u = F.tid; u < (LDS_BYTES - LDSCTL_OFF) / 4; u += NWAVES * 64) ((LAS unsigned*)(F.lds + LDSCTL_OFF))[u] = 0u;
    __syncthreads();
    if (F.tid == 0) { LAS unsigned long long* pt = (LAS unsigned long long*)(F.lds + PTAB_OFF);
#pragma unroll
        for (int i = 0; i < 35; ++i) pt[i] = (unsigned long long)a.in[i]; }
    __syncthreads();
    const bool multi = (a.ph_hi - a.ph_lo) > 1;
    XcdBarrier bar; bar.bar = (unsigned*)(a.ws + WS_CTL) + CW_BAR; bar.x = 0; bar.st = nullptr;
    if (multi) bar = xcd_barrier_post((unsigned*)(a.ws + WS_CTL) + CW_BAR, MISC + 8);

#ifndef DUP_CLS
#define DUP_CLS -1
#endif
    for (int ph = a.ph_lo, rep_ = 0; ph < a.ph_hi; ) {
        { int t_ = threadIdx.x, b_ = blockIdx.x; asm volatile("" : "+v"(t_)); asm volatile("" : "+s"(b_));
          F.tid = t_; F.lane = t_ & 63; F.wave = __builtin_amdgcn_readfirstlane(t_ >> 6); F.bx = b_; F.vcu = (b_ % 8) * (F.G / 8) + b_ / 8; }
        unsigned char* ws = a.ws; float* X = a.out; asm volatile("" : "+s"(ws)); asm volatile("" : "+s"(X));
        bf16* XB16 = (bf16*)(ws + WS_XN); unsigned char* T = ws + WS_T; bf16* Y = (bf16*)(T + T_Y);
        float* SX0 = (float*)(ws + WS_SX0); float* SX1 = (float*)(ws + WS_SX1); float* SV = (float*)(ws + WS_SV);
        if (ph == 0) {
            prologue_rows(F, inp(F, 0), inp(F, 1), X, XB16, SX0);
            { const float* wsf = inp(F, 13); bf16* wm = (bf16*)(ws + WS_WM);
              for (int i = F.vcu * 512 + F.tid; i < 2 * 8 * 128 * 128; i += F.G * 512) { const int s_ = i & 127, t_ = (i >> 7) & 127; wm[i] = s_ <= t_ ? (bf16)(cvt_pk_bf16(wsf[i], 0.f) & 0xffffu) : (bf16)0; } }
            s5_tables(F, inp(F, 26), inp(F, 27), inp(F, 28), inp(F, 29), inp(F, 30), inp(F, 31), inp(F, 32), ws + WS_S5T);
            rglru_tables(F, inp(F, 19), inp(F, 21), inp(F, 20), inp(F, 22), inp(F, 23), ws + WS_RGT);
            const int gw = F.vcu * NWAVES + F.wave, NGW = F.G * NWAVES; const float* gm = inp(F, 6);
            for (int it0 = gw; it0 < 6144; it0 += NGW) { int it = it0;
                if (conv_job(F, it, inp(F, 11), D, 2048, (bf16*)(ws + WS_W_INA), false, gm)) continue;
                if (conv_job(F, it, inp(F, 11) + (size_t)D * 2048, D, 2048, (bf16*)(ws + WS_W_INA + 4 * MiB), false, gm + 3 * D)) continue;
                if (conv_job(F, it, inp(F, 15), D, D, (bf16*)(ws + WS_W_OUTA), false, nullptr)) continue;
                if (conv_job(F, it, inp(F, 15) + (size_t)D * D, D, D, (bf16*)(ws + WS_W_OUTA + 2 * MiB), false, nullptr)) continue;
                if (conv_job(F, it, inp(F, 16), D, 2048, (bf16*)(ws + WS_W_INB), false, gm + D)) continue;
                if (conv_job(F, it, inp(F, 24), D, D, (bf16*)(ws + WS_W_OUTB), false, nullptr)) continue;
                if (conv_job(F, it, inp(F, 25), D, D, (bf16*)(ws + WS_W_INC), false, gm + 2 * D)) continue;
                conv_job(F, it, inp(F, 34), D, 2048, (bf16*)(ws + WS_W_GLU), true, nullptr);
            }
        } else if (ph == PH_FINAL) {
            norm_final(F, X, inp(F, 8));
        } else {
            const int l = (ph - 1) / 5, st = (ph - 1) % 5, kind = l % 3, j = l / 3;
            if (st == ST_GIN) {
                if (kind == 0) { const bf16* W = (const bf16*)(ws + WS_W_INA + (size_t)j * 4 * MiB); EpiRow8<FAct<ACT_GELU, true>> E{{(bf16*)T, 2048, SX0, 16, SV}};
                    big_gemm(F, XB16, W, 2048, D, E); small_gemm<2>(F, XB16, W, D, E.f); }
                else if (kind == 1) { const bf16* W = (const bf16*)(ws + WS_W_INB); EpiRow8<FRglru> E{{(bf16*)T, (float*)(T + 33 * MiB), SX0}};
                    big_gemm(F, XB16, W, 2048, D, E); small_gemm<2>(F, XB16, W, D, E.f); }
                else { const bf16* W = (const bf16*)(ws + WS_W_INC); EpiRow8<FF32> E{{(float*)T, D, SX0}};
                    big_gemm(F, XB16, W, D, D, E); small_gemm<1>(F, XB16, W, D, E.f); }
            } else if (st == ST_MIX) {
                if (kind == 0) sgu_mix_phase(F, (const bf16*)T, SV, inp(F, 12) + j * 1024, (const bf16*)(ws + WS_WM) + (size_t)j * 8 * 128 * 128, inp(F, 14) + j * 8 * 128, inp(F, 13) + (size_t)j * 8 * 128 * 128, Y, X + O_VS + (size_t)j * MS * 1024);
                else if (kind == 1) rglru_phase(F, (const float*)(T + 33 * MiB), (const bf16*)T, Y, inp(F, 17), inp(F, 18), ws + WS_RGT, inp(F, 2), inp(F, 3), X);
                else s5_phase(F, (const float*)T, Y, inp(F, 33), ws + WS_S5T, inp(F, 4), inp(F, 5), X);
                __syncthreads();
                ffn_conv(F, l, inp(F, 9), inp(F, 10), inp(F, 7), ws);
            } else if (st == ST_GOUT) {
                if (kind == 2) { const bf16* W = (const bf16*)(ws + WS_W_GLU); EpiPair8<FGlu> E{{X, XB16, SX1}};
                    big_gemm(F, Y, W, 2048, D, E); small_gemm_glu(F, Y, W, D, E.f); }
                else { const bf16* W = kind == 0 ? (const bf16*)(ws + WS_W_OUTA + (size_t)j * 2 * MiB) : (const bf16*)(ws + WS_W_OUTB); EpiResid8<FResid> E{{X, XB16, SX1}};
                    big_gemm(F, Y, W, D, D, E); small_gemm<1>(F, Y, W, D, E.f); }
            } else if (st == ST_FF1) {
                const bf16* W = (const bf16*)(ws + WS_W_FF1); EpiRow8<FAct<ACT_SQRELU, false>> E{{(bf16*)T, FF, SX1, kind == 2 ? 32 : 16, nullptr}};
                big_gemm(F, XB16, W, FF, D, E); small_gemm<4>(F, XB16, W, D, E.f);
            } else {
                const bf16* W = (const bf16*)(ws + WS_W_FF2); EpiResid8<FResid> E{{X, XB16, SX0}};
                big_gemm(F, (const bf16*)T, W, D, FF, E); small_gemm<1>(F, (const bf16*)T, W, FF, E.f);
            }
        }
        { int reps_ = 1;
          if (ph > 0 && ph < PH_FINAL) { const int st_ = (ph - 1) % 5;
              if (DUP_CLS == 1 && st_ == ST_GIN) reps_ = 2;
              if (DUP_CLS == 2 && st_ == ST_MIX) reps_ = 2;
              if (DUP_CLS >= 20 && DUP_CLS <= 22 && st_ == ST_MIX && (((ph - 1) / 5) % 3) == DUP_CLS - 20) reps_ = 2;
              if (DUP_CLS == 4 && st_ == ST_FF1) reps_ = 2; }
          if (DUP_CLS == 6 && ph == 0) reps_ = 2;
          if (DUP_CLS == 7 && ph == PH_FINAL - 1) reps_ = 1;
          if (rep_ + 1 < reps_) { ++rep_; __syncthreads(); continue; }
          rep_ = 0; }
        if (ph + 1 < a.ph_hi) xcd_barrier(bar);
        ++ph;
    }
}

static void launch_mk(const Args& base, int lo, int hi, hipStream_t stream) {
    Args a = base; a.ph_lo = lo; a.ph_hi = hi;
    hipLaunchKernelGGL(mk, dim3(256), dim3(NWAVES * 64), LDS_BYTES, stream, a);
}

extern "C" void kernel_launch(void* const* d_in, const int* in_sizes, int n_in, void* d_out, int out_size, void* d_ws, size_t ws_size, hipStream_t stream) {
    static int inited = 0;
    if (!inited) {
        if (n_in != 35 || out_size != (int)O_END || ws_size < WS_END) { fprintf(stderr, "kernel_launch: unexpected sizes n_in %d out %d ws %zu\n", n_in, out_size, ws_size); }
        if (hipFuncSetAttribute((const void*)mk, hipFuncAttributeMaxDynamicSharedMemorySize, LDS_BYTES) != hipSuccess) fprintf(stderr, "kernel_launch: hipFuncSetAttribute failed\n");
        (void)hipGetLastError(); inited = 1;
    }
    (void)hipMemsetAsync((unsigned char*)d_ws + WS_CTL, 0, CTL_ZERO_BYTES, stream);
    Args base{}; for (int i = 0; i < 35; ++i) base.in[i] = (const float*)d_in[i]; base.out = (float*)d_out; base.ws = (unsigned char*)d_ws;
    launch_mk(base, 0, PH_END, stream);
}
```

```cpp
#include <hip/hip_runtime.h>
#include <cstdio>
#include <cstdint>

constexpr int MP = 16384, MS = 512, M = MP + MS, D = 1024, FF = 4096;
constexpr float EPS = 1e-6f;

constexpr size_t O_YP = 0, O_YS = (size_t)MP * D, O_VS = O_YS + (size_t)MS * D, O_CONVP = O_VS + 2 * (size_t)MS * D, O_HP = O_CONVP + 8 * 3 * 1024,
                 O_CONVS = O_HP + 8 * 1024, O_HS = O_CONVS + 128 * 3 * 1024, O_SREP = O_HS + 128 * 1024, O_SIMP = O_SREP + 8 * 4096, O_SRES = O_SIMP + 8 * 4096,
                 O_SIMS = O_SRES + 128 * 4096, O_END = O_SIMS + 128 * 4096;

constexpr size_t MiB = 1u << 20;
constexpr size_t WS_CTL = 0, CTL_ZERO_BYTES = 64 * 1024;
constexpr size_t WS_XN = 1 * MiB;
constexpr size_t WS_T = 34 * MiB;
constexpr size_t WS_RSV = 128 * 1024;
constexpr size_t WS_WM = 166 * MiB;
constexpr size_t WS_RGT = 167 * MiB;
constexpr size_t WS_S5T = 168 * MiB;
constexpr size_t WS_S5AB = 170 * MiB;
constexpr size_t WS_S5BB = 170 * MiB + 512 * 1024;
constexpr size_t WS_HST = 171 * MiB;
constexpr size_t WS_S5ST = 172 * MiB;
constexpr size_t WS_CHA = 176 * MiB;
constexpr size_t WS_CHB = 180 * MiB;
constexpr size_t WS_XSR = 184 * MiB;
constexpr size_t WS_XSI = 200 * MiB;
constexpr size_t WS_W_INA = 216 * MiB, WS_W_OUTA = 224 * MiB, WS_W_INB = 228 * MiB, WS_W_OUTB = 232 * MiB, WS_W_INC = 234 * MiB, WS_W_GLU = 236 * MiB,
                 WS_W_FF1 = 240 * MiB, WS_W_FF2 = 248 * MiB, WS_END = 256 * MiB;
constexpr int CW_BAR = 4096;

#define GAS __attribute__((address_space(1)))
#define LAS __attribute__((address_space(3)))
typedef unsigned short bf16;
typedef unsigned v4u __attribute__((ext_vector_type(4)));
typedef float f32x4 __attribute__((ext_vector_type(4)));
typedef short bf16x8 __attribute__((ext_vector_type(8)));
typedef GAS unsigned gu32;
typedef GAS unsigned long long gu64;
#define RLX_AGENT __ATOMIC_RELAXED, __HIP_MEMORY_SCOPE_AGENT
#define LDS_WAIT() asm volatile("s_waitcnt lgkmcnt(0)" ::: "memory")
#define VM_WAIT() asm volatile("s_waitcnt vmcnt(0)" ::: "memory")
__device__ __forceinline__ unsigned long long rt() { return __builtin_amdgcn_s_memrealtime(); }
__device__ __forceinline__ unsigned f2bf(float f) { unsigned u = __builtin_bit_cast(unsigned, f); return (u + 0x7fffu + ((u >> 16) & 1u)) >> 16; }
__device__ __forceinline__ unsigned pk2(float lo, float hi) { return f2bf(lo) | (f2bf(hi) << 16); }

#define XB_TMO      128
#define XB_XCNT(j)  (256  + 64 * (j))
#define XB_XSUB(j)  (1280 + 64 * (j))
#define XB_XGEN(j)  (2304 + 64 * (j))
#define XB_TOP      3328
#define XB_TOPGEN   3392
#define XCD_BAR_WORDS 3456
#define XB_SPIN_CAP (1u << 18)

__device__ __forceinline__ unsigned xb_ld(unsigned* p)              { return __hip_atomic_load(p, __ATOMIC_RELAXED, __HIP_MEMORY_SCOPE_AGENT); }
__device__ __forceinline__ unsigned xb_add(unsigned* p, unsigned v) { return __hip_atomic_fetch_add(p, v, __ATOMIC_RELAXED, __HIP_MEMORY_SCOPE_AGENT); }
__device__ __forceinline__ unsigned xb_xcc_id() { return (unsigned)__builtin_amdgcn_s_getreg((3 << 11) | 20) & 0xFu; }
#define XB_SPIN(cond, bar) do { unsigned _sp = 0; while (cond) { __builtin_amdgcn_s_sleep(1); \
    if ((++_sp & 255u) == 0u) { if (xb_ld(&(bar)[XB_TMO])) break; if (_sp > XB_SPIN_CAP) { atomicAdd(&(bar)[XB_TMO], 1u); break; } } } } while (0)

struct XcdBarrier {
    unsigned* bar; unsigned x;
    volatile LAS unsigned* st;
};

__device__ __forceinline__ XcdBarrier xcd_barrier_post(unsigned* bar, volatile LAS unsigned* st) {
    XcdBarrier b; b.bar = bar; b.x = xb_xcc_id(); b.st = st;
    if (threadIdx.x == 0) (void)xb_add(&bar[XB_XCNT(b.x)], 1u);
    return b;
}
__device__ __forceinline__ void xcd_barrier_complete(unsigned* bar, unsigned x, unsigned& nloc, unsigned& nx) {
    const unsigned G = gridDim.x * gridDim.y * gridDim.z;
    unsigned sum, cnt, mine, sp = 0u;
    for (;;) {
        sum = 0u; cnt = 0u; mine = 0u;
#pragma unroll
        for (unsigned j = 0; j < 16; ++j) { const unsigned c = xb_ld(&bar[XB_XCNT(j)]); sum += c; cnt += (c > 0u) ? 1u : 0u; mine = (j == x) ? c : mine; }
        if (sum == G) break;
        __builtin_amdgcn_s_sleep(1);
        if ((++sp & 255u) == 0u) { if (xb_ld(&bar[XB_TMO])) break; if (sp > XB_SPIN_CAP) { atomicAdd(&bar[XB_TMO], 1u); break; } }
    }
    nloc = mine > 0u ? mine : 1u; nx = cnt > 0u ? cnt : 1u;
}

__device__ __forceinline__ void xcd_barrier(const XcdBarrier& b) {
    asm volatile("s_waitcnt vmcnt(0)" ::: "memory");
    __syncthreads();
    if (threadIdx.x == 0) {
        unsigned* bar = b.bar;
        __builtin_amdgcn_s_waitcnt(0);
        unsigned nloc = b.st[0], nx = b.st[1];
        if (nloc == 0u) { xcd_barrier_complete(bar, b.x, nloc, nx); b.st[0] = nloc; b.st[1] = nx; }
        const unsigned old = xb_add(&bar[XB_XSUB(b.x)], 1u);
        const unsigned gen = old / nloc;
        if (old + 1u == (gen + 1u) * nloc) {
            __builtin_amdgcn_fence(__ATOMIC_RELEASE, "agent");
            asm volatile("s_waitcnt vmcnt(0)" ::: "memory");
            const unsigned og = xb_add(&bar[XB_TOP], 1u);
            const unsigned tg = og / nx;
            if (og + 1u == (tg + 1u) * nx) xb_add(&bar[XB_TOPGEN], 1u);
            else XB_SPIN(xb_ld(&bar[XB_TOPGEN]) == tg, bar);
            __builtin_amdgcn_fence(__ATOMIC_ACQUIRE, "agent");
            xb_add(&bar[XB_XGEN(b.x)], 1u);
            asm volatile("s_waitcnt vmcnt(0)" ::: "memory");
        } else {
            XB_SPIN(xb_ld(&bar[XB_XGEN(b.x)]) == gen, bar);
            __builtin_amdgcn_fence(__ATOMIC_ACQUIRE, "agent");
            asm volatile("s_waitcnt vmcnt(0)" ::: "memory");
        }
    }
    __syncthreads();
}
namespace pg8 {
#define PG8_LAS __attribute__((address_space(3)))
typedef unsigned short bf16_t;
typedef short bf16x8 __attribute__((ext_vector_type(8)));
typedef float f32x4 __attribute__((ext_vector_type(4)));
typedef unsigned u32x4 __attribute__((ext_vector_type(4)));
constexpr int BM = 256, BK = 64, HALF = 128, HTB = HALF * BK * 2  , STAGE_BYTES = 8 * HTB, NXCD = 8, WGM = 8;

__host__ __device__ __forceinline__ int lds_byte(int r, int c) { const int st = (r >> 4) * 2 + (c >> 5), rr = r & 15, cc = c & 31, ob = rr * 64 + cc * 2; return st * 1024 + (ob ^ (((ob >> 9) & 1) << 5)); }
__host__ __device__ __forceinline__ void stage_rc(int b, int& R, int& C) { const int st = b / 1024, sb = b % 1024, swz = sb ^ (((sb >> 9) & 1) << 5); R = (st >> 1) * 16 + swz / 64; C = (st & 1) * 32 + (swz % 64) / 2; }
__host__ __device__ __forceinline__ int perm32(int rho) { const int n = rho >> 4, i = rho & 15; return 8 * (i >> 2) + 4 * n + (i & 3); }

struct Unit { int pm, pn; };
struct Gemm { const bf16_t* A; const bf16_t* Bt; int M, N, K; };

struct StaticOrder {
    int nM, nN, nwg, G, c;
    __host__ __device__ void init(int M, int N, int G_, int c_) { nM = M / BM; nN = N / BM; nwg = nM * nN; G = G_; c = c_; }
    __host__ __device__ bool next(int i, Unit& u) const {
        const long L = (long)i * G + c; if (L >= nwg) return false;
        int wgid = (int)L; { const int q = nwg / NXCD, r = nwg % NXCD, xcd = wgid % NXCD, off = wgid / NXCD; wgid = (xcd < r ? xcd * (q + 1) : r * (q + 1) + (xcd - r) * q) + off; }
        const int nig = WGM * nN, gid = wgid / nig, fm = gid * WGM, gsz = (nM - fm) < WGM ? (nM - fm) : WGM;
        u.pm = fm + ((wgid % nig) % gsz); u.pn = (wgid % nig) / gsz; return true;
    }
    __device__ __forceinline__ void a_ready(const Unit&) const {}
    __device__ __forceinline__ void done(const Unit&) const {}
};

template <class Epi, class Sched, bool ALIGN_EPI = false, bool SP2 = false>
__device__ __forceinline__ void gemm_phase(PG8_LAS unsigned char* lds, const Gemm g, const Sched& S, const Epi& E, const int tid_in) {
    const int tid = tid_in, wid = __builtin_amdgcn_readfirstlane(tid >> 6), lane = tid & 63, wr = wid >> 2, wc = wid & 3, fr = lane & 15, fq = lane >> 4;
    const int K = g.K, nt = K / BK;
    unsigned voffA[2], voffB[2];
#pragma unroll
    for (int i = 0; i < 2; ++i) { int R, C; stage_rc(tid * 16 + i * 8192, R, C); const int Rb = Epi::PERM ? ((R & ~31) + perm32(R & 31)) : R;
        voffA[i] = (unsigned)(R * K + C) * 2u; voffB[i] = (unsigned)(Rb * K + C) * 2u; }
    const size_t kstep = (size_t)(BK * 2);
    const size_t hstep = (size_t)HALF * K * 2;
    const size_t tstep = 2 * hstep;
    const unsigned ldsw = (unsigned)wid * 1024u;
    const int aoff = lds_byte(wr * 64 + fr, fq * 8), boff = lds_byte(wc * 32 + fr, fq * 8);
#define PG8_SA(b, h) (((b) * 2 + (h)) * HTB)
#define PG8_SB(b, h) ((4 + (b) * 2 + (h)) * HTB)
#define PG8_STAGE(bufoff, gbase, voff) do { _Pragma("unroll") for (int _i = 0; _i < 2; ++_i) \
        __builtin_amdgcn_global_load_lds((const unsigned*)((const char*)(gbase) + (voff)[_i]), (PG8_LAS unsigned*)(lds + (bufoff) + ldsw + _i * 8192), 16, 0, 0); } while (0)
#define PG8_LDA(dst, b, h) do { _Pragma("unroll") for (int m = 0; m < 4; ++m) _Pragma("unroll") for (int k = 0; k < 2; ++k) dst[m][k] = *(const PG8_LAS bf16x8*)(lds + PG8_SA(b, h) + aoff + m * 2048 + k * 1024); } while (0)
#define PG8_LDB(dst, b, h) do { _Pragma("unroll") for (int n = 0; n < 2; ++n) _Pragma("unroll") for (int k = 0; k < 2; ++k) dst[n][k] = *(const PG8_LAS bf16x8*)(lds + PG8_SB(b, h) + boff + n * 2048 + k * 1024); } while (0)
#define PG8_MMA(ai, bj, At, Bt) do { __builtin_amdgcn_s_setprio(1); _Pragma("unroll") for (int m = 0; m < 4; ++m) _Pragma("unroll") for (int n = 0; n < 2; ++n) _Pragma("unroll") for (int k = 0; k < 2; ++k) \
        acc[ai][bj][m][n] = __builtin_amdgcn_mfma_f32_16x16x32_bf16(Bt[n][k], At[m][k], acc[ai][bj][m][n], 0, 0, 0); __builtin_amdgcn_s_setprio(0); } while (0)
#define PG8_WAIT_V(n) asm volatile("s_waitcnt vmcnt(" #n ")" ::: "memory")
#define PG8_WAIT_L(n) asm volatile("s_waitcnt lgkmcnt(" #n ")" ::: "memory")
#define PG8_BAR __builtin_amdgcn_s_barrier()
#define PG8_SCHED __builtin_amdgcn_sched_barrier(0)
    Unit cur, nxt; int ui = 0;
    if (!S.next(0, cur)) return;
    E.first(lds, cur, tid);
    f32x4 acc[2][2][4][2];
#pragma unroll
    for (int a = 0; a < 2; ++a)
#pragma unroll
        for (int b = 0; b < 2; ++b)
#pragma unroll
            for (int m = 0; m < 4; ++m)
#pragma unroll
                for (int n = 0; n < 2; ++n) acc[a][b][m][n] = (f32x4){0.f, 0.f, 0.f, 0.f};
    bf16x8 At[4][2], B0[2][2], B1[2][2];
    const char* cA = (const char*)g.A + (size_t)cur.pm * tstep; const char* cB = (const char*)g.Bt + (size_t)cur.pn * tstep;
    S.a_ready(cur);
    if constexpr (SP2) {
        PG8_STAGE(PG8_SB(0, 0), cB, voffB); PG8_STAGE(PG8_SB(0, 1), cB + hstep, voffB); PG8_STAGE(PG8_SA(0, 0), cA, voffA); PG8_STAGE(PG8_SA(0, 1), cA + hstep, voffA);
        if (wr == 1) PG8_BAR;
        PG8_WAIT_V(2); PG8_BAR;
        PG8_STAGE(PG8_SB(1, 0), cB + kstep, voffB); PG8_STAGE(PG8_SA(1, 0), cA + kstep, voffA); PG8_STAGE(PG8_SB(1, 1), cB + hstep + kstep, voffB);
        PG8_WAIT_V(6); PG8_BAR;
    } else {
        PG8_STAGE(PG8_SB(0, 0), cB, voffB); PG8_STAGE(PG8_SA(0, 0), cA, voffA); PG8_STAGE(PG8_SB(0, 1), cB + hstep, voffB); PG8_STAGE(PG8_SA(0, 1), cA + hstep, voffA);
        if (wr == 1) PG8_BAR;
        PG8_WAIT_V(4); PG8_BAR;
        PG8_STAGE(PG8_SB(1, 0), cB + kstep, voffB); PG8_STAGE(PG8_SA(1, 0), cA + kstep, voffA); PG8_STAGE(PG8_SB(1, 1), cB + hstep + kstep, voffB);
        PG8_WAIT_V(6); PG8_BAR;
    }
    for (;;) {
        const bool has_next = S.next(ui + 1, nxt);
        const char* nA = has_next ? (const char*)g.A + (size_t)nxt.pm * tstep : cA; const char* nB = has_next ? (const char*)g.Bt + (size_t)nxt.pn * tstep : cB;
        for (int t = 0; t < nt; t += 2) {
            const bool last = (t == nt - 2);
            const char* a1 = cA + (size_t)(t + 1) * kstep;
            const char* a2 = last ? nA : cA + (size_t)(t + 2) * kstep; const char* b2 = last ? nB : cB + (size_t)(t + 2) * kstep;
            const char* a3 = a2 + kstep; const char* b3 = b2 + kstep;
            if (last && has_next) S.a_ready(nxt);
            if constexpr (SP2) {
            PG8_LDB(B0, 0, 0); PG8_LDB(B1, 0, 1); PG8_SCHED; PG8_LDA(At, 0, 0); PG8_STAGE(PG8_SA(1, 1), a1 + hstep, voffA);
            PG8_WAIT_V(8); PG8_WAIT_L(0); PG8_BAR; PG8_MMA(0, 0, At, B0); PG8_MMA(0, 1, At, B1); PG8_BAR; PG8_SCHED;
            PG8_LDA(At, 0, 1); PG8_STAGE(PG8_SB(0, 0), b2, voffB); PG8_STAGE(PG8_SB(0, 1), b2 + hstep, voffB); PG8_STAGE(PG8_SA(0, 0), a2, voffA);
            PG8_WAIT_V(8); PG8_WAIT_L(0); PG8_BAR; PG8_MMA(1, 0, At, B0); PG8_MMA(1, 1, At, B1); PG8_BAR; PG8_SCHED;
            PG8_LDB(B0, 1, 0); PG8_LDB(B1, 1, 1); PG8_SCHED; PG8_LDA(At, 1, 0); PG8_STAGE(PG8_SA(0, 1), a2 + hstep, voffA);
            PG8_WAIT_V(8); PG8_WAIT_L(0); PG8_BAR; PG8_MMA(0, 0, At, B0); PG8_MMA(0, 1, At, B1); PG8_BAR; PG8_SCHED;
            PG8_LDA(At, 1, 1); PG8_STAGE(PG8_SB(1, 0), b3, voffB); PG8_STAGE(PG8_SB(1, 1), b3 + hstep, voffB); PG8_STAGE(PG8_SA(1, 0), a3, voffA);
            PG8_WAIT_V(8); PG8_WAIT_L(0); PG8_BAR; PG8_MMA(1, 0, At, B0); PG8_MMA(1, 1, At, B1); PG8_BAR; PG8_SCHED;
            } else {
            PG8_LDB(B0, 0, 0); PG8_SCHED; PG8_LDA(At, 0, 0); PG8_STAGE(PG8_SA(1, 1), a1 + hstep, voffA);
            PG8_WAIT_L(8); PG8_BAR; PG8_WAIT_L(0); PG8_MMA(0, 0, At, B0); PG8_BAR; PG8_SCHED;
            PG8_LDB(B1, 0, 1); PG8_STAGE(PG8_SB(0, 0), b2, voffB);
            PG8_BAR; PG8_WAIT_L(0); PG8_MMA(0, 1, At, B1); PG8_BAR;
            PG8_LDA(At, 0, 1); PG8_STAGE(PG8_SA(0, 0), a2, voffA);
            PG8_BAR; PG8_WAIT_L(0); PG8_MMA(1, 0, At, B0); PG8_BAR; PG8_SCHED;
            PG8_STAGE(PG8_SB(0, 1), b2 + hstep, voffB);
            PG8_WAIT_V(6); PG8_BAR; PG8_MMA(1, 1, At, B1); PG8_BAR;
            PG8_LDB(B0, 1, 0); PG8_SCHED; PG8_LDA(At, 1, 0); PG8_STAGE(PG8_SA(0, 1), a2 + hstep, voffA);
            PG8_WAIT_L(8); PG8_BAR; PG8_WAIT_L(0); PG8_MMA(0, 0, At, B0); PG8_BAR; PG8_SCHED;
            PG8_LDB(B1, 1, 1); PG8_STAGE(PG8_SB(1, 0), b3, voffB);
            PG8_BAR; PG8_WAIT_L(0); PG8_MMA(0, 1, At, B1); PG8_BAR;
            PG8_LDA(At, 1, 1); PG8_STAGE(PG8_SA(1, 0), a3, voffA);
            PG8_BAR; PG8_WAIT_L(0); PG8_MMA(1, 0, At, B0); PG8_BAR; PG8_SCHED;
            PG8_STAGE(PG8_SB(1, 1), b3 + hstep, voffB);
            PG8_WAIT_V(6); PG8_BAR; PG8_MMA(1, 1, At, B1); PG8_BAR;
            }
        }
        if constexpr (ALIGN_EPI) { if (wr == 0) PG8_BAR; }
        if constexpr (!Epi::AFTER_DRAIN) { E(acc, cur, wr, wc, fr, fq, lds, nxt, has_next, ui, tid); S.done(cur); }
        if (!has_next) break;
#pragma unroll
        for (int a = 0; a < 2; ++a)
#pragma unroll
            for (int b = 0; b < 2; ++b)
#pragma unroll
                for (int m = 0; m < 4; ++m)
#pragma unroll
                    for (int n = 0; n < 2; ++n) acc[a][b][m][n] = (f32x4){0.f, 0.f, 0.f, 0.f};
        cur = nxt; cA = nA; cB = nB; ++ui;
        if constexpr (ALIGN_EPI) { if (wr == 1) PG8_BAR; }
    }
    PG8_WAIT_V(0);
    if constexpr (!ALIGN_EPI) { if (wr == 0) PG8_BAR; }
    PG8_BAR;
    if constexpr (Epi::AFTER_DRAIN) { E.fused(acc, cur, wr, wc, fr, fq, lds, wid, lane); S.done(cur); }
#undef PG8_SA
#undef PG8_SB
#undef PG8_STAGE
#undef PG8_LDA
#undef PG8_LDB
#undef PG8_MMA
#undef PG8_WAIT_V
#undef PG8_WAIT_L
#undef PG8_BAR
#undef PG8_SCHED
}
}
__device__ __forceinline__ float bf2f(unsigned short h) { return __builtin_bit_cast(float, (unsigned)h << 16); }
__device__ __forceinline__ float gelu_tanh(float x) { const float u = 0.7978845608028654f * (x + 0.044715f * x * x * x); return 0.5f * x * (1.f + tanhf(u)); }
__device__ __forceinline__ float sigmoidf_(float x) { return 1.f / (1.f + expf(-x)); }
template <int CTRL> __device__ __forceinline__ float dpp0(float src) { return __builtin_bit_cast(float, __builtin_amdgcn_update_dpp(0, __builtin_bit_cast(int, src), CTRL, 0xf, 0xf, true)); }
__device__ __forceinline__ float xor16f(float v) { return __shfl_xor(v, 16); }
__device__ __forceinline__ float sum32f(float v) { return v + __shfl_xor(v, 32); }
__device__ __forceinline__ float wave_sum(float v) {
#pragma unroll
    for (int o = 1; o < 64; o <<= 1) v += __shfl_xor(v, o);
    return v;
}
__device__ __forceinline__ unsigned cvt_pk_bf16(float lo, float hi) { unsigned r; asm volatile("v_cvt_pk_bf16_f32 %0, %1, %2" : "=v"(r) : "v"(lo), "v"(hi)); return r; }
__device__ __forceinline__ float gelu_fast(float x) { const float u = x * (0.7978845608028654f + 0.035677408136300125f * x * x); return x * __builtin_amdgcn_rcpf(1.f + __builtin_amdgcn_exp2f(-2.8853900817779268f * u)); }
__device__ __forceinline__ float sigmoid_fast(float x) { return __builtin_amdgcn_rcpf(1.f + __builtin_amdgcn_exp2f(-1.4426950408889634f * x)); }
enum { ACT_GELU = 0, ACT_SQRELU = 1 };
typedef unsigned u32x2 __attribute__((ext_vector_type(2)));
struct RowCtx { float rs, ss; };
constexpr int XS_P = 32, XS_S = 64, VS_P = 16, VS_S = 64;
template <int N4> __device__ __forceinline__ float sum_slots_n(const float* p) { f32x4 v[N4];
#pragma unroll
    for (int i = 0; i < N4; ++i) v[i] = ((const f32x4*)p)[i];
    float s = 0.f;
#pragma unroll
    for (int i = 0; i < N4; ++i) s += (v[i].x + v[i].y) + (v[i].z + v[i].w);
    return s; }
__device__ __forceinline__ float sum_slots(const float* p, int n4) { return n4 == 4 ? sum_slots_n<4>(p) : (n4 == 8 ? sum_slots_n<8>(p) : sum_slots_n<16>(p)); }
__device__ __forceinline__ float rs_x(const float* P, int nslot, int row) {
    const float s = row < MP ? sum_slots(P + (size_t)row * XS_P, nslot >> 2) : sum_slots(P + (size_t)MP * XS_P + (size_t)(row - MP) * XS_S, XS_S >> 2); return rsqrtf(s * (1.f / 1024.f) + EPS); }
__device__ __forceinline__ float rs_v(const float* P, int row) {
    const float s = row < MP ? sum_slots(P + (size_t)row * VS_P, VS_P >> 2) : sum_slots(P + (size_t)MP * VS_P + (size_t)(row - MP) * VS_S, VS_S >> 2); return rsqrtf(s * (1.f / 1024.f) + EPS); }
__device__ __forceinline__ float fq_sum(float ss) { ss += xor16f(ss); return sum32f(ss); }
__device__ __forceinline__ void xs_store(float* P, int row, int col, bool pair, float ss, int fq) {
    ss = fq_sum(ss); if (fq != 0) return;
    if (row < MP) P[(size_t)row * XS_P + (pair ? (col >> 5) : (((col >> 8) << 2) | ((col >> 5) & 3)))] = ss; else P[(size_t)MP * XS_P + (size_t)(row - MP) * XS_S + (col >> 4)] = ss; }
__device__ __forceinline__ void vs_store(float* P, int row, int col, float ss, int fq) {
    ss = fq_sum(ss); if (fq != 0) return; const int c = col - 1024;
    if (row < MP) P[(size_t)row * VS_P + (((c >> 8) << 2) | ((c >> 5) & 3))] = ss; else P[(size_t)MP * VS_P + (size_t)(row - MP) * VS_S + (c >> 4)] = ss; }
constexpr int RSTAB_OFF = 131072 + 2048;
__device__ __forceinline__ LAS float* rstab(LAS unsigned char* lds, int par) { return (LAS float*)(lds + RSTAB_OFF) + par * 256; }
template <int ACT> __device__ __forceinline__ float act_f(float x) { if (ACT == ACT_GELU) return gelu_fast(x); const float t = fmaxf(x, 0.f); return t * t; }

template <int ACT, bool VSTAT> struct FAct { bf16* O; int ldc; const float* S; int nslot; float* SV;
    __device__ __forceinline__ RowCtx begin(int row) const { return RowCtx{rs_x(S, nslot, row), 0.f}; }
    __device__ __forceinline__ float rs_row(int row) const { return rs_x(S, nslot, row); }
    __device__ __forceinline__ void apply8(RowCtx& c, int row, int col, f32x4 v0, f32x4 v1) const {
        float r[8];
#pragma unroll
        for (int i = 0; i < 4; ++i) { r[i] = act_f<ACT>(v0[i] * c.rs); r[4 + i] = act_f<ACT>(v1[i] * c.rs); }
        if (VSTAT && col >= 1024) {
#pragma unroll
            for (int i = 0; i < 8; ++i) c.ss += r[i] * r[i]; }
        v4u w; w.x = cvt_pk_bf16(r[0], r[1]); w.y = cvt_pk_bf16(r[2], r[3]); w.z = cvt_pk_bf16(r[4], r[5]); w.w = cvt_pk_bf16(r[6], r[7]); *(v4u*)(O + (size_t)row * ldc + col) = w; }
    __device__ __forceinline__ void apply4(RowCtx& c, int row, int col, f32x4 v) const {
        float r[4];
#pragma unroll
        for (int i = 0; i < 4; ++i) r[i] = act_f<ACT>(v[i] * c.rs);
        if (VSTAT && col >= 1024) c.ss += (r[0] * r[0] + r[1] * r[1]) + (r[2] * r[2] + r[3] * r[3]);
        u32x2 w; w.x = cvt_pk_bf16(r[0], r[1]); w.y = cvt_pk_bf16(r[2], r[3]); *(u32x2*)(O + (size_t)row * ldc + col) = w; }
    __device__ __forceinline__ void end(RowCtx& c, int row, int col, int fq) const { if (VSTAT && col >= 1024) vs_store(SV, row, col, c.ss, fq); } };
struct FRglru { bf16* G; float* XB; const float* S;
    __device__ __forceinline__ RowCtx begin(int row) const { return RowCtx{rs_x(S, 16, row), 0.f}; }
    __device__ __forceinline__ float rs_row(int row) const { return rs_x(S, 16, row); }
    __device__ __forceinline__ void apply8(RowCtx& c, int row, int col, f32x4 v0, f32x4 v1) const {
        if (col < 1024) { v4u w; w.x = cvt_pk_bf16(gelu_fast(v0[0] * c.rs), gelu_fast(v0[1] * c.rs)); w.y = cvt_pk_bf16(gelu_fast(v0[2] * c.rs), gelu_fast(v0[3] * c.rs));
            w.z = cvt_pk_bf16(gelu_fast(v1[0] * c.rs), gelu_fast(v1[1] * c.rs)); w.w = cvt_pk_bf16(gelu_fast(v1[2] * c.rs), gelu_fast(v1[3] * c.rs)); *(v4u*)(G + (size_t)row * 1024 + col) = w; }
        else { float* p = XB + (size_t)row * 1024 + col - 1024; *(f32x4*)p = v0 * c.rs; *(f32x4*)(p + 4) = v1 * c.rs; } }
    __device__ __forceinline__ void apply4(RowCtx& c, int row, int col, f32x4 v) const {
        if (col < 1024) { u32x2 w; w.x = cvt_pk_bf16(gelu_fast(v[0] * c.rs), gelu_fast(v[1] * c.rs)); w.y = cvt_pk_bf16(gelu_fast(v[2] * c.rs), gelu_fast(v[3] * c.rs)); *(u32x2*)(G + (size_t)row * 1024 + col) = w; }
        else *(f32x4*)(XB + (size_t)row * 1024 + col - 1024) = v * c.rs; }
    __device__ __forceinline__ void end(RowCtx&, int, int, int) const {} };
struct FF32 { float* O; int ldc; const float* S;
    __device__ __forceinline__ RowCtx begin(int row) const { return RowCtx{rs_x(S, 16, row), 0.f}; }
    __device__ __forceinline__ float rs_row(int row) const { return rs_x(S, 16, row); }
    __device__ __forceinline__ void apply8(RowCtx& c, int row, int col, f32x4 v0, f32x4 v1) const { float* p = O + (size_t)row * ldc + col; *(f32x4*)p = v0 * c.rs; *(f32x4*)(p + 4) = v1 * c.rs; }
    __device__ __forceinline__ void apply4(RowCtx& c, int row, int col, f32x4 v) const { *(f32x4*)(O + (size_t)row * ldc + col) = v * c.rs; }
    __device__ __forceinline__ void end(RowCtx&, int, int, int) const {} };
struct FResid { float* X; bf16* XB16; float* Sacc;
    __device__ __forceinline__ RowCtx begin(int) const { return RowCtx{0.f, 0.f}; }
    __device__ __forceinline__ void load8(int row, int col, f32x4& xa, f32x4& xb) const { const float* p = X + (size_t)row * D + col; xa = *(const f32x4*)p; xb = *(const f32x4*)(p + 4); }
    __device__ __forceinline__ void apply8x(RowCtx& c, int row, int col, f32x4 v0, f32x4 v1, f32x4 xa, f32x4 xb) const { float* p = X + (size_t)row * D + col;
        const f32x4 x0 = xa + v0, x1 = xb + v1; *(f32x4*)p = x0; *(f32x4*)(p + 4) = x1;
        c.ss += (x0[0] * x0[0] + x0[1] * x0[1]) + (x0[2] * x0[2] + x0[3] * x0[3]) + (x1[0] * x1[0] + x1[1] * x1[1]) + (x1[2] * x1[2] + x1[3] * x1[3]);
        v4u w; w.x = cvt_pk_bf16(x0[0], x0[1]); w.y = cvt_pk_bf16(x0[2], x0[3]); w.z = cvt_pk_bf16(x1[0], x1[1]); w.w = cvt_pk_bf16(x1[2], x1[3]); *(v4u*)(XB16 + (size_t)row * D + col) = w; }
    __device__ __forceinline__ void apply4(RowCtx& c, int row, int col, f32x4 v) const { float* p = X + (size_t)row * D + col; const f32x4 x0 = *(const f32x4*)p + v; *(f32x4*)p = x0;
        c.ss += (x0[0] * x0[0] + x0[1] * x0[1]) + (x0[2] * x0[2] + x0[3] * x0[3]);
        u32x2 w; w.x = cvt_pk_bf16(x0[0], x0[1]); w.y = cvt_pk_bf16(x0[2], x0[3]); *(u32x2*)(XB16 + (size_t)row * D + col) = w; }
    __device__ __forceinline__ void end(RowCtx& c, int row, int col, int fq) const { xs_store(Sacc, row, col, false, c.ss, fq); } };
struct FGlu { float* X; bf16* XB16; float* Sacc;
    __device__ __forceinline__ RowCtx begin(int) const { return RowCtx{0.f, 0.f}; }
    __device__ __forceinline__ void apply4_pair(RowCtx& c, int row, int col, f32x4 a, f32x4 b) const { float* p = X + (size_t)row * D + col; f32x4 x0 = *(const f32x4*)p;
#pragma unroll
        for (int i = 0; i < 4; ++i) x0[i] += a[i] * sigmoid_fast(b[i]);
        *(f32x4*)p = x0; c.ss += (x0[0] * x0[0] + x0[1] * x0[1]) + (x0[2] * x0[2] + x0[3] * x0[3]);
        u32x2 w; w.x = cvt_pk_bf16(x0[0], x0[1]); w.y = cvt_pk_bf16(x0[2], x0[3]); *(u32x2*)(XB16 + (size_t)row * D + col) = w; }
    __device__ __forceinline__ void load8(int row, int col, f32x4& xa, f32x4& xb) const { const float* p = X + (size_t)row * D + col; xa = *(const f32x4*)p; xb = *(const f32x4*)(p + 4); }
    __device__ __forceinline__ void apply8x_pair(RowCtx& c, int row, int col, f32x4 a0, f32x4 a1, f32x4 b0, f32x4 b1, f32x4 x0, f32x4 x1) const { float* p = X + (size_t)row * D + col;
#pragma unroll
        for (int i = 0; i < 4; ++i) { x0[i] += a0[i] * sigmoid_fast(b0[i]); x1[i] += a1[i] * sigmoid_fast(b1[i]); }
        *(f32x4*)p = x0; *(f32x4*)(p + 4) = x1;
        c.ss += (x0[0] * x0[0] + x0[1] * x0[1]) + (x0[2] * x0[2] + x0[3] * x0[3]) + (x1[0] * x1[0] + x1[1] * x1[1]) + (x1[2] * x1[2] + x1[3] * x1[3]);
        v4u w; w.x = cvt_pk_bf16(x0[0], x0[1]); w.y = cvt_pk_bf16(x0[2], x0[3]); w.z = cvt_pk_bf16(x1[0], x1[1]); w.w = cvt_pk_bf16(x1[2], x1[3]); *(v4u*)(XB16 + (size_t)row * D + col) = w; }
    __device__ __forceinline__ void end(RowCtx& c, int row, int col, int fq) const { xs_store(Sacc, row, col, true, c.ss, fq); } };

template <class F> struct EpiRow8 { static constexpr bool PERM = true, AFTER_DRAIN = false; F f;
    __device__ __forceinline__ void first(PG8_LAS unsigned char* lds, const pg8::Unit& u, int tid) const { if (tid < 256) rstab(lds, 0)[tid] = f.rs_row(u.pm * 256 + tid); }
    __device__ __forceinline__ void operator()(const pg8::f32x4 (&acc)[2][2][4][2], const pg8::Unit& u, int wr, int wc, int fr, int fq, PG8_LAS unsigned char* lds, const pg8::Unit& nxt, bool has_next, int ui, int tid) const {
        const LAS float* tab = rstab(lds, ui & 1);
        float nrs = 0.f; if (has_next && tid < 256) nrs = f.rs_row(nxt.pm * 256 + tid);
#pragma unroll
        for (int ai = 0; ai < 2; ++ai)
#pragma unroll
            for (int m = 0; m < 4; ++m) { const int rl = ai * 128 + wr * 64 + m * 16 + fr, row = u.pm * 256 + rl; RowCtx c = RowCtx{tab[rl], 0.f};
#pragma unroll
                for (int bj = 0; bj < 2; ++bj) f.apply8(c, row, u.pn * 256 + bj * 128 + wc * 32 + 8 * fq, acc[ai][bj][m][0], acc[ai][bj][m][1]);
                f.end(c, row, u.pn * 256 + wc * 32, fq); }
        if (has_next && tid < 256) rstab(lds, (ui + 1) & 1)[tid] = nrs; } };
template <class F> struct EpiResid8 { static constexpr bool PERM = true, AFTER_DRAIN = false; F f;
    __device__ __forceinline__ void first(PG8_LAS unsigned char*, const pg8::Unit&, int) const {}
    __device__ __forceinline__ void operator()(const pg8::f32x4 (&acc)[2][2][4][2], const pg8::Unit& u, int wr, int wc, int fr, int fq, PG8_LAS unsigned char*, const pg8::Unit&, bool, int, int) const {
#pragma unroll
        for (int ai = 0; ai < 2; ++ai)
#pragma unroll
            for (int mh = 0; mh < 2; ++mh) {
                f32x4 xo[2][2][2];
#pragma unroll
                for (int mm = 0; mm < 2; ++mm)
#pragma unroll
                    for (int bj = 0; bj < 2; ++bj) f.load8(u.pm * 256 + ai * 128 + wr * 64 + (2 * mh + mm) * 16 + fr, u.pn * 256 + bj * 128 + wc * 32 + 8 * fq, xo[mm][bj][0], xo[mm][bj][1]);
#pragma unroll
                for (int mm = 0; mm < 2; ++mm) { const int m = 2 * mh + mm, row = u.pm * 256 + ai * 128 + wr * 64 + m * 16 + fr; RowCtx c = f.begin(row);
#pragma unroll
                    for (int bj = 0; bj < 2; ++bj) f.apply8x(c, row, u.pn * 256 + bj * 128 + wc * 32 + 8 * fq, acc[ai][bj][m][0], acc[ai][bj][m][1], xo[mm][bj][0], xo[mm][bj][1]);
                    f.end(c, row, u.pn * 256 + wc * 32, fq); }
                asm volatile("" ::: "memory"); } } };
template <class F> struct EpiPair8 { static constexpr bool PERM = true, AFTER_DRAIN = false; F f;
    __device__ __forceinline__ void first(PG8_LAS unsigned char*, const pg8::Unit&, int) const {}
    __device__ __forceinline__ void operator()(const pg8::f32x4 (&acc)[2][2][4][2], const pg8::Unit& u, int wr, int wc, int fr, int fq, PG8_LAS unsigned char*, const pg8::Unit&, bool, int, int) const {
#pragma unroll
        for (int ai = 0; ai < 2; ++ai) {
            f32x4 xo[4][2];
#pragma unroll
            for (int m = 0; m < 4; ++m) f.load8(u.pm * 256 + ai * 128 + wr * 64 + m * 16 + fr, u.pn * 128 + wc * 32 + 8 * fq, xo[m][0], xo[m][1]);
#pragma unroll
            for (int m = 0; m < 4; ++m) { const int row = u.pm * 256 + ai * 128 + wr * 64 + m * 16 + fr; RowCtx c = f.begin(row);
                f.apply8x_pair(c, row, u.pn * 128 + wc * 32 + 8 * fq, acc[ai][0][m][0], acc[ai][0][m][1], acc[ai][1][m][0], acc[ai][1][m][1], xo[m][0], xo[m][1]);
                f.end(c, row, u.pn * 128 + wc * 32, fq); }
            asm volatile("" ::: "memory"); } } };

constexpr int NWAVES = 8;
constexpr int RING_BYTES = 131072, LDSCTL_OFF = RING_BYTES, MISC_OFF = LDSCTL_OFF + 320, LDS_BYTES = 147456;
constexpr int PTAB_OFF = LDSCTL_OFF + 1024;
struct Frame { LAS unsigned char* lds; int tid, lane, wave, vcu, G, bx; };
__device__ __forceinline__ const float* inp(const Frame& F, int i) {
    const volatile LAS unsigned* t = (const volatile LAS unsigned*)(F.lds + PTAB_OFF) + 2 * i;
    const unsigned lo = __builtin_amdgcn_readfirstlane(t[0]), hi = __builtin_amdgcn_readfirstlane(t[1]);
    return (const float*)(((unsigned long long)hi << 32) | lo);
}

template <int NCT, int KS, bool GLU, int UNR, class F>
__device__ __forceinline__ void small_gemm(const Frame& Fr, const bf16* A, const bf16* WT, int K, const F& f) {
    constexpr int CS = 8 / KS, CT = NCT / CS, NT = 4 * CT;
    const int rb = Fr.vcu & 7, cb = Fr.vcu >> 3, kq = Fr.wave % KS, cs = Fr.wave / KS, fr = Fr.lane & 15, fq = Fr.lane >> 4;
    const int m0 = MP + rb * 64, ksl = K / KS;
    const bf16* ap = A + (size_t)(m0 + fr) * K + kq * ksl + 8 * fq;
    const bf16* bp[CT];
#pragma unroll
    for (int j = 0; j < CT; ++j) { const int ct = cs * CT + j; int wrow;
        if (GLU) { const int c = cb * 32 + (ct & 1) * 16; wrow = 256 * (c >> 7) + 128 * (ct >> 1) + (c & 127); } else wrow = (cb * NCT + ct) * 16;
        bp[j] = WT + (size_t)(wrow + fr) * K + kq * ksl + 8 * fq; }
    f32x4 acc[4][CT];
#pragma unroll
    for (int r = 0; r < 4; ++r)
#pragma unroll
        for (int j = 0; j < CT; ++j) acc[r][j] = (f32x4){0.f, 0.f, 0.f, 0.f};
#pragma unroll UNR
    for (int k0 = 0; k0 < ksl; k0 += 32) {
        bf16x8 a[4], b[CT];
#pragma unroll
        for (int r = 0; r < 4; ++r) a[r] = *(const bf16x8*)(ap + (size_t)r * 16 * K + k0);
#pragma unroll
        for (int j = 0; j < CT; ++j) b[j] = *(const bf16x8*)(bp[j] + k0);
#pragma unroll
        for (int r = 0; r < 4; ++r)
#pragma unroll
            for (int j = 0; j < CT; ++j) acc[r][j] = __builtin_amdgcn_mfma_f32_16x16x32_bf16(b[j], a[r], acc[r][j], 0, 0, 0);
    }
    LAS f32x4* RED = (LAS f32x4*)Fr.lds;
#pragma unroll
    for (int r = 0; r < 4; ++r)
#pragma unroll
        for (int j = 0; j < CT; ++j) RED[(Fr.wave * NT + r * CT + j) * 64 + Fr.lane] = acc[r][j];
    __syncthreads();
    const int rt = Fr.wave & 3, hf = Fr.wave >> 2, row = m0 + rt * 16 + fr;
    RowCtx c = f.begin(row);
    if constexpr (GLU) {
        f32x4 va = (f32x4){0.f, 0.f, 0.f, 0.f}, vb = va;
#pragma unroll
        for (int q = 0; q < KS; ++q) { va = va + RED[(q * NT + rt * CT + hf) * 64 + Fr.lane]; vb = vb + RED[(q * NT + rt * CT + 2 + hf) * 64 + Fr.lane]; }
        const int col = cb * 32 + hf * 16; c.ss = 0.f; f.apply4_pair(c, row, col + 4 * fq, va, vb); f.end(c, row, col, fq);
    } else {
#pragma unroll
        for (int jj = 0; jj < NCT / 2; ++jj) { const int ct = hf * (NCT / 2) + jj, g = ct / CT, j = ct % CT; f32x4 v = (f32x4){0.f, 0.f, 0.f, 0.f};
#pragma unroll
            for (int q = 0; q < KS; ++q) v = v + RED[((g * KS + q) * NT + rt * CT + j) * 64 + Fr.lane];
            const int col = (cb * NCT + ct) * 16; c.ss = 0.f; f.apply4(c, row, col + 4 * fq, v); f.end(c, row, col, fq); }
    }
    __syncthreads();
}

__device__ __forceinline__ void transpose_item(const float* W, int K, int N, bf16* WT, int drow0, LAS float* scr, int k0, int n0, int lane, const float* gain) {
#pragma unroll 8
    for (int i = 0; i < 32; ++i) { const int kk = 2 * i + (lane >> 5); scr[kk * 33 + (lane & 31)] = W[(size_t)(k0 + kk) * N + n0 + (lane & 31)] * (gain ? gain[k0 + kk] : 1.f); }
    LDS_WAIT(); asm volatile("" ::: "memory");
    const int c = lane & 7;
#pragma unroll
    for (int j = 0; j < 4; ++j) { const int n = (lane >> 3) + 8 * j; const LAS float* s = scr + (8 * c) * 33 + n;
        v4u o; o.x = cvt_pk_bf16(s[0 * 33], s[1 * 33]); o.y = cvt_pk_bf16(s[2 * 33], s[3 * 33]); o.z = cvt_pk_bf16(s[4 * 33], s[5 * 33]); o.w = cvt_pk_bf16(s[6 * 33], s[7 * 33]);
        *(GAS v4u*)(WT + (size_t)(drow0 + n) * K + k0 + 8 * c) = o; }
    LDS_WAIT(); asm volatile("" ::: "memory");
}
__device__ __forceinline__ bool conv_job(const Frame& F, int& it, const float* W, int K, int N, bf16* WT, bool glu, const float* gain) {
    const int nblk = N / 32, nit = (K / 64) * nblk;
    if (it >= nit) { it -= nit; return false; }
    const int kb = it / nblk, nb = it % nblk, n0 = 32 * nb; int drow0 = n0;
    if (glu) { const int bj = n0 >> 10, r = n0 & 1023; drow0 = 256 * (r >> 7) + 128 * bj + (r & 127); }
    transpose_item(W, K, N, WT, drow0, (LAS float*)(F.lds + F.wave * 16384), 64 * kb, n0, F.lane, gain);
    return true;
}
__device__ __forceinline__ void ffn_conv(const Frame& F, int l, const float* w1, const float* w2, const float* gffn, unsigned char* ws) {
    const int gw = F.vcu * NWAVES + F.wave, NGW = F.G * NWAVES;
    for (int it0 = gw; it0 < 4096; it0 += NGW) { int it = it0;
        if (conv_job(F, it, w1 + (size_t)l * D * FF, D, FF, (bf16*)(ws + WS_W_FF1), false, gffn + l * D)) continue;
        conv_job(F, it, w2 + (size_t)l * FF * D, FF, D, (bf16*)(ws + WS_W_FF2), false, nullptr);
    }
}

struct Args { const float* in[35]; float* out; unsigned char* ws; int ph_lo, ph_hi; };

__device__ __forceinline__ void prologue_rows(const Frame& F, const float* xp, const float* xs, float* X, bf16* XB16, float* SX0) {
    const int gw = F.vcu * NWAVES + F.wave, NGW = F.G * NWAVES;
    for (int row = gw; row < M; row += NGW) {
        const f32x4* xr = (const f32x4*)(row < MP ? xp + (size_t)row * D : xs + (size_t)(row - MP) * D) + F.lane; f32x4 v[4]; float s = 0.f;
#pragma unroll
        for (int j = 0; j < 4; ++j) { v[j] = xr[64 * j]; s += (v[j].x * v[j].x + v[j].y * v[j].y) + (v[j].z * v[j].z + v[j].w * v[j].w); }
        s = wave_sum(s);
        if (row < MP) { if (F.lane < 16) SX0[(size_t)row * XS_P + F.lane] = F.lane == 0 ? s : 0.f; } else SX0[(size_t)MP * XS_P + (size_t)(row - MP) * XS_S + F.lane] = F.lane == 0 ? s : 0.f;
        f32x4* xo = (f32x4*)(X + (size_t)row * D) + F.lane; u32x2* o = (u32x2*)(XB16 + (size_t)row * D) + F.lane;
#pragma unroll
        for (int j = 0; j < 4; ++j) { xo[64 * j] = v[j]; u32x2 w; w.x = cvt_pk_bf16(v[j].x, v[j].y); w.y = cvt_pk_bf16(v[j].z, v[j].w); o[64 * j] = w; }
    }
}
__device__ __forceinline__ void norm_final(const Frame& F, float* X, const float* g) {
    const int gw = F.vcu * NWAVES + F.wave, NGW = F.G * NWAVES;
    f32x4 gv[4];
#pragma unroll
    for (int j = 0; j < 4; ++j) gv[j] = ((const f32x4*)g)[F.lane + 64 * j];
    for (int row = gw; row < M; row += NGW) {
        f32x4* xr = (f32x4*)(X + (size_t)row * D) + F.lane; f32x4 v[4]; float s = 0.f;
#pragma unroll
        for (int j = 0; j < 4; ++j) { v[j] = xr[64 * j]; s += (v[j].x * v[j].x + v[j].y * v[j].y) + (v[j].z * v[j].z + v[j].w * v[j].w); }
        const float rs = rsqrtf(wave_sum(s) * (1.f / D) + EPS);
#pragma unroll
        for (int j = 0; j < 4; ++j) xr[64 * j] = v[j] * rs * gv[j];
    }
}

template <class Epi> __device__ __forceinline__ void big_gemm(const Frame& F, const bf16* A, const bf16* WT, int N, int K, const Epi& E) {
    pg8::Gemm g{A, WT, MP, N, K}; pg8::StaticOrder S; S.init(MP, N, F.G, F.bx);
    pg8::gemm_phase<Epi, pg8::StaticOrder, true, true>(F.lds, g, S, E, F.tid);
}

__device__ __forceinline__ float bflo(unsigned u) { return __builtin_bit_cast(float, u << 16); }
__device__ __forceinline__ float bfhi(unsigned u) { return __builtin_bit_cast(float, u & 0xffff0000u); }
constexpr int VS_STRIDE = 264;
__device__ __forceinline__ void sgu_mix_phase(const Frame& F, const bf16* UV, const float* SV, const float* sg, const bf16* Wm, const float* bs, const float* wsf, bf16* Y, float* vs_out) {
    LAS unsigned char* Vs = F.lds; const int fr = F.lane & 15, fq = F.lane >> 4;
    for (int u = F.vcu; u < 1024; u += F.G) {
        const int g = u & 7, r0 = (u >> 3) * 128;
#pragma unroll
        for (int i = 0; i < 4; ++i) { const int id = F.tid + 512 * i, row = id >> 4, ch = id & 15;
            const v4u raw = *(const v4u*)(UV + (size_t)(r0 + row) * 2048 + 1024 + g * 128 + ch * 8); const float rs = rs_v(SV, r0 + row);
            const f32x4 g0 = *(const f32x4*)(sg + g * 128 + ch * 8), g1 = *(const f32x4*)(sg + g * 128 + ch * 8 + 4);
            u32x2 w0, w1; w0.x = cvt_pk_bf16(bflo(raw.x) * rs * g0.x, bfhi(raw.x) * rs * g0.y); w0.y = cvt_pk_bf16(bflo(raw.y) * rs * g0.z, bfhi(raw.y) * rs * g0.w);
            w1.x = cvt_pk_bf16(bflo(raw.z) * rs * g1.x, bfhi(raw.z) * rs * g1.y); w1.y = cvt_pk_bf16(bflo(raw.w) * rs * g1.z, bfhi(raw.w) * rs * g1.w);
            *(LAS u32x2*)(Vs + row * VS_STRIDE + ch * 16) = w0; *(LAS u32x2*)(Vs + row * VS_STRIDE + ch * 16 + 8) = w1; }
        __syncthreads();
        bf16x8 af[4];
#pragma unroll
        for (int kk = 0; kk < 4; ++kk)
#pragma unroll
            for (int j = 0; j < 8; ++j) af[kk][j] = (short)*(const LAS unsigned short*)(Vs + (32 * kk + 8 * fq + j) * VS_STRIDE + (16 * F.wave + fr) * 2);
        f32x4 acc[8]; const bf16* wg = Wm + (size_t)g * 128 * 128;
#pragma unroll
        for (int n = 0; n < 8; ++n) { acc[n] = (f32x4){0.f, 0.f, 0.f, 0.f};
#pragma unroll
            for (int kk = 0; kk <= n / 2; ++kk) { const bf16x8 b = *(const bf16x8*)(wg + (size_t)(16 * n + fr) * 128 + 32 * kk + 8 * fq); acc[n] = __builtin_amdgcn_mfma_f32_16x16x32_bf16(af[kk], b, acc[n], 0, 0, 0); } }
#pragma unroll
        for (int n = 0; n < 8; ++n) { const int t = 16 * n + fr, row = r0 + t, col = g * 128 + 16 * F.wave + 4 * fq; const float bb = bs[g * 128 + t];
            const u32x2 uu = *(const u32x2*)(UV + (size_t)row * 2048 + col);
            u32x2 w; w.x = cvt_pk_bf16(bflo(uu.x) * (acc[n][0] + bb), bfhi(uu.x) * (acc[n][1] + bb)); w.y = cvt_pk_bf16(bflo(uu.y) * (acc[n][2] + bb), bfhi(uu.y) * (acc[n][3] + bb));
            *(u32x2*)(Y + (size_t)row * 1024 + col) = w; }
        __syncthreads();
    }
    for (int it = F.vcu * 512 + F.tid; it < 128 * 256; it += F.G * 512) {
        const int b = it >> 8, d = (it & 255) * 4, gh = d >> 7, rowb = MP + b * 4; const f32x4 gg = *(const f32x4*)(sg + d);
        float v[4][4], uu[4][4];
#pragma unroll
        for (int s = 0; s < 4; ++s) { const u32x2 rv = *(const u32x2*)(UV + (size_t)(rowb + s) * 2048 + 1024 + d), ru = *(const u32x2*)(UV + (size_t)(rowb + s) * 2048 + d); const float rs = rs_v(SV, rowb + s);
            v[s][0] = bflo(rv.x) * rs; v[s][1] = bfhi(rv.x) * rs; v[s][2] = bflo(rv.y) * rs; v[s][3] = bfhi(rv.y) * rs;
            uu[s][0] = bflo(ru.x); uu[s][1] = bfhi(ru.x); uu[s][2] = bflo(ru.y); uu[s][3] = bfhi(ru.y);
            *(f32x4*)(vs_out + (size_t)(b * 4 + s) * 1024 + d) = (f32x4){v[s][0] * gg.x, v[s][1] * gg.y, v[s][2] * gg.z, v[s][3] * gg.w}; }
#pragma unroll
        for (int t = 0; t < 4; ++t) { float m[4] = {0.f, 0.f, 0.f, 0.f};
#pragma unroll
            for (int s = 0; s <= t; ++s) { const float w = wsf[((size_t)gh * 128 + t) * 128 + s];
#pragma unroll
                for (int e = 0; e < 4; ++e) m[e] += w * v[s][e]; }
            const float bb = bs[gh * 128 + t];
            u32x2 w; w.x = cvt_pk_bf16(uu[t][0] * (m[0] * gg.x + bb), uu[t][1] * (m[1] * gg.y + bb)); w.y = cvt_pk_bf16(uu[t][2] * (m[2] * gg.z + bb), uu[t][3] * (m[3] * gg.w + bb));
            *(u32x2*)(Y + (size_t)(rowb + t) * 1024 + d) = w; }
    }
}
constexpr size_t RGT_W = 0, RGT_BA = 512 * 1024, RGT_BX = RGT_BA + 4096, RGT_NSP = RGT_BX + 4096;
__device__ __forceinline__ int rg_jch(int m, int r) { return 8 * (r >> 2) + 4 * (m & 1) + (r & 3) + 32 * (m >> 1); }
__device__ __forceinline__ void rglru_tables(const Frame& F, const float* wa, const float* wx, const float* ba, const float* bx, const float* lam, unsigned char* tab) {
    bf16* W = (bf16*)(tab + RGT_W);
    for (int i = F.vcu * 512 + F.tid; i < 16 * 2 * 4 * 2 * 64 * 8; i += F.G * 512) {
        const int e = i & 7, lane = (i >> 3) & 63, ks = (i >> 9) & 1, m = (i >> 10) & 3, type = (i >> 12) & 1, h = i >> 13, fr = lane & 15, fq = lane >> 4;
        const float* w = type ? wx : wa; const float v = w[((size_t)h * 64 + 32 * ks + 8 * fq + e) * 64 + rg_jch(m, fr)];
        W[i] = (bf16)(cvt_pk_bf16(v, 0.f) & 0xffffu);
    }
    for (int c = F.vcu * 512 + F.tid; c < 1024; c += F.G * 512) {
        ((float*)(tab + RGT_BA))[c] = ba[c]; ((float*)(tab + RGT_BX))[c] = bx[c]; ((float*)(tab + RGT_NSP))[c] = -8.0f * log1pf(expf(-lam[c]));
    }
}
template <int CTRL> __device__ __forceinline__ float dpp_f(float old, float src) {
    return __builtin_bit_cast(float, __builtin_amdgcn_update_dpp(__builtin_bit_cast(int, old), __builtin_bit_cast(int, src), CTRL, 0xf, 0xf, false)); }
template <int CTRL> __device__ __forceinline__ float dpp_z(float src) {
    return __builtin_bit_cast(float, __builtin_amdgcn_update_dpp(0, __builtin_bit_cast(int, src), CTRL, 0xf, 0xf, true)); }
constexpr int RG_XC_STRIDE = 68, RG_XC_BYTES = 128 * RG_XC_STRIDE * 4, RG_TOT_OFF = 2 * RG_XC_BYTES, RG_CARRY_OFF = RG_TOT_OFF + 2 * 2 * 8 * 64 * 4;
template <int D_, bool SAMPLE> __device__ __forceinline__ void ks_step(float (&a)[16], float (&b)[16], int tt) {
#pragma unroll
    for (int i = 0; i < 16; ++i) {
        float as = dpp_f<0x110 + D_>(1.0f, a[i]), bs = dpp_z<0x110 + D_>(b[i]);
        if (SAMPLE) { const bool ok = tt >= D_; as = ok ? as : 1.0f; bs = ok ? bs : 0.0f; }
        b[i] = a[i] * bs + b[i]; a[i] = a[i] * as;
    }
}
template <bool SAMPLE>
__device__ __forceinline__ void rglru_unit(const Frame& F, int unit, const float* XB, const bf16* G, bf16* Y, const float* cw, const float* cb, const unsigned char* tab,
                                           const float* cstate, const float* hstate, float* conv_out, float* h_out) {
    const int fr = F.lane & 15, fq = F.lane >> 4, w = F.wave;
    int h, b0, rowbase, nchunk;
    if (SAMPLE) { h = unit >> 2; b0 = (unit & 3) * 32; rowbase = MP + b0 * 4; nchunk = 1; }
    else { b0 = unit >> 4; h = unit & 15; rowbase = b0 * 2048; nchunk = 16; }
    LAS float* XC = (LAS float*)F.lds; LAS float* TOT = (LAS float*)(F.lds + RG_TOT_OFF); LAS float* CARRY = (LAS float*)(F.lds + RG_CARRY_OFF);
    const int chq = F.tid & 15, rsub = F.tid >> 4, cA = h * 64 + 4 * chq;
    bf16x8 Af[2][4][2];
#pragma unroll
    for (int ty = 0; ty < 2; ++ty)
#pragma unroll
        for (int m = 0; m < 4; ++m)
#pragma unroll
            for (int ks = 0; ks < 2; ++ks) Af[ty][m][ks] = *(const bf16x8*)((const bf16*)(tab + RGT_W) + ((((size_t)(h * 2 + ty) * 4 + m) * 2 + ks) * 64 + F.lane) * 8);
    for (int c = 0; c < nchunk; ++c) {
        const int buf = c & 1, c0 = c * 128;
        const float* cw_ = cw; const float* cb_ = cb; asm volatile("" : "+s"(cw_)); asm volatile("" : "+s"(cb_));
        f32x4 cwv[4];
#pragma unroll
        for (int k = 0; k < 4; ++k) cwv[k] = *(const f32x4*)(cw_ + k * 1024 + cA);
        const f32x4 cbv = *(const f32x4*)(cb_ + cA);
#pragma unroll
        for (int i = 0; i < 4; ++i) { const int r = rsub + 32 * i; f32x4 acc = cbv;
#pragma unroll
            for (int k = 0; k < 4; ++k) { f32x4 xe;
                if (SAMPLE) { const int bi = r >> 2, tau = (r & 3) + k - 3;
                    xe = tau >= 0 ? *(const f32x4*)(XB + (size_t)(rowbase + bi * 4 + tau) * 1024 + cA) : *(const f32x4*)(cstate + ((size_t)(b0 + bi) * 3 + (tau + 3)) * 1024 + cA); }
                else { const int tau = c0 + r + k - 3; xe = tau >= 0 ? *(const f32x4*)(XB + (size_t)(rowbase + tau) * 1024 + cA) : (f32x4){0.f, 0.f, 0.f, 0.f}; }
                acc = acc + cwv[k] * xe; }
            *(LAS f32x4*)(XC + (size_t)buf * (128 * RG_XC_STRIDE) + r * RG_XC_STRIDE + 4 * chq) = acc; }
        __syncthreads();
        const int trow = 16 * w + fr;
        float xc[16];
        { const LAS float* xp = XC + (size_t)buf * (128 * RG_XC_STRIDE) + trow * RG_XC_STRIDE + 8 * fq;
          const f32x4 x0 = *(const LAS f32x4*)(xp), x1 = *(const LAS f32x4*)(xp + 4), x2 = *(const LAS f32x4*)(xp + 32), x3 = *(const LAS f32x4*)(xp + 36);
          xc[0] = x0.x; xc[1] = x0.y; xc[2] = x0.z; xc[3] = x0.w; xc[4] = x1.x; xc[5] = x1.y; xc[6] = x1.z; xc[7] = x1.w;
          xc[8] = x2.x; xc[9] = x2.y; xc[10] = x2.z; xc[11] = x2.w; xc[12] = x3.x; xc[13] = x3.y; xc[14] = x3.z; xc[15] = x3.w; }
        bf16x8 bf0, bf1;
        { v4u p0, p1; p0.x = cvt_pk_bf16(xc[0], xc[1]); p0.y = cvt_pk_bf16(xc[2], xc[3]); p0.z = cvt_pk_bf16(xc[4], xc[5]); p0.w = cvt_pk_bf16(xc[6], xc[7]);
          p1.x = cvt_pk_bf16(xc[8], xc[9]); p1.y = cvt_pk_bf16(xc[10], xc[11]); p1.z = cvt_pk_bf16(xc[12], xc[13]); p1.w = cvt_pk_bf16(xc[14], xc[15]);
          bf0 = __builtin_bit_cast(bf16x8, p0); bf1 = __builtin_bit_cast(bf16x8, p1); }
        float av[16], bv[16];
#pragma unroll
        for (int m = 0; m < 4; ++m) {
            f32x4 ra = (f32x4){0.f, 0.f, 0.f, 0.f}, rx = ra;
            ra = __builtin_amdgcn_mfma_f32_16x16x32_bf16(Af[0][m][0], bf0, ra, 0, 0, 0); ra = __builtin_amdgcn_mfma_f32_16x16x32_bf16(Af[0][m][1], bf1, ra, 0, 0, 0);
            rx = __builtin_amdgcn_mfma_f32_16x16x32_bf16(Af[1][m][0], bf0, rx, 0, 0, 0); rx = __builtin_amdgcn_mfma_f32_16x16x32_bf16(Af[1][m][1], bf1, rx, 0, 0, 0);
            const int cg = h * 64 + 8 * fq + 4 * (m & 1) + 32 * (m >> 1);
            const f32x4 ba4 = *(const f32x4*)((const float*)(tab + RGT_BA) + cg), bx4 = *(const f32x4*)((const float*)(tab + RGT_BX) + cg), ns4 = *(const f32x4*)((const float*)(tab + RGT_NSP) + cg);
#pragma unroll
            for (int r = 0; r < 4; ++r) { const float rg = sigmoid_fast(ra[r] + ba4[r]), ig = sigmoid_fast(rx[r] + bx4[r]);
                const float la = ns4[r] * rg, a = __builtin_amdgcn_exp2f(1.4426950408889634f * la), mult = __builtin_amdgcn_sqrtf(fmaxf(1.f - a * a, 0.f));
                av[4 * m + r] = a; bv[4 * m + r] = mult * ig * xc[4 * m + r]; }
        }
        const int tt = fr & 3;
        if (SAMPLE) {
            const int bi = (16 * w + fr) >> 2;
#pragma unroll
            for (int m = 0; m < 4; ++m) { const int cg = h * 64 + 8 * fq + 4 * (m & 1) + 32 * (m >> 1); const f32x4 h0 = *(const f32x4*)(hstate + (size_t)(b0 + bi) * 1024 + cg);
#pragma unroll
                for (int r = 0; r < 4; ++r) if (tt == 0) bv[4 * m + r] += av[4 * m + r] * h0[r]; }
            ks_step<1, true>(av, bv, tt); ks_step<2, true>(av, bv, tt);
        } else {
            ks_step<1, false>(av, bv, tt); ks_step<2, false>(av, bv, tt); ks_step<4, false>(av, bv, tt); ks_step<8, false>(av, bv, tt);
            if (fr == 15) { LAS float* ta = TOT + ((size_t)(buf * 2 + 0) * 8 + w) * 64 + fq * 16; LAS float* th = TOT + ((size_t)(buf * 2 + 1) * 8 + w) * 64 + fq * 16;
#pragma unroll
                for (int i = 0; i < 16; i += 4) { *(LAS f32x4*)(ta + i) = (f32x4){av[i], av[i + 1], av[i + 2], av[i + 3]}; *(LAS f32x4*)(th + i) = (f32x4){bv[i], bv[i + 1], bv[i + 2], bv[i + 3]}; } }
            __syncthreads();
            float ch[16];
            if (c == 0) {
#pragma unroll
                for (int i = 0; i < 16; ++i) ch[i] = 0.f;
            } else {
#pragma unroll
                for (int i = 0; i < 16; i += 4) { const f32x4 t = *(const LAS f32x4*)(CARRY + buf * 64 + fq * 16 + i); ch[i] = t.x; ch[i + 1] = t.y; ch[i + 2] = t.z; ch[i + 3] = t.w; }
            }
            for (int v = 0; v < w; ++v) { const LAS float* ta = TOT + ((size_t)(buf * 2 + 0) * 8 + v) * 64 + fq * 16; const LAS float* th = TOT + ((size_t)(buf * 2 + 1) * 8 + v) * 64 + fq * 16;
#pragma unroll
                for (int i = 0; i < 16; i += 4) { const f32x4 A4 = *(const LAS f32x4*)(ta + i), H4 = *(const LAS f32x4*)(th + i);
                    ch[i] = A4.x * ch[i] + H4.x; ch[i + 1] = A4.y * ch[i + 1] + H4.y; ch[i + 2] = A4.z * ch[i + 2] + H4.z; ch[i + 3] = A4.w * ch[i + 3] + H4.w; } }
#pragma unroll
            for (int i = 0; i < 16; ++i) bv[i] = bv[i] + av[i] * ch[i];
            if (w == 7 && fr == 15) {
#pragma unroll
                for (int i = 0; i < 16; i += 4) *(LAS f32x4*)(CARRY + (buf ^ 1) * 64 + fq * 16 + i) = (f32x4){bv[i], bv[i + 1], bv[i + 2], bv[i + 3]}; }
        }
        { const size_t row = (size_t)rowbase + c0 + trow; const size_t o0 = row * 1024 + h * 64 + 8 * fq;
          const v4u g0 = *(const v4u*)(G + o0), g1 = *(const v4u*)(G + o0 + 32); v4u y0, y1;
          y0.x = cvt_pk_bf16(bv[0] * bflo(g0.x), bv[1] * bfhi(g0.x)); y0.y = cvt_pk_bf16(bv[2] * bflo(g0.y), bv[3] * bfhi(g0.y)); y0.z = cvt_pk_bf16(bv[4] * bflo(g0.z), bv[5] * bfhi(g0.z)); y0.w = cvt_pk_bf16(bv[6] * bflo(g0.w), bv[7] * bfhi(g0.w));
          y1.x = cvt_pk_bf16(bv[8] * bflo(g1.x), bv[9] * bfhi(g1.x)); y1.y = cvt_pk_bf16(bv[10] * bflo(g1.y), bv[11] * bfhi(g1.y)); y1.z = cvt_pk_bf16(bv[12] * bflo(g1.z), bv[13] * bfhi(g1.z)); y1.w = cvt_pk_bf16(bv[14] * bflo(g1.w), bv[15] * bfhi(g1.w));
          *(v4u*)(Y + o0) = y0; *(v4u*)(Y + o0 + 32) = y1; }
        if (SAMPLE) {
            if (tt == 3) { const int bi = (16 * w + fr) >> 2; float* ho = h_out + (size_t)(b0 + bi) * 1024 + h * 64 + 8 * fq;
                *(f32x4*)(ho) = (f32x4){bv[0], bv[1], bv[2], bv[3]}; *(f32x4*)(ho + 4) = (f32x4){bv[4], bv[5], bv[6], bv[7]};
                *(f32x4*)(ho + 32) = (f32x4){bv[8], bv[9], bv[10], bv[11]}; *(f32x4*)(ho + 36) = (f32x4){bv[12], bv[13], bv[14], bv[15]}; }
        } else if (c == nchunk - 1 && w == 7 && fr == 15) { float* ho = h_out + (size_t)b0 * 1024 + h * 64 + 8 * fq;
            *(f32x4*)(ho) = (f32x4){bv[0], bv[1], bv[2], bv[3]}; *(f32x4*)(ho + 4) = (f32x4){bv[4], bv[5], bv[6], bv[7]};
            *(f32x4*)(ho + 32) = (f32x4){bv[8], bv[9], bv[10], bv[11]}; *(f32x4*)(ho + 36) = (f32x4){bv[12], bv[13], bv[14], bv[15]}; }
    }
    if (SAMPLE) { for (int i = F.tid; i < 32 * 3 * 64; i += 512) { const int cc = i & 63, r = (i >> 6) % 3, bi = i / 192;
            conv_out[((size_t)(b0 + bi) * 3 + r) * 1024 + h * 64 + cc] = XB[(size_t)(rowbase + bi * 4 + 1 + r) * 1024 + h * 64 + cc]; } }
    else if (F.tid < 192) { const int cc = F.tid & 63, r = F.tid >> 6; conv_out[((size_t)b0 * 3 + r) * 1024 + h * 64 + cc] = XB[(size_t)(rowbase + 2045 + r) * 1024 + h * 64 + cc]; }
    __syncthreads();
}
__device__ __forceinline__ void rglru_phase(const Frame& F, const float* XB, const bf16* G, bf16* Y, const float* cw, const float* cb, const unsigned char* tab, const float* cstate, const float* hstate, float* out) {
    for (int unit = F.vcu; unit < 192; unit += F.G) {
        if (unit < 128) rglru_unit<false>(F, unit, XB, G, Y, cw, cb, tab, nullptr, nullptr, out + O_CONVP, out + O_HP);
        else rglru_unit<true>(F, unit - 128, XB, G, Y, cw, cb, tab, cstate, hstate, out + O_CONVS, out + O_HS);
    }
}
constexpr size_t S5T_AP = 0, S5T_BF = 128 * 1024, S5T_CF = S5T_BF + 1024 * 1024;
__device__ __forceinline__ void s5_disc(const float* lre, const float* lim, const float* ldt, int g, int p, float& ar, float& ai, float& qr, float& qi) {
    const float dt = expf(ldt[g]), lr = lre[g * 64 + p], li = lim[g * 64 + p], mag = expf(lr * dt); ar = mag * cosf(li * dt); ai = mag * sinf(li * dt);
    const float zr = ar - 1.f, zi = ai, den = lr * lr + li * li; qr = (zr * lr + zi * li) / den; qi = (zi * lr - zr * li) / den;
}
__device__ __forceinline__ void s5_tables(const Frame& F, const float* lre, const float* lim, const float* ldt, const float* bre, const float* bim, const float* cre, const float* cim, unsigned char* tab) {
    for (int i = F.vcu * 512 + F.tid; i < 4096; i += F.G * 512) { float ar, ai, qr, qi; s5_disc(lre, lim, ldt, i >> 6, i & 63, ar, ai, qr, qi);
        float* o = (float*)(tab + S5T_AP) + (size_t)i * 8; o[0] = ar; o[1] = ai;
        float r2 = ar * ar - ai * ai, i2 = 2.f * ar * ai; o[2] = r2; o[3] = i2; float r4 = r2 * r2 - i2 * i2, i4 = 2.f * r2 * i2; o[4] = r4; o[5] = i4; o[6] = r4 * r4 - i4 * i4; o[7] = 2.f * r4 * i4; }
    for (int i = F.vcu * 512 + F.tid; i < 64 * 4 * 4 * 64 * 8; i += F.G * 512) {
        const int e = i & 7, lane = (i >> 3) & 63, kind = (i >> 9) & 3, w = (i >> 11) & 3, g = i >> 13, fr = lane & 15, fq = lane >> 4, h = (8 * fq + e) & 15, p = 16 * w + fr;
        float ar, ai, qr, qi; s5_disc(lre, lim, ldt, g, p, ar, ai, qr, qi);
        const float br = bre[((size_t)g * 64 + p) * 16 + h], bi = bim[((size_t)g * 64 + p) * 16 + h]; const float v = (kind & 1) ? (qr * bi + qi * br) : (qr * br - qi * bi);
        ((bf16*)(tab + S5T_BF))[i] = (kind < 2 && fq < 2) ? (bf16)(cvt_pk_bf16(v, 0.f) & 0xffffu) : (bf16)0;
    }
    for (int i = F.vcu * 512 + F.tid; i < 64 * 4 * 64 * 8; i += F.G * 512) {
        const int e = i & 7, lane = (i >> 3) & 63, w = (i >> 9) & 3, g = i >> 11, fr = lane & 15, fq = lane >> 4, p = 16 * w + 4 * fq + (e & 3);
        const float v = e < 4 ? cre[((size_t)g * 16 + fr) * 64 + p] : -cim[((size_t)g * 16 + fr) * 64 + p];
        ((bf16*)(tab + S5T_CF))[i] = (bf16)(cvt_pk_bf16(v, 0.f) & 0xffffu);
    }
}
typedef float f32x2 __attribute__((ext_vector_type(2)));
template <int D_, bool SAMPLE> __device__ __forceinline__ void s5_ks(f32x2 (&x)[4], const float (&ap)[4][8], int pi, int tt) {
    f32x2 sh[4];
#pragma unroll
    for (int s = 0; s < 4; ++s) { sh[s].x = dpp_z<0x110 + D_>(x[s].x); sh[s].y = dpp_z<0x110 + D_>(x[s].y); }
    if (SAMPLE) { const bool ok = tt >= D_;
#pragma unroll
        for (int s = 0; s < 4; ++s) { sh[s].x = ok ? sh[s].x : 0.f; sh[s].y = ok ? sh[s].y : 0.f; } }
#pragma unroll
    for (int s = 0; s < 4; ++s) { const float ar = ap[s][2 * pi], ai = ap[s][2 * pi + 1];
        x[s] = (f32x2){ar, ar} * sh[s] + x[s]; x[s] = (f32x2){-ai, ai} * __builtin_shufflevector(sh[s], sh[s], 1, 0) + x[s]; }
}
template <bool SAMPLE>
__device__ __forceinline__ void s5_pass(const Frame& F, int unit, const float* U, bf16* Gs, const float* dsk, const unsigned char* tab, const float* sre, const float* sim, float* ore, float* oim) {
    const int fr = F.lane & 15, fq = F.lane >> 4, wq = F.wave & 3, usel = F.wave >> 2, tt = fr & 3;
    int g, rowbase, ntile, bidx;
    if (SAMPLE) { g = unit >> 5; bidx = (unit & 31) * 4; rowbase = MP + bidx * 4; ntile = 1; }
    else { bidx = unit >> 6; g = unit & 63; rowbase = bidx * 2048; ntile = 128; }
    LAS f32x4* YP = (LAS f32x4*)F.lds;
    float ap[4][8];
#pragma unroll
    for (int s = 0; s < 4; ++s) { const f32x4* a4 = (const f32x4*)((const float*)(tab + S5T_AP) + ((size_t)g * 64 + 16 * wq + 4 * fq + s) * 8); const f32x4 lo = a4[0], hi = a4[1];
        ap[s][0] = lo.x; ap[s][1] = lo.y; ap[s][2] = lo.z; ap[s][3] = lo.w; ap[s][4] = hi.x; ap[s][5] = hi.y; ap[s][6] = hi.z; ap[s][7] = hi.w; }
    bf16x8 Bf[2];
#pragma unroll
    for (int k = 0; k < 2; ++k) Bf[k] = *(const bf16x8*)((const bf16*)(tab + S5T_BF) + ((((size_t)g * 4 + wq) * 4 + k) * 64 + F.lane) * 8);
    const bf16x8 Cf = *(const bf16x8*)((const bf16*)(tab + S5T_CF) + (((size_t)g * 4 + wq) * 64 + F.lane) * 8);
    f32x2 x[4];
#pragma unroll
    for (int s = 0; s < 4; ++s) x[s] = (f32x2){0.f, 0.f};
    f32x4 ua[8], ub[8];
#pragma unroll
    for (int tl = 0; tl < (SAMPLE ? 1 : 8); ++tl) { const GAS float* up = (const GAS float*)U + ((size_t)rowbase + (size_t)tl * 16 + fr) * 1024 + g * 16 + 8 * (fq & 1);
        ua[tl] = *(const GAS f32x4*)up; ub[tl] = *(const GAS f32x4*)(up + 4); }
    for (int t0 = 0; t0 < ntile; t0 += 8) {
#pragma unroll
        for (int tl = 0; tl < 8; ++tl) {
            if (SAMPLE && tl > 0) continue;
            const f32x4 u0 = ua[tl], u1 = ub[tl];
            v4u bw; bw.x = cvt_pk_bf16(u0.x, u0.y); bw.y = cvt_pk_bf16(u0.z, u0.w); bw.z = cvt_pk_bf16(u1.x, u1.y); bw.w = cvt_pk_bf16(u1.z, u1.w);
            const bf16x8 Bop = __builtin_bit_cast(bf16x8, bw);
            f32x4 br = __builtin_amdgcn_mfma_f32_16x16x32_bf16(Bf[0], Bop, (f32x4){0.f, 0.f, 0.f, 0.f}, 0, 0, 0);
            f32x4 bi = __builtin_amdgcn_mfma_f32_16x16x32_bf16(Bf[1], Bop, (f32x4){0.f, 0.f, 0.f, 0.f}, 0, 0, 0);
            f32x2 cin[4];
            if (SAMPLE) {
                const int bi_ = fr >> 2; const size_t so = ((size_t)(bidx + bi_) * 64 + g) * 64 + 16 * wq + 4 * fq; const f32x4 s_r = *(const f32x4*)(sre + so), s_i = *(const f32x4*)(sim + so);
#pragma unroll
                for (int s = 0; s < 4; ++s) cin[s] = tt == 0 ? (f32x2){s_r[s], s_i[s]} : (f32x2){0.f, 0.f};
            } else {
#pragma unroll
                for (int s = 0; s < 4; ++s) { cin[s].x = dpp_z<0x121>(x[s].x); cin[s].y = dpp_z<0x121>(x[s].y); }
#pragma unroll
                for (int s = 0; s < 4; ++s) cin[s] = fr == 0 ? cin[s] : (f32x2){0.f, 0.f};
            }
#pragma unroll
            for (int s = 0; s < 4; ++s) { const float a_r = ap[s][0], a_i = ap[s][1];
                f32x2 n = (f32x2){br[s], bi[s]}; n = (f32x2){a_r, a_r} * cin[s] + n; n = (f32x2){-a_i, a_i} * __builtin_shufflevector(cin[s], cin[s], 1, 0) + n; x[s] = n; }
            s5_ks<1, SAMPLE>(x, ap, 0, tt); s5_ks<2, SAMPLE>(x, ap, 1, tt);
            if (!SAMPLE) { s5_ks<4, false>(x, ap, 2, tt); s5_ks<8, false>(x, ap, 3, tt); }
            v4u xw; xw.x = cvt_pk_bf16(x[0].x, x[1].x); xw.y = cvt_pk_bf16(x[2].x, x[3].x); xw.z = cvt_pk_bf16(x[0].y, x[1].y); xw.w = cvt_pk_bf16(x[2].y, x[3].y);
            YP[((usel * 4 + wq) * 8 + tl) * 64 + F.lane] = __builtin_amdgcn_mfma_f32_16x16x32_bf16(Cf, __builtin_bit_cast(bf16x8, xw), (f32x4){0.f, 0.f, 0.f, 0.f}, 0, 0, 0);
        }
        if (!SAMPLE && t0 + 8 < ntile) {
#pragma unroll
            for (int tl = 0; tl < 8; ++tl) { const GAS float* up = (const GAS float*)U + ((size_t)rowbase + (size_t)(t0 + 8 + tl) * 16 + fr) * 1024 + g * 16 + 8 * (fq & 1);
                ua[tl] = *(const GAS f32x4*)up; ub[tl] = *(const GAS f32x4*)(up + 4); } }
        __syncthreads();
#pragma unroll
        for (int k = 0; k < 2; ++k) { const int tl = 2 * wq + k; if (SAMPLE && tl > 0) continue;
            f32x4 y = YP[((usel * 4 + 0) * 8 + tl) * 64 + F.lane] + YP[((usel * 4 + 1) * 8 + tl) * 64 + F.lane] + YP[((usel * 4 + 2) * 8 + tl) * 64 + F.lane] + YP[((usel * 4 + 3) * 8 + tl) * 64 + F.lane];
            const size_t row = (size_t)rowbase + (size_t)(t0 + tl) * 16 + fr; const int ch = g * 16 + 4 * fq;
            const f32x4 u4 = *(const f32x4*)(U + row * 1024 + ch), d4 = *(const f32x4*)(dsk + ch); y = y + d4 * u4;
            u32x2 o; o.x = cvt_pk_bf16(gelu_fast(y.x), gelu_fast(y.y)); o.y = cvt_pk_bf16(gelu_fast(y.z), gelu_fast(y.w)); *(u32x2*)(Gs + row * 1024 + ch) = o; }
        __syncthreads();
    }
    if (SAMPLE) { if (tt == 3) { const size_t so = ((size_t)(bidx + (fr >> 2)) * 64 + g) * 64 + 16 * wq + 4 * fq; *(f32x4*)(ore + so) = (f32x4){x[0].x, x[1].x, x[2].x, x[3].x}; *(f32x4*)(oim + so) = (f32x4){x[0].y, x[1].y, x[2].y, x[3].y}; } }
    else if (fr == 15) { const size_t so = ((size_t)bidx * 64 + g) * 64 + 16 * wq + 4 * fq; *(f32x4*)(ore + so) = (f32x4){x[0].x, x[1].x, x[2].x, x[3].x}; *(f32x4*)(oim + so) = (f32x4){x[0].y, x[1].y, x[2].y, x[3].y}; }
}
__device__ __forceinline__ void s5_phase(const Frame& F, const float* U, bf16* Gs, const float* dsk, const unsigned char* tab, const float* sre, const float* sim, float* out) {
    const int usel = F.wave >> 2;
    for (int u0 = F.vcu; u0 < 256; u0 += F.G) s5_pass<false>(F, u0 * 2 + usel, U, Gs, dsk, tab, nullptr, nullptr, out + O_SREP, out + O_SIMP);
    for (int u0 = F.vcu; u0 < 1024; u0 += F.G) s5_pass<true>(F, u0 * 2 + usel, U, Gs, dsk, tab, sre, sim, out + O_SRES, out + O_SIMS);
}
constexpr int PH_FINAL = 21, PH_END = 22;
enum { ST_GIN = 0, ST_MIX = 1, ST_GOUT = 2, ST_FF1 = 3, ST_FF2 = 4 };
constexpr size_t WS_SX0 = 172 * MiB, WS_SX1 = 175 * MiB, WS_SV = 178 * MiB;
constexpr size_t T_Y = 99 * MiB;

__global__ void __launch_bounds__(NWAVES * 64, 2) mk(Args a) {
    extern __shared__ __attribute__((aligned(16))) unsigned char lds_raw[];
    Frame F; F.lds = (LAS unsigned char*)lds_raw; F.tid = threadIdx.x; F.lane = F.tid & 63; F.wave = __builtin_amdgcn_readfirstlane(F.tid >> 6);
    F.G = gridDim.x; F.bx = blockIdx.x; F.vcu = (F.bx % 8) * (F.G / 8) + F.bx / 8;
    volatile LAS unsigned* MISC = (volatile LAS unsigned*)(F.lds + MISC_OFF);
    for (int u = F.tid; u < (LDS_BYTES - LDSCTL_OFF) / 4; u += NWAVES * 64) ((LAS unsigned*)(F.lds + LDSCTL_OFF))[u] = 0u;
    __syncthreads();
    if (F.tid == 0) { LAS unsigned long long* pt = (LAS unsigned long long*)(F.lds + PTAB_OFF);
#pragma unroll
        for (int i = 0; i < 35; ++i) pt[i] = (unsigned long long)a.in[i]; }
    __syncthreads();
    const bool multi = (a.ph_hi - a.ph_lo) > 1;
    XcdBarrier bar; bar.bar = (unsigned*)(a.ws + WS_CTL) + CW_BAR; bar.x = 0; bar.st = nullptr;
    if (multi) bar = xcd_barrier_post((unsigned*)(a.ws + WS_CTL) + CW_BAR, MISC + 8);

#ifndef DUP_CLS
#define DUP_CLS -1
#endif
    for (int ph = a.ph_lo, rep_ = 0; ph < a.ph_hi; ) {
        { int t_ = threadIdx.x, b_ = blockIdx.x; asm volatile("" : "+v"(t_)); asm volatile("" : "+s"(b_));
          F.tid = t_; F.lane = t_ & 63; F.wave = __builtin_amdgcn_readfirstlane(t_ >> 6); F.bx = b_; F.vcu = (b_ % 8) * (F.G / 8) + b_ / 8; }
        unsigned char* ws = a.ws; float* X = a.out; asm volatile("" : "+s"(ws)); asm volatile("" : "+s"(X));
        bf16* XB16 = (bf16*)(ws + WS_XN); unsigned char* T = ws + WS_T; bf16* Y = (bf16*)(T + T_Y);
        float* SX0 = (float*)(ws + WS_SX0); float* SX1 = (float*)(ws + WS_SX1); float* SV = (float*)(ws + WS_SV);
        if (ph == 0) {
            prologue_rows(F, inp(F, 0), inp(F, 1), X, XB16, SX0);
            { const float* wsf = inp(F, 13); bf16* wm = (bf16*)(ws + WS_WM);
              for (int i = F.vcu * 512 + F.tid; i < 2 * 8 * 128 * 128; i += F.G * 512) { const int s_ = i & 127, t_ = (i >> 7) & 127; wm[i] = s_ <= t_ ? (bf16)(cvt_pk_bf16(wsf[i], 0.f) & 0xffffu) : (bf16)0; } }
            s5_tables(F, inp(F, 26), inp(F, 27), inp(F, 28), inp(F, 29), inp(F, 30), inp(F, 31), inp(F, 32), ws + WS_S5T);
            rglru_tables(F, inp(F, 19), inp(F, 21), inp(F, 20), inp(F, 22), inp(F, 23), ws + WS_RGT);
            const int gw = F.vcu * NWAVES + F.wave, NGW = F.G * NWAVES; const float* gm = inp(F, 6);
            for (int it0 = gw; it0 < 6144; it0 += NGW) { int it = it0;
                if (conv_job(F, it, inp(F, 11), D, 2048, (bf16*)(ws + WS_W_INA), false, gm)) continue;
                if (conv_job(F, it, inp(F, 11) + (size_t)D * 2048, D, 2048, (bf16*)(ws + WS_W_INA + 4 * MiB), false, gm + 3 * D)) continue;
                if (conv_job(F, it, inp(F, 15), D, D, (bf16*)(ws + WS_W_OUTA), false, nullptr)) continue;
                if (conv_job(F, it, inp(F, 15) + (size_t)D * D, D, D, (bf16*)(ws + WS_W_OUTA + 2 * MiB), false, nullptr)) continue;
                if (conv_job(F, it, inp(F, 16), D, 2048, (bf16*)(ws + WS_W_INB), false, gm + D)) continue;
                if (conv_job(F, it, inp(F, 24), D, D, (bf16*)(ws + WS_W_OUTB), false, nullptr)) continue;
                if (conv_job(F, it, inp(F, 25), D, D, (bf16*)(ws + WS_W_INC), false, gm + 2 * D)) continue;
                conv_job(F, it, inp(F, 34), D, 2048, (bf16*)(ws + WS_W_GLU), true, nullptr);
            }
        } else if (ph == PH_FINAL) {
            norm_final(F, X, inp(F, 8));
        } else {
            const int l = (ph - 1) / 5, st = (ph - 1) % 5, kind = l % 3, j = l / 3;
            if (st == ST_GIN) {
                if (kind == 0) { const bf16* W = (const bf16*)(ws + WS_W_INA + (size_t)j * 4 * MiB); EpiRow8<FAct<ACT_GELU, true>> E{{(bf16*)T, 2048, SX0, 16, SV}};
                    big_gemm(F, XB16, W, 2048, D, E); small_gemm<4, 8, false, 4>(F, XB16, W, D, E.f); }
                else if (kind == 1) { const bf16* W = (const bf16*)(ws + WS_W_INB); EpiRow8<FRglru> E{{(bf16*)T, (float*)(T + 33 * MiB), SX0}};
                    big_gemm(F, XB16, W, 2048, D, E); small_gemm<4, 8, false, 4>(F, XB16, W, D, E.f); }
                else { const bf16* W = (const bf16*)(ws + WS_W_INC); EpiRow8<FF32> E{{(float*)T, D, SX0}};
                    big_gemm(F, XB16, W, D, D, E); small_gemm<2, 8, false, 4>(F, XB16, W, D, E.f); }
            } else if (st == ST_MIX) {
                if (kind == 0) sgu_mix_phase(F, (const bf16*)T, SV, inp(F, 12) + j * 1024, (const bf16*)(ws + WS_WM) + (size_t)j * 8 * 128 * 128, inp(F, 14) + j * 8 * 128, inp(F, 13) + (size_t)j * 8 * 128 * 128, Y, X + O_VS + (size_t)j * MS * 1024);
                else if (kind == 1) rglru_phase(F, (const float*)(T + 33 * MiB), (const bf16*)T, Y, inp(F, 17), inp(F, 18), ws + WS_RGT, inp(F, 2), inp(F, 3), X);
                else s5_phase(F, (const float*)T, Y, inp(F, 33), ws + WS_S5T, inp(F, 4), inp(F, 5), X);
                __syncthreads();
                ffn_conv(F, l, inp(F, 9), inp(F, 10), inp(F, 7), ws);
            } else if (st == ST_GOUT) {
                if (kind == 2) { const bf16* W = (const bf16*)(ws + WS_W_GLU); EpiPair8<FGlu> E{{X, XB16, SX1}};
                    big_gemm(F, Y, W, 2048, D, E); small_gemm<4, 8, true, 4>(F, Y, W, D, E.f); }
                else { const bf16* W = kind == 0 ? (const bf16*)(ws + WS_W_OUTA + (size_t)j * 2 * MiB) : (const bf16*)(ws + WS_W_OUTB); EpiResid8<FResid> E{{X, XB16, SX1}};
                    big_gemm(F, Y, W, D, D, E); small_gemm<2, 8, false, 4>(F, Y, W, D, E.f); }
            } else if (st == ST_FF1) {
                const bf16* W = (const bf16*)(ws + WS_W_FF1); EpiRow8<FAct<ACT_SQRELU, false>> E{{(bf16*)T, FF, SX1, kind == 2 ? 32 : 16, nullptr}};
                big_gemm(F, XB16, W, FF, D, E); small_gemm<8, 4, false, 4>(F, XB16, W, D, E.f);
            } else {
                const bf16* W = (const bf16*)(ws + WS_W_FF2); EpiResid8<FResid> E{{X, XB16, SX0}};
                big_gemm(F, (const bf16*)T, W, D, FF, E); small_gemm<2, 8, false, 4>(F, (const bf16*)T, W, FF, E.f);
            }
        }
        { int reps_ = 1;
          if (ph > 0 && ph < PH_FINAL) { const int st_ = (ph - 1) % 5;
              if (DUP_CLS == 1 && st_ == ST_GIN) reps_ = 2;
              if (DUP_CLS == 2 && st_ == ST_MIX) reps_ = 2;
              if (DUP_CLS >= 20 && DUP_CLS <= 22 && st_ == ST_MIX && (((ph - 1) / 5) % 3) == DUP_CLS - 20) reps_ = 2;
              if (DUP_CLS == 4 && st_ == ST_FF1) reps_ = 2; }
          if (DUP_CLS == 6 && ph == 0) reps_ = 2;
          if (DUP_CLS == 7 && ph == PH_FINAL - 1) reps_ = 1;
          if (rep_ + 1 < reps_) { ++rep_; __syncthreads(); continue; }
          rep_ = 0; }
        if (ph + 1 < a.ph_hi) xcd_barrier(bar);
        ++ph;
    }
}

static void launch_mk(const Args& base, int lo, int hi, hipStream_t stream) {
    Args a = base; a.ph_lo = lo; a.ph_hi = hi;
    hipLaunchKernelGGL(mk, dim3(256), dim3(NWAVES * 64), LDS_BYTES, stream, a);
}

extern "C" void kernel_launch(void* const* d_in, const int* in_sizes, int n_in, void* d_out, int out_size, void* d_ws, size_t ws_size, hipStream_t stream) {
    static int inited = 0;
    if (!inited) {
        if (n_in != 35 || out_size != (int)O_END || ws_size < WS_END) { fprintf(stderr, "kernel_launch: unexpected sizes n_in %d out %d ws %zu\n", n_in, out_size, ws_size); }
        if (hipFuncSetAttribute((const void*)mk, hipFuncAttributeMaxDynamicSharedMemorySize, LDS_BYTES) != hipSuccess) fprintf(stderr, "kernel_launch: hipFuncSetAttribute failed\n");
        (void)hipGetLastError(); inited = 1;
    }
    (void)hipMemsetAsync((unsigned char*)d_ws + WS_CTL, 0, CTL_ZERO_BYTES, stream);
    Args base{}; for (int i = 0; i < 35; ++i) base.in[i] = (const float*)d_in[i]; base.out = (float*)d_out; base.ws = (unsigned char*)d_ws;
    launch_mk(base, 0, PH_END, stream);
}
```

```cpp
#include <hip/hip_runtime.h>
#include <cstdio>
#include <cstdint>

constexpr int MP = 16384, MS = 512, M = MP + MS, D = 1024, FF = 4096;
constexpr float EPS = 1e-6f;

constexpr size_t O_YP = 0, O_YS = (size_t)MP * D, O_VS = O_YS + (size_t)MS * D, O_CONVP = O_VS + 2 * (size_t)MS * D, O_HP = O_CONVP + 8 * 3 * 1024,
                 O_CONVS = O_HP + 8 * 1024, O_HS = O_CONVS + 128 * 3 * 1024, O_SREP = O_HS + 128 * 1024, O_SIMP = O_SREP + 8 * 4096, O_SRES = O_SIMP + 8 * 4096,
                 O_SIMS = O_SRES + 128 * 4096, O_END = O_SIMS + 128 * 4096;

constexpr size_t MiB = 1u << 20;
constexpr size_t WS_CTL = 0, CTL_ZERO_BYTES = 64 * 1024;
constexpr size_t WS_XN = 1 * MiB;
constexpr size_t WS_T = 34 * MiB;
constexpr size_t WS_RSV = 128 * 1024;
constexpr size_t WS_WM = 166 * MiB;
constexpr size_t WS_RGT = 167 * MiB;
constexpr size_t WS_S5T = 168 * MiB;
constexpr size_t WS_S5AB = 170 * MiB;
constexpr size_t WS_S5BB = 170 * MiB + 512 * 1024;
constexpr size_t WS_HST = 171 * MiB;
constexpr size_t WS_S5ST = 172 * MiB;
constexpr size_t WS_CHA = 176 * MiB;
constexpr size_t WS_CHB = 180 * MiB;
constexpr size_t WS_XSR = 184 * MiB;
constexpr size_t WS_XSI = 200 * MiB;
constexpr size_t WS_W_INA = 216 * MiB, WS_W_OUTA = 224 * MiB, WS_W_INB = 228 * MiB, WS_W_OUTB = 232 * MiB, WS_W_INC = 234 * MiB, WS_W_GLU = 236 * MiB,
                 WS_W_FF1 = 240 * MiB, WS_W_FF2 = 248 * MiB, WS_END = 256 * MiB;
constexpr int CW_BAR = 4096;

#define GAS __attribute__((address_space(1)))
#define LAS __attribute__((address_space(3)))
typedef unsigned short bf16;
typedef unsigned v4u __attribute__((ext_vector_type(4)));
typedef float f32x4 __attribute__((ext_vector_type(4)));
typedef short bf16x8 __attribute__((ext_vector_type(8)));
typedef GAS unsigned gu32;
typedef GAS unsigned long long gu64;
#define RLX_AGENT __ATOMIC_RELAXED, __HIP_MEMORY_SCOPE_AGENT
#define LDS_WAIT() asm volatile("s_waitcnt lgkmcnt(0)" ::: "memory")
#define VM_WAIT() asm volatile("s_waitcnt vmcnt(0)" ::: "memory")
__device__ __forceinline__ unsigned long long rt() { return __builtin_amdgcn_s_memrealtime(); }
__device__ __forceinline__ unsigned f2bf(float f) { unsigned u = __builtin_bit_cast(unsigned, f); return (u + 0x7fffu + ((u >> 16) & 1u)) >> 16; }
__device__ __forceinline__ unsigned pk2(float lo, float hi) { return f2bf(lo) | (f2bf(hi) << 16); }

#define XB_TMO      128
#define XB_XCNT(j)  (256  + 64 * (j))
#define XB_XSUB(j)  (1280 + 64 * (j))
#define XB_XGEN(j)  (2304 + 64 * (j))
#define XB_TOP      3328
#define XB_TOPGEN   3392
#define XCD_BAR_WORDS 3456
#define XB_SPIN_CAP (1u << 18)

__device__ __forceinline__ unsigned xb_ld(unsigned* p)              { return __hip_atomic_load(p, __ATOMIC_RELAXED, __HIP_MEMORY_SCOPE_AGENT); }
__device__ __forceinline__ unsigned xb_add(unsigned* p, unsigned v) { return __hip_atomic_fetch_add(p, v, __ATOMIC_RELAXED, __HIP_MEMORY_SCOPE_AGENT); }
__device__ __forceinline__ unsigned xb_xcc_id() { return (unsigned)__builtin_amdgcn_s_getreg((3 << 11) | 20) & 0xFu; }
#define XB_SPIN(cond, bar) do { unsigned _sp = 0; while (cond) { __builtin_amdgcn_s_sleep(1); \
    if ((++_sp & 255u) == 0u) { if (xb_ld(&(bar)[XB_TMO])) break; if (_sp > XB_SPIN_CAP) { atomicAdd(&(bar)[XB_TMO], 1u); break; } } } } while (0)

struct XcdBarrier {
    unsigned* bar; unsigned x;
    volatile LAS unsigned* st;
};

__device__ __forceinline__ XcdBarrier xcd_barrier_post(unsigned* bar, volatile LAS unsigned* st) {
    XcdBarrier b; b.bar = bar; b.x = xb_xcc_id(); b.st = st;
    if (threadIdx.x == 0) (void)xb_add(&bar[XB_XCNT(b.x)], 1u);
    return b;
}
__device__ __forceinline__ void xcd_barrier_complete(unsigned* bar, unsigned x, unsigned& nloc, unsigned& nx) {
    const unsigned G = gridDim.x * gridDim.y * gridDim.z;
    unsigned sum, cnt, mine, sp = 0u;
    for (;;) {
        sum = 0u; cnt = 0u; mine = 0u;
#pragma unroll
        for (unsigned j = 0; j < 16; ++j) { const unsigned c = xb_ld(&bar[XB_XCNT(j)]); sum += c; cnt += (c > 0u) ? 1u : 0u; mine = (j == x) ? c : mine; }
        if (sum == G) break;
        __builtin_amdgcn_s_sleep(1);
        if ((++sp & 255u) == 0u) { if (xb_ld(&bar[XB_TMO])) break; if (sp > XB_SPIN_CAP) { atomicAdd(&bar[XB_TMO], 1u); break; } }
    }
    nloc = mine > 0u ? mine : 1u; nx = cnt > 0u ? cnt : 1u;
}

__device__ __forceinline__ void xcd_barrier(const XcdBarrier& b) {
    asm volatile("s_waitcnt vmcnt(0)" ::: "memory");
    __syncthreads();
    if (threadIdx.x == 0) {
        unsigned* bar = b.bar;
        __builtin_amdgcn_s_waitcnt(0);
        unsigned nloc = b.st[0], nx = b.st[1];
        if (nloc == 0u) { xcd_barrier_complete(bar, b.x, nloc, nx); b.st[0] = nloc; b.st[1] = nx; }
        const unsigned old = xb_add(&bar[XB_XSUB(b.x)], 1u);
        const unsigned gen = old / nloc;
        if (old + 1u == (gen + 1u) * nloc) {
            __builtin_amdgcn_fence(__ATOMIC_RELEASE, "agent");
            asm volatile("s_waitcnt vmcnt(0)" ::: "memory");
            const unsigned og = xb_add(&bar[XB_TOP], 1u);
            const unsigned tg = og / nx;
            if (og + 1u == (tg + 1u) * nx) xb_add(&bar[XB_TOPGEN], 1u);
            else XB_SPIN(xb_ld(&bar[XB_TOPGEN]) == tg, bar);
            __builtin_amdgcn_fence(__ATOMIC_ACQUIRE, "agent");
            xb_add(&bar[XB_XGEN(b.x)], 1u);
            asm volatile("s_waitcnt vmcnt(0)" ::: "memory");
        } else {
            XB_SPIN(xb_ld(&bar[XB_XGEN(b.x)]) == gen, bar);
            __builtin_amdgcn_fence(__ATOMIC_ACQUIRE, "agent");
            asm volatile("s_waitcnt vmcnt(0)" ::: "memory");
        }
    }
    __syncthreads();
}
namespace pg8 {
#define PG8_LAS __attribute__((address_space(3)))
typedef unsigned short bf16_t;
typedef short bf16x8 __attribute__((ext_vector_type(8)));
typedef float f32x4 __attribute__((ext_vector_type(4)));
typedef unsigned u32x4 __attribute__((ext_vector_type(4)));
constexpr int BM = 256, BK = 64, HALF = 128, HTB = HALF * BK * 2  , STAGE_BYTES = 8 * HTB, NXCD = 8, WGM = 8;

__host__ __device__ __forceinline__ int lds_byte(int r, int c) { const int st = (r >> 4) * 2 + (c >> 5), rr = r & 15, cc = c & 31, ob = rr * 64 + cc * 2; return st * 1024 + (ob ^ (((ob >> 9) & 1) << 5)); }
__host__ __device__ __forceinline__ void stage_rc(int b, int& R, int& C) { const int st = b / 1024, sb = b % 1024, swz = sb ^ (((sb >> 9) & 1) << 5); R = (st >> 1) * 16 + swz / 64; C = (st & 1) * 32 + (swz % 64) / 2; }
__host__ __device__ __forceinline__ int perm32(int rho) { const int n = rho >> 4, i = rho & 15; return 8 * (i >> 2) + 4 * n + (i & 3); }

struct Unit { int pm, pn; };
struct Gemm { const bf16_t* A; const bf16_t* Bt; int M, N, K; };

struct StaticOrder {
    int nM, nN, nwg, G, c;
    __host__ __device__ void init(int M, int N, int G_, int c_) { nM = M / BM; nN = N / BM; nwg = nM * nN; G = G_; c = c_; }
    __host__ __device__ bool next(int i, Unit& u) const {
        const long L = (long)i * G + c; if (L >= nwg) return false;
        int wgid = (int)L; { const int q = nwg / NXCD, r = nwg % NXCD, xcd = wgid % NXCD, off = wgid / NXCD; wgid = (xcd < r ? xcd * (q + 1) : r * (q + 1) + (xcd - r) * q) + off; }
        const int nig = WGM * nN, gid = wgid / nig, fm = gid * WGM, gsz = (nM - fm) < WGM ? (nM - fm) : WGM;
        u.pm = fm + ((wgid % nig) % gsz); u.pn = (wgid % nig) / gsz; return true;
    }
    __device__ __forceinline__ void a_ready(const Unit&) const {}
    __device__ __forceinline__ void done(const Unit&) const {}
};

template <class Epi, class Sched, bool ALIGN_EPI = false, bool SP2 = false>
__device__ __forceinline__ void gemm_phase(PG8_LAS unsigned char* lds, const Gemm g, const Sched& S, const Epi& E, const int tid_in) {
    const int tid = tid_in, wid = __builtin_amdgcn_readfirstlane(tid >> 6), lane = tid & 63, wr = wid >> 2, wc = wid & 3, fr = lane & 15, fq = lane >> 4;
    const int K = g.K, nt = K / BK;
    unsigned voffA[2], voffB[2];
#pragma unroll
    for (int i = 0; i < 2; ++i) { int R, C; stage_rc(tid * 16 + i * 8192, R, C); const int Rb = Epi::PERM ? ((R & ~31) + perm32(R & 31)) : R;
        voffA[i] = (unsigned)(R * K + C) * 2u; voffB[i] = (unsigned)(Rb * K + C) * 2u; }
    const size_t kstep = (size_t)(BK * 2);
    const size_t hstep = (size_t)HALF * K * 2;
    const size_t tstep = 2 * hstep;
    const unsigned ldsw = (unsigned)wid * 1024u;
    const int aoff = lds_byte(wr * 64 + fr, fq * 8), boff = lds_byte(wc * 32 + fr, fq * 8);
#define PG8_SA(b, h) (((b) * 2 + (h)) * HTB)
#define PG8_SB(b, h) ((4 + (b) * 2 + (h)) * HTB)
#define PG8_STAGE(bufoff, gbase, voff) do { _Pragma("unroll") for (int _i = 0; _i < 2; ++_i) \
        __builtin_amdgcn_global_load_lds((const unsigned*)((const char*)(gbase) + (voff)[_i]), (PG8_LAS unsigned*)(lds + (bufoff) + ldsw + _i * 8192), 16, 0, 0); } while (0)
#define PG8_LDA(dst, b, h) do { _Pragma("unroll") for (int m = 0; m < 4; ++m) _Pragma("unroll") for (int k = 0; k < 2; ++k) dst[m][k] = *(const PG8_LAS bf16x8*)(lds + PG8_SA(b, h) + aoff + m * 2048 + k * 1024); } while (0)
#define PG8_LDB(dst, b, h) do { _Pragma("unroll") for (int n = 0; n < 2; ++n) _Pragma("unroll") for (int k = 0; k < 2; ++k) dst[n][k] = *(const PG8_LAS bf16x8*)(lds + PG8_SB(b, h) + boff + n * 2048 + k * 1024); } while (0)
#define PG8_MMA(ai, bj, At, Bt) do { __builtin_amdgcn_s_setprio(1); _Pragma("unroll") for (int m = 0; m < 4; ++m) _Pragma("unroll") for (int n = 0; n < 2; ++n) _Pragma("unroll") for (int k = 0; k < 2; ++k) \
        acc[ai][bj][m][n] = __builtin_amdgcn_mfma_f32_16x16x32_bf16(Bt[n][k], At[m][k], acc[ai][bj][m][n], 0, 0, 0); __builtin_amdgcn_s_setprio(0); } while (0)
#define PG8_WAIT_V(n) asm volatile("s_waitcnt vmcnt(" #n ")" ::: "memory")
#define PG8_WAIT_L(n) asm volatile("s_waitcnt lgkmcnt(" #n ")" ::: "memory")
#define PG8_BAR __builtin_amdgcn_s_barrier()
#define PG8_SCHED __builtin_amdgcn_sched_barrier(0)
    Unit cur, nxt; int ui = 0;
    if (!S.next(0, cur)) return;
    E.first(lds, cur, tid);
    f32x4 acc[2][2][4][2];
#pragma unroll
    for (int a = 0; a < 2; ++a)
#pragma unroll
        for (int b = 0; b < 2; ++b)
#pragma unroll
            for (int m = 0; m < 4; ++m)
#pragma unroll
                for (int n = 0; n < 2; ++n) acc[a][b][m][n] = (f32x4){0.f, 0.f, 0.f, 0.f};
    bf16x8 At[4][2], B0[2][2], B1[2][2];
    const char* cA = (const char*)g.A + (size_t)cur.pm * tstep; const char* cB = (const char*)g.Bt + (size_t)cur.pn * tstep;
    S.a_ready(cur);
    if constexpr (SP2) {
        PG8_STAGE(PG8_SB(0, 0), cB, voffB); PG8_STAGE(PG8_SB(0, 1), cB + hstep, voffB); PG8_STAGE(PG8_SA(0, 0), cA, voffA); PG8_STAGE(PG8_SA(0, 1), cA + hstep, voffA);
        if (wr == 1) PG8_BAR;
        PG8_WAIT_V(2); PG8_BAR;
        PG8_STAGE(PG8_SB(1, 0), cB + kstep, voffB); PG8_STAGE(PG8_SA(1, 0), cA + kstep, voffA); PG8_STAGE(PG8_SB(1, 1), cB + hstep + kstep, voffB);
        PG8_WAIT_V(6); PG8_BAR;
    } else {
        PG8_STAGE(PG8_SB(0, 0), cB, voffB); PG8_STAGE(PG8_SA(0, 0), cA, voffA); PG8_STAGE(PG8_SB(0, 1), cB + hstep, voffB); PG8_STAGE(PG8_SA(0, 1), cA + hstep, voffA);
        if (wr == 1) PG8_BAR;
        PG8_WAIT_V(4); PG8_BAR;
        PG8_STAGE(PG8_SB(1, 0), cB + kstep, voffB); PG8_STAGE(PG8_SA(1, 0), cA + kstep, voffA); PG8_STAGE(PG8_SB(1, 1), cB + hstep + kstep, voffB);
        PG8_WAIT_V(6); PG8_BAR;
    }
    for (;;) {
        const bool has_next = S.next(ui + 1, nxt);
        const char* nA = has_next ? (const char*)g.A + (size_t)nxt.pm * tstep : cA; const char* nB = has_next ? (const char*)g.Bt + (size_t)nxt.pn * tstep : cB;
        for (int t = 0; t < nt; t += 2) {
            const bool last = (t == nt - 2);
            const char* a1 = cA + (size_t)(t + 1) * kstep;
            const char* a2 = last ? nA : cA + (size_t)(t + 2) * kstep; const char* b2 = last ? nB : cB + (size_t)(t + 2) * kstep;
            const char* a3 = a2 + kstep; const char* b3 = b2 + kstep;
            if (last && has_next) S.a_ready(nxt);
            if constexpr (SP2) {
            PG8_LDB(B0, 0, 0); PG8_LDB(B1, 0, 1); PG8_SCHED; PG8_LDA(At, 0, 0); PG8_STAGE(PG8_SA(1, 1), a1 + hstep, voffA);
            PG8_WAIT_V(8); PG8_WAIT_L(0); PG8_BAR; PG8_MMA(0, 0, At, B0); PG8_MMA(0, 1, At, B1); PG8_BAR; PG8_SCHED;
            PG8_LDA(At, 0, 1); PG8_STAGE(PG8_SB(0, 0), b2, voffB); PG8_STAGE(PG8_SB(0, 1), b2 + hstep, voffB); PG8_STAGE(PG8_SA(0, 0), a2, voffA);
            PG8_WAIT_V(8); PG8_WAIT_L(0); PG8_BAR; PG8_MMA(1, 0, At, B0); PG8_MMA(1, 1, At, B1); PG8_BAR; PG8_SCHED;
            PG8_LDB(B0, 1, 0); PG8_LDB(B1, 1, 1); PG8_SCHED; PG8_LDA(At, 1, 0); PG8_STAGE(PG8_SA(0, 1), a2 + hstep, voffA);
            PG8_WAIT_V(8); PG8_WAIT_L(0); PG8_BAR; PG8_MMA(0, 0, At, B0); PG8_MMA(0, 1, At, B1); PG8_BAR; PG8_SCHED;
            PG8_LDA(At, 1, 1); PG8_STAGE(PG8_SB(1, 0), b3, voffB); PG8_STAGE(PG8_SB(1, 1), b3 + hstep, voffB); PG8_STAGE(PG8_SA(1, 0), a3, voffA);
            PG8_WAIT_V(8); PG8_WAIT_L(0); PG8_BAR; PG8_MMA(1, 0, At, B0); PG8_MMA(1, 1, At, B1); PG8_BAR; PG8_SCHED;
            } else {
            PG8_LDB(B0, 0, 0); PG8_SCHED; PG8_LDA(At, 0, 0); PG8_STAGE(PG8_SA(1, 1), a1 + hstep, voffA);
            PG8_WAIT_L(8); PG8_BAR; PG8_WAIT_L(0); PG8_MMA(0, 0, At, B0); PG8_BAR; PG8_SCHED;
            PG8_LDB(B1, 0, 1); PG8_STAGE(PG8_SB(0, 0), b2, voffB);
            PG8_BAR; PG8_WAIT_L(0); PG8_MMA(0, 1, At, B1); PG8_BAR;
            PG8_LDA(At, 0, 1); PG8_STAGE(PG8_SA(0, 0), a2, voffA);
            PG8_BAR; PG8_WAIT_L(0); PG8_MMA(1, 0, At, B0); PG8_BAR; PG8_SCHED;
            PG8_STAGE(PG8_SB(0, 1), b2 + hstep, voffB);
            PG8_WAIT_V(6); PG8_BAR; PG8_MMA(1, 1, At, B1); PG8_BAR;
            PG8_LDB(B0, 1, 0); PG8_SCHED; PG8_LDA(At, 1, 0); PG8_STAGE(PG8_SA(0, 1), a2 + hstep, voffA);
            PG8_WAIT_L(8); PG8_BAR; PG8_WAIT_L(0); PG8_MMA(0, 0, At, B0); PG8_BAR; PG8_SCHED;
            PG8_LDB(B1, 1, 1); PG8_STAGE(PG8_SB(1, 0), b3, voffB);
            PG8_BAR; PG8_WAIT_L(0); PG8_MMA(0, 1, At, B1); PG8_BAR;
            PG8_LDA(At, 1, 1); PG8_STAGE(PG8_SA(1, 0), a3, voffA);
            PG8_BAR; PG8_WAIT_L(0); PG8_MMA(1, 0, At, B0); PG8_BAR; PG8_SCHED;
            PG8_STAGE(PG8_SB(1, 1), b3 + hstep, voffB);
            PG8_WAIT_V(6); PG8_BAR; PG8_MMA(1, 1, At, B1); PG8_BAR;
            }
        }
        if constexpr (ALIGN_EPI) { if (wr == 0) PG8_BAR; }
        if constexpr (!Epi::AFTER_DRAIN) { E(acc, cur, wr, wc, fr, fq, lds, nxt, has_next, ui, tid); S.done(cur); }
        if (!has_next) break;
#pragma unroll
        for (int a = 0; a < 2; ++a)
#pragma unroll
            for (int b = 0; b < 2; ++b)
#pragma unroll
                for (int m = 0; m < 4; ++m)
#pragma unroll
                    for (int n = 0; n < 2; ++n) acc[a][b][m][n] = (f32x4){0.f, 0.f, 0.f, 0.f};
        cur = nxt; cA = nA; cB = nB; ++ui;
        if constexpr (ALIGN_EPI) { if (wr == 1) PG8_BAR; }
    }
    PG8_WAIT_V(0);
    if constexpr (!ALIGN_EPI) { if (wr == 0) PG8_BAR; }
    PG8_BAR;
    if constexpr (Epi::AFTER_DRAIN) { E.fused(acc, cur, wr, wc, fr, fq, lds, wid, lane); S.done(cur); }
#undef PG8_SA
#undef PG8_SB
#undef PG8_STAGE
#undef PG8_LDA
#undef PG8_LDB
#undef PG8_MMA
#undef PG8_WAIT_V
#undef PG8_WAIT_L
#undef PG8_BAR
#undef PG8_SCHED
}
}
__device__ __forceinline__ float bf2f(unsigned short h) { return __builtin_bit_cast(float, (unsigned)h << 16); }
__device__ __forceinline__ float gelu_tanh(float x) { const float u = 0.7978845608028654f * (x + 0.044715f * x * x * x); return 0.5f * x * (1.f + tanhf(u)); }
__device__ __forceinline__ float sigmoidf_(float x) { return 1.f / (1.f + expf(-x)); }
template <int CTRL> __device__ __forceinline__ float dpp0(float src) { return __builtin_bit_cast(float, __builtin_amdgcn_update_dpp(0, __builtin_bit_cast(int, src), CTRL, 0xf, 0xf, true)); }
__device__ __forceinline__ float xor16f(float v) { return __shfl_xor(v, 16); }
__device__ __forceinline__ float sum32f(float v) { return v + __shfl_xor(v, 32); }
__device__ __forceinline__ float wave_sum(float v) {
#pragma unroll
    for (int o = 1; o < 64; o <<= 1) v += __shfl_xor(v, o);
    return v;
}
__device__ __forceinline__ unsigned cvt_pk_bf16(float lo, float hi) { unsigned r; asm volatile("v_cvt_pk_bf16_f32 %0, %1, %2" : "=v"(r) : "v"(lo), "v"(hi)); return r; }
__device__ __forceinline__ float gelu_fast(float x) { const float u = x * (0.7978845608028654f + 0.035677408136300125f * x * x); return x * __builtin_amdgcn_rcpf(1.f + __builtin_amdgcn_exp2f(-2.8853900817779268f * u)); }
__device__ __forceinline__ float sigmoid_fast(float x) { return __builtin_amdgcn_rcpf(1.f + __builtin_amdgcn_exp2f(-1.4426950408889634f * x)); }
enum { ACT_GELU = 0, ACT_SQRELU = 1 };
typedef unsigned u32x2 __attribute__((ext_vector_type(2)));
struct RowCtx { float rs, ss; };
constexpr int XS_P = 32, XS_S = 64, VS_P = 16, VS_S = 64;
template <int N4> __device__ __forceinline__ float sum_slots_n(const float* p) { f32x4 v[N4];
#pragma unroll
    for (int i = 0; i < N4; ++i) v[i] = ((const f32x4*)p)[i];
    float s = 0.f;
#pragma unroll
    for (int i = 0; i < N4; ++i) s += (v[i].x + v[i].y) + (v[i].z + v[i].w);
    return s; }
__device__ __forceinline__ float sum_slots(const float* p, int n4) { return n4 == 4 ? sum_slots_n<4>(p) : (n4 == 8 ? sum_slots_n<8>(p) : sum_slots_n<16>(p)); }
__device__ __forceinline__ float rs_x(const float* P, int nslot, int row) {
    const float s = row < MP ? sum_slots(P + (size_t)row * XS_P, nslot >> 2) : sum_slots(P + (size_t)MP * XS_P + (size_t)(row - MP) * XS_S, XS_S >> 2); return rsqrtf(s * (1.f / 1024.f) + EPS); }
__device__ __forceinline__ float rs_v(const float* P, int row) {
    const float s = row < MP ? sum_slots(P + (size_t)row * VS_P, VS_P >> 2) : sum_slots(P + (size_t)MP * VS_P + (size_t)(row - MP) * VS_S, VS_S >> 2); return rsqrtf(s * (1.f / 1024.f) + EPS); }
__device__ __forceinline__ float fq_sum(float ss) { ss += xor16f(ss); return sum32f(ss); }
__device__ __forceinline__ void xs_store(float* P, int row, int col, bool pair, float ss, int fq) {
    ss = fq_sum(ss); if (fq != 0) return;
    if (row < MP) P[(size_t)row * XS_P + (pair ? (col >> 5) : (((col >> 8) << 2) | ((col >> 5) & 3)))] = ss; else P[(size_t)MP * XS_P + (size_t)(row - MP) * XS_S + (col >> 4)] = ss; }
__device__ __forceinline__ void vs_store(float* P, int row, int col, float ss, int fq) {
    ss = fq_sum(ss); if (fq != 0) return; const int c = col - 1024;
    if (row < MP) P[(size_t)row * VS_P + (((c >> 8) << 2) | ((c >> 5) & 3))] = ss; else P[(size_t)MP * VS_P + (size_t)(row - MP) * VS_S + (c >> 4)] = ss; }
constexpr int RSTAB_OFF = 131072 + 2048;
__device__ __forceinline__ LAS float* rstab(LAS unsigned char* lds, int par) { return (LAS float*)(lds + RSTAB_OFF) + par * 256; }
template <int ACT> __device__ __forceinline__ float act_f(float x) { if (ACT == ACT_GELU) return gelu_fast(x); const float t = fmaxf(x, 0.f); return t * t; }

template <int ACT, bool VSTAT> struct FAct { bf16* O; int ldc; const float* S; int nslot; float* SV;
    __device__ __forceinline__ RowCtx begin(int row) const { return RowCtx{rs_x(S, nslot, row), 0.f}; }
    __device__ __forceinline__ float rs_row(int row) const { return rs_x(S, nslot, row); }
    __device__ __forceinline__ void apply8(RowCtx& c, int row, int col, f32x4 v0, f32x4 v1) const {
        float r[8];
#pragma unroll
        for (int i = 0; i < 4; ++i) { r[i] = act_f<ACT>(v0[i] * c.rs); r[4 + i] = act_f<ACT>(v1[i] * c.rs); }
        if (VSTAT && col >= 1024) {
#pragma unroll
            for (int i = 0; i < 8; ++i) c.ss += r[i] * r[i]; }
        v4u w; w.x = cvt_pk_bf16(r[0], r[1]); w.y = cvt_pk_bf16(r[2], r[3]); w.z = cvt_pk_bf16(r[4], r[5]); w.w = cvt_pk_bf16(r[6], r[7]); *(v4u*)(O + (size_t)row * ldc + col) = w; }
    __device__ __forceinline__ void apply4(RowCtx& c, int row, int col, f32x4 v) const {
        float r[4];
#pragma unroll
        for (int i = 0; i < 4; ++i) r[i] = act_f<ACT>(v[i] * c.rs);
        if (VSTAT && col >= 1024) c.ss += (r[0] * r[0] + r[1] * r[1]) + (r[2] * r[2] + r[3] * r[3]);
        u32x2 w; w.x = cvt_pk_bf16(r[0], r[1]); w.y = cvt_pk_bf16(r[2], r[3]); *(u32x2*)(O + (size_t)row * ldc + col) = w; }
    __device__ __forceinline__ void end(RowCtx& c, int row, int col, int fq) const { if (VSTAT && col >= 1024) vs_store(SV, row, col, c.ss, fq); } };
struct FRglru { bf16* G; float* XB; const float* S;
    __device__ __forceinline__ RowCtx begin(int row) const { return RowCtx{rs_x(S, 16, row), 0.f}; }
    __device__ __forceinline__ float rs_row(int row) const { return rs_x(S, 16, row); }
    __device__ __forceinline__ void apply8(RowCtx& c, int row, int col, f32x4 v0, f32x4 v1) const {
        if (col < 1024) { v4u w; w.x = cvt_pk_bf16(gelu_fast(v0[0] * c.rs), gelu_fast(v0[1] * c.rs)); w.y = cvt_pk_bf16(gelu_fast(v0[2] * c.rs), gelu_fast(v0[3] * c.rs));
            w.z = cvt_pk_bf16(gelu_fast(v1[0] * c.rs), gelu_fast(v1[1] * c.rs)); w.w = cvt_pk_bf16(gelu_fast(v1[2] * c.rs), gelu_fast(v1[3] * c.rs)); *(v4u*)(G + (size_t)row * 1024 + col) = w; }
        else { float* p = XB + (size_t)row * 1024 + col - 1024; *(f32x4*)p = v0 * c.rs; *(f32x4*)(p + 4) = v1 * c.rs; } }
    __device__ __forceinline__ void apply4(RowCtx& c, int row, int col, f32x4 v) const {
        if (col < 1024) { u32x2 w; w.x = cvt_pk_bf16(gelu_fast(v[0] * c.rs), gelu_fast(v[1] * c.rs)); w.y = cvt_pk_bf16(gelu_fast(v[2] * c.rs), gelu_fast(v[3] * c.rs)); *(u32x2*)(G + (size_t)row * 1024 + col) = w; }
        else *(f32x4*)(XB + (size_t)row * 1024 + col - 1024) = v * c.rs; }
    __device__ __forceinline__ void end(RowCtx&, int, int, int) const {} };
struct FF32 { float* O; int ldc; const float* S;
    __device__ __forceinline__ RowCtx begin(int row) const { return RowCtx{rs_x(S, 16, row), 0.f}; }
    __device__ __forceinline__ float rs_row(int row) const { return rs_x(S, 16, row); }
    __device__ __forceinline__ void apply8(RowCtx& c, int row, int col, f32x4 v0, f32x4 v1) const { float* p = O + (size_t)row * ldc + col; *(f32x4*)p = v0 * c.rs; *(f32x4*)(p + 4) = v1 * c.rs; }
    __device__ __forceinline__ void apply4(RowCtx& c, int row, int col, f32x4 v) const { *(f32x4*)(O + (size_t)row * ldc + col) = v * c.rs; }
    __device__ __forceinline__ void end(RowCtx&, int, int, int) const {} };
struct FResid { float* X; bf16* XB16; float* Sacc; const float* Xr; const float* Xs;
    __device__ __forceinline__ RowCtx begin(int) const { return RowCtx{0.f, 0.f}; }
    __device__ __forceinline__ void load8(int row, int col, f32x4& xa, f32x4& xb) const { const float* p = Xr + (size_t)row * D + col; xa = *(const f32x4*)p; xb = *(const f32x4*)(p + 4); }
    __device__ __forceinline__ void apply8x(RowCtx& c, int row, int col, f32x4 v0, f32x4 v1, f32x4 xa, f32x4 xb) const { float* p = X + (size_t)row * D + col;
        const f32x4 x0 = xa + v0, x1 = xb + v1; *(f32x4*)p = x0; *(f32x4*)(p + 4) = x1;
        c.ss += (x0[0] * x0[0] + x0[1] * x0[1]) + (x0[2] * x0[2] + x0[3] * x0[3]) + (x1[0] * x1[0] + x1[1] * x1[1]) + (x1[2] * x1[2] + x1[3] * x1[3]);
        v4u w; w.x = cvt_pk_bf16(x0[0], x0[1]); w.y = cvt_pk_bf16(x0[2], x0[3]); w.z = cvt_pk_bf16(x1[0], x1[1]); w.w = cvt_pk_bf16(x1[2], x1[3]); *(v4u*)(XB16 + (size_t)row * D + col) = w; }
    __device__ __forceinline__ void apply4(RowCtx& c, int row, int col, f32x4 v) const { float* p = X + (size_t)row * D + col; const f32x4 x0 = *(const f32x4*)(Xs + (size_t)row * D + col) + v; *(f32x4*)p = x0;
        c.ss += (x0[0] * x0[0] + x0[1] * x0[1]) + (x0[2] * x0[2] + x0[3] * x0[3]);
        u32x2 w; w.x = cvt_pk_bf16(x0[0], x0[1]); w.y = cvt_pk_bf16(x0[2], x0[3]); *(u32x2*)(XB16 + (size_t)row * D + col) = w; }
    __device__ __forceinline__ void end(RowCtx& c, int row, int col, int fq) const { xs_store(Sacc, row, col, false, c.ss, fq); } };
struct FGlu { float* X; bf16* XB16; float* Sacc;
    __device__ __forceinline__ RowCtx begin(int) const { return RowCtx{0.f, 0.f}; }
    __device__ __forceinline__ void apply4_pair(RowCtx& c, int row, int col, f32x4 a, f32x4 b) const { float* p = X + (size_t)row * D + col; f32x4 x0 = *(const f32x4*)p;
#pragma unroll
        for (int i = 0; i < 4; ++i) x0[i] += a[i] * sigmoid_fast(b[i]);
        *(f32x4*)p = x0; c.ss += (x0[0] * x0[0] + x0[1] * x0[1]) + (x0[2] * x0[2] + x0[3] * x0[3]);
        u32x2 w; w.x = cvt_pk_bf16(x0[0], x0[1]); w.y = cvt_pk_bf16(x0[2], x0[3]); *(u32x2*)(XB16 + (size_t)row * D + col) = w; }
    __device__ __forceinline__ void load8(int row, int col, f32x4& xa, f32x4& xb) const { const float* p = X + (size_t)row * D + col; xa = *(const f32x4*)p; xb = *(const f32x4*)(p + 4); }
    __device__ __forceinline__ void apply8x_pair(RowCtx& c, int row, int col, f32x4 a0, f32x4 a1, f32x4 b0, f32x4 b1, f32x4 x0, f32x4 x1) const { float* p = X + (size_t)row * D + col;
#pragma unroll
        for (int i = 0; i < 4; ++i) { x0[i] += a0[i] * sigmoid_fast(b0[i]); x1[i] += a1[i] * sigmoid_fast(b1[i]); }
        *(f32x4*)p = x0; *(f32x4*)(p + 4) = x1;
        c.ss += (x0[0] * x0[0] + x0[1] * x0[1]) + (x0[2] * x0[2] + x0[3] * x0[3]) + (x1[0] * x1[0] + x1[1] * x1[1]) + (x1[2] * x1[2] + x1[3] * x1[3]);
        v4u w; w.x = cvt_pk_bf16(x0[0], x0[1]); w.y = cvt_pk_bf16(x0[2], x0[3]); w.z = cvt_pk_bf16(x1[0], x1[1]); w.w = cvt_pk_bf16(x1[2], x1[3]); *(v4u*)(XB16 + (size_t)row * D + col) = w; }
    __device__ __forceinline__ void end(RowCtx& c, int row, int col, int fq) const { xs_store(Sacc, row, col, true, c.ss, fq); } };

template <class F> struct EpiRow8 { static constexpr bool PERM = true, AFTER_DRAIN = false; F f;
    __device__ __forceinline__ void first(PG8_LAS unsigned char* lds, const pg8::Unit& u, int tid) const { if (tid < 256) rstab(lds, 0)[tid] = f.rs_row(u.pm * 256 + tid); }
    __device__ __forceinline__ void operator()(const pg8::f32x4 (&acc)[2][2][4][2], const pg8::Unit& u, int wr, int wc, int fr, int fq, PG8_LAS unsigned char* lds, const pg8::Unit& nxt, bool has_next, int ui, int tid) const {
        const LAS float* tab = rstab(lds, ui & 1);
        float nrs = 0.f; if (has_next && tid < 256) nrs = f.rs_row(nxt.pm * 256 + tid);
#pragma unroll
        for (int ai = 0; ai < 2; ++ai)
#pragma unroll
            for (int m = 0; m < 4; ++m) { const int rl = ai * 128 + wr * 64 + m * 16 + fr, row = u.pm * 256 + rl; RowCtx c = RowCtx{tab[rl], 0.f};
#pragma unroll
                for (int bj = 0; bj < 2; ++bj) f.apply8(c, row, u.pn * 256 + bj * 128 + wc * 32 + 8 * fq, acc[ai][bj][m][0], acc[ai][bj][m][1]);
                f.end(c, row, u.pn * 256 + wc * 32, fq); }
        if (has_next && tid < 256) rstab(lds, (ui + 1) & 1)[tid] = nrs; } };
template <class F> struct EpiResid8 { static constexpr bool PERM = true, AFTER_DRAIN = true; F f;
    __device__ __forceinline__ void first(PG8_LAS unsigned char*, const pg8::Unit&, int) const {}
    __device__ __forceinline__ void operator()(const pg8::f32x4 (&)[2][2][4][2], const pg8::Unit&, int, int, int, int, PG8_LAS unsigned char*, const pg8::Unit&, bool, int, int) const {}
    __device__ __forceinline__ void rows2(const pg8::f32x4 (&acc)[2][2][4][2], const pg8::Unit& u, int wr, int wc, int fr, int fq, int ai, int mh, const f32x4 (&xo)[2][2][2]) const {
#pragma unroll
        for (int mm = 0; mm < 2; ++mm) { const int m = 2 * mh + mm, row = u.pm * 256 + ai * 128 + wr * 64 + m * 16 + fr; RowCtx c = f.begin(row);
#pragma unroll
            for (int bj = 0; bj < 2; ++bj) f.apply8x(c, row, u.pn * 256 + bj * 128 + wc * 32 + 8 * fq, acc[ai][bj][m][0], acc[ai][bj][m][1], xo[mm][bj][0], xo[mm][bj][1]);
            f.end(c, row, u.pn * 256 + wc * 32, fq); } }
    __device__ __forceinline__ void fused(pg8::f32x4 (&acc)[2][2][4][2], const pg8::Unit& u, int wr, int wc, int fr, int fq, PG8_LAS unsigned char* lds, int wid, int lane) const {
#pragma unroll
        for (int m = 0; m < 4; ++m)
#pragma unroll
            for (int bj = 0; bj < 2; ++bj)
#pragma unroll
                for (int hf = 0; hf < 2; ++hf) { const float* src = f.Xr + (size_t)(u.pm * 256 + wr * 64 + m * 16 + fr) * D + u.pn * 256 + bj * 128 + wc * 32 + 8 * fq + 4 * hf;
                    __builtin_amdgcn_global_load_lds((const unsigned*)src, (PG8_LAS unsigned*)(lds + ((m * 2 + bj) * 2 + hf) * 8192 + wid * 1024), 16, 0, 0); }
        f32x4 xa[2][2][2], xb[2][2][2];
#pragma unroll
        for (int mm = 0; mm < 2; ++mm)
#pragma unroll
            for (int bj = 0; bj < 2; ++bj) f.load8(u.pm * 256 + 128 + wr * 64 + mm * 16 + fr, u.pn * 256 + bj * 128 + wc * 32 + 8 * fq, xa[mm][bj][0], xa[mm][bj][1]);
        asm volatile("s_waitcnt vmcnt(0)" ::: "memory");
        rows2(acc, u, wr, wc, fr, fq, 1, 0, xa);
#pragma unroll
        for (int mm = 0; mm < 2; ++mm)
#pragma unroll
            for (int bj = 0; bj < 2; ++bj) f.load8(u.pm * 256 + 128 + wr * 64 + (2 + mm) * 16 + fr, u.pn * 256 + bj * 128 + wc * 32 + 8 * fq, xb[mm][bj][0], xb[mm][bj][1]);
#pragma unroll
        for (int mh = 0; mh < 2; ++mh) { f32x4 xl[2][2][2];
#pragma unroll
            for (int mm = 0; mm < 2; ++mm)
#pragma unroll
                for (int bj = 0; bj < 2; ++bj)
#pragma unroll
                    for (int hf = 0; hf < 2; ++hf) xl[mm][bj][hf] = *(const PG8_LAS f32x4*)(lds + (((2 * mh + mm) * 2 + bj) * 2 + hf) * 8192 + wid * 1024 + lane * 16);
            rows2(acc, u, wr, wc, fr, fq, 0, mh, xl); }
        rows2(acc, u, wr, wc, fr, fq, 1, 1, xb);
    } };
template <class F> struct EpiPair8 { static constexpr bool PERM = true, AFTER_DRAIN = false; F f;
    __device__ __forceinline__ void first(PG8_LAS unsigned char*, const pg8::Unit&, int) const {}
    __device__ __forceinline__ void operator()(const pg8::f32x4 (&acc)[2][2][4][2], const pg8::Unit& u, int wr, int wc, int fr, int fq, PG8_LAS unsigned char*, const pg8::Unit&, bool, int, int) const {
#pragma unroll
        for (int ai = 0; ai < 2; ++ai) {
            f32x4 xo[4][2];
#pragma unroll
            for (int m = 0; m < 4; ++m) f.load8(u.pm * 256 + ai * 128 + wr * 64 + m * 16 + fr, u.pn * 128 + wc * 32 + 8 * fq, xo[m][0], xo[m][1]);
#pragma unroll
            for (int m = 0; m < 4; ++m) { const int row = u.pm * 256 + ai * 128 + wr * 64 + m * 16 + fr; RowCtx c = f.begin(row);
                f.apply8x_pair(c, row, u.pn * 128 + wc * 32 + 8 * fq, acc[ai][0][m][0], acc[ai][0][m][1], acc[ai][1][m][0], acc[ai][1][m][1], xo[m][0], xo[m][1]);
                f.end(c, row, u.pn * 128 + wc * 32, fq); }
            asm volatile("" ::: "memory"); } } };

constexpr int NWAVES = 8;
constexpr int RING_BYTES = 131072, LDSCTL_OFF = RING_BYTES, MISC_OFF = LDSCTL_OFF + 320, LDS_BYTES = 147456;
constexpr int PTAB_OFF = LDSCTL_OFF + 1024;
struct Frame { LAS unsigned char* lds; int tid, lane, wave, vcu, G, bx; };
__device__ __forceinline__ const float* inp(const Frame& F, int i) {
    const volatile LAS unsigned* t = (const volatile LAS unsigned*)(F.lds + PTAB_OFF) + 2 * i;
    const unsigned lo = __builtin_amdgcn_readfirstlane(t[0]), hi = __builtin_amdgcn_readfirstlane(t[1]);
    return (const float*)(((unsigned long long)hi << 32) | lo);
}

template <int NCT, int KS, bool GLU, int UNR, class F>
__device__ __forceinline__ void small_gemm(const Frame& Fr, const bf16* A, const bf16* WT, int K, const F& f) {
    constexpr int CS = 8 / KS, CT = NCT / CS, NT = 4 * CT;
    const int rb = Fr.vcu & 7, cb = Fr.vcu >> 3, kq = Fr.wave % KS, cs = Fr.wave / KS, fr = Fr.lane & 15, fq = Fr.lane >> 4;
    const int m0 = MP + rb * 64, ksl = K / KS;
    const bf16* ap = A + (size_t)(m0 + fr) * K + kq * ksl + 8 * fq;
    const bf16* bp[CT];
#pragma unroll
    for (int j = 0; j < CT; ++j) { const int ct = cs * CT + j; int wrow;
        if (GLU) { const int c = cb * 32 + (ct & 1) * 16; wrow = 256 * (c >> 7) + 128 * (ct >> 1) + (c & 127); } else wrow = (cb * NCT + ct) * 16;
        bp[j] = WT + (size_t)(wrow + fr) * K + kq * ksl + 8 * fq; }
    f32x4 acc[4][CT];
#pragma unroll
    for (int r = 0; r < 4; ++r)
#pragma unroll
        for (int j = 0; j < CT; ++j) acc[r][j] = (f32x4){0.f, 0.f, 0.f, 0.f};
#pragma unroll UNR
    for (int k0 = 0; k0 < ksl; k0 += 32) {
        bf16x8 a[4], b[CT];
#pragma unroll
        for (int r = 0; r < 4; ++r) a[r] = *(const bf16x8*)(ap + (size_t)r * 16 * K + k0);
#pragma unroll
        for (int j = 0; j < CT; ++j) b[j] = *(const bf16x8*)(bp[j] + k0);
#pragma unroll
        for (int r = 0; r < 4; ++r)
#pragma unroll
            for (int j = 0; j < CT; ++j) acc[r][j] = __builtin_amdgcn_mfma_f32_16x16x32_bf16(b[j], a[r], acc[r][j], 0, 0, 0);
    }
    LAS f32x4* RED = (LAS f32x4*)Fr.lds;
    __syncthreads();
#pragma unroll
    for (int r = 0; r < 4; ++r)
#pragma unroll
        for (int j = 0; j < CT; ++j) RED[(Fr.wave * NT + r * CT + j) * 64 + Fr.lane] = acc[r][j];
    __syncthreads();
    const int rt = Fr.wave & 3, hf = Fr.wave >> 2, row = m0 + rt * 16 + fr;
    RowCtx c = f.begin(row);
    if constexpr (GLU) {
        f32x4 va = (f32x4){0.f, 0.f, 0.f, 0.f}, vb = va;
#pragma unroll
        for (int q = 0; q < KS; ++q) { va = va + RED[(q * NT + rt * CT + hf) * 64 + Fr.lane]; vb = vb + RED[(q * NT + rt * CT + 2 + hf) * 64 + Fr.lane]; }
        const int col = cb * 32 + hf * 16; c.ss = 0.f; f.apply4_pair(c, row, col + 4 * fq, va, vb); f.end(c, row, col, fq);
    } else {
#pragma unroll
        for (int jj = 0; jj < NCT / 2; ++jj) { const int ct = hf * (NCT / 2) + jj, g = ct / CT, j = ct % CT; f32x4 v = (f32x4){0.f, 0.f, 0.f, 0.f};
#pragma unroll
            for (int q = 0; q < KS; ++q) v = v + RED[((g * KS + q) * NT + rt * CT + j) * 64 + Fr.lane];
            const int col = (cb * NCT + ct) * 16; c.ss = 0.f; f.apply4(c, row, col + 4 * fq, v); f.end(c, row, col, fq); }
    }
    __syncthreads();
}

__device__ __forceinline__ void transpose_item(const float* W, int K, int N, bf16* WT, int drow0, LAS float* scr, int k0, int n0, int lane, const float* gain) {
#pragma unroll 8
    for (int i = 0; i < 32; ++i) { const int kk = 2 * i + (lane >> 5); scr[kk * 33 + (lane & 31)] = W[(size_t)(k0 + kk) * N + n0 + (lane & 31)] * (gain ? gain[k0 + kk] : 1.f); }
    LDS_WAIT(); asm volatile("" ::: "memory");
    const int c = lane & 7;
#pragma unroll
    for (int j = 0; j < 4; ++j) { const int n = (lane >> 3) + 8 * j; const LAS float* s = scr + (8 * c) * 33 + n;
        v4u o; o.x = cvt_pk_bf16(s[0 * 33], s[1 * 33]); o.y = cvt_pk_bf16(s[2 * 33], s[3 * 33]); o.z = cvt_pk_bf16(s[4 * 33], s[5 * 33]); o.w = cvt_pk_bf16(s[6 * 33], s[7 * 33]);
        *(GAS v4u*)(WT + (size_t)(drow0 + n) * K + k0 + 8 * c) = o; }
    LDS_WAIT(); asm volatile("" ::: "memory");
}
__device__ __forceinline__ bool conv_job(const Frame& F, int& it, const float* W, int K, int N, bf16* WT, bool glu, const float* gain) {
    const int nblk = N / 32, nit = (K / 64) * nblk;
    if (it >= nit) { it -= nit; return false; }
    const int kb = it / nblk, nb = it % nblk, n0 = 32 * nb; int drow0 = n0;
    if (glu) { const int bj = n0 >> 10, r = n0 & 1023; drow0 = 256 * (r >> 7) + 128 * bj + (r & 127); }
    transpose_item(W, K, N, WT, drow0, (LAS float*)(F.lds + F.wave * 16384), 64 * kb, n0, F.lane, gain);
    return true;
}
__device__ __forceinline__ void ffn_conv(const Frame& F, int l, const float* w1, const float* w2, const float* gffn, unsigned char* ws) {
    const int gw = F.vcu * NWAVES + F.wave, NGW = F.G * NWAVES;
    for (int it0 = gw; it0 < 4096; it0 += NGW) { int it = it0;
        if (conv_job(F, it, w1 + (size_t)l * D * FF, D, FF, (bf16*)(ws + WS_W_FF1), false, gffn + l * D)) continue;
        conv_job(F, it, w2 + (size_t)l * FF * D, FF, D, (bf16*)(ws + WS_W_FF2), false, nullptr);
    }
}

struct Args { const float* in[35]; float* out; unsigned char* ws; int ph_lo, ph_hi; };

__device__ __forceinline__ void prologue_rows(const Frame& F, const float* xp, const float* xs, bf16* XB16, float* SX0) {
    const int gw = F.vcu * NWAVES + F.wave, NGW = F.G * NWAVES;
    for (int row = gw; row < M; row += NGW) {
        const f32x4* xr = (const f32x4*)(row < MP ? xp + (size_t)row * D : xs + (size_t)(row - MP) * D) + F.lane; f32x4 v[4]; float s = 0.f;
#pragma unroll
        for (int j = 0; j < 4; ++j) { v[j] = xr[64 * j]; s += (v[j].x * v[j].x + v[j].y * v[j].y) + (v[j].z * v[j].z + v[j].w * v[j].w); }
        s = wave_sum(s);
        if (row < MP) { if (F.lane < 16) SX0[(size_t)row * XS_P + F.lane] = F.lane == 0 ? s : 0.f; } else SX0[(size_t)MP * XS_P + (size_t)(row - MP) * XS_S + F.lane] = F.lane == 0 ? s : 0.f;
        u32x2* o = (u32x2*)(XB16 + (size_t)row * D) + F.lane;
#pragma unroll
        for (int j = 0; j < 4; ++j) { u32x2 w; w.x = cvt_pk_bf16(v[j].x, v[j].y); w.y = cvt_pk_bf16(v[j].z, v[j].w); o[64 * j] = w; }
    }
}
__device__ __forceinline__ void norm_final(const Frame& F, float* X, const float* g) {
    const int gw = F.vcu * NWAVES + F.wave, NGW = F.G * NWAVES;
    f32x4 gv[4];
#pragma unroll
    for (int j = 0; j < 4; ++j) gv[j] = ((const f32x4*)g)[F.lane + 64 * j];
    for (int row = gw; row < M; row += NGW) {
        f32x4* xr = (f32x4*)(X + (size_t)row * D) + F.lane; f32x4 v[4]; float s = 0.f;
#pragma unroll
        for (int j = 0; j < 4; ++j) { v[j] = xr[64 * j]; s += (v[j].x * v[j].x + v[j].y * v[j].y) + (v[j].z * v[j].z + v[j].w * v[j].w); }
        const float rs = rsqrtf(wave_sum(s) * (1.f / D) + EPS);
#pragma unroll
        for (int j = 0; j < 4; ++j) xr[64 * j] = v[j] * rs * gv[j];
    }
}

template <class Epi> __device__ __forceinline__ void big_gemm(const Frame& F, const bf16* A, const bf16* WT, int N, int K, const Epi& E) {
    pg8::Gemm g{A, WT, MP, N, K}; pg8::StaticOrder S; S.init(MP, N, F.G, F.bx);
    pg8::gemm_phase<Epi, pg8::StaticOrder, true, true>(F.lds, g, S, E, F.tid);
}

__device__ __forceinline__ float bflo(unsigned u) { return __builtin_bit_cast(float, u << 16); }
__device__ __forceinline__ float bfhi(unsigned u) { return __builtin_bit_cast(float, u & 0xffff0000u); }
constexpr int VS_STRIDE = 264;
constexpr int SGU_RS_OFF = 128 * VS_STRIDE;
__device__ __forceinline__ void sgu_mix_phase(const Frame& F, const bf16* UV, const float* SV, const float* sg, const bf16* Wm, const float* bs, const float* wsf, bf16* Y, float* vs_out) {
    LAS unsigned char* Vs = F.lds; LAS float* RS = (LAS float*)(F.lds + SGU_RS_OFF); const int fr = F.lane & 15, fq = F.lane >> 4;
    { const int i = F.tid >> 7, u = F.vcu + 256 * i; if (u < 1024) RS[F.tid] = rs_v(SV, (u >> 3) * 128 + (F.tid & 127)); }
    __syncthreads();
    for (int ui = 0, u = F.vcu; u < 1024; u += F.G, ++ui) {
        const int g = u & 7, r0 = (u >> 3) * 128; const bf16* wg = Wm + (size_t)g * 128 * 128;
        v4u raw[4];
#pragma unroll
        for (int i = 0; i < 4; ++i) { const int id = F.tid + 512 * i, row = id >> 4, ch = id & 15; raw[i] = *(const GAS v4u*)((const GAS bf16*)UV + (size_t)(r0 + row) * 2048 + 1024 + g * 128 + ch * 8); }
        bf16x8 bfr[20]; { int q = 0;
#pragma unroll
            for (int n = 0; n < 8; ++n)
#pragma unroll
                for (int kk = 0; kk <= n / 2; ++kk) bfr[q++] = *(const GAS bf16x8*)((const GAS bf16*)wg + (size_t)(16 * n + fr) * 128 + 32 * kk + 8 * fq); }
        u32x2 uu[8]; float bb[8];
#pragma unroll
        for (int n = 0; n < 8; ++n) { const int t = 16 * n + fr; uu[n] = *(const GAS u32x2*)((const GAS bf16*)UV + (size_t)(r0 + t) * 2048 + g * 128 + 16 * F.wave + 4 * fq); bb[n] = bs[g * 128 + t]; }
        const f32x4 g4 = *(const f32x4*)(sg + g * 128 + 16 * F.wave + 4 * fq);
#pragma unroll
        for (int i = 0; i < 4; ++i) { const int id = F.tid + 512 * i, row = id >> 4, ch = id & 15;
            *(LAS u32x2*)(Vs + row * VS_STRIDE + ch * 16) = (u32x2){raw[i].x, raw[i].y}; *(LAS u32x2*)(Vs + row * VS_STRIDE + ch * 16 + 8) = (u32x2){raw[i].z, raw[i].w}; }
        __syncthreads();
        bf16x8 af[4];
#pragma unroll
        for (int kk = 0; kk < 4; ++kk) { float e[8];
#pragma unroll
            for (int j = 0; j < 8; ++j) { const int sr = 32 * kk + 8 * fq + j; e[j] = bf2f(*(const LAS unsigned short*)(Vs + sr * VS_STRIDE + (16 * F.wave + fr) * 2)) * RS[ui * 128 + sr]; }
            v4u p; p.x = cvt_pk_bf16(e[0], e[1]); p.y = cvt_pk_bf16(e[2], e[3]); p.z = cvt_pk_bf16(e[4], e[5]); p.w = cvt_pk_bf16(e[6], e[7]); af[kk] = __builtin_bit_cast(bf16x8, p); }
        f32x4 acc[8]; { int q = 0;
#pragma unroll
            for (int n = 0; n < 8; ++n) { acc[n] = (f32x4){0.f, 0.f, 0.f, 0.f};
#pragma unroll
                for (int kk = 0; kk <= n / 2; ++kk) acc[n] = __builtin_amdgcn_mfma_f32_16x16x32_bf16(af[kk], bfr[q++], acc[n], 0, 0, 0); } }
#pragma unroll
        for (int n = 0; n < 8; ++n) { const int t = 16 * n + fr, row = r0 + t, col = g * 128 + 16 * F.wave + 4 * fq;
            u32x2 w; w.x = cvt_pk_bf16(bflo(uu[n].x) * (acc[n][0] * g4.x + bb[n]), bfhi(uu[n].x) * (acc[n][1] * g4.y + bb[n])); w.y = cvt_pk_bf16(bflo(uu[n].y) * (acc[n][2] * g4.z + bb[n]), bfhi(uu[n].y) * (acc[n][3] * g4.w + bb[n]));
            *(u32x2*)(Y + (size_t)row * 1024 + col) = w; }
        __syncthreads();
    }
    for (int it = F.vcu * 512 + F.tid; it < 128 * 256; it += F.G * 512) {
        const int b = it >> 8, d = (it & 255) * 4, gh = d >> 7, rowb = MP + b * 4; const f32x4 gg = *(const f32x4*)(sg + d);
        float v[4][4], uu[4][4];
#pragma unroll
        for (int s = 0; s < 4; ++s) { const u32x2 rv = *(const u32x2*)(UV + (size_t)(rowb + s) * 2048 + 1024 + d), ru = *(const u32x2*)(UV + (size_t)(rowb + s) * 2048 + d); const float rs = rs_v(SV, rowb + s);
            v[s][0] = bflo(rv.x) * rs; v[s][1] = bfhi(rv.x) * rs; v[s][2] = bflo(rv.y) * rs; v[s][3] = bfhi(rv.y) * rs;
            uu[s][0] = bflo(ru.x); uu[s][1] = bfhi(ru.x); uu[s][2] = bflo(ru.y); uu[s][3] = bfhi(ru.y);
            *(f32x4*)(vs_out + (size_t)(b * 4 + s) * 1024 + d) = (f32x4){v[s][0] * gg.x, v[s][1] * gg.y, v[s][2] * gg.z, v[s][3] * gg.w}; }
#pragma unroll
        for (int t = 0; t < 4; ++t) { float m[4] = {0.f, 0.f, 0.f, 0.f};
#pragma unroll
            for (int s = 0; s <= t; ++s) { const float w = wsf[((size_t)gh * 128 + t) * 128 + s];
#pragma unroll
                for (int e = 0; e < 4; ++e) m[e] += w * v[s][e]; }
            const float bb = bs[gh * 128 + t];
            u32x2 w; w.x = cvt_pk_bf16(uu[t][0] * (m[0] * gg.x + bb), uu[t][1] * (m[1] * gg.y + bb)); w.y = cvt_pk_bf16(uu[t][2] * (m[2] * gg.z + bb), uu[t][3] * (m[3] * gg.w + bb));
            *(u32x2*)(Y + (size_t)(rowb + t) * 1024 + d) = w; }
    }
}
constexpr size_t RGT_W = 0, RGT_BA = 512 * 1024, RGT_BX = RGT_BA + 4096, RGT_NSP = RGT_BX + 4096;
__device__ __forceinline__ int rg_jch(int m, int r) { return 8 * (r >> 2) + 4 * (m & 1) + (r & 3) + 32 * (m >> 1); }
__device__ __forceinline__ void rglru_tables(const Frame& F, const float* wa, const float* wx, const float* ba, const float* bx, const float* lam, unsigned char* tab) {
    bf16* W = (bf16*)(tab + RGT_W);
    for (int i = F.vcu * 512 + F.tid; i < 16 * 2 * 4 * 2 * 64 * 8; i += F.G * 512) {
        const int e = i & 7, lane = (i >> 3) & 63, ks = (i >> 9) & 1, m = (i >> 10) & 3, type = (i >> 12) & 1, h = i >> 13, fr = lane & 15, fq = lane >> 4;
        const float* w = type ? wx : wa; const float v = w[((size_t)h * 64 + 32 * ks + 8 * fq + e) * 64 + rg_jch(m, fr)];
        W[i] = (bf16)(cvt_pk_bf16(v, 0.f) & 0xffffu);
    }
    for (int c = F.vcu * 512 + F.tid; c < 1024; c += F.G * 512) {
        ((float*)(tab + RGT_BA))[c] = ba[c]; ((float*)(tab + RGT_BX))[c] = bx[c]; ((float*)(tab + RGT_NSP))[c] = -8.0f * log1pf(expf(-lam[c]));
    }
}
template <int CTRL> __device__ __forceinline__ float dpp_f(float old, float src) {
    return __builtin_bit_cast(float, __builtin_amdgcn_update_dpp(__builtin_bit_cast(int, old), __builtin_bit_cast(int, src), CTRL, 0xf, 0xf, false)); }
template <int CTRL> __device__ __forceinline__ float dpp_z(float src) {
    return __builtin_bit_cast(float, __builtin_amdgcn_update_dpp(0, __builtin_bit_cast(int, src), CTRL, 0xf, 0xf, true)); }
constexpr int RG_XC_STRIDE = 68, RG_XC_BYTES = 128 * RG_XC_STRIDE * 4, RG_TOT_OFF = 2 * RG_XC_BYTES, RG_CARRY_OFF = RG_TOT_OFF + 2 * 2 * 8 * 64 * 4, RG_AF_OFF = RG_CARRY_OFF + 512;
template <int D_, bool SAMPLE, int NCH> __device__ __forceinline__ void ks_step(float (&a)[NCH], float (&b)[NCH], int tt) {
#pragma unroll
    for (int i = 0; i < NCH; ++i) {
        float as = dpp_f<0x110 + D_>(1.0f, a[i]), bs = dpp_z<0x110 + D_>(b[i]);
        if (SAMPLE) { const bool ok = tt >= D_; as = ok ? as : 1.0f; bs = ok ? bs : 0.0f; }
        b[i] = a[i] * bs + b[i]; a[i] = a[i] * as;
    }
}
template <bool SAMPLE>
__device__ __forceinline__ void rglru_unit(const Frame& F, int unit, const float* XB, const bf16* G, bf16* Y, const float* cw, const float* cb, const unsigned char* tab,
                                           const float* cstate, const float* hstate, float* conv_out, float* h_out) {
    constexpr int NCH = SAMPLE ? 16 : 8, NM = NCH / 4, CW = SAMPLE ? 64 : 32;
    const int fr = F.lane & 15, fq = F.lane >> 4, w = F.wave;
    int h, b0, rowbase, nchunk, mh;
    if (SAMPLE) { h = unit >> 2; b0 = (unit & 3) * 32; rowbase = MP + b0 * 4; nchunk = 1; mh = 0; }
    else { b0 = unit >> 5; h = (unit >> 1) & 15; mh = unit & 1; rowbase = b0 * 2048; nchunk = 16; }
    LAS float* XC = (LAS float*)F.lds; LAS float* TOT = (LAS float*)(F.lds + RG_TOT_OFF); LAS float* CARRY = (LAS float*)(F.lds + RG_CARRY_OFF);
    const int chq = F.tid & 15, rg = F.tid >> 4, cA = h * 64 + 4 * chq;
    f32x4 nx[7];
    auto loadA = [&](int c) {
#pragma unroll
        for (int i = 0; i < 7; ++i) {
            if (SAMPLE) nx[i] = i < 3 ? *(const GAS f32x4*)((const GAS float*)cstate + ((size_t)(b0 + rg) * 3 + i) * 1024 + cA) : *(const GAS f32x4*)((const GAS float*)XB + (size_t)(rowbase + rg * 4 + i - 3) * 1024 + cA);
            else { const int tau = c * 128 + 4 * rg + i - 3; nx[i] = tau >= 0 ? *(const GAS f32x4*)((const GAS float*)XB + (size_t)(rowbase + tau) * 1024 + cA) : (f32x4){0.f, 0.f, 0.f, 0.f}; } } };
    loadA(0);
    { const v4u* src = (const v4u*)((const bf16*)(tab + RGT_W) + (size_t)h * 16 * 64 * 8); LAS v4u* dst = (LAS v4u*)(F.lds + RG_AF_OFF);
      dst[F.tid] = src[F.tid]; dst[F.tid + 512] = src[F.tid + 512]; }
    const LAS bf16x8* AfL = (const LAS bf16x8*)(F.lds + RG_AF_OFF) + F.lane;
    const int chl = h * 64 + 32 * mh + 8 * fq;
    for (int c = 0; c < nchunk; ++c) {
        const int buf = c & 1, c0 = c * 128;
        const float* cw_ = cw; const float* cb_ = cb; asm volatile("" : "+s"(cw_)); asm volatile("" : "+s"(cb_));
        { f32x4 cwv[4];
#pragma unroll
          for (int k = 0; k < 4; ++k) cwv[k] = *(const f32x4*)(cw_ + k * 1024 + cA);
          const f32x4 cbv = *(const f32x4*)(cb_ + cA);
#pragma unroll
          for (int i = 0; i < 4; ++i) { f32x4 acc = cbv;
#pragma unroll
              for (int k = 0; k < 4; ++k) acc = acc + cwv[k] * nx[i + k];
              *(LAS f32x4*)(XC + (size_t)buf * (128 * RG_XC_STRIDE) + (4 * rg + i) * RG_XC_STRIDE + 4 * chq) = acc; } }
        if (c + 1 < nchunk) loadA(c + 1);
        const int trow = 16 * w + fr;
        const size_t o0 = ((size_t)rowbase + c0 + trow) * 1024 + (SAMPLE ? h * 64 + 8 * fq : chl);
        const v4u g0 = *(const GAS v4u*)((const GAS bf16*)G + o0); v4u g1 = g0; if (SAMPLE) g1 = *(const GAS v4u*)((const GAS bf16*)G + o0 + 32);
        __syncthreads();
        float xc[16];
        { const LAS float* xp = XC + (size_t)buf * (128 * RG_XC_STRIDE) + trow * RG_XC_STRIDE + 8 * fq;
          const f32x4 x0 = *(const LAS f32x4*)(xp), x1 = *(const LAS f32x4*)(xp + 4), x2 = *(const LAS f32x4*)(xp + 32), x3 = *(const LAS f32x4*)(xp + 36);
          xc[0] = x0.x; xc[1] = x0.y; xc[2] = x0.z; xc[3] = x0.w; xc[4] = x1.x; xc[5] = x1.y; xc[6] = x1.z; xc[7] = x1.w;
          xc[8] = x2.x; xc[9] = x2.y; xc[10] = x2.z; xc[11] = x2.w; xc[12] = x3.x; xc[13] = x3.y; xc[14] = x3.z; xc[15] = x3.w; }
        bf16x8 bf0, bf1;
        { v4u p0, p1; p0.x = cvt_pk_bf16(xc[0], xc[1]); p0.y = cvt_pk_bf16(xc[2], xc[3]); p0.z = cvt_pk_bf16(xc[4], xc[5]); p0.w = cvt_pk_bf16(xc[6], xc[7]);
          p1.x = cvt_pk_bf16(xc[8], xc[9]); p1.y = cvt_pk_bf16(xc[10], xc[11]); p1.z = cvt_pk_bf16(xc[12], xc[13]); p1.w = cvt_pk_bf16(xc[14], xc[15]);
          bf0 = __builtin_bit_cast(bf16x8, p0); bf1 = __builtin_bit_cast(bf16x8, p1); }
        float av[NCH], bv[NCH];
#pragma unroll
        for (int mm = 0; mm < NM; ++mm) { const int m = SAMPLE ? mm : 2 * mh + mm;
            f32x4 ra = (f32x4){0.f, 0.f, 0.f, 0.f}, rx = ra;
            ra = __builtin_amdgcn_mfma_f32_16x16x32_bf16(AfL[((0 * 4 + m) * 2 + 0) * 64], bf0, ra, 0, 0, 0); ra = __builtin_amdgcn_mfma_f32_16x16x32_bf16(AfL[((0 * 4 + m) * 2 + 1) * 64], bf1, ra, 0, 0, 0);
            rx = __builtin_amdgcn_mfma_f32_16x16x32_bf16(AfL[((1 * 4 + m) * 2 + 0) * 64], bf0, rx, 0, 0, 0); rx = __builtin_amdgcn_mfma_f32_16x16x32_bf16(AfL[((1 * 4 + m) * 2 + 1) * 64], bf1, rx, 0, 0, 0);
            const int cg = h * 64 + 8 * fq + 4 * (m & 1) + 32 * (m >> 1);
            const f32x4 ba4 = *(const f32x4*)((const float*)(tab + RGT_BA) + cg), bx4 = *(const f32x4*)((const float*)(tab + RGT_BX) + cg), ns4 = *(const f32x4*)((const float*)(tab + RGT_NSP) + cg);
#pragma unroll
            for (int r = 0; r < 4; ++r) { const float rg_ = sigmoid_fast(ra[r] + ba4[r]), ig = sigmoid_fast(rx[r] + bx4[r]);
                const float la = ns4[r] * rg_, a = __builtin_amdgcn_exp2f(1.4426950408889634f * la), mult = __builtin_amdgcn_sqrtf(fmaxf(1.f - a * a, 0.f));
                const float xcv = SAMPLE ? xc[4 * mm + r] : (mh ? xc[8 + 4 * mm + r] : xc[4 * mm + r]);
                av[4 * mm + r] = a; bv[4 * mm + r] = mult * ig * xcv; }
        }
        const int tt = fr & 3;
        if (SAMPLE) {
            const int bi = (16 * w + fr) >> 2;
#pragma unroll
            for (int m = 0; m < 4; ++m) { const int cg = h * 64 + 8 * fq + 4 * (m & 1) + 32 * (m >> 1); const f32x4 h0 = *(const f32x4*)(hstate + (size_t)(b0 + bi) * 1024 + cg);
#pragma unroll
                for (int r = 0; r < 4; ++r) if (tt == 0) bv[4 * m + r] += av[4 * m + r] * h0[r]; }
            ks_step<1, true, NCH>(av, bv, tt); ks_step<2, true, NCH>(av, bv, tt);
        } else {
            ks_step<1, false, NCH>(av, bv, tt); ks_step<2, false, NCH>(av, bv, tt); ks_step<4, false, NCH>(av, bv, tt); ks_step<8, false, NCH>(av, bv, tt);
            if (fr == 15) { LAS float* ta = TOT + ((size_t)(buf * 2 + 0) * 8 + w) * 64 + fq * NCH; LAS float* th = TOT + ((size_t)(buf * 2 + 1) * 8 + w) * 64 + fq * NCH;
#pragma unroll
                for (int i = 0; i < NCH; i += 4) { *(LAS f32x4*)(ta + i) = (f32x4){av[i], av[i + 1], av[i + 2], av[i + 3]}; *(LAS f32x4*)(th + i) = (f32x4){bv[i], bv[i + 1], bv[i + 2], bv[i + 3]}; } }
            __syncthreads();
            float ch[NCH];
            if (c == 0) {
#pragma unroll
                for (int i = 0; i < NCH; ++i) ch[i] = 0.f;
            } else {
#pragma unroll
                for (int i = 0; i < NCH; i += 4) { const f32x4 t = *(const LAS f32x4*)(CARRY + buf * 64 + fq * NCH + i); ch[i] = t.x; ch[i + 1] = t.y; ch[i + 2] = t.z; ch[i + 3] = t.w; }
            }
            for (int v = 0; v < w; ++v) { const LAS float* ta = TOT + ((size_t)(buf * 2 + 0) * 8 + v) * 64 + fq * NCH; const LAS float* th = TOT + ((size_t)(buf * 2 + 1) * 8 + v) * 64 + fq * NCH;
#pragma unroll
                for (int i = 0; i < NCH; i += 4) { const f32x4 A4 = *(const LAS f32x4*)(ta + i), H4 = *(const LAS f32x4*)(th + i);
                    ch[i] = A4.x * ch[i] + H4.x; ch[i + 1] = A4.y * ch[i + 1] + H4.y; ch[i + 2] = A4.z * ch[i + 2] + H4.z; ch[i + 3] = A4.w * ch[i + 3] + H4.w; } }
#pragma unroll
            for (int i = 0; i < NCH; ++i) bv[i] = bv[i] + av[i] * ch[i];
            if (w == 7 && fr == 15) {
#pragma unroll
                for (int i = 0; i < NCH; i += 4) *(LAS f32x4*)(CARRY + (buf ^ 1) * 64 + fq * NCH + i) = (f32x4){bv[i], bv[i + 1], bv[i + 2], bv[i + 3]}; }
        }
        { v4u y0;
          y0.x = cvt_pk_bf16(bv[0] * bflo(g0.x), bv[1] * bfhi(g0.x)); y0.y = cvt_pk_bf16(bv[2] * bflo(g0.y), bv[3] * bfhi(g0.y)); y0.z = cvt_pk_bf16(bv[4] * bflo(g0.z), bv[5] * bfhi(g0.z)); y0.w = cvt_pk_bf16(bv[6] * bflo(g0.w), bv[7] * bfhi(g0.w));
          *(v4u*)(Y + o0) = y0;
          if constexpr (SAMPLE) { v4u y1;
            y1.x = cvt_pk_bf16(bv[8] * bflo(g1.x), bv[9] * bfhi(g1.x)); y1.y = cvt_pk_bf16(bv[10] * bflo(g1.y), bv[11] * bfhi(g1.y)); y1.z = cvt_pk_bf16(bv[12] * bflo(g1.z), bv[13] * bfhi(g1.z)); y1.w = cvt_pk_bf16(bv[14] * bflo(g1.w), bv[15] * bfhi(g1.w));
            *(v4u*)(Y + o0 + 32) = y1; } }
        if constexpr (SAMPLE) {
            if (tt == 3) { const int bi = (16 * w + fr) >> 2; float* ho = h_out + (size_t)(b0 + bi) * 1024 + h * 64 + 8 * fq;
                *(f32x4*)(ho) = (f32x4){bv[0], bv[1], bv[2], bv[3]}; *(f32x4*)(ho + 4) = (f32x4){bv[4], bv[5], bv[6], bv[7]};
                *(f32x4*)(ho + 32) = (f32x4){bv[8], bv[9], bv[10], bv[11]}; *(f32x4*)(ho + 36) = (f32x4){bv[12], bv[13], bv[14], bv[15]}; }
        } else if (c == nchunk - 1 && w == 7 && fr == 15) { float* ho = h_out + (size_t)b0 * 1024 + chl;
            *(f32x4*)(ho) = (f32x4){bv[0], bv[1], bv[2], bv[3]}; *(f32x4*)(ho + 4) = (f32x4){bv[4], bv[5], bv[6], bv[7]}; }
    }
    if (SAMPLE) { for (int i = F.tid; i < 32 * 3 * 64; i += 512) { const int cc = i & 63, r = (i >> 6) % 3, bi = i / 192;
            conv_out[((size_t)(b0 + bi) * 3 + r) * 1024 + h * 64 + cc] = XB[(size_t)(rowbase + bi * 4 + 1 + r) * 1024 + h * 64 + cc]; } }
    else if (mh == 0 && F.tid < 192) { const int cc = F.tid & 63, r = F.tid >> 6; conv_out[((size_t)b0 * 3 + r) * 1024 + h * 64 + cc] = XB[(size_t)(rowbase + 2045 + r) * 1024 + h * 64 + cc]; }
    __syncthreads();
}
__device__ __forceinline__ void rglru_phase(const Frame& F, const float* XB, const bf16* G, bf16* Y, const float* cw, const float* cb, const unsigned char* tab, const float* cstate, const float* hstate, float* out) {
    for (int unit = F.vcu; unit < 320; unit += F.G) {
        if (unit < 256) rglru_unit<false>(F, unit, XB, G, Y, cw, cb, tab, nullptr, nullptr, out + O_CONVP, out + O_HP);
        else rglru_unit<true>(F, unit - 256, XB, G, Y, cw, cb, tab, cstate, hstate, out + O_CONVS, out + O_HS);
    }
}
typedef float f32x16 __attribute__((ext_vector_type(16)));
typedef float f32x2 __attribute__((ext_vector_type(2)));
constexpr size_t S5T_AP = 0, S5T_BF = 128 * 1024, S5T_CF = S5T_BF + 256 * 1024;
__device__ __forceinline__ void s5_disc(const float* lre, const float* lim, const float* ldt, int g, int p, float& ar, float& ai, float& qr, float& qi) {
    const float dt = expf(ldt[g]), lr = lre[g * 64 + p], li = lim[g * 64 + p], mag = expf(lr * dt); ar = mag * cosf(li * dt); ai = mag * sinf(li * dt);
    const float zr = ar - 1.f, zi = ai, den = lr * lr + li * li; qr = (zr * lr + zi * li) / den; qi = (zi * lr - zr * li) / den;
}
__device__ __forceinline__ void s5_tables(const Frame& F, const float* lre, const float* lim, const float* ldt, const float* bre, const float* bim, const float* cre, const float* cim, unsigned char* tab) {
    for (int i = F.vcu * 512 + F.tid; i < 4096; i += F.G * 512) { float ar, ai, qr, qi; s5_disc(lre, lim, ldt, i >> 6, i & 63, ar, ai, qr, qi);
        float* o = (float*)(tab + S5T_AP) + (size_t)i * 8; o[0] = ar; o[1] = ai;
        const float r2 = ar * ar - ai * ai, i2 = 2.f * ar * ai; o[2] = r2; o[3] = i2; const float r3 = r2 * ar - i2 * ai, i3 = r2 * ai + i2 * ar; o[4] = r3; o[5] = i3; o[6] = r2 * r2 - i2 * i2; o[7] = 2.f * r2 * i2; }
    for (int i = F.vcu * 512 + F.tid; i < 64 * 2 * 2 * 64 * 8; i += F.G * 512) {
        const int j = i & 7, lane = (i >> 3) & 63, c = (i >> 9) & 1, ws = (i >> 10) & 1, g = i >> 11, p = 32 * ws + (lane & 31), h = 8 * (lane >> 5) + j;
        float ar, ai, qr, qi; s5_disc(lre, lim, ldt, g, p, ar, ai, qr, qi);
        const float br = bre[((size_t)g * 64 + p) * 16 + h], bi = bim[((size_t)g * 64 + p) * 16 + h]; const float v = c ? (qr * bi + qi * br) : (qr * br - qi * bi);
        ((bf16*)(tab + S5T_BF))[i] = (bf16)(cvt_pk_bf16(v, 0.f) & 0xffffu);
    }
    for (int i = F.vcu * 512 + F.tid; i < 64 * 4 * 64 * 8; i += F.G * 512) {
        const int j = i & 7, lane = (i >> 3) & 63, kk = (i >> 9) & 3, g = i >> 11, h = lane & 15, k = 32 * kk + 8 * (lane >> 4) + j, p = k >> 1;
        const float v = (k & 1) ? -cim[((size_t)g * 16 + h) * 64 + p] : cre[((size_t)g * 16 + h) * 64 + p];
        ((bf16*)(tab + S5T_CF))[i] = (bf16)(cvt_pk_bf16(v, 0.f) & 0xffffu);
    }
}
constexpr int S5_XT_STRIDE = 272;
constexpr int S5_XT_UNIT = 128 * S5_XT_STRIDE;
__device__ __forceinline__ f32x2 cmadd(f32x2 a, f32x2 x, f32x2 c) {
    c = (f32x2){a.x, a.x} * x + c; return (f32x2){-a.y, a.y} * __builtin_shufflevector(x, x, 1, 0) + c; }
template <bool SAMPLE>
__device__ __forceinline__ void s5_pass(const Frame& F, int upair, const float* U, bf16* Gs, const float* dsk, const unsigned char* tab, const float* sre, const float* sim, float* ore, float* oim) {
    const int w = F.wave, l31 = F.lane & 31, hh = F.lane >> 5, fr = F.lane & 15, fq = F.lane >> 4;
    constexpr int NTILE = SAMPLE ? 1 : 4, NCHUNK = SAMPLE ? 1 : 16, CROWS = SAMPLE ? 32 : 128;
    LAS unsigned char* XT = F.lds;
    const int su = (w >> 1) & 1, ws = w & 1, sunit = upair * 2 + su;
    int sg, srow, sb0; if (SAMPLE) { sg = sunit >> 4; sb0 = (sunit & 15) * 8; srow = MP + sb0 * 4; } else { sb0 = sunit >> 6; sg = sunit & 63; srow = sb0 * 2048; }
    const int pw = SAMPLE ? ((w >> 1) & 1) : (w >> 2), punit = upair * 2 + pw;
    int pg, prow; if (SAMPLE) { pg = punit >> 4; prow = MP + (punit & 15) * 32; } else { pg = punit & 63; prow = (punit >> 6) * 2048; }
    bf16x8 Cf[4];
#pragma unroll
    for (int kk = 0; kk < 4; ++kk) Cf[kk] = *(const bf16x8*)((const bf16*)(tab + S5T_CF) + (((size_t)pg * 4 + kk) * 64 + F.lane) * 8);
    const f32x4 d4 = *(const f32x4*)(dsk + pg * 16 + 4 * fq);
    f32x2 A1, A2, A3, A4, X = (f32x2){0.f, 0.f}; bf16x8 Bf0, Bf1; f32x4 ua[NTILE][2];
    if (w < 4) {
        const f32x4* a4 = (const f32x4*)((const float*)(tab + S5T_AP) + ((size_t)sg * 64 + 32 * ws + l31) * 8); const f32x4 lo = a4[0], hi = a4[1];
        A1 = (f32x2){lo.x, lo.y}; A2 = (f32x2){lo.z, lo.w}; A3 = (f32x2){hi.x, hi.y}; A4 = (f32x2){hi.z, hi.w};
        Bf0 = *(const bf16x8*)((const bf16*)(tab + S5T_BF) + ((((size_t)sg * 2 + ws) * 2 + 0) * 64 + F.lane) * 8);
        Bf1 = *(const bf16x8*)((const bf16*)(tab + S5T_BF) + ((((size_t)sg * 2 + ws) * 2 + 1) * 64 + F.lane) * 8);
#pragma unroll
        for (int tl = 0; tl < NTILE; ++tl) { const GAS float* up = (const GAS float*)U + ((size_t)srow + tl * 32 + l31) * 1024 + sg * 16 + 8 * hh; ua[tl][0] = *(const GAS f32x4*)up; ua[tl][1] = *(const GAS f32x4*)(up + 4); }
    }
    for (int c = 0; c < NCHUNK; ++c) {
        f32x4 up4[2];
#pragma unroll
        for (int q2 = 0; q2 < (SAMPLE ? 1 : 2); ++q2) { const int st = SAMPLE ? (w & 1) : ((w & 3) * 2 + q2);
            up4[q2] = *(const GAS f32x4*)((const GAS float*)U + ((size_t)prow + c * 128 + st * 16 + fr) * 1024 + pg * 16 + 4 * fq); }
        if (w < 4) {
#pragma unroll
            for (int tl = 0; tl < NTILE; ++tl) {
                v4u aw; aw.x = cvt_pk_bf16(ua[tl][0].x, ua[tl][0].y); aw.y = cvt_pk_bf16(ua[tl][0].z, ua[tl][0].w); aw.z = cvt_pk_bf16(ua[tl][1].x, ua[tl][1].y); aw.w = cvt_pk_bf16(ua[tl][1].z, ua[tl][1].w);
                const bf16x8 Au = __builtin_bit_cast(bf16x8, aw); f32x16 z16;
#pragma unroll
                for (int i = 0; i < 16; ++i) z16[i] = 0.f;
                const f32x16 bur = __builtin_amdgcn_mfma_f32_32x32x16_bf16(Au, Bf0, z16, 0, 0, 0), bui = __builtin_amdgcn_mfma_f32_32x32x16_bf16(Au, Bf1, z16, 0, 0, 0);
                f32x2 x[16];
#pragma unroll
                for (int k = 0; k < 4; ++k) { f32x2 s = (f32x2){0.f, 0.f};
                    if (SAMPLE) { const size_t so = ((size_t)(sb0 + 2 * k + hh) * 64 + sg) * 64 + 32 * ws + l31; s = (f32x2){sre[so], sim[so]}; }
#pragma unroll
                    for (int i = 0; i < 4; ++i) { s = cmadd(A1, s, (f32x2){bur[4 * k + i], bui[4 * k + i]}); x[4 * k + i] = s; } }
                if (!SAMPLE) {
                    f32x2 xin[4];
#pragma unroll
                    for (int k = 0; k < 4; ++k) {
                        const f32x2 own = x[4 * k + 3], oth = (f32x2){__shfl_xor(own.x, 32), __shfl_xor(own.y, 32)};
                        const f32x2 L0 = hh ? oth : own, L1 = hh ? own : oth;
                        const f32x2 X0 = X; const f32x2 X1 = cmadd(A4, X0, L0); X = cmadd(A4, X1, L1);
                        xin[k] = hh ? X1 : X0; }
#pragma unroll
                    for (int k = 0; k < 4; ++k) { x[4 * k + 0] = cmadd(A1, xin[k], x[4 * k + 0]); x[4 * k + 1] = cmadd(A2, xin[k], x[4 * k + 1]); x[4 * k + 2] = cmadd(A3, xin[k], x[4 * k + 2]); x[4 * k + 3] = cmadd(A4, xin[k], x[4 * k + 3]); }
                }
                LAS unsigned char* xt = XT + su * S5_XT_UNIT + (32 * ws + l31) * 4;
#pragma unroll
                for (int r = 0; r < 16; ++r) *(LAS unsigned*)(xt + (tl * 32 + 8 * (r >> 2) + 4 * hh + (r & 3)) * S5_XT_STRIDE) = cvt_pk_bf16(x[r].x, x[r].y);
                if (SAMPLE) {
#pragma unroll
                    for (int k = 0; k < 4; ++k) { const size_t so = ((size_t)(sb0 + 2 * k + hh) * 64 + sg) * 64 + 32 * ws + l31; ore[so] = x[4 * k + 3].x; oim[so] = x[4 * k + 3].y; } }
            }
            if (!SAMPLE && c + 1 < NCHUNK) {
#pragma unroll
                for (int tl = 0; tl < NTILE; ++tl) { const GAS float* up = (const GAS float*)U + ((size_t)srow + (c + 1) * 128 + tl * 32 + l31) * 1024 + sg * 16 + 8 * hh; ua[tl][0] = *(const GAS f32x4*)up; ua[tl][1] = *(const GAS f32x4*)(up + 4); } }
        }
        __syncthreads();
        if (!SAMPLE || w < 4) {
#pragma unroll
            for (int q2 = 0; q2 < (SAMPLE ? 1 : 2); ++q2) { const int st = SAMPLE ? (w & 1) : ((w & 3) * 2 + q2);
                const size_t row = (size_t)prow + c * 128 + st * 16 + fr; const int ch = pg * 16 + 4 * fq;
                const f32x4 u4 = up4[q2];
                const LAS unsigned char* xr = XT + pw * S5_XT_UNIT + (st * 16 + fr) * S5_XT_STRIDE + 16 * fq; f32x4 y = (f32x4){0.f, 0.f, 0.f, 0.f};
#pragma unroll
                for (int kk = 0; kk < 4; ++kk) y = __builtin_amdgcn_mfma_f32_16x16x32_bf16(Cf[kk], *(const LAS bf16x8*)(xr + 64 * kk), y, 0, 0, 0);
                y = y + d4 * u4;
                u32x2 o; o.x = cvt_pk_bf16(gelu_fast(y.x), gelu_fast(y.y)); o.y = cvt_pk_bf16(gelu_fast(y.z), gelu_fast(y.w)); *(u32x2*)(Gs + row * 1024 + ch) = o; }
        }
        __syncthreads();
    }
    if (!SAMPLE && w < 4 && hh == 0) { const size_t so = ((size_t)sb0 * 64 + sg) * 64 + 32 * ws + l31; ore[so] = X.x; oim[so] = X.y; }
}
__device__ __forceinline__ void s5_phase(const Frame& F, const float* U, bf16* Gs, const float* dsk, const unsigned char* tab, const float* sre, const float* sim, float* out) {
    for (int u0 = F.vcu; u0 < 256; u0 += F.G) s5_pass<false>(F, u0, U, Gs, dsk, tab, nullptr, nullptr, out + O_SREP, out + O_SIMP);
    for (int u0 = F.vcu; u0 < 512; u0 += F.G) s5_pass<true>(F, u0, U, Gs, dsk, tab, sre, sim, out + O_SRES, out + O_SIMS);
}
constexpr int PH_FINAL = 21, PH_END = 22;
enum { ST_GIN = 0, ST_MIX = 1, ST_GOUT = 2, ST_FF1 = 3, ST_FF2 = 4 };
constexpr size_t WS_SX0 = 172 * MiB, WS_SX1 = 175 * MiB, WS_SV = 178 * MiB;
constexpr size_t T_Y = 99 * MiB;

__global__ void __launch_bounds__(NWAVES * 64, 2) mk(Args a) {
    extern __shared__ __attribute__((aligned(16))) unsigned char lds_raw[];
    Frame F; F.lds = (LAS unsigned char*)lds_raw; F.tid = threadIdx.x; F.lane = F.tid & 63; F.wave = __builtin_amdgcn_readfirstlane(F.tid >> 6);
    F.G = gridDim.x; F.bx = blockIdx.x; F.vcu = (F.bx % 8) * (F.G / 8) + F.bx / 8;
    volatile LAS unsigned* MISC = (volatile LAS unsigned*)(F.lds + MISC_OFF);
    for (int u = F.tid; u < (LDS_BYTES - LDSCTL_OFF) / 4; u += NWAVES * 64) ((LAS unsigned*)(F.lds + LDSCTL_OFF))[u] = 0u;
    __syncthreads();
    if (F.tid == 0) { LAS unsigned long long* pt = (LAS unsigned long long*)(F.lds + PTAB_OFF);
#pragma unroll
        for (int i = 0; i < 35; ++i) pt[i] = (unsigned long long)a.in[i]; }
    __syncthreads();
    const bool multi = (a.ph_hi - a.ph_lo) > 1;
    XcdBarrier bar; bar.bar = (unsigned*)(a.ws + WS_CTL) + CW_BAR; bar.x = 0; bar.st = nullptr;
    if (multi) bar = xcd_barrier_post((unsigned*)(a.ws + WS_CTL) + CW_BAR, MISC + 8);

#ifndef DUP_CLS
#define DUP_CLS -1
#endif
    for (int ph = a.ph_lo, rep_ = 0; ph < a.ph_hi; ) {
        { int t_ = threadIdx.x, b_ = blockIdx.x; asm volatile("" : "+v"(t_)); asm volatile("" : "+s"(b_));
          F.tid = t_; F.lane = t_ & 63; F.wave = __builtin_amdgcn_readfirstlane(t_ >> 6); F.bx = b_; F.vcu = (b_ % 8) * (F.G / 8) + b_ / 8; }
        unsigned char* ws = a.ws; float* X = a.out; asm volatile("" : "+s"(ws)); asm volatile("" : "+s"(X));
        bf16* XB16 = (bf16*)(ws + WS_XN); unsigned char* T = ws + WS_T; bf16* Y = (bf16*)(T + T_Y);
        float* SX0 = (float*)(ws + WS_SX0); float* SX1 = (float*)(ws + WS_SX1); float* SV = (float*)(ws + WS_SV);
        if (ph == 0) {
            prologue_rows(F, inp(F, 0), inp(F, 1), XB16, SX0);
            { const float* wsf = inp(F, 13); bf16* wm = (bf16*)(ws + WS_WM);
              for (int i = F.vcu * 512 + F.tid; i < 2 * 8 * 128 * 128; i += F.G * 512) { const int s_ = i & 127, t_ = (i >> 7) & 127; wm[i] = s_ <= t_ ? (bf16)(cvt_pk_bf16(wsf[i], 0.f) & 0xffffu) : (bf16)0; } }
            s5_tables(F, inp(F, 26), inp(F, 27), inp(F, 28), inp(F, 29), inp(F, 30), inp(F, 31), inp(F, 32), ws + WS_S5T);
            rglru_tables(F, inp(F, 19), inp(F, 21), inp(F, 20), inp(F, 22), inp(F, 23), ws + WS_RGT);
            const int gw = F.vcu * NWAVES + F.wave, NGW = F.G * NWAVES; const float* gm = inp(F, 6);
            for (int it0 = gw; it0 < 6144; it0 += NGW) { int it = it0;
                if (conv_job(F, it, inp(F, 11), D, 2048, (bf16*)(ws + WS_W_INA), false, gm)) continue;
                if (conv_job(F, it, inp(F, 11) + (size_t)D * 2048, D, 2048, (bf16*)(ws + WS_W_INA + 4 * MiB), false, gm + 3 * D)) continue;
                if (conv_job(F, it, inp(F, 15), D, D, (bf16*)(ws + WS_W_OUTA), false, nullptr)) continue;
                if (conv_job(F, it, inp(F, 15) + (size_t)D * D, D, D, (bf16*)(ws + WS_W_OUTA + 2 * MiB), false, nullptr)) continue;
                if (conv_job(F, it, inp(F, 16), D, 2048, (bf16*)(ws + WS_W_INB), false, gm + D)) continue;
                if (conv_job(F, it, inp(F, 24), D, D, (bf16*)(ws + WS_W_OUTB), false, nullptr)) continue;
                if (conv_job(F, it, inp(F, 25), D, D, (bf16*)(ws + WS_W_INC), false, gm + 2 * D)) continue;
                conv_job(F, it, inp(F, 34), D, 2048, (bf16*)(ws + WS_W_GLU), true, nullptr);
            }
        } else if (ph == PH_FINAL) {
            norm_final(F, X, inp(F, 8));
        } else {
            const int l = (ph - 1) / 5, st = (ph - 1) % 5, kind = l % 3, j = l / 3;
            if (st == ST_GIN) {
                if (kind == 0) { const bf16* W = (const bf16*)(ws + WS_W_INA + (size_t)j * 4 * MiB); EpiRow8<FAct<ACT_GELU, true>> E{{(bf16*)T, 2048, SX0, 16, SV}};
                    big_gemm(F, XB16, W, 2048, D, E); small_gemm<4, 8, false, 4>(F, XB16, W, D, E.f); }
                else if (kind == 1) { const bf16* W = (const bf16*)(ws + WS_W_INB); EpiRow8<FRglru> E{{(bf16*)T, (float*)(T + 33 * MiB), SX0}};
                    big_gemm(F, XB16, W, 2048, D, E); small_gemm<4, 8, false, 4>(F, XB16, W, D, E.f); }
                else { const bf16* W = (const bf16*)(ws + WS_W_INC); EpiRow8<FF32> E{{(float*)T, D, SX0}};
                    big_gemm(F, XB16, W, D, D, E); small_gemm<2, 8, false, 4>(F, XB16, W, D, E.f); }
            } else if (st == ST_MIX) {
                if (kind == 0) sgu_mix_phase(F, (const bf16*)T, SV, inp(F, 12) + j * 1024, (const bf16*)(ws + WS_WM) + (size_t)j * 8 * 128 * 128, inp(F, 14) + j * 8 * 128, inp(F, 13) + (size_t)j * 8 * 128 * 128, Y, X + O_VS + (size_t)j * MS * 1024);
                else if (kind == 1) rglru_phase(F, (const float*)(T + 33 * MiB), (const bf16*)T, Y, inp(F, 17), inp(F, 18), ws + WS_RGT, inp(F, 2), inp(F, 3), X);
                else s5_phase(F, (const float*)T, Y, inp(F, 33), ws + WS_S5T, inp(F, 4), inp(F, 5), X);
                __syncthreads();
                ffn_conv(F, l, inp(F, 9), inp(F, 10), inp(F, 7), ws);
            } else if (st == ST_GOUT) {
                if (kind == 2) { const bf16* W = (const bf16*)(ws + WS_W_GLU); EpiPair8<FGlu> E{{X, XB16, SX1}};
                    big_gemm(F, Y, W, 2048, D, E); small_gemm<4, 8, true, 4>(F, Y, W, D, E.f); }
                else { const bf16* W = kind == 0 ? (const bf16*)(ws + WS_W_OUTA + (size_t)j * 2 * MiB) : (const bf16*)(ws + WS_W_OUTB); const float* xrp = l == 0 ? inp(F, 0) : X; const float* xrs = l == 0 ? inp(F, 1) - (size_t)MP * D : X;
                    EpiResid8<FResid> E{{X, XB16, SX1, xrp, xrs}};
                    big_gemm(F, Y, W, D, D, E); small_gemm<2, 8, false, 4>(F, Y, W, D, E.f); }
            } else if (st == ST_FF1) {
                const bf16* W = (const bf16*)(ws + WS_W_FF1); EpiRow8<FAct<ACT_SQRELU, false>> E{{(bf16*)T, FF, SX1, kind == 2 ? 32 : 16, nullptr}};
                big_gemm(F, XB16, W, FF, D, E); small_gemm<8, 4, false, 4>(F, XB16, W, D, E.f);
            } else {
                const bf16* W = (const bf16*)(ws + WS_W_FF2); EpiResid8<FResid> E{{X, XB16, SX0, X, X}};
                big_gemm(F, (const bf16*)T, W, D, FF, E); small_gemm<2, 8, false, 4>(F, (const bf16*)T, W, FF, E.f);
            }
        }
        { int reps_ = 1;
          if (ph > 0 && ph < PH_FINAL) { const int st_ = (ph - 1) % 5;
              if (DUP_CLS == 1 && st_ == ST_GIN) reps_ = 2;
              if (DUP_CLS == 2 && st_ == ST_MIX) reps_ = 2;
              if (DUP_CLS >= 20 && DUP_CLS <= 22 && st_ == ST_MIX && (((ph - 1) / 5) % 3) == DUP_CLS - 20) reps_ = 2;
              if (DUP_CLS == 4 && st_ == ST_FF1) reps_ = 2; }
          if (DUP_CLS == 6 && ph == 0) reps_ = 2;
          if (DUP_CLS == 7 && ph == PH_FINAL - 1) reps_ = 1;
          if (rep_ + 1 < reps_) { ++rep_; __syncthreads(); continue; }
          rep_ = 0; }
        if (ph + 1 < a.ph_hi) xcd_barrier(bar);
        ++ph;
    }
}

static void launch_mk(const Args& base, int lo, int hi, hipStream_t stream) {
    Args a = base; a.ph_lo = lo; a.ph_hi = hi;
    hipLaunchKernelGGL(mk, dim3(256), dim3(NWAVES * 64), LDS_BYTES, stream, a);
}

extern "C" void kernel_launch(void* const* d_in, const int* in_sizes, int n_in, void* d_out, int out_size, void* d_ws, size_t ws_size, hipStream_t stream) {
    static int inited = 0;
    if (!inited) {
        if (n_in != 35 || out_size != (int)O_END || ws_size < WS_END) { fprintf(stderr, "kernel_launch: unexpected sizes n_in %d out %d ws %zu\n", n_in, out_size, ws_size); }
        if (hipFuncSetAttribute((const void*)mk, hipFuncAttributeMaxDynamicSharedMemorySize, LDS_BYTES) != hipSuccess) fprintf(stderr, "kernel_launch: hipFuncSetAttribute failed\n");
        (void)hipGetLastError(); inited = 1;
    }
    (void)hipMemsetAsync((unsigned char*)d_ws + WS_CTL, 0, CTL_ZERO_BYTES, stream);
    Args base{}; for (int i = 0; i < 35; ++i) base.in[i] = (const float*)d_in[i]; base.out = (float*)d_out; base.ws = (unsigned char*)d_ws;
    launch_mk(base, 0, PH_END, stream);
}
```

```cpp
#include <hip/hip_runtime.h>
#include <cstdio>
#include <cstdint>

constexpr int MP = 16384, MS = 512, M = MP + MS, D = 1024, FF = 4096;
constexpr float EPS = 1e-6f;

constexpr size_t O_YP = 0, O_YS = (size_t)MP * D, O_VS = O_YS + (size_t)MS * D, O_CONVP = O_VS + 2 * (size_t)MS * D, O_HP = O_CONVP + 8 * 3 * 1024,
                 O_CONVS = O_HP + 8 * 1024, O_HS = O_CONVS + 128 * 3 * 1024, O_SREP = O_HS + 128 * 1024, O_SIMP = O_SREP + 8 * 4096, O_SRES = O_SIMP + 8 * 4096,
                 O_SIMS = O_SRES + 128 * 4096, O_END = O_SIMS + 128 * 4096;

constexpr size_t MiB = 1u << 20;
constexpr size_t WS_CTL = 0, CTL_ZERO_BYTES = 64 * 1024;
constexpr size_t WS_XN = 1 * MiB;
constexpr size_t WS_T = 34 * MiB;
constexpr size_t WS_RSV = 128 * 1024;
constexpr size_t WS_WM = 166 * MiB;
constexpr size_t WS_RGT = 167 * MiB;
constexpr size_t WS_S5T = 168 * MiB;
constexpr size_t WS_S5AB = 170 * MiB;
constexpr size_t WS_S5BB = 170 * MiB + 512 * 1024;
constexpr size_t WS_HST = 171 * MiB;
constexpr size_t WS_S5ST = 172 * MiB;
constexpr size_t WS_CHA = 176 * MiB;
constexpr size_t WS_CHB = 180 * MiB;
constexpr size_t WS_XSR = 184 * MiB;
constexpr size_t WS_XSI = 200 * MiB;
constexpr size_t WS_W_INA = 216 * MiB, WS_W_OUTA = 224 * MiB, WS_W_INB = 228 * MiB, WS_W_OUTB = 232 * MiB, WS_W_INC = 234 * MiB, WS_W_GLU = 236 * MiB,
                 WS_W_FF1 = 240 * MiB, WS_W_FF2 = 248 * MiB, WS_END = 256 * MiB;
constexpr int CW_BAR = 4096;

#define GAS __attribute__((address_space(1)))
#define LAS __attribute__((address_space(3)))
typedef unsigned short bf16;
typedef unsigned v4u __attribute__((ext_vector_type(4)));
typedef float f32x4 __attribute__((ext_vector_type(4)));
typedef short bf16x8 __attribute__((ext_vector_type(8)));
typedef GAS unsigned gu32;
typedef GAS unsigned long long gu64;
#define RLX_AGENT __ATOMIC_RELAXED, __HIP_MEMORY_SCOPE_AGENT
#define LDS_WAIT() asm volatile("s_waitcnt lgkmcnt(0)" ::: "memory")
#define VM_WAIT() asm volatile("s_waitcnt vmcnt(0)" ::: "memory")
__device__ __forceinline__ unsigned long long rt() { return __builtin_amdgcn_s_memrealtime(); }
__device__ __forceinline__ unsigned f2bf(float f) { unsigned u = __builtin_bit_cast(unsigned, f); return (u + 0x7fffu + ((u >> 16) & 1u)) >> 16; }
__device__ __forceinline__ unsigned pk2(float lo, float hi) { return f2bf(lo) | (f2bf(hi) << 16); }

#define XB_TMO      128
#define XB_XCNT(j)  (256  + 64 * (j))
#define XB_XSUB(j)  (1280 + 64 * (j))
#define XB_XGEN(j)  (2304 + 64 * (j))
#define XB_TOP      3328
#define XB_TOPGEN   3392
#define XCD_BAR_WORDS 3456
#define XB_SPIN_CAP (1u << 18)

__device__ __forceinline__ unsigned xb_ld(unsigned* p)              { return __hip_atomic_load(p, __ATOMIC_RELAXED, __HIP_MEMORY_SCOPE_AGENT); }
__device__ __forceinline__ unsigned xb_add(unsigned* p, unsigned v) { return __hip_atomic_fetch_add(p, v, __ATOMIC_RELAXED, __HIP_MEMORY_SCOPE_AGENT); }
__device__ __forceinline__ unsigned xb_xcc_id() { return (unsigned)__builtin_amdgcn_s_getreg((3 << 11) | 20) & 0xFu; }
#define XB_SPIN(cond, bar) do { unsigned _sp = 0; while (cond) { __builtin_amdgcn_s_sleep(1); \
    if ((++_sp & 255u) == 0u) { if (xb_ld(&(bar)[XB_TMO])) break; if (_sp > XB_SPIN_CAP) { atomicAdd(&(bar)[XB_TMO], 1u); break; } } } } while (0)

struct XcdBarrier {
    unsigned* bar; unsigned x;
    volatile LAS unsigned* st;
};

__device__ __forceinline__ XcdBarrier xcd_barrier_post(unsigned* bar, volatile LAS unsigned* st) {
    XcdBarrier b; b.bar = bar; b.x = xb_xcc_id(); b.st = st;
    if (threadIdx.x == 0) (void)xb_add(&bar[XB_XCNT(b.x)], 1u);
    return b;
}
__device__ __forceinline__ void xcd_barrier_complete(unsigned* bar, unsigned x, unsigned& nloc, unsigned& nx) {
    const unsigned G = gridDim.x * gridDim.y * gridDim.z;
    unsigned sum, cnt, mine, sp = 0u;
    for (;;) {
        sum = 0u; cnt = 0u; mine = 0u;
#pragma unroll
        for (unsigned j = 0; j < 16; ++j) { const unsigned c = xb_ld(&bar[XB_XCNT(j)]); sum += c; cnt += (c > 0u) ? 1u : 0u; mine = (j == x) ? c : mine; }
        if (sum == G) break;
        __builtin_amdgcn_s_sleep(1);
        if ((++sp & 255u) == 0u) { if (xb_ld(&bar[XB_TMO])) break; if (sp > XB_SPIN_CAP) { atomicAdd(&bar[XB_TMO], 1u); break; } }
    }
    nloc = mine > 0u ? mine : 1u; nx = cnt > 0u ? cnt : 1u;
}

__device__ __forceinline__ void xcd_barrier(const XcdBarrier& b) {
    asm volatile("s_waitcnt vmcnt(0)" ::: "memory");
    __syncthreads();
    if (threadIdx.x == 0) {
        unsigned* bar = b.bar;
        __builtin_amdgcn_s_waitcnt(0);
        unsigned nloc = b.st[0], nx = b.st[1];
        if (nloc == 0u) { xcd_barrier_complete(bar, b.x, nloc, nx); b.st[0] = nloc; b.st[1] = nx; }
        const unsigned old = xb_add(&bar[XB_XSUB(b.x)], 1u);
        const unsigned gen = old / nloc;
        if (old + 1u == (gen + 1u) * nloc) {
            __builtin_amdgcn_fence(__ATOMIC_RELEASE, "agent");
            asm volatile("s_waitcnt vmcnt(0)" ::: "memory");
            const unsigned og = xb_add(&bar[XB_TOP], 1u);
            const unsigned tg = og / nx;
            if (og + 1u == (tg + 1u) * nx) xb_add(&bar[XB_TOPGEN], 1u);
            else XB_SPIN(xb_ld(&bar[XB_TOPGEN]) == tg, bar);
            __builtin_amdgcn_fence(__ATOMIC_ACQUIRE, "agent");
            xb_add(&bar[XB_XGEN(b.x)], 1u);
            asm volatile("s_waitcnt vmcnt(0)" ::: "memory");
        } else {
            XB_SPIN(xb_ld(&bar[XB_XGEN(b.x)]) == gen, bar);
            __builtin_amdgcn_fence(__ATOMIC_ACQUIRE, "agent");
            asm volatile("s_waitcnt vmcnt(0)" ::: "memory");
        }
    }
    __syncthreads();
}
__device__ __forceinline__ void xcd_barrier_arrive(const XcdBarrier& b) {
    asm volatile("s_waitcnt vmcnt(0)" ::: "memory");
    __syncthreads();
    if (threadIdx.x == 0) {
        unsigned* bar = b.bar;
        __builtin_amdgcn_s_waitcnt(0);
        unsigned nloc = b.st[0], nx = b.st[1];
        if (nloc == 0u) { xcd_barrier_complete(bar, b.x, nloc, nx); b.st[0] = nloc; b.st[1] = nx; }
        const unsigned old = xb_add(&bar[XB_XSUB(b.x)], 1u);
        const unsigned gen = old / nloc;
        if (old + 1u == (gen + 1u) * nloc) {
            __builtin_amdgcn_fence(__ATOMIC_RELEASE, "agent");
            asm volatile("s_waitcnt vmcnt(0)" ::: "memory");
            const unsigned og = xb_add(&bar[XB_TOP], 1u);
            const unsigned tg = og / nx;
            if (og + 1u == (tg + 1u) * nx) xb_add(&bar[XB_TOPGEN], 1u);
        } else {
            const unsigned pos = old - gen * nloc;
            if (pos + 1u == nloc / 2u || pos + 1u == nloc - nloc / 4u || pos + 1u == nloc - nloc / 8u || pos + 2u == nloc) {
                __builtin_amdgcn_fence(__ATOMIC_RELEASE, "agent");
                asm volatile("s_waitcnt vmcnt(0)" ::: "memory"); }
        }
        b.st[2] = gen;
    }
}
__device__ __forceinline__ void xcd_barrier_wait(const XcdBarrier& b) {
    if (threadIdx.x == 0) {
        unsigned* bar = b.bar; const unsigned gen = b.st[2];
        XB_SPIN(xb_ld(&bar[XB_TOPGEN]) == gen, bar);
        __builtin_amdgcn_fence(__ATOMIC_ACQUIRE, "agent");
        asm volatile("s_waitcnt vmcnt(0)" ::: "memory");
    }
    __syncthreads();
}
namespace pg8 {
#define PG8_LAS __attribute__((address_space(3)))
typedef unsigned short bf16_t;
typedef short bf16x8 __attribute__((ext_vector_type(8)));
typedef float f32x4 __attribute__((ext_vector_type(4)));
typedef unsigned u32x4 __attribute__((ext_vector_type(4)));
constexpr int BM = 256, BK = 64, HALF = 128, HTB = HALF * BK * 2  , STAGE_BYTES = 8 * HTB, NXCD = 8, WGM = 8;

__host__ __device__ __forceinline__ int lds_byte(int r, int c) { const int st = (r >> 4) * 2 + (c >> 5), rr = r & 15, cc = c & 31, ob = rr * 64 + cc * 2; return st * 1024 + (ob ^ (((ob >> 9) & 1) << 5)); }
__host__ __device__ __forceinline__ void stage_rc(int b, int& R, int& C) { const int st = b / 1024, sb = b % 1024, swz = sb ^ (((sb >> 9) & 1) << 5); R = (st >> 1) * 16 + swz / 64; C = (st & 1) * 32 + (swz % 64) / 2; }
__host__ __device__ __forceinline__ int perm32(int rho) { const int n = rho >> 4, i = rho & 15; return 8 * (i >> 2) + 4 * n + (i & 3); }

struct Unit { int pm, pn; };
struct Gemm { const bf16_t* A; const bf16_t* Bt; int M, N, K; };

struct StaticOrder {
    int nM, nN, nwg, G, c;
    __host__ __device__ void init(int M, int N, int G_, int c_) { nM = M / BM; nN = N / BM; nwg = nM * nN; G = G_; c = c_; }
    __host__ __device__ bool next(int i, Unit& u) const {
        const long L = (long)i * G + c; if (L >= nwg) return false;
        int wgid = (int)L; { const int q = nwg / NXCD, r = nwg % NXCD, xcd = wgid % NXCD, off = wgid / NXCD; wgid = (xcd < r ? xcd * (q + 1) : r * (q + 1) + (xcd - r) * q) + off; }
        const int nig = WGM * nN, gid = wgid / nig, fm = gid * WGM, gsz = (nM - fm) < WGM ? (nM - fm) : WGM;
        u.pm = fm + ((wgid % nig) % gsz); u.pn = (wgid % nig) / gsz; return true;
    }
    __device__ __forceinline__ void a_ready(const Unit&) const {}
    __device__ __forceinline__ void done(const Unit&) const {}
};

template <class Epi, class Sched, bool ALIGN_EPI = false, bool SP2 = false>
__device__ __forceinline__ void gemm_phase(PG8_LAS unsigned char* lds, const Gemm g, const Sched& S, const Epi& E, const int tid_in) {
    const int tid = tid_in, wid = __builtin_amdgcn_readfirstlane(tid >> 6), lane = tid & 63, wr = wid >> 2, wc = wid & 3, fr = lane & 15, fq = lane >> 4;
    const int K = g.K, nt = K / BK;
    unsigned voffA[2], voffB[2];
#pragma unroll
    for (int i = 0; i < 2; ++i) { int R, C; stage_rc(tid * 16 + i * 8192, R, C); const int Rb = Epi::PERM ? ((R & ~31) + perm32(R & 31)) : R;
        voffA[i] = (unsigned)(R * K + C) * 2u; voffB[i] = (unsigned)(Rb * K + C) * 2u; }
    const size_t kstep = (size_t)(BK * 2);
    const size_t hstep = (size_t)HALF * K * 2;
    const size_t tstep = 2 * hstep;
    const unsigned ldsw = (unsigned)wid * 1024u;
    const int aoff = lds_byte(wr * 64 + fr, fq * 8), boff = lds_byte(wc * 32 + fr, fq * 8);
#define PG8_SA(b, h) (((b) * 2 + (h)) * HTB)
#define PG8_SB(b, h) ((4 + (b) * 2 + (h)) * HTB)
#define PG8_STAGE(bufoff, gbase, voff) do { _Pragma("unroll") for (int _i = 0; _i < 2; ++_i) \
        __builtin_amdgcn_global_load_lds((const unsigned*)((const char*)(gbase) + (voff)[_i]), (PG8_LAS unsigned*)(lds + (bufoff) + ldsw + _i * 8192), 16, 0, 0); } while (0)
#define PG8_LDA(dst, b, h) do { _Pragma("unroll") for (int m = 0; m < 4; ++m) _Pragma("unroll") for (int k = 0; k < 2; ++k) dst[m][k] = *(const PG8_LAS bf16x8*)(lds + PG8_SA(b, h) + aoff + m * 2048 + k * 1024); } while (0)
#define PG8_LDB(dst, b, h) do { _Pragma("unroll") for (int n = 0; n < 2; ++n) _Pragma("unroll") for (int k = 0; k < 2; ++k) dst[n][k] = *(const PG8_LAS bf16x8*)(lds + PG8_SB(b, h) + boff + n * 2048 + k * 1024); } while (0)
#define PG8_MMA(ai, bj, At, Bt) do { __builtin_amdgcn_s_setprio(1); _Pragma("unroll") for (int m = 0; m < 4; ++m) _Pragma("unroll") for (int n = 0; n < 2; ++n) _Pragma("unroll") for (int k = 0; k < 2; ++k) \
        acc[ai][bj][m][n] = __builtin_amdgcn_mfma_f32_16x16x32_bf16(Bt[n][k], At[m][k], acc[ai][bj][m][n], 0, 0, 0); __builtin_amdgcn_s_setprio(0); } while (0)
#define PG8_WAIT_V(n) asm volatile("s_waitcnt vmcnt(" #n ")" ::: "memory")
#define PG8_WAIT_L(n) asm volatile("s_waitcnt lgkmcnt(" #n ")" ::: "memory")
#define PG8_BAR __builtin_amdgcn_s_barrier()
#define PG8_SCHED __builtin_amdgcn_sched_barrier(0)
    Unit cur, nxt; int ui = 0;
    if (!S.next(0, cur)) return;
    E.first(lds, cur, tid);
    f32x4 acc[2][2][4][2];
#pragma unroll
    for (int a = 0; a < 2; ++a)
#pragma unroll
        for (int b = 0; b < 2; ++b)
#pragma unroll
            for (int m = 0; m < 4; ++m)
#pragma unroll
                for (int n = 0; n < 2; ++n) acc[a][b][m][n] = (f32x4){0.f, 0.f, 0.f, 0.f};
    bf16x8 At[4][2], B0[2][2], B1[2][2];
    const char* cA = (const char*)g.A + (size_t)cur.pm * tstep; const char* cB = (const char*)g.Bt + (size_t)cur.pn * tstep;
    S.a_ready(cur);
    if constexpr (SP2) {
        PG8_STAGE(PG8_SB(0, 0), cB, voffB); PG8_STAGE(PG8_SB(0, 1), cB + hstep, voffB); PG8_STAGE(PG8_SA(0, 0), cA, voffA); PG8_STAGE(PG8_SA(0, 1), cA + hstep, voffA);
        if (wr == 1) PG8_BAR;
        PG8_WAIT_V(2); PG8_BAR;
        PG8_STAGE(PG8_SB(1, 0), cB + kstep, voffB); PG8_STAGE(PG8_SA(1, 0), cA + kstep, voffA); PG8_STAGE(PG8_SB(1, 1), cB + hstep + kstep, voffB);
        PG8_WAIT_V(6); PG8_BAR;
    } else {
        PG8_STAGE(PG8_SB(0, 0), cB, voffB); PG8_STAGE(PG8_SA(0, 0), cA, voffA); PG8_STAGE(PG8_SB(0, 1), cB + hstep, voffB); PG8_STAGE(PG8_SA(0, 1), cA + hstep, voffA);
        if (wr == 1) PG8_BAR;
        PG8_WAIT_V(4); PG8_BAR;
        PG8_STAGE(PG8_SB(1, 0), cB + kstep, voffB); PG8_STAGE(PG8_SA(1, 0), cA + kstep, voffA); PG8_STAGE(PG8_SB(1, 1), cB + hstep + kstep, voffB);
        PG8_WAIT_V(6); PG8_BAR;
    }
    for (;;) {
        const bool has_next = S.next(ui + 1, nxt);
        const char* nA = has_next ? (const char*)g.A + (size_t)nxt.pm * tstep : cA; const char* nB = has_next ? (const char*)g.Bt + (size_t)nxt.pn * tstep : cB;
        for (int t = 0; t < nt; t += 2) {
            const bool last = (t == nt - 2);
            const char* a1 = cA + (size_t)(t + 1) * kstep;
            const char* a2 = last ? nA : cA + (size_t)(t + 2) * kstep; const char* b2 = last ? nB : cB + (size_t)(t + 2) * kstep;
            const char* a3 = a2 + kstep; const char* b3 = b2 + kstep;
            if (last && has_next) S.a_ready(nxt);
            if constexpr (SP2) {
            PG8_LDB(B0, 0, 0); PG8_LDB(B1, 0, 1); PG8_SCHED; PG8_LDA(At, 0, 0); PG8_STAGE(PG8_SA(1, 1), a1 + hstep, voffA);
            PG8_WAIT_V(8); PG8_WAIT_L(0); PG8_BAR; PG8_MMA(0, 0, At, B0); PG8_MMA(0, 1, At, B1); PG8_BAR; PG8_SCHED;
            PG8_LDA(At, 0, 1); PG8_STAGE(PG8_SB(0, 0), b2, voffB); PG8_STAGE(PG8_SB(0, 1), b2 + hstep, voffB); PG8_STAGE(PG8_SA(0, 0), a2, voffA);
            PG8_WAIT_V(8); PG8_WAIT_L(0); PG8_BAR; PG8_MMA(1, 0, At, B0); PG8_MMA(1, 1, At, B1); PG8_BAR; PG8_SCHED;
            PG8_LDB(B0, 1, 0); PG8_LDB(B1, 1, 1); PG8_SCHED; PG8_LDA(At, 1, 0); PG8_STAGE(PG8_SA(0, 1), a2 + hstep, voffA);
            PG8_WAIT_V(8); PG8_WAIT_L(0); PG8_BAR; PG8_MMA(0, 0, At, B0); PG8_MMA(0, 1, At, B1); PG8_BAR; PG8_SCHED;
            PG8_LDA(At, 1, 1); PG8_STAGE(PG8_SB(1, 0), b3, voffB); PG8_STAGE(PG8_SB(1, 1), b3 + hstep, voffB); PG8_STAGE(PG8_SA(1, 0), a3, voffA);
            PG8_WAIT_V(8); PG8_WAIT_L(0); PG8_BAR; PG8_MMA(1, 0, At, B0); PG8_MMA(1, 1, At, B1); PG8_BAR; PG8_SCHED;
            } else {
            PG8_LDB(B0, 0, 0); PG8_SCHED; PG8_LDA(At, 0, 0); PG8_STAGE(PG8_SA(1, 1), a1 + hstep, voffA);
            PG8_WAIT_L(8); PG8_BAR; PG8_WAIT_L(0); PG8_MMA(0, 0, At, B0); PG8_BAR; PG8_SCHED;
            PG8_LDB(B1, 0, 1); PG8_STAGE(PG8_SB(0, 0), b2, voffB);
            PG8_BAR; PG8_WAIT_L(0); PG8_MMA(0, 1, At, B1); PG8_BAR;
            PG8_LDA(At, 0, 1); PG8_STAGE(PG8_SA(0, 0), a2, voffA);
            PG8_BAR; PG8_WAIT_L(0); PG8_MMA(1, 0, At, B0); PG8_BAR; PG8_SCHED;
            PG8_STAGE(PG8_SB(0, 1), b2 + hstep, voffB);
            PG8_WAIT_V(6); PG8_BAR; PG8_MMA(1, 1, At, B1); PG8_BAR;
            PG8_LDB(B0, 1, 0); PG8_SCHED; PG8_LDA(At, 1, 0); PG8_STAGE(PG8_SA(0, 1), a2 + hstep, voffA);
            PG8_WAIT_L(8); PG8_BAR; PG8_WAIT_L(0); PG8_MMA(0, 0, At, B0); PG8_BAR; PG8_SCHED;
            PG8_LDB(B1, 1, 1); PG8_STAGE(PG8_SB(1, 0), b3, voffB);
            PG8_BAR; PG8_WAIT_L(0); PG8_MMA(0, 1, At, B1); PG8_BAR;
            PG8_LDA(At, 1, 1); PG8_STAGE(PG8_SA(1, 0), a3, voffA);
            PG8_BAR; PG8_WAIT_L(0); PG8_MMA(1, 0, At, B0); PG8_BAR; PG8_SCHED;
            PG8_STAGE(PG8_SB(1, 1), b3 + hstep, voffB);
            PG8_WAIT_V(6); PG8_BAR; PG8_MMA(1, 1, At, B1); PG8_BAR;
            }
        }
        if constexpr (ALIGN_EPI) { if (wr == 0) PG8_BAR; }
        if constexpr (!Epi::AFTER_DRAIN) { E(acc, cur, wr, wc, fr, fq, lds, nxt, has_next, ui, tid); S.done(cur); }
        if (!has_next) break;
#pragma unroll
        for (int a = 0; a < 2; ++a)
#pragma unroll
            for (int b = 0; b < 2; ++b)
#pragma unroll
                for (int m = 0; m < 4; ++m)
#pragma unroll
                    for (int n = 0; n < 2; ++n) acc[a][b][m][n] = (f32x4){0.f, 0.f, 0.f, 0.f};
        cur = nxt; cA = nA; cB = nB; ++ui;
        if constexpr (ALIGN_EPI) { if (wr == 1) PG8_BAR; }
    }
    PG8_WAIT_V(0);
    if constexpr (!ALIGN_EPI) { if (wr == 0) PG8_BAR; }
    PG8_BAR;
    if constexpr (Epi::AFTER_DRAIN) { E.fused(acc, cur, wr, wc, fr, fq, lds, wid, lane); S.done(cur); }
#undef PG8_SA
#undef PG8_SB
#undef PG8_STAGE
#undef PG8_LDA
#undef PG8_LDB
#undef PG8_MMA
#undef PG8_WAIT_V
#undef PG8_WAIT_L
#undef PG8_BAR
#undef PG8_SCHED
}
}
__device__ __forceinline__ float bf2f(unsigned short h) { return __builtin_bit_cast(float, (unsigned)h << 16); }
__device__ __forceinline__ float gelu_tanh(float x) { const float u = 0.7978845608028654f * (x + 0.044715f * x * x * x); return 0.5f * x * (1.f + tanhf(u)); }
__device__ __forceinline__ float sigmoidf_(float x) { return 1.f / (1.f + expf(-x)); }
template <int CTRL> __device__ __forceinline__ float dpp0(float src) { return __builtin_bit_cast(float, __builtin_amdgcn_update_dpp(0, __builtin_bit_cast(int, src), CTRL, 0xf, 0xf, true)); }
__device__ __forceinline__ float xor16f(float v) { return __shfl_xor(v, 16); }
__device__ __forceinline__ float sum32f(float v) { return v + __shfl_xor(v, 32); }
__device__ __forceinline__ float wave_sum(float v) {
#pragma unroll
    for (int o = 1; o < 64; o <<= 1) v += __shfl_xor(v, o);
    return v;
}
__device__ __forceinline__ unsigned cvt_pk_bf16(float lo, float hi) { unsigned r; asm volatile("v_cvt_pk_bf16_f32 %0, %1, %2" : "=v"(r) : "v"(lo), "v"(hi)); return r; }
__device__ __forceinline__ void wt16(const void* base, size_t byte_off, v4u v) { __builtin_amdgcn_raw_buffer_store_b128(v, __builtin_amdgcn_make_buffer_rsrc((void*)base, 0, 0x7fffffff, 0x00020000), (int)byte_off, 0, 16); }
__device__ __forceinline__ float gelu_fast(float x) { const float u = x * (0.7978845608028654f + 0.035677408136300125f * x * x); return x * __builtin_amdgcn_rcpf(1.f + __builtin_amdgcn_exp2f(-2.8853900817779268f * u)); }
__device__ __forceinline__ float sigmoid_fast(float x) { return __builtin_amdgcn_rcpf(1.f + __builtin_amdgcn_exp2f(-1.4426950408889634f * x)); }
__device__ __forceinline__ float bflo(unsigned u) { return __builtin_bit_cast(float, u << 16); }
__device__ __forceinline__ float bfhi(unsigned u) { return __builtin_bit_cast(float, u & 0xffff0000u); }
enum { ACT_GELU = 0, ACT_SQRELU = 1 };
typedef unsigned u32x2 __attribute__((ext_vector_type(2)));
struct RowCtx { float rs, ss; };
constexpr int XS_P = 32, XS_S = 64, VS_P = 16, VS_S = 64;
template <int N4> __device__ __forceinline__ float sum_slots_n(const float* p) { f32x4 v[N4];
#pragma unroll
    for (int i = 0; i < N4; ++i) v[i] = ((const f32x4*)p)[i];
    float s = 0.f;
#pragma unroll
    for (int i = 0; i < N4; ++i) s += (v[i].x + v[i].y) + (v[i].z + v[i].w);
    return s; }
__device__ __forceinline__ float sum_slots(const float* p, int n4) { return n4 == 4 ? sum_slots_n<4>(p) : (n4 == 8 ? sum_slots_n<8>(p) : sum_slots_n<16>(p)); }
__device__ __forceinline__ float rs_x(const float* P, int nslot, int row) {
    const float s = row < MP ? sum_slots(P + (size_t)row * XS_P, nslot >> 2) : sum_slots(P + (size_t)MP * XS_P + (size_t)(row - MP) * XS_S, XS_S >> 2); return rsqrtf(s * (1.f / 1024.f) + EPS); }
__device__ __forceinline__ float rs_v(const float* P, int row) {
    const float s = row < MP ? sum_slots(P + (size_t)row * VS_P, VS_P >> 2) : sum_slots(P + (size_t)MP * VS_P + (size_t)(row - MP) * VS_S, VS_S >> 2); return rsqrtf(s * (1.f / 1024.f) + EPS); }
__device__ __forceinline__ float fq_sum(float ss) { ss += xor16f(ss); return sum32f(ss); }
__device__ __forceinline__ void xs_store(float* P, int row, int col, bool pair, float ss, int fq) {
    ss = fq_sum(ss); if (fq != 0) return;
    if (row < MP) P[(size_t)row * XS_P + (pair ? (col >> 5) : (((col >> 8) << 2) | ((col >> 5) & 3)))] = ss; else P[(size_t)MP * XS_P + (size_t)(row - MP) * XS_S + (col >> 4)] = ss; }
__device__ __forceinline__ void vs_store(float* P, int row, int col, float ss, int fq) {
    ss = fq_sum(ss); if (fq != 0) return; const int c = col - 1024;
    if (row < MP) P[(size_t)row * VS_P + (((c >> 8) << 2) | ((c >> 5) & 3))] = ss; else P[(size_t)MP * VS_P + (size_t)(row - MP) * VS_S + (c >> 4)] = ss; }
constexpr int RSTAB_OFF = 131072 + 2048;
__device__ __forceinline__ LAS float* rstab(LAS unsigned char* lds, int par) { return (LAS float*)(lds + RSTAB_OFF) + par * 256; }
template <int ACT> __device__ __forceinline__ float act_f(float x) { if (ACT == ACT_GELU) return gelu_fast(x); const float t = fmaxf(x, 0.f); return t * t; }

template <int ACT, bool VSTAT> struct FAct { bf16* O; int ldc; const float* S; int nslot; float* SV;
    __device__ __forceinline__ RowCtx begin(int row) const { return RowCtx{rs_x(S, nslot, row), 0.f}; }
    __device__ __forceinline__ float rs_row(int row) const { return rs_x(S, nslot, row); }
    __device__ __forceinline__ void apply8(RowCtx& c, int row, int col, f32x4 v0, f32x4 v1) const {
        float r[8];
#pragma unroll
        for (int i = 0; i < 4; ++i) { r[i] = act_f<ACT>(v0[i] * c.rs); r[4 + i] = act_f<ACT>(v1[i] * c.rs); }
        if (VSTAT && col >= 1024) {
#pragma unroll
            for (int i = 0; i < 8; ++i) c.ss += r[i] * r[i]; }
        v4u w; w.x = cvt_pk_bf16(r[0], r[1]); w.y = cvt_pk_bf16(r[2], r[3]); w.z = cvt_pk_bf16(r[4], r[5]); w.w = cvt_pk_bf16(r[6], r[7]); if (ACT == ACT_SQRELU) wt16(O, ((size_t)row * ldc + col) * 2, w); else *(v4u*)(O + (size_t)row * ldc + col) = w; }
    __device__ __forceinline__ void apply4(RowCtx& c, int row, int col, f32x4 v) const {
        float r[4];
#pragma unroll
        for (int i = 0; i < 4; ++i) r[i] = act_f<ACT>(v[i] * c.rs);
        if (VSTAT && col >= 1024) c.ss += (r[0] * r[0] + r[1] * r[1]) + (r[2] * r[2] + r[3] * r[3]);
        u32x2 w; w.x = cvt_pk_bf16(r[0], r[1]); w.y = cvt_pk_bf16(r[2], r[3]); *(u32x2*)(O + (size_t)row * ldc + col) = w; }
    __device__ __forceinline__ void end(RowCtx& c, int row, int col, int fq) const { if (VSTAT && col >= 1024) vs_store(SV, row, col, c.ss, fq); } };
struct FRglru { bf16* G; float* XB; const float* S;
    __device__ __forceinline__ RowCtx begin(int row) const { return RowCtx{rs_x(S, 16, row), 0.f}; }
    __device__ __forceinline__ float rs_row(int row) const { return rs_x(S, 16, row); }
    __device__ __forceinline__ void apply8(RowCtx& c, int row, int col, f32x4 v0, f32x4 v1) const {
        if (col < 1024) { v4u w; w.x = cvt_pk_bf16(gelu_fast(v0[0] * c.rs), gelu_fast(v0[1] * c.rs)); w.y = cvt_pk_bf16(gelu_fast(v0[2] * c.rs), gelu_fast(v0[3] * c.rs));
            w.z = cvt_pk_bf16(gelu_fast(v1[0] * c.rs), gelu_fast(v1[1] * c.rs)); w.w = cvt_pk_bf16(gelu_fast(v1[2] * c.rs), gelu_fast(v1[3] * c.rs)); *(v4u*)(G + (size_t)row * 1024 + col) = w; }
        else { const f32x4 a = v0 * c.rs, b = v1 * c.rs; v4u w; w.x = cvt_pk_bf16(a[0], a[1]); w.y = cvt_pk_bf16(a[2], a[3]); w.z = cvt_pk_bf16(b[0], b[1]); w.w = cvt_pk_bf16(b[2], b[3]);
            *(v4u*)((bf16*)XB + (size_t)row * 1024 + col - 1024) = w; } }
    __device__ __forceinline__ void apply4(RowCtx& c, int row, int col, f32x4 v) const {
        if (col < 1024) { u32x2 w; w.x = cvt_pk_bf16(gelu_fast(v[0] * c.rs), gelu_fast(v[1] * c.rs)); w.y = cvt_pk_bf16(gelu_fast(v[2] * c.rs), gelu_fast(v[3] * c.rs)); *(u32x2*)(G + (size_t)row * 1024 + col) = w; }
        else { const f32x4 a = v * c.rs; u32x2 w; w.x = cvt_pk_bf16(a[0], a[1]); w.y = cvt_pk_bf16(a[2], a[3]); *(u32x2*)((bf16*)XB + (size_t)row * 1024 + col - 1024) = w; } }
    __device__ __forceinline__ void end(RowCtx&, int, int, int) const {} };
struct FBf { bf16* O; int ldc; const float* S;
    __device__ __forceinline__ RowCtx begin(int row) const { return RowCtx{rs_x(S, 16, row), 0.f}; }
    __device__ __forceinline__ float rs_row(int row) const { return rs_x(S, 16, row); }
    __device__ __forceinline__ void apply8(RowCtx& c, int row, int col, f32x4 v0, f32x4 v1) const { const f32x4 a = v0 * c.rs, b = v1 * c.rs; v4u w; w.x = cvt_pk_bf16(a[0], a[1]); w.y = cvt_pk_bf16(a[2], a[3]); w.z = cvt_pk_bf16(b[0], b[1]); w.w = cvt_pk_bf16(b[2], b[3]); *(v4u*)(O + (size_t)row * ldc + col) = w; }
    __device__ __forceinline__ void apply4(RowCtx& c, int row, int col, f32x4 v) const { const f32x4 a = v * c.rs; u32x2 w; w.x = cvt_pk_bf16(a[0], a[1]); w.y = cvt_pk_bf16(a[2], a[3]); *(u32x2*)(O + (size_t)row * ldc + col) = w; }
    __device__ __forceinline__ void end(RowCtx&, int, int, int) const {} };
struct FF32 { float* O; int ldc; const float* S;
    __device__ __forceinline__ RowCtx begin(int row) const { return RowCtx{rs_x(S, 16, row), 0.f}; }
    __device__ __forceinline__ float rs_row(int row) const { return rs_x(S, 16, row); }
    __device__ __forceinline__ void apply8(RowCtx& c, int row, int col, f32x4 v0, f32x4 v1) const { float* p = O + (size_t)row * ldc + col; *(f32x4*)p = v0 * c.rs; *(f32x4*)(p + 4) = v1 * c.rs; }
    __device__ __forceinline__ void apply4(RowCtx& c, int row, int col, f32x4 v) const { *(f32x4*)(O + (size_t)row * ldc + col) = v * c.rs; }
    __device__ __forceinline__ void end(RowCtx&, int, int, int) const {} };
__device__ __forceinline__ f32x4 bf_lo4(v4u w) { return (f32x4){bflo(w.x), bfhi(w.x), bflo(w.y), bfhi(w.y)}; }
__device__ __forceinline__ f32x4 bf_hi4(v4u w) { return (f32x4){bflo(w.z), bfhi(w.z), bflo(w.w), bfhi(w.w)}; }
struct FResid { bf16* XB16; float* Sacc;
    __device__ __forceinline__ RowCtx begin(int) const { return RowCtx{0.f, 0.f}; }
    __device__ __forceinline__ void load8(int row, int col, v4u& xo) const { xo = *(const v4u*)(XB16 + (size_t)row * D + col); }
    __device__ __forceinline__ void apply8x(RowCtx& c, int row, int col, f32x4 v0, f32x4 v1, v4u xo) const {
        const f32x4 x0 = bf_lo4(xo) + v0, x1 = bf_hi4(xo) + v1;
        c.ss += (x0[0] * x0[0] + x0[1] * x0[1]) + (x0[2] * x0[2] + x0[3] * x0[3]) + (x1[0] * x1[0] + x1[1] * x1[1]) + (x1[2] * x1[2] + x1[3] * x1[3]);
        v4u w; w.x = cvt_pk_bf16(x0[0], x0[1]); w.y = cvt_pk_bf16(x0[2], x0[3]); w.z = cvt_pk_bf16(x1[0], x1[1]); w.w = cvt_pk_bf16(x1[2], x1[3]); *(v4u*)(XB16 + (size_t)row * D + col) = w; }
    __device__ __forceinline__ void apply4(RowCtx& c, int row, int col, f32x4 v) const { bf16* p = XB16 + (size_t)row * D + col; const u32x2 o = *(const u32x2*)p;
        const f32x4 x0 = (f32x4){bflo(o.x), bfhi(o.x), bflo(o.y), bfhi(o.y)} + v; c.ss += (x0[0] * x0[0] + x0[1] * x0[1]) + (x0[2] * x0[2] + x0[3] * x0[3]);
        u32x2 w; w.x = cvt_pk_bf16(x0[0], x0[1]); w.y = cvt_pk_bf16(x0[2], x0[3]); *(u32x2*)p = w; }
    __device__ __forceinline__ void end(RowCtx& c, int row, int col, int fq) const { xs_store(Sacc, row, col, false, c.ss, fq); } };
struct FGlu { bf16* XB16; float* Sacc;
    __device__ __forceinline__ RowCtx begin(int) const { return RowCtx{0.f, 0.f}; }
    __device__ __forceinline__ void load8(int row, int col, v4u& xo) const { xo = *(const v4u*)(XB16 + (size_t)row * D + col); }
    __device__ __forceinline__ void apply8x_pair(RowCtx& c, int row, int col, f32x4 a0, f32x4 a1, f32x4 b0, f32x4 b1, v4u xo) const {
        f32x4 x0 = bf_lo4(xo), x1 = bf_hi4(xo);
#pragma unroll
        for (int i = 0; i < 4; ++i) { x0[i] += a0[i] * sigmoid_fast(b0[i]); x1[i] += a1[i] * sigmoid_fast(b1[i]); }
        c.ss += (x0[0] * x0[0] + x0[1] * x0[1]) + (x0[2] * x0[2] + x0[3] * x0[3]) + (x1[0] * x1[0] + x1[1] * x1[1]) + (x1[2] * x1[2] + x1[3] * x1[3]);
        v4u w; w.x = cvt_pk_bf16(x0[0], x0[1]); w.y = cvt_pk_bf16(x0[2], x0[3]); w.z = cvt_pk_bf16(x1[0], x1[1]); w.w = cvt_pk_bf16(x1[2], x1[3]); *(v4u*)(XB16 + (size_t)row * D + col) = w; }
    __device__ __forceinline__ void apply4_pair(RowCtx& c, int row, int col, f32x4 a, f32x4 b) const { bf16* p = XB16 + (size_t)row * D + col; const u32x2 o = *(const u32x2*)p;
        f32x4 x0 = (f32x4){bflo(o.x), bfhi(o.x), bflo(o.y), bfhi(o.y)};
#pragma unroll
        for (int i = 0; i < 4; ++i) x0[i] += a[i] * sigmoid_fast(b[i]);
        c.ss += (x0[0] * x0[0] + x0[1] * x0[1]) + (x0[2] * x0[2] + x0[3] * x0[3]);
        u32x2 w; w.x = cvt_pk_bf16(x0[0], x0[1]); w.y = cvt_pk_bf16(x0[2], x0[3]); *(u32x2*)p = w; }
    __device__ __forceinline__ void end(RowCtx& c, int row, int col, int fq) const { xs_store(Sacc, row, col, true, c.ss, fq); } };

template <class F> struct EpiRow8 { static constexpr bool PERM = true, AFTER_DRAIN = false; F f;
    __device__ __forceinline__ void first(PG8_LAS unsigned char* lds, const pg8::Unit& u, int tid) const { if (tid < 256) rstab(lds, 0)[tid] = f.rs_row(u.pm * 256 + tid); }
    __device__ __forceinline__ void operator()(const pg8::f32x4 (&acc)[2][2][4][2], const pg8::Unit& u, int wr, int wc, int fr, int fq, PG8_LAS unsigned char* lds, const pg8::Unit& nxt, bool has_next, int ui, int tid) const {
        const LAS float* tab = rstab(lds, ui & 1);
        float nrs = 0.f; if (has_next && tid < 256) nrs = f.rs_row(nxt.pm * 256 + tid);
#pragma unroll
        for (int ai = 0; ai < 2; ++ai)
#pragma unroll
            for (int m = 0; m < 4; ++m) { const int rl = ai * 128 + wr * 64 + m * 16 + fr, row = u.pm * 256 + rl; RowCtx c = RowCtx{tab[rl], 0.f};
#pragma unroll
                for (int bj = 0; bj < 2; ++bj) f.apply8(c, row, u.pn * 256 + bj * 128 + wc * 32 + 8 * fq, acc[ai][bj][m][0], acc[ai][bj][m][1]);
                f.end(c, row, u.pn * 256 + wc * 32, fq); }
        if (has_next && tid < 256) rstab(lds, (ui + 1) & 1)[tid] = nrs; } };
template <class F> struct EpiResid8 { static constexpr bool PERM = true, AFTER_DRAIN = true; F f;
    __device__ __forceinline__ void first(PG8_LAS unsigned char*, const pg8::Unit&, int) const {}
    __device__ __forceinline__ void operator()(const pg8::f32x4 (&)[2][2][4][2], const pg8::Unit&, int, int, int, int, PG8_LAS unsigned char*, const pg8::Unit&, bool, int, int) const {}
    __device__ __forceinline__ void fused(pg8::f32x4 (&acc)[2][2][4][2], const pg8::Unit& u, int wr, int wc, int fr, int fq, PG8_LAS unsigned char* lds, int wid, int lane) const {
#pragma unroll
        for (int m = 0; m < 4; ++m)
#pragma unroll
            for (int bj = 0; bj < 2; ++bj) { const bf16* src = f.XB16 + (size_t)(u.pm * 256 + wr * 64 + m * 16 + fr) * D + u.pn * 256 + bj * 128 + wc * 32 + 8 * fq;
                __builtin_amdgcn_global_load_lds((const unsigned*)src, (PG8_LAS unsigned*)(lds + (m * 2 + bj) * 8192 + wid * 1024), 16, 0, 0); }
        v4u xr[4][2];
#pragma unroll
        for (int m = 0; m < 4; ++m)
#pragma unroll
            for (int bj = 0; bj < 2; ++bj) f.load8(u.pm * 256 + 128 + wr * 64 + m * 16 + fr, u.pn * 256 + bj * 128 + wc * 32 + 8 * fq, xr[m][bj]);
        asm volatile("s_waitcnt vmcnt(0)" ::: "memory");
#pragma unroll
        for (int ai = 1; ai >= 0; --ai)
#pragma unroll
            for (int m = 0; m < 4; ++m) { const int row = u.pm * 256 + ai * 128 + wr * 64 + m * 16 + fr; RowCtx c = f.begin(row);
#pragma unroll
                for (int bj = 0; bj < 2; ++bj) { const v4u xo = ai ? xr[m][bj] : *(const PG8_LAS v4u*)(lds + (m * 2 + bj) * 8192 + wid * 1024 + lane * 16);
                    f.apply8x(c, row, u.pn * 256 + bj * 128 + wc * 32 + 8 * fq, acc[ai][bj][m][0], acc[ai][bj][m][1], xo); }
                f.end(c, row, u.pn * 256 + wc * 32, fq); }
    } };
template <class F> struct EpiPair8 { static constexpr bool PERM = true, AFTER_DRAIN = false; F f;
    __device__ __forceinline__ void first(PG8_LAS unsigned char*, const pg8::Unit&, int) const {}
    __device__ __forceinline__ void operator()(const pg8::f32x4 (&acc)[2][2][4][2], const pg8::Unit& u, int wr, int wc, int fr, int fq, PG8_LAS unsigned char*, const pg8::Unit&, bool, int, int) const {
        v4u xo[2][4];
#pragma unroll
        for (int ai = 0; ai < 2; ++ai)
#pragma unroll
            for (int m = 0; m < 4; ++m) f.load8(u.pm * 256 + ai * 128 + wr * 64 + m * 16 + fr, u.pn * 128 + wc * 32 + 8 * fq, xo[ai][m]);
#pragma unroll
        for (int ai = 0; ai < 2; ++ai)
#pragma unroll
            for (int m = 0; m < 4; ++m) { const int row = u.pm * 256 + ai * 128 + wr * 64 + m * 16 + fr; RowCtx c = f.begin(row);
                f.apply8x_pair(c, row, u.pn * 128 + wc * 32 + 8 * fq, acc[ai][0][m][0], acc[ai][0][m][1], acc[ai][1][m][0], acc[ai][1][m][1], xo[ai][m]);
                f.end(c, row, u.pn * 128 + wc * 32, fq); } } };

constexpr int NWAVES = 8;
constexpr int RING_BYTES = 131072, LDSCTL_OFF = RING_BYTES, MISC_OFF = LDSCTL_OFF + 320, LDS_BYTES = 147456;
constexpr int PTAB_OFF = LDSCTL_OFF + 1024;
struct Frame { LAS unsigned char* lds; int tid, lane, wave, vcu, G, bx; };
__device__ __forceinline__ const float* inp(const Frame& F, int i) {
    const volatile LAS unsigned* t = (const volatile LAS unsigned*)(F.lds + PTAB_OFF) + 2 * i;
    const unsigned lo = __builtin_amdgcn_readfirstlane(t[0]), hi = __builtin_amdgcn_readfirstlane(t[1]);
    return (const float*)(((unsigned long long)hi << 32) | lo);
}

template <int NCT, int KS, bool GLU, int UNR, class F>
__device__ __forceinline__ void small_gemm(const Frame& Fr, const bf16* A, const bf16* WT, int K, const F& f) {
    constexpr int CS = 8 / KS, CT = NCT / CS, NT = 4 * CT;
    const int rb = Fr.vcu & 7, cb = Fr.vcu >> 3, kq = Fr.wave % KS, cs = Fr.wave / KS, fr = Fr.lane & 15, fq = Fr.lane >> 4;
    const int m0 = MP + rb * 64, ksl = K / KS;
    const bf16* ap = A + (size_t)(m0 + fr) * K + kq * ksl + 8 * fq;
    const bf16* bp[CT];
#pragma unroll
    for (int j = 0; j < CT; ++j) { const int ct = cs * CT + j; int wrow;
        if (GLU) { const int c = cb * 32 + (ct & 1) * 16; wrow = 256 * (c >> 7) + 128 * (ct >> 1) + (c & 127); } else wrow = (cb * NCT + ct) * 16;
        bp[j] = WT + (size_t)(wrow + fr) * K + kq * ksl + 8 * fq; }
    f32x4 acc[4][CT];
#pragma unroll
    for (int r = 0; r < 4; ++r)
#pragma unroll
        for (int j = 0; j < CT; ++j) acc[r][j] = (f32x4){0.f, 0.f, 0.f, 0.f};
    (void)UNR;
    bf16x8 a0[2][4], b0[2][CT], a1[2][4], b1[2][CT];
    auto ldb = [&](bf16x8 (&a)[2][4], bf16x8 (&b)[2][CT], int kb) {
#pragma unroll
        for (int s_ = 0; s_ < 2; ++s_) {
#pragma unroll
            for (int r = 0; r < 4; ++r) a[s_][r] = *(const bf16x8*)(ap + (size_t)r * 16 * K + kb + 32 * s_);
#pragma unroll
            for (int j = 0; j < CT; ++j) b[s_][j] = *(const bf16x8*)(bp[j] + kb + 32 * s_); } };
    auto mmb = [&](const bf16x8 (&a)[2][4], const bf16x8 (&b)[2][CT]) {
#pragma unroll
        for (int s_ = 0; s_ < 2; ++s_)
#pragma unroll
            for (int r = 0; r < 4; ++r)
#pragma unroll
                for (int j = 0; j < CT; ++j) acc[r][j] = __builtin_amdgcn_mfma_f32_16x16x32_bf16(b[s_][j], a[s_][r], acc[r][j], 0, 0, 0); };
    ldb(a0, b0, 0);
    for (int kb = 0; kb < ksl; kb += 128) {
        if (kb + 64 < ksl) ldb(a1, b1, kb + 64);
        mmb(a0, b0);
        if (kb + 128 < ksl) ldb(a0, b0, kb + 128);
        if (kb + 64 < ksl) mmb(a1, b1);
    }
    LAS f32x4* RED = (LAS f32x4*)Fr.lds;
    __syncthreads();
#pragma unroll
    for (int r = 0; r < 4; ++r)
#pragma unroll
        for (int j = 0; j < CT; ++j) RED[(Fr.wave * NT + r * CT + j) * 64 + Fr.lane] = acc[r][j];
    __syncthreads();
    const int rt = Fr.wave & 3, hf = Fr.wave >> 2, row = m0 + rt * 16 + fr;
    RowCtx c = f.begin(row);
    if constexpr (GLU) {
        f32x4 va = (f32x4){0.f, 0.f, 0.f, 0.f}, vb = va;
#pragma unroll
        for (int q = 0; q < KS; ++q) { va = va + RED[(q * NT + rt * CT + hf) * 64 + Fr.lane]; vb = vb + RED[(q * NT + rt * CT + 2 + hf) * 64 + Fr.lane]; }
        const int col = cb * 32 + hf * 16; c.ss = 0.f; f.apply4_pair(c, row, col + 4 * fq, va, vb); f.end(c, row, col, fq);
    } else {
#pragma unroll
        for (int jj = 0; jj < NCT / 2; ++jj) { const int ct = hf * (NCT / 2) + jj, g = ct / CT, j = ct % CT; f32x4 v = (f32x4){0.f, 0.f, 0.f, 0.f};
#pragma unroll
            for (int q = 0; q < KS; ++q) v = v + RED[((g * KS + q) * NT + rt * CT + j) * 64 + Fr.lane];
            const int col = (cb * NCT + ct) * 16; c.ss = 0.f; f.apply4(c, row, col + 4 * fq, v); f.end(c, row, col, fq); }
    }
    __syncthreads();
}

__device__ __forceinline__ void transpose_item(const float* W, int K, int N, bf16* WT, int drow0, LAS float* scr, int k0, int n0, int lane, const float* gain) {
    const int rq = lane >> 3, cq = lane & 7;
    f32x4 v[8]; float gn[8];
#pragma unroll
    for (int i = 0; i < 8; ++i) { const int kk = 8 * i + rq; v[i] = *(const GAS f32x4*)((const GAS float*)W + (size_t)(k0 + kk) * N + n0 + 4 * cq); gn[i] = gain ? gain[k0 + kk] : 1.f; }
#pragma unroll
    for (int i = 0; i < 8; ++i) { LAS float* d = scr + (8 * i + rq) * 33 + 4 * cq; d[0] = v[i].x * gn[i]; d[1] = v[i].y * gn[i]; d[2] = v[i].z * gn[i]; d[3] = v[i].w * gn[i]; }
    LDS_WAIT(); asm volatile("" ::: "memory");
    const int c = lane & 7;
#pragma unroll
    for (int j = 0; j < 4; ++j) { const int n = (lane >> 3) + 8 * j; const LAS float* s = scr + (8 * c) * 33 + n;
        v4u o; o.x = cvt_pk_bf16(s[0 * 33], s[1 * 33]); o.y = cvt_pk_bf16(s[2 * 33], s[3 * 33]); o.z = cvt_pk_bf16(s[4 * 33], s[5 * 33]); o.w = cvt_pk_bf16(s[6 * 33], s[7 * 33]);
        *(GAS v4u*)(WT + (size_t)(drow0 + n) * K + k0 + 8 * c) = o; }
    LDS_WAIT(); asm volatile("" ::: "memory");
}
__device__ __forceinline__ bool conv_job(const Frame& F, int& it, const float* W, int K, int N, bf16* WT, bool glu, const float* gain) {
    const int nblk = N / 32, nit = (K / 64) * nblk;
    if (it >= nit) { it -= nit; return false; }
    const int kb = it / nblk, nb = it % nblk, n0 = 32 * nb; int drow0 = n0;
    if (glu) { const int bj = n0 >> 10, r = n0 & 1023; drow0 = 256 * (r >> 7) + 128 * bj + (r & 127); }
    transpose_item(W, K, N, WT, drow0, (LAS float*)(F.lds + F.wave * 16384), 64 * kb, n0, F.lane, gain);
    return true;
}
__device__ __forceinline__ void ffn_conv(const Frame& F, int l, const float* w1, const float* w2, const float* gffn, unsigned char* ws, int half) {
    const int gw = F.vcu * NWAVES + F.wave, NGW = F.G * NWAVES;
    for (int it0 = 2048 * half + gw; it0 < 2048 * half + 2048; it0 += NGW) { int it = it0;
        if (conv_job(F, it, w1 + (size_t)l * D * FF, D, FF, (bf16*)(ws + WS_W_FF1), false, gffn + l * D)) continue;
        conv_job(F, it, w2 + (size_t)l * FF * D, FF, D, (bf16*)(ws + WS_W_FF2), false, nullptr);
    }
}

__device__ __forceinline__ void proj_conv(const Frame& F, unsigned char* ws, int grp) {
    const int gw = F.vcu * NWAVES + F.wave, NGW = F.G * NWAVES; const float* gm = inp(F, 6);
    if (grp == 0) {
        for (int it0 = gw; it0 < 2048; it0 += NGW) { int it = it0;
            if (conv_job(F, it, inp(F, 15), D, D, (bf16*)(ws + WS_W_OUTA), false, nullptr)) continue;
            if (conv_job(F, it, inp(F, 16), D, 2048, (bf16*)(ws + WS_W_INB), false, gm + D)) continue;
            conv_job(F, it, inp(F, 24), D, D, (bf16*)(ws + WS_W_OUTB), false, nullptr); }
    } else if (grp == 1) {
        for (int it0 = gw; it0 < 2048; it0 += NGW) { int it = it0;
            if (conv_job(F, it, inp(F, 25), D, D, (bf16*)(ws + WS_W_INC), false, gm + 2 * D)) continue;
            if (conv_job(F, it, inp(F, 34), D, 2048, (bf16*)(ws + WS_W_GLU), true, nullptr)) continue;
            conv_job(F, it, inp(F, 15) + (size_t)D * D, D, D, (bf16*)(ws + WS_W_OUTA + 2 * MiB), false, nullptr); }
    } else {
        for (int it0 = gw; it0 < 1024; it0 += NGW) { int it = it0; conv_job(F, it, inp(F, 11) + (size_t)D * 2048, D, 2048, (bf16*)(ws + WS_W_INA + 4 * MiB), false, gm + 3 * D); }
    }
}

struct Args { const float* in[35]; float* out; unsigned char* ws; int ph_lo, ph_hi; };

__device__ __forceinline__ void prologue_rows(const Frame& F, const float* xp, const float* xs, bf16* XB16, float* SX0) {
    const int gw = F.vcu * NWAVES + F.wave, NGW = F.G * NWAVES;
    for (int row0 = gw; row0 < M; row0 += 3 * NGW) {
        f32x4 v[3][4];
#pragma unroll
        for (int q = 0; q < 3; ++q) { const int row = row0 + q * NGW; if (row < M) {
            const GAS f32x4* xr = (const GAS f32x4*)(row < MP ? xp + (size_t)row * D : xs + (size_t)(row - MP) * D) + F.lane;
#pragma unroll
            for (int j = 0; j < 4; ++j) v[q][j] = xr[64 * j]; } }
#pragma unroll
        for (int q = 0; q < 3; ++q) { const int row = row0 + q * NGW; if (row < M) { float s = 0.f;
#pragma unroll
            for (int j = 0; j < 4; ++j) s += (v[q][j].x * v[q][j].x + v[q][j].y * v[q][j].y) + (v[q][j].z * v[q][j].z + v[q][j].w * v[q][j].w);
            s = wave_sum(s);
            if (row < MP) { if (F.lane < 16) SX0[(size_t)row * XS_P + F.lane] = F.lane == 0 ? s : 0.f; } else SX0[(size_t)MP * XS_P + (size_t)(row - MP) * XS_S + F.lane] = F.lane == 0 ? s : 0.f;
            u32x2* o = (u32x2*)(XB16 + (size_t)row * D) + F.lane;
#pragma unroll
            for (int j = 0; j < 4; ++j) { u32x2 w; w.x = cvt_pk_bf16(v[q][j].x, v[q][j].y); w.y = cvt_pk_bf16(v[q][j].z, v[q][j].w); o[64 * j] = w; } } }
    }
}
__device__ __forceinline__ void norm_final(const Frame& F, const bf16* XB16, float* out, const float* g) {
    const int gw = F.vcu * NWAVES + F.wave, NGW = F.G * NWAVES;
    f32x4 gv[4];
#pragma unroll
    for (int j = 0; j < 4; ++j) gv[j] = ((const f32x4*)g)[F.lane + 64 * j];
    for (int row = gw; row < M; row += NGW) {
        const u32x2* xr = (const u32x2*)(XB16 + (size_t)row * D) + F.lane; f32x4 v[4]; float s = 0.f;
#pragma unroll
        for (int j = 0; j < 4; ++j) { const u32x2 o = xr[64 * j]; v[j] = (f32x4){bflo(o.x), bfhi(o.x), bflo(o.y), bfhi(o.y)}; s += (v[j].x * v[j].x + v[j].y * v[j].y) + (v[j].z * v[j].z + v[j].w * v[j].w); }
        const float rs = rsqrtf(wave_sum(s) * (1.f / D) + EPS);
        f32x4* yo = (f32x4*)(out + (size_t)row * D) + F.lane;
#pragma unroll
        for (int j = 0; j < 4; ++j) yo[64 * j] = v[j] * rs * gv[j];
    }
}

template <class Epi> __device__ __forceinline__ void big_gemm(const Frame& F, const bf16* A, const bf16* WT, int N, int K, const Epi& E) {
    pg8::Gemm g{A, WT, MP, N, K}; pg8::StaticOrder S; S.init(MP, N, F.G, F.bx);
    pg8::gemm_phase<Epi, pg8::StaticOrder, true, true>(F.lds, g, S, E, F.tid);
}

constexpr int VS_STRIDE = 264;
constexpr int SGU_RS_OFF = 128 * VS_STRIDE;
constexpr int SGU_ST_OFF = 40960, SGU_ST_STRIDE = 272;
__device__ __forceinline__ void sgu_mix_phase(const Frame& F, const bf16* UV, const float* SV, const float* sg, const bf16* Wm, const float* bs, const float* wsf, bf16* Y, float* vs_out) {
    LAS unsigned char* Vs = F.lds; LAS float* RS = (LAS float*)(F.lds + SGU_RS_OFF); const int fr = F.lane & 15, fq = F.lane >> 4;
    { const int i = F.tid >> 7, u = F.vcu + 256 * i; if (u < 1024) RS[F.tid] = rs_v(SV, (u >> 3) * 128 + (F.tid & 127)); }
    const int g = F.vcu & 7; const bf16* wg = Wm + (size_t)g * 128 * 128;
    bf16x8 bfr[20]; { int q = 0;
#pragma unroll
        for (int n = 0; n < 8; ++n)
#pragma unroll
            for (int kk = 0; kk <= n / 2; ++kk) bfr[q++] = *(const GAS bf16x8*)((const GAS bf16*)wg + (size_t)(16 * n + fr) * 128 + 32 * kk + 8 * fq); }
    float bb[8];
#pragma unroll
    for (int n = 0; n < 8; ++n) bb[n] = bs[g * 128 + 16 * n + fr];
    const f32x4 g4 = *(const f32x4*)(sg + g * 128 + 16 * F.wave + 4 * fq);
    v4u raw[4]; u32x2 uu[8];
    auto load_unit = [&](int u) { const int r0 = (u >> 3) * 128;
#pragma unroll
        for (int i = 0; i < 4; ++i) { const int id = F.tid + 512 * i, row = id >> 4, ch = id & 15; raw[i] = *(const GAS v4u*)((const GAS bf16*)UV + (size_t)(r0 + row) * 2048 + 1024 + g * 128 + ch * 8); }
#pragma unroll
        for (int n = 0; n < 8; ++n) uu[n] = *(const GAS u32x2*)((const GAS bf16*)UV + (size_t)(r0 + 16 * n + fr) * 2048 + g * 128 + 16 * F.wave + 4 * fq); };
    load_unit(F.vcu);
    __syncthreads();
    for (int ui = 0, u = F.vcu; u < 1024; u += F.G, ++ui) {
        const int r0 = (u >> 3) * 128;
#pragma unroll
        for (int i = 0; i < 4; ++i) { const int id = F.tid + 512 * i, row = id >> 4, ch = id & 15;
            *(LAS u32x2*)(Vs + row * VS_STRIDE + ch * 16) = (u32x2){raw[i].x, raw[i].y}; *(LAS u32x2*)(Vs + row * VS_STRIDE + ch * 16 + 8) = (u32x2){raw[i].z, raw[i].w}; }
        u32x2 uc[8];
#pragma unroll
        for (int n = 0; n < 8; ++n) uc[n] = uu[n];
        if (u + F.G < 1024) load_unit(u + F.G);
        __syncthreads();
        bf16x8 af[4];
#pragma unroll
        for (int kk = 0; kk < 4; ++kk) { float e[8];
#pragma unroll
            for (int j = 0; j < 8; ++j) { const int sr = 32 * kk + 8 * fq + j; e[j] = bf2f(*(const LAS unsigned short*)(Vs + sr * VS_STRIDE + (16 * F.wave + fr) * 2)) * RS[ui * 128 + sr]; }
            v4u p; p.x = cvt_pk_bf16(e[0], e[1]); p.y = cvt_pk_bf16(e[2], e[3]); p.z = cvt_pk_bf16(e[4], e[5]); p.w = cvt_pk_bf16(e[6], e[7]); af[kk] = __builtin_bit_cast(bf16x8, p); }
        f32x4 acc[8]; { int q = 0;
#pragma unroll
            for (int n = 0; n < 8; ++n) { acc[n] = (f32x4){0.f, 0.f, 0.f, 0.f};
#pragma unroll
                for (int kk = 0; kk <= n / 2; ++kk) acc[n] = __builtin_amdgcn_mfma_f32_16x16x32_bf16(af[kk], bfr[q++], acc[n], 0, 0, 0); } }
#pragma unroll
        for (int n = 0; n < 8; ++n) { const int t = 16 * n + fr, row = r0 + t, col = g * 128 + 16 * F.wave + 4 * fq;
            u32x2 w; w.x = cvt_pk_bf16(bflo(uc[n].x) * (acc[n][0] * g4.x + bb[n]), bfhi(uc[n].x) * (acc[n][1] * g4.y + bb[n])); w.y = cvt_pk_bf16(bflo(uc[n].y) * (acc[n][2] * g4.z + bb[n]), bfhi(uc[n].y) * (acc[n][3] * g4.w + bb[n]));
            (void)row; (void)col; *(LAS u32x2*)(F.lds + SGU_ST_OFF + t * SGU_ST_STRIDE + (16 * F.wave + 4 * fq) * 2) = w; }
        __syncthreads();
#pragma unroll
        for (int i = 0; i < 4; ++i) { const int id = F.tid + 512 * i, row = id >> 4, ch = id & 15;
            *(GAS v4u*)((GAS bf16*)Y + (size_t)(r0 + row) * 1024 + g * 128 + ch * 8) = *(const LAS v4u*)(F.lds + SGU_ST_OFF + row * SGU_ST_STRIDE + ch * 16); }
        __syncthreads();
    }
    for (int it = F.vcu * 512 + F.tid; it < 128 * 256; it += F.G * 512) {
        const int b = it >> 8, d = (it & 255) * 4, gh = d >> 7, rowb = MP + b * 4; const f32x4 gg = *(const f32x4*)(sg + d);
        float v[4][4], uu[4][4];
#pragma unroll
        for (int s = 0; s < 4; ++s) { const u32x2 rv = *(const u32x2*)(UV + (size_t)(rowb + s) * 2048 + 1024 + d), ru = *(const u32x2*)(UV + (size_t)(rowb + s) * 2048 + d); const float rs = rs_v(SV, rowb + s);
            v[s][0] = bflo(rv.x) * rs; v[s][1] = bfhi(rv.x) * rs; v[s][2] = bflo(rv.y) * rs; v[s][3] = bfhi(rv.y) * rs;
            uu[s][0] = bflo(ru.x); uu[s][1] = bfhi(ru.x); uu[s][2] = bflo(ru.y); uu[s][3] = bfhi(ru.y);
            *(f32x4*)(vs_out + (size_t)(b * 4 + s) * 1024 + d) = (f32x4){v[s][0] * gg.x, v[s][1] * gg.y, v[s][2] * gg.z, v[s][3] * gg.w}; }
#pragma unroll
        for (int t = 0; t < 4; ++t) { float m[4] = {0.f, 0.f, 0.f, 0.f};
#pragma unroll
            for (int s = 0; s <= t; ++s) { const float w = wsf[((size_t)gh * 128 + t) * 128 + s];
#pragma unroll
                for (int e = 0; e < 4; ++e) m[e] += w * v[s][e]; }
            const float bb = bs[gh * 128 + t];
            u32x2 w; w.x = cvt_pk_bf16(uu[t][0] * (m[0] * gg.x + bb), uu[t][1] * (m[1] * gg.y + bb)); w.y = cvt_pk_bf16(uu[t][2] * (m[2] * gg.z + bb), uu[t][3] * (m[3] * gg.w + bb));
            *(u32x2*)(Y + (size_t)(rowb + t) * 1024 + d) = w; }
    }
}
constexpr size_t RGT_W = 0, RGT_BA = 512 * 1024, RGT_BX = RGT_BA + 4096, RGT_NSP = RGT_BX + 4096;
__device__ __forceinline__ int rg_jch(int m, int r) { return 8 * (r >> 2) + 4 * (m & 1) + (r & 3) + 32 * (m >> 1); }
__device__ __forceinline__ void rglru_tables(const Frame& F, const float* wa, const float* wx, const float* ba, const float* bx, const float* lam, unsigned char* tab) {
    bf16* W = (bf16*)(tab + RGT_W);
    for (int i = F.vcu * 512 + F.tid; i < 16 * 2 * 4 * 2 * 64 * 8; i += F.G * 512) {
        const int e = i & 7, lane = (i >> 3) & 63, ks = (i >> 9) & 1, m = (i >> 10) & 3, type = (i >> 12) & 1, h = i >> 13, fr = lane & 15, fq = lane >> 4;
        const float* w = type ? wx : wa; const float v = w[((size_t)h * 64 + 32 * ks + 8 * fq + e) * 64 + rg_jch(m, fr)];
        W[i] = (bf16)(cvt_pk_bf16(v, 0.f) & 0xffffu);
    }
    for (int c = F.vcu * 512 + F.tid; c < 1024; c += F.G * 512) {
        ((float*)(tab + RGT_BA))[c] = ba[c]; ((float*)(tab + RGT_BX))[c] = bx[c]; ((float*)(tab + RGT_NSP))[c] = -8.0f * log1pf(expf(-lam[c]));
    }
}
template <int CTRL> __device__ __forceinline__ float dpp_f(float old, float src) {
    return __builtin_bit_cast(float, __builtin_amdgcn_update_dpp(__builtin_bit_cast(int, old), __builtin_bit_cast(int, src), CTRL, 0xf, 0xf, false)); }
template <int CTRL> __device__ __forceinline__ float dpp_z(float src) {
    return __builtin_bit_cast(float, __builtin_amdgcn_update_dpp(0, __builtin_bit_cast(int, src), CTRL, 0xf, 0xf, true)); }
constexpr int RG_XC_STRIDE = 68, RG_XC_BYTES = 128 * RG_XC_STRIDE * 4, RG_TOT_OFF = 2 * RG_XC_BYTES, RG_CARRY_OFF = RG_TOT_OFF + 2 * 2 * 8 * 64 * 4, RG_AF_OFF = RG_CARRY_OFF + 512, RG_CT_OFF = RG_AF_OFF + 16384;
template <int D_, bool SAMPLE, int NCH> __device__ __forceinline__ void ks_step(float (&a)[NCH], float (&b)[NCH], int tt) {
#pragma unroll
    for (int i = 0; i < NCH; ++i) {
        float as = dpp_f<0x110 + D_>(1.0f, a[i]), bs = dpp_z<0x110 + D_>(b[i]);
        if (SAMPLE) { const bool ok = tt >= D_; as = ok ? as : 1.0f; bs = ok ? bs : 0.0f; }
        b[i] = a[i] * bs + b[i]; a[i] = a[i] * as;
    }
}
template <bool SAMPLE>
__device__ __forceinline__ void rglru_unit(const Frame& F, int unit, const float* XB, const bf16* G, bf16* Y, const float* cw, const float* cb, const unsigned char* tab,
                                           const float* cstate, const float* hstate, float* conv_out, float* h_out) {
    constexpr int NCH = SAMPLE ? 16 : 8, NM = NCH / 4, CW = SAMPLE ? 64 : 32;
    const int fr = F.lane & 15, fq = F.lane >> 4, w = F.wave;
    int h, b0, rowbase, nchunk, mh;
    if (SAMPLE) { h = unit >> 2; b0 = (unit & 3) * 32; rowbase = MP + b0 * 4; nchunk = 1; mh = 0; }
    else { b0 = unit >> 5; h = (unit >> 1) & 15; mh = unit & 1; rowbase = b0 * 2048; nchunk = 16; }
    LAS float* XC = (LAS float*)F.lds; LAS float* TOT = (LAS float*)(F.lds + RG_TOT_OFF); LAS float* CARRY = (LAS float*)(F.lds + RG_CARRY_OFF);
    const int chq = F.tid & 15, rg = F.tid >> 4, cA = h * 64 + 4 * chq;
    f32x4 nx[7]; u32x2 nq[7];
    auto loadA = [&](int c) {
#pragma unroll
        for (int i = 0; i < 7; ++i) {
            if (SAMPLE) { if (i < 3) nx[i] = *(const GAS f32x4*)((const GAS float*)cstate + ((size_t)(b0 + rg) * 3 + i) * 1024 + cA);
                else { const u32x2 q = *(const GAS u32x2*)((const GAS bf16*)XB + (size_t)(rowbase + rg * 4 + i - 3) * 1024 + cA); nx[i] = (f32x4){bflo(q.x), bfhi(q.x), bflo(q.y), bfhi(q.y)}; } }
            else { const int tau = c * 128 + 4 * rg + i - 3, tc = tau < 0 ? 0 : tau;
                nq[i] = *(const GAS u32x2*)((const GAS bf16*)XB + (size_t)(rowbase + tc) * 1024 + cA); } } };
    loadA(0);
    { const v4u* src = (const v4u*)((const bf16*)(tab + RGT_W) + (size_t)h * 16 * 64 * 8); LAS v4u* dst = (LAS v4u*)(F.lds + RG_AF_OFF);
      dst[F.tid] = src[F.tid]; dst[F.tid + 512] = src[F.tid + 512]; }
    { LAS float* CT = (LAS float*)(F.lds + RG_CT_OFF);
      if (F.tid < 64) { CT[F.tid] = ((const float*)(tab + RGT_BA))[h * 64 + F.tid]; CT[64 + F.tid] = ((const float*)(tab + RGT_BX))[h * 64 + F.tid]; CT[128 + F.tid] = ((const float*)(tab + RGT_NSP))[h * 64 + F.tid];
                        CT[448 + F.tid] = cb[h * 64 + F.tid]; }
      if (F.tid < 256) CT[192 + F.tid] = cw[(F.tid >> 6) * 1024 + h * 64 + (F.tid & 63)]; }
    __syncthreads();
    const LAS float* CTL = (const LAS float*)(F.lds + RG_CT_OFF);
    const LAS bf16x8* AfL = (const LAS bf16x8*)(F.lds + RG_AF_OFF) + F.lane;
    const int chl = h * 64 + 32 * mh + 8 * fq;
    for (int c = 0; c < nchunk; ++c) {
        const int buf = c & 1, c0 = c * 128;
        if (!SAMPLE) {
#pragma unroll
            for (int i = 0; i < 7; ++i) { const bool z = c == 0 && 4 * rg + i - 3 < 0; const u32x2 q = nq[i]; nx[i] = z ? (f32x4){0.f, 0.f, 0.f, 0.f} : (f32x4){bflo(q.x), bfhi(q.x), bflo(q.y), bfhi(q.y)}; } }
        { f32x4 cwv[4];
#pragma unroll
          for (int k = 0; k < 4; ++k) cwv[k] = *(const LAS f32x4*)(CTL + 192 + k * 64 + 4 * chq);
          const f32x4 cbv = *(const LAS f32x4*)(CTL + 448 + 4 * chq);
#pragma unroll
          for (int i = 0; i < 4; ++i) { f32x4 acc = cbv;
#pragma unroll
              for (int k = 0; k < 4; ++k) acc = acc + cwv[k] * nx[i + k];
              *(LAS f32x4*)(XC + (size_t)buf * (128 * RG_XC_STRIDE) + (4 * rg + i) * RG_XC_STRIDE + 4 * chq) = acc; } }
        if (c + 1 < nchunk) loadA(c + 1);
        const int trow = 16 * w + fr;
        const size_t o0 = ((size_t)rowbase + c0 + trow) * 1024 + (SAMPLE ? h * 64 + 8 * fq : chl);
        const v4u g0 = *(const GAS v4u*)((const GAS bf16*)G + o0); v4u g1 = g0; if (SAMPLE) g1 = *(const GAS v4u*)((const GAS bf16*)G + o0 + 32);
        __syncthreads();
        float xc[16];
        { const LAS float* xp = XC + (size_t)buf * (128 * RG_XC_STRIDE) + trow * RG_XC_STRIDE + 8 * fq;
          const f32x4 x0 = *(const LAS f32x4*)(xp), x1 = *(const LAS f32x4*)(xp + 4), x2 = *(const LAS f32x4*)(xp + 32), x3 = *(const LAS f32x4*)(xp + 36);
          xc[0] = x0.x; xc[1] = x0.y; xc[2] = x0.z; xc[3] = x0.w; xc[4] = x1.x; xc[5] = x1.y; xc[6] = x1.z; xc[7] = x1.w;
          xc[8] = x2.x; xc[9] = x2.y; xc[10] = x2.z; xc[11] = x2.w; xc[12] = x3.x; xc[13] = x3.y; xc[14] = x3.z; xc[15] = x3.w; }
        bf16x8 bf0, bf1;
        { v4u p0, p1; p0.x = cvt_pk_bf16(xc[0], xc[1]); p0.y = cvt_pk_bf16(xc[2], xc[3]); p0.z = cvt_pk_bf16(xc[4], xc[5]); p0.w = cvt_pk_bf16(xc[6], xc[7]);
          p1.x = cvt_pk_bf16(xc[8], xc[9]); p1.y = cvt_pk_bf16(xc[10], xc[11]); p1.z = cvt_pk_bf16(xc[12], xc[13]); p1.w = cvt_pk_bf16(xc[14], xc[15]);
          bf0 = __builtin_bit_cast(bf16x8, p0); bf1 = __builtin_bit_cast(bf16x8, p1); }
        float av[NCH], bv[NCH];
#pragma unroll
        for (int mm = 0; mm < NM; ++mm) { const int m = SAMPLE ? mm : 2 * mh + mm;
            f32x4 ra = (f32x4){0.f, 0.f, 0.f, 0.f}, rx = ra;
            ra = __builtin_amdgcn_mfma_f32_16x16x32_bf16(AfL[((0 * 4 + m) * 2 + 0) * 64], bf0, ra, 0, 0, 0); ra = __builtin_amdgcn_mfma_f32_16x16x32_bf16(AfL[((0 * 4 + m) * 2 + 1) * 64], bf1, ra, 0, 0, 0);
            rx = __builtin_amdgcn_mfma_f32_16x16x32_bf16(AfL[((1 * 4 + m) * 2 + 0) * 64], bf0, rx, 0, 0, 0); rx = __builtin_amdgcn_mfma_f32_16x16x32_bf16(AfL[((1 * 4 + m) * 2 + 1) * 64], bf1, rx, 0, 0, 0);
            const int cg = h * 64 + 8 * fq + 4 * (m & 1) + 32 * (m >> 1);
            const int cgl = cg - h * 64; const f32x4 ba4 = *(const LAS f32x4*)(CTL + cgl), bx4 = *(const LAS f32x4*)(CTL + 64 + cgl), ns4 = *(const LAS f32x4*)(CTL + 128 + cgl);
#pragma unroll
            for (int r = 0; r < 4; ++r) { const float rg_ = sigmoid_fast(ra[r] + ba4[r]), ig = sigmoid_fast(rx[r] + bx4[r]);
                const float la = ns4[r] * rg_, a = __builtin_amdgcn_exp2f(1.4426950408889634f * la), mult = __builtin_amdgcn_sqrtf(fmaxf(1.f - a * a, 0.f));
                const float xcv = SAMPLE ? xc[4 * mm + r] : (mh ? xc[8 + 4 * mm + r] : xc[4 * mm + r]);
                av[4 * mm + r] = a; bv[4 * mm + r] = mult * ig * xcv; }
        }
        const int tt = fr & 3;
        if (SAMPLE) {
            const int bi = (16 * w + fr) >> 2;
#pragma unroll
            for (int m = 0; m < 4; ++m) { const int cg = h * 64 + 8 * fq + 4 * (m & 1) + 32 * (m >> 1); const f32x4 h0 = *(const f32x4*)(hstate + (size_t)(b0 + bi) * 1024 + cg);
#pragma unroll
                for (int r = 0; r < 4; ++r) if (tt == 0) bv[4 * m + r] += av[4 * m + r] * h0[r]; }
            ks_step<1, true, NCH>(av, bv, tt); ks_step<2, true, NCH>(av, bv, tt);
        } else {
            ks_step<1, false, NCH>(av, bv, tt); ks_step<2, false, NCH>(av, bv, tt); ks_step<4, false, NCH>(av, bv, tt); ks_step<8, false, NCH>(av, bv, tt);
            if (fr == 15) { LAS float* ta = TOT + ((size_t)(buf * 2 + 0) * 8 + w) * 64 + fq * NCH; LAS float* th = TOT + ((size_t)(buf * 2 + 1) * 8 + w) * 64 + fq * NCH;
#pragma unroll
                for (int i = 0; i < NCH; i += 4) { *(LAS f32x4*)(ta + i) = (f32x4){av[i], av[i + 1], av[i + 2], av[i + 3]}; *(LAS f32x4*)(th + i) = (f32x4){bv[i], bv[i + 1], bv[i + 2], bv[i + 3]}; } }
            __syncthreads();
            float ch[NCH];
            if (c == 0) {
#pragma unroll
                for (int i = 0; i < NCH; ++i) ch[i] = 0.f;
            } else {
#pragma unroll
                for (int i = 0; i < NCH; i += 4) { const f32x4 t = *(const LAS f32x4*)(CARRY + buf * 64 + fq * NCH + i); ch[i] = t.x; ch[i + 1] = t.y; ch[i + 2] = t.z; ch[i + 3] = t.w; }
            }
            for (int v = 0; v < w; ++v) { const LAS float* ta = TOT + ((size_t)(buf * 2 + 0) * 8 + v) * 64 + fq * NCH; const LAS float* th = TOT + ((size_t)(buf * 2 + 1) * 8 + v) * 64 + fq * NCH;
#pragma unroll
                for (int i = 0; i < NCH; i += 4) { const f32x4 A4 = *(const LAS f32x4*)(ta + i), H4 = *(const LAS f32x4*)(th + i);
                    ch[i] = A4.x * ch[i] + H4.x; ch[i + 1] = A4.y * ch[i + 1] + H4.y; ch[i + 2] = A4.z * ch[i + 2] + H4.z; ch[i + 3] = A4.w * ch[i + 3] + H4.w; } }
#pragma unroll
            for (int i = 0; i < NCH; ++i) bv[i] = bv[i] + av[i] * ch[i];
            if (w == 7 && fr == 15) {
#pragma unroll
                for (int i = 0; i < NCH; i += 4) *(LAS f32x4*)(CARRY + (buf ^ 1) * 64 + fq * NCH + i) = (f32x4){bv[i], bv[i + 1], bv[i + 2], bv[i + 3]}; }
        }
        { v4u y0;
          y0.x = cvt_pk_bf16(bv[0] * bflo(g0.x), bv[1] * bfhi(g0.x)); y0.y = cvt_pk_bf16(bv[2] * bflo(g0.y), bv[3] * bfhi(g0.y)); y0.z = cvt_pk_bf16(bv[4] * bflo(g0.z), bv[5] * bfhi(g0.z)); y0.w = cvt_pk_bf16(bv[6] * bflo(g0.w), bv[7] * bfhi(g0.w));
          *(v4u*)(Y + o0) = y0;
          if constexpr (SAMPLE) { v4u y1;
            y1.x = cvt_pk_bf16(bv[8] * bflo(g1.x), bv[9] * bfhi(g1.x)); y1.y = cvt_pk_bf16(bv[10] * bflo(g1.y), bv[11] * bfhi(g1.y)); y1.z = cvt_pk_bf16(bv[12] * bflo(g1.z), bv[13] * bfhi(g1.z)); y1.w = cvt_pk_bf16(bv[14] * bflo(g1.w), bv[15] * bfhi(g1.w));
            *(v4u*)(Y + o0 + 32) = y1; } }
        if constexpr (SAMPLE) {
            if (tt == 3) { const int bi = (16 * w + fr) >> 2; float* ho = h_out + (size_t)(b0 + bi) * 1024 + h * 64 + 8 * fq;
                *(f32x4*)(ho) = (f32x4){bv[0], bv[1], bv[2], bv[3]}; *(f32x4*)(ho + 4) = (f32x4){bv[4], bv[5], bv[6], bv[7]};
                *(f32x4*)(ho + 32) = (f32x4){bv[8], bv[9], bv[10], bv[11]}; *(f32x4*)(ho + 36) = (f32x4){bv[12], bv[13], bv[14], bv[15]}; }
        } else if (c == nchunk - 1 && w == 7 && fr == 15) { float* ho = h_out + (size_t)b0 * 1024 + chl;
            *(f32x4*)(ho) = (f32x4){bv[0], bv[1], bv[2], bv[3]}; *(f32x4*)(ho + 4) = (f32x4){bv[4], bv[5], bv[6], bv[7]}; }
    }
    if (SAMPLE) { for (int i = F.tid; i < 32 * 3 * 64; i += 512) { const int cc = i & 63, r = (i >> 6) % 3, bi = i / 192;
            conv_out[((size_t)(b0 + bi) * 3 + r) * 1024 + h * 64 + cc] = bf2f(((const bf16*)XB)[(size_t)(rowbase + bi * 4 + 1 + r) * 1024 + h * 64 + cc]); } }
    else if (mh == 0 && F.tid < 192) { const int cc = F.tid & 63, r = F.tid >> 6; conv_out[((size_t)b0 * 3 + r) * 1024 + h * 64 + cc] = bf2f(((const bf16*)XB)[(size_t)(rowbase + 2045 + r) * 1024 + h * 64 + cc]); }
    __syncthreads();
}
__device__ __forceinline__ void rglru_phase(const Frame& F, const float* XB, const bf16* G, bf16* Y, const float* cw, const float* cb, const unsigned char* tab, const float* cstate, const float* hstate, float* out) {
    for (int unit = F.vcu; unit < 320; unit += F.G) {
        if (unit < 256) rglru_unit<false>(F, unit, XB, G, Y, cw, cb, tab, nullptr, nullptr, out + O_CONVP, out + O_HP);
        else rglru_unit<true>(F, unit - 256, XB, G, Y, cw, cb, tab, cstate, hstate, out + O_CONVS, out + O_HS);
    }
}
typedef float f32x16 __attribute__((ext_vector_type(16)));
typedef float f32x2 __attribute__((ext_vector_type(2)));
constexpr size_t S5T_AP = 0, S5T_BF = 128 * 1024, S5T_CF = S5T_BF + 256 * 1024;
__device__ __forceinline__ void s5_disc(const float* lre, const float* lim, const float* ldt, int g, int p, float& ar, float& ai, float& qr, float& qi) {
    const float dt = expf(ldt[g]), lr = lre[g * 64 + p], li = lim[g * 64 + p], mag = expf(lr * dt); ar = mag * cosf(li * dt); ai = mag * sinf(li * dt);
    const float zr = ar - 1.f, zi = ai, den = lr * lr + li * li; qr = (zr * lr + zi * li) / den; qi = (zi * lr - zr * li) / den;
}
__device__ __forceinline__ void s5_tables(const Frame& F, const float* lre, const float* lim, const float* ldt, const float* bre, const float* bim, const float* cre, const float* cim, unsigned char* tab) {
    for (int i = F.vcu * 512 + F.tid; i < 4096; i += F.G * 512) { float ar, ai, qr, qi; s5_disc(lre, lim, ldt, i >> 6, i & 63, ar, ai, qr, qi);
        float* o = (float*)(tab + S5T_AP) + (size_t)i * 8; o[0] = ar; o[1] = ai;
        const float r2 = ar * ar - ai * ai, i2 = 2.f * ar * ai; o[2] = r2; o[3] = i2; const float r3 = r2 * ar - i2 * ai, i3 = r2 * ai + i2 * ar; o[4] = r3; o[5] = i3; o[6] = r2 * r2 - i2 * i2; o[7] = 2.f * r2 * i2; }
    for (int i = F.vcu * 512 + F.tid; i < 64 * 2 * 2 * 64 * 8; i += F.G * 512) {
        const int j = i & 7, lane = (i >> 3) & 63, c = (i >> 9) & 1, ws = (i >> 10) & 1, g = i >> 11, p = 32 * ws + (lane & 31), h = 8 * (lane >> 5) + j;
        float ar, ai, qr, qi; s5_disc(lre, lim, ldt, g, p, ar, ai, qr, qi);
        const float br = bre[((size_t)g * 64 + p) * 16 + h], bi = bim[((size_t)g * 64 + p) * 16 + h]; const float v = c ? (qr * bi + qi * br) : (qr * br - qi * bi);
        ((bf16*)(tab + S5T_BF))[i] = (bf16)(cvt_pk_bf16(v, 0.f) & 0xffffu);
    }
    for (int i = F.vcu * 512 + F.tid; i < 64 * 4 * 64 * 8; i += F.G * 512) {
        const int j = i & 7, lane = (i >> 3) & 63, kk = (i >> 9) & 3, g = i >> 11, h = lane & 15, k = 32 * kk + 8 * (lane >> 4) + j, p = k >> 1;
        const float v = (k & 1) ? -cim[((size_t)g * 16 + h) * 64 + p] : cre[((size_t)g * 16 + h) * 64 + p];
        ((bf16*)(tab + S5T_CF))[i] = (bf16)(cvt_pk_bf16(v, 0.f) & 0xffffu);
    }
}
constexpr int S5_XT_STRIDE = 272;
constexpr int S5_XT_UNIT = 128 * S5_XT_STRIDE;
__device__ __forceinline__ f32x2 cmadd(f32x2 a, f32x2 x, f32x2 c) {
    c = (f32x2){a.x, a.x} * x + c; return (f32x2){-a.y, a.y} * __builtin_shufflevector(x, x, 1, 0) + c; }
template <bool SAMPLE>
__device__ __forceinline__ void s5_pass(const Frame& F, int upair, const float* U, bf16* Gs, const float* dsk, const unsigned char* tab, const float* sre, const float* sim, float* ore, float* oim) {
    const int w = F.wave, l31 = F.lane & 31, hh = F.lane >> 5, fr = F.lane & 15, fq = F.lane >> 4;
    constexpr int NTILE = SAMPLE ? 1 : 4, NCHUNK = SAMPLE ? 1 : 16, CROWS = SAMPLE ? 32 : 128;
    LAS unsigned char* XT = F.lds;
    const int su = (w >> 1) & 1, ws = w & 1, sunit = upair * 2 + su;
    int sg, srow, sb0; if (SAMPLE) { sg = sunit >> 4; sb0 = (sunit & 15) * 8; srow = MP + sb0 * 4; } else { sb0 = sunit >> 6; sg = sunit & 63; srow = sb0 * 2048; }
    const int pw = SAMPLE ? ((w >> 1) & 1) : (w >> 2), punit = upair * 2 + pw;
    int pg, prow; if (SAMPLE) { pg = punit >> 4; prow = MP + (punit & 15) * 32; } else { pg = punit & 63; prow = (punit >> 6) * 2048; }
    bf16x8 Cf[4];
#pragma unroll
    for (int kk = 0; kk < 4; ++kk) Cf[kk] = *(const bf16x8*)((const bf16*)(tab + S5T_CF) + (((size_t)pg * 4 + kk) * 64 + F.lane) * 8);
    const f32x4 d4 = *(const f32x4*)(dsk + pg * 16 + 4 * fq);
    f32x2 A1, A2, A3, A4, X = (f32x2){0.f, 0.f}; bf16x8 Bf0, Bf1; v4u ua[NTILE];
    if (w < 4) {
        const f32x4* a4 = (const f32x4*)((const float*)(tab + S5T_AP) + ((size_t)sg * 64 + 32 * ws + l31) * 8); const f32x4 lo = a4[0], hi = a4[1];
        A1 = (f32x2){lo.x, lo.y}; A2 = (f32x2){lo.z, lo.w}; A3 = (f32x2){hi.x, hi.y}; A4 = (f32x2){hi.z, hi.w};
        Bf0 = *(const bf16x8*)((const bf16*)(tab + S5T_BF) + ((((size_t)sg * 2 + ws) * 2 + 0) * 64 + F.lane) * 8);
        Bf1 = *(const bf16x8*)((const bf16*)(tab + S5T_BF) + ((((size_t)sg * 2 + ws) * 2 + 1) * 64 + F.lane) * 8);
#pragma unroll
        for (int tl = 0; tl < NTILE; ++tl) if (SAMPLE) ua[tl] = *(const GAS v4u*)((const GAS bf16*)U + ((size_t)srow + tl * 32 + l31) * 1024 + sg * 16 + 8 * hh);
    }
    constexpr int S5_YS_OFF = 2 * S5_XT_UNIT, S5_YS_STRIDE = 80, S5_YS_BUF = 128 * S5_YS_STRIDE;
    const int ys_row = 16 * F.wave + (F.lane >> 2), ys_pc = F.lane & 3;
    bf16* ys_dst = Gs + ((size_t)((upair * 2) >> 6) * 2048 + ys_row) * 1024 + ((upair * 2) & 63) * 16 + ys_pc * 8;
    constexpr int S5_UL_OFF = S5_YS_OFF + 2 * S5_YS_BUF, S5_UL_STRIDE = 80, S5_UL_BUF = 128 * S5_UL_STRIDE;
    const GAS bf16* ul_src = (const GAS bf16*)U + ((size_t)((upair * 2) >> 6) * 2048 + ys_row) * 1024 + ((upair * 2) & 63) * 16 + ys_pc * 8;
    v4u un = (v4u){0u, 0u, 0u, 0u};
    if (!SAMPLE) { un = *(const GAS v4u*)ul_src; *(LAS v4u*)(F.lds + S5_UL_OFF + ys_row * S5_UL_STRIDE + ys_pc * 16) = un; __syncthreads(); }
    for (int c = 0; c < NCHUNK; ++c) {
        if (!SAMPLE && c + 1 < NCHUNK) un = *(const GAS v4u*)(ul_src + (size_t)(c + 1) * 128 * 1024);
        if (!SAMPLE && c > 0) *(GAS v4u*)((GAS bf16*)ys_dst + (size_t)(c - 1) * 128 * 1024) = *(const LAS v4u*)(F.lds + S5_YS_OFF + ((c - 1) & 1) * S5_YS_BUF + ys_row * S5_YS_STRIDE + ys_pc * 16);
        u32x2 up4[2];
#pragma unroll
        for (int q2 = 0; q2 < (SAMPLE ? 1 : 2); ++q2) { const int st = SAMPLE ? (w & 1) : ((w & 3) * 2 + q2);
            if (SAMPLE) up4[q2] = *(const GAS u32x2*)((const GAS bf16*)U + ((size_t)prow + c * 128 + st * 16 + fr) * 1024 + pg * 16 + 4 * fq);
            else up4[q2] = (u32x2){0u, 0u}; }
        if (w < 4) {
#pragma unroll
            for (int tl = 0; tl < NTILE; ++tl) {
                const v4u aw = SAMPLE ? ua[tl] : *(const LAS v4u*)(F.lds + S5_UL_OFF + (c & 1) * S5_UL_BUF + (tl * 32 + l31) * S5_UL_STRIDE + su * 32 + hh * 16);
                const bf16x8 Au = __builtin_bit_cast(bf16x8, aw); f32x16 z16;
#pragma unroll
                for (int i = 0; i < 16; ++i) z16[i] = 0.f;
                const f32x16 bur = __builtin_amdgcn_mfma_f32_32x32x16_bf16(Au, Bf0, z16, 0, 0, 0), bui = __builtin_amdgcn_mfma_f32_32x32x16_bf16(Au, Bf1, z16, 0, 0, 0);
                f32x2 x[16];
#pragma unroll
                for (int k = 0; k < 4; ++k) { f32x2 s = (f32x2){0.f, 0.f};
                    if (SAMPLE) { const size_t so = ((size_t)(sb0 + 2 * k + hh) * 64 + sg) * 64 + 32 * ws + l31; s = (f32x2){sre[so], sim[so]}; }
#pragma unroll
                    for (int i = 0; i < 4; ++i) { const f32x2 bu = (f32x2){bur[4 * k + i], bui[4 * k + i]}; s = (!SAMPLE && i == 0) ? bu : cmadd(A1, s, bu); x[4 * k + i] = s; } }
                if (!SAMPLE) {
                    f32x2 xin[4];
#pragma unroll
                    for (int k = 0; k < 4; ++k) {
                        const f32x2 own = x[4 * k + 3]; float ax = own.x, bx = own.x, ay = own.y, by = own.y;
                        asm volatile("v_nop\n\tv_nop\n\tv_permlane32_swap_b32 %0, %1" : "+v"(ax), "+v"(bx)); asm volatile("v_nop\n\tv_nop\n\tv_permlane32_swap_b32 %0, %1" : "+v"(ay), "+v"(by));
                        const f32x2 L0 = (f32x2){ax, ay}, L1 = (f32x2){bx, by};
                        const f32x2 X0 = X; const f32x2 X1 = cmadd(A4, X0, L0); X = cmadd(A4, X1, L1);
                        xin[k] = hh ? X1 : X0; }
#pragma unroll
                    for (int k = 0; k < 4; ++k) { x[4 * k + 0] = cmadd(A1, xin[k], x[4 * k + 0]); x[4 * k + 1] = cmadd(A2, xin[k], x[4 * k + 1]); x[4 * k + 2] = cmadd(A3, xin[k], x[4 * k + 2]); x[4 * k + 3] = cmadd(A4, xin[k], x[4 * k + 3]); }
                }
                LAS unsigned char* xt = XT + su * S5_XT_UNIT + (32 * ws + l31) * 4;
#pragma unroll
                for (int r = 0; r < 16; ++r) *(LAS unsigned*)(xt + (tl * 32 + 8 * (r >> 2) + 4 * hh + (r & 3)) * S5_XT_STRIDE) = cvt_pk_bf16(x[r].x, x[r].y);
                if (SAMPLE) {
#pragma unroll
                    for (int k = 0; k < 4; ++k) { const size_t so = ((size_t)(sb0 + 2 * k + hh) * 64 + sg) * 64 + 32 * ws + l31; ore[so] = x[4 * k + 3].x; oim[so] = x[4 * k + 3].y; } }
            }
        }
        __syncthreads();
        if (!SAMPLE || w < 4) {
#pragma unroll
            for (int q2 = 0; q2 < (SAMPLE ? 1 : 2); ++q2) { const int st = SAMPLE ? (w & 1) : ((w & 3) * 2 + q2);
                const size_t row = (size_t)prow + c * 128 + st * 16 + fr; const int ch = pg * 16 + 4 * fq;
                const u32x2 uq = SAMPLE ? up4[q2] : *(const LAS u32x2*)(F.lds + S5_UL_OFF + (c & 1) * S5_UL_BUF + (st * 16 + fr) * S5_UL_STRIDE + pw * 32 + fq * 8);
                const f32x4 u4 = (f32x4){bflo(uq.x), bfhi(uq.x), bflo(uq.y), bfhi(uq.y)};
                const LAS unsigned char* xr = XT + pw * S5_XT_UNIT + (st * 16 + fr) * S5_XT_STRIDE + 16 * fq; f32x4 y = (f32x4){0.f, 0.f, 0.f, 0.f};
#pragma unroll
                for (int kk = 0; kk < 4; ++kk) y = __builtin_amdgcn_mfma_f32_16x16x32_bf16(Cf[kk], *(const LAS bf16x8*)(xr + 64 * kk), y, 0, 0, 0);
                y = y + d4 * u4;
                u32x2 o; o.x = cvt_pk_bf16(gelu_fast(y.x), gelu_fast(y.y)); o.y = cvt_pk_bf16(gelu_fast(y.z), gelu_fast(y.w));
                if (SAMPLE) *(u32x2*)(Gs + row * 1024 + ch) = o; else *(LAS u32x2*)(F.lds + S5_YS_OFF + (c & 1) * S5_YS_BUF + (st * 16 + fr) * S5_YS_STRIDE + pw * 32 + fq * 8) = o; }
        }
        if (!SAMPLE && c + 1 < NCHUNK) *(LAS v4u*)(F.lds + S5_UL_OFF + ((c + 1) & 1) * S5_UL_BUF + ys_row * S5_UL_STRIDE + ys_pc * 16) = un;
        __syncthreads();
    }
    if (!SAMPLE) *(GAS v4u*)((GAS bf16*)ys_dst + (size_t)(NCHUNK - 1) * 128 * 1024) = *(const LAS v4u*)(F.lds + S5_YS_OFF + ((NCHUNK - 1) & 1) * S5_YS_BUF + ys_row * S5_YS_STRIDE + ys_pc * 16);
    if (!SAMPLE && w < 4 && hh == 0) { const size_t so = ((size_t)sb0 * 64 + sg) * 64 + 32 * ws + l31; ore[so] = X.x; oim[so] = X.y; }
    if (!SAMPLE) __syncthreads();
}
__device__ __forceinline__ void s5_phase(const Frame& F, const float* U, bf16* Gs, const float* dsk, const unsigned char* tab, const float* sre, const float* sim, float* out) {
    for (int u0 = F.vcu; u0 < 256; u0 += F.G) s5_pass<false>(F, u0, U, Gs, dsk, tab, nullptr, nullptr, out + O_SREP, out + O_SIMP);
    for (int u0 = F.vcu; u0 < 512; u0 += F.G) s5_pass<true>(F, u0, U, Gs, dsk, tab, sre, sim, out + O_SRES, out + O_SIMS);
}
constexpr int PH_FINAL = 21, PH_END = 22;
enum { ST_GIN = 0, ST_MIX = 1, ST_GOUT = 2, ST_FF1 = 3, ST_FF2 = 4 };
constexpr size_t WS_SX0 = 172 * MiB, WS_SX1 = 175 * MiB, WS_SV = 178 * MiB;
constexpr size_t T_Y = 99 * MiB;

__global__ void __launch_bounds__(NWAVES * 64, 2) mk(Args a) {
    extern __shared__ __attribute__((aligned(16))) unsigned char lds_raw[];
    Frame F; F.lds = (LAS unsigned char*)lds_raw; F.tid = threadIdx.x; F.lane = F.tid & 63; F.wave = __builtin_amdgcn_readfirstlane(F.tid >> 6);
    F.G = gridDim.x; F.bx = blockIdx.x; F.vcu = (F.bx % 8) * (F.G / 8) + F.bx / 8;
    volatile LAS unsigned* MISC = (volatile LAS unsigned*)(F.lds + MISC_OFF);
    for (int u = F.tid; u < (LDS_BYTES - LDSCTL_OFF) / 4; u += NWAVES * 64) ((LAS unsigned*)(F.lds + LDSCTL_OFF))[u] = 0u;
    __syncthreads();
    if (F.tid == 0) { LAS unsigned long long* pt = (LAS unsigned long long*)(F.lds + PTAB_OFF);
#pragma unroll
        for (int i = 0; i < 35; ++i) pt[i] = (unsigned long long)a.in[i]; }
    __syncthreads();
    const bool multi = (a.ph_hi - a.ph_lo) > 1;
    XcdBarrier bar; bar.bar = (unsigned*)(a.ws + WS_CTL) + CW_BAR; bar.x = 0; bar.st = nullptr;
    if (multi) bar = xcd_barrier_post((unsigned*)(a.ws + WS_CTL) + CW_BAR, MISC + 8);

    for (int ph = a.ph_lo; ph < a.ph_hi; ++ph) {
        { int t_ = threadIdx.x, b_ = blockIdx.x; asm volatile("" : "+v"(t_)); asm volatile("" : "+s"(b_));
          F.tid = t_; F.lane = t_ & 63; F.wave = __builtin_amdgcn_readfirstlane(t_ >> 6); F.bx = b_; F.vcu = (b_ % 8) * (F.G / 8) + b_ / 8; }
        unsigned char* ws = a.ws; float* X = a.out; asm volatile("" : "+s"(ws)); asm volatile("" : "+s"(X));
        bf16* XB16 = (bf16*)(ws + WS_XN); unsigned char* T = ws + WS_T; bf16* Y = (bf16*)(T + T_Y);
        float* SX0 = (float*)(ws + WS_SX0); float* SX1 = (float*)(ws + WS_SX1); float* SV = (float*)(ws + WS_SV);
        if (ph == 0) {
            prologue_rows(F, inp(F, 0), inp(F, 1), XB16, SX0);
            { const float* wsf = inp(F, 13); bf16* wm = (bf16*)(ws + WS_WM);
              for (int i = F.vcu * 512 + F.tid; i < 2 * 8 * 128 * 128; i += F.G * 512) { const int s_ = i & 127, t_ = (i >> 7) & 127; wm[i] = s_ <= t_ ? (bf16)(cvt_pk_bf16(wsf[i], 0.f) & 0xffffu) : (bf16)0; } }
            s5_tables(F, inp(F, 26), inp(F, 27), inp(F, 28), inp(F, 29), inp(F, 30), inp(F, 31), inp(F, 32), ws + WS_S5T);
            rglru_tables(F, inp(F, 19), inp(F, 21), inp(F, 20), inp(F, 22), inp(F, 23), ws + WS_RGT);
            const int gw = F.vcu * NWAVES + F.wave, NGW = F.G * NWAVES; const float* gm = inp(F, 6);
            for (int it0 = gw; it0 < 1024; it0 += NGW) { int it = it0; conv_job(F, it, inp(F, 11), D, 2048, (bf16*)(ws + WS_W_INA), false, gm); }
        } else if (ph == PH_FINAL) {
            norm_final(F, XB16, X, inp(F, 8));
        } else {
            const int l = (ph - 1) / 5, st = (ph - 1) % 5, kind = l % 3, j = l / 3;
            if (st == ST_GIN) {
                if (kind == 0) { const bf16* W = (const bf16*)(ws + WS_W_INA + (size_t)j * 4 * MiB); EpiRow8<FAct<ACT_GELU, true>> E{{(bf16*)T, 2048, SX0, 16, SV}};
                    if (F.vcu & 1) { small_gemm<4, 8, false, 4>(F, XB16, W, D, E.f); big_gemm(F, XB16, W, 2048, D, E); } else { big_gemm(F, XB16, W, 2048, D, E); small_gemm<4, 8, false, 4>(F, XB16, W, D, E.f); } }
                else if (kind == 1) { const bf16* W = (const bf16*)(ws + WS_W_INB); EpiRow8<FRglru> E{{(bf16*)T, (float*)(T + 33 * MiB), SX0}};
                    if (F.vcu & 1) { small_gemm<4, 8, false, 4>(F, XB16, W, D, E.f); big_gemm(F, XB16, W, 2048, D, E); } else { big_gemm(F, XB16, W, 2048, D, E); small_gemm<4, 8, false, 4>(F, XB16, W, D, E.f); } }
                else { const bf16* W = (const bf16*)(ws + WS_W_INC); EpiRow8<FBf> E{{(bf16*)T, D, SX0}};
                    if (F.vcu & 1) { small_gemm<2, 8, false, 4>(F, XB16, W, D, E.f); big_gemm(F, XB16, W, D, D, E); } else { big_gemm(F, XB16, W, D, D, E); small_gemm<2, 8, false, 4>(F, XB16, W, D, E.f); } }
            } else if (st == ST_MIX) {
                if (kind == 0) sgu_mix_phase(F, (const bf16*)T, SV, inp(F, 12) + j * 1024, (const bf16*)(ws + WS_WM) + (size_t)j * 8 * 128 * 128, inp(F, 14) + j * 8 * 128, inp(F, 13) + (size_t)j * 8 * 128 * 128, Y, X + O_VS + (size_t)j * MS * 1024);
                else if (kind == 1) rglru_phase(F, (const float*)(T + 33 * MiB), (const bf16*)T, Y, inp(F, 17), inp(F, 18), ws + WS_RGT, inp(F, 2), inp(F, 3), X);
                else s5_phase(F, (const float*)T, Y, inp(F, 33), ws + WS_S5T, inp(F, 4), inp(F, 5), X);
            } else if (st == ST_GOUT) {
                if (kind == 2) { const bf16* W = (const bf16*)(ws + WS_W_GLU); EpiPair8<FGlu> E{{XB16, SX1}};
                    if (F.vcu & 1) { small_gemm<4, 8, true, 4>(F, Y, W, D, E.f); big_gemm(F, Y, W, 2048, D, E); } else { big_gemm(F, Y, W, 2048, D, E); small_gemm<4, 8, true, 4>(F, Y, W, D, E.f); } }
                else { const bf16* W = kind == 0 ? (const bf16*)(ws + WS_W_OUTA + (size_t)j * 2 * MiB) : (const bf16*)(ws + WS_W_OUTB); EpiResid8<FResid> E{{XB16, SX1}};
                    if (F.vcu & 1) { small_gemm<2, 8, false, 4>(F, Y, W, D, E.f); big_gemm(F, Y, W, D, D, E); } else { big_gemm(F, Y, W, D, D, E); small_gemm<2, 8, false, 4>(F, Y, W, D, E.f); } }
            } else if (st == ST_FF1) {
                const bf16* W = (const bf16*)(ws + WS_W_FF1); EpiRow8<FAct<ACT_SQRELU, false>> E{{(bf16*)T, FF, SX1, kind == 2 ? 32 : 16, nullptr}};
                if (F.vcu & 1) { small_gemm<8, 4, false, 4>(F, XB16, W, D, E.f); big_gemm(F, XB16, W, FF, D, E); } else { big_gemm(F, XB16, W, FF, D, E); small_gemm<8, 4, false, 4>(F, XB16, W, D, E.f); }
            } else {
                const bf16* W = (const bf16*)(ws + WS_W_FF2); EpiResid8<FResid> E{{XB16, SX0}};
                if (F.vcu & 1) { small_gemm<2, 8, false, 4>(F, (const bf16*)T, W, FF, E.f); big_gemm(F, (const bf16*)T, W, D, FF, E); } else { big_gemm(F, (const bf16*)T, W, D, FF, E); small_gemm<2, 8, false, 4>(F, (const bf16*)T, W, FF, E.f); }
            }
        }
        if (ph + 1 < a.ph_hi) {
            xcd_barrier_arrive(bar);
            if (ph >= 1 && ph < PH_FINAL) { const int st = (ph - 1) % 5;
                if (st == ST_GIN || st == ST_MIX) ffn_conv(F, (ph - 1) / 5, inp(F, 9), inp(F, 10), inp(F, 7), ws, st == ST_MIX ? 1 : 0);
                else if (ph == 1 + ST_GOUT) proj_conv(F, ws, 1);
                else if (ph == 1 + ST_FF1) proj_conv(F, ws, 2); }
            else if (ph == 0) proj_conv(F, ws, 0);
            xcd_barrier_wait(bar);
        }
    }
}

static void launch_mk(const Args& base, int lo, int hi, hipStream_t stream) {
    Args a = base; a.ph_lo = lo; a.ph_hi = hi;
    hipLaunchKernelGGL(mk, dim3(256), dim3(NWAVES * 64), LDS_BYTES, stream, a);
}

extern "C" void kernel_launch(void* const* d_in, const int* in_sizes, int n_in, void* d_out, int out_size, void* d_ws, size_t ws_size, hipStream_t stream) {
    static int inited = 0;
    if (!inited) {
        if (n_in != 35 || out_size != (int)O_END || ws_size < WS_END) { fprintf(stderr, "kernel_launch: unexpected sizes n_in %d out %d ws %zu\n", n_in, out_size, ws_size); }
        if (hipFuncSetAttribute((const void*)mk, hipFuncAttributeMaxDynamicSharedMemorySize, LDS_BYTES) != hipSuccess) fprintf(stderr, "kernel_launch: hipFuncSetAttribute failed\n");
        (void)hipGetLastError(); inited = 1;
    }
    (void)hipMemsetAsync((unsigned char*)d_ws + WS_CTL, 0, CTL_ZERO_BYTES, stream);
    Args base{}; for (int i = 0; i < 35; ++i) base.in[i] = (const float*)d_in[i]; base.out = (float*)d_out; base.ws = (unsigned char*)d_ws;
    launch_mk(base, 0, PH_END, stream);
}
```

```cpp
#include <hip/hip_runtime.h>
#include <cstdio>
#include <cstdint>

constexpr int MP = 16384, MS = 512, M = MP + MS, D = 1024, FF = 4096;
constexpr float EPS = 1e-6f;

constexpr size_t O_YP = 0, O_YS = (size_t)MP * D, O_VS = O_YS + (size_t)MS * D, O_CONVP = O_VS + 2 * (size_t)MS * D, O_HP = O_CONVP + 8 * 3 * 1024,
                 O_CONVS = O_HP + 8 * 1024, O_HS = O_CONVS + 128 * 3 * 1024, O_SREP = O_HS + 128 * 1024, O_SIMP = O_SREP + 8 * 4096, O_SRES = O_SIMP + 8 * 4096,
                 O_SIMS = O_SRES + 128 * 4096, O_END = O_SIMS + 128 * 4096;

constexpr size_t MiB = 1u << 20;
constexpr size_t WS_CTL = 0, CTL_ZERO_BYTES = 64 * 1024;
constexpr size_t WS_XN = 1 * MiB;
constexpr size_t WS_T = 34 * MiB;
constexpr size_t WS_RSV = 128 * 1024;
constexpr size_t WS_WM = 166 * MiB;
constexpr size_t WS_RGT = 167 * MiB;
constexpr size_t WS_S5T = 168 * MiB;
constexpr size_t WS_S5AB = 170 * MiB;
constexpr size_t WS_S5BB = 170 * MiB + 512 * 1024;
constexpr size_t WS_HST = 171 * MiB;
constexpr size_t WS_S5ST = 172 * MiB;
constexpr size_t WS_CHA = 176 * MiB;
constexpr size_t WS_CHB = 180 * MiB;
constexpr size_t WS_XSR = 184 * MiB;
constexpr size_t WS_XSI = 200 * MiB;
constexpr size_t WS_W_INA = 216 * MiB, WS_W_OUTA = 224 * MiB, WS_W_INB = 228 * MiB, WS_W_OUTB = 232 * MiB, WS_W_INC = 234 * MiB, WS_W_GLU = 236 * MiB,
                 WS_W_FF1 = 240 * MiB, WS_W_FF2 = 248 * MiB, WS_END = 256 * MiB;
constexpr int CW_BAR = 4096;

#define GAS __attribute__((address_space(1)))
#define LAS __attribute__((address_space(3)))
typedef unsigned short bf16;
typedef unsigned v4u __attribute__((ext_vector_type(4)));
typedef float f32x4 __attribute__((ext_vector_type(4)));
typedef short bf16x8 __attribute__((ext_vector_type(8)));
typedef GAS unsigned gu32;
typedef GAS unsigned long long gu64;
#define RLX_AGENT __ATOMIC_RELAXED, __HIP_MEMORY_SCOPE_AGENT
#define LDS_WAIT() asm volatile("s_waitcnt lgkmcnt(0)" ::: "memory")
#define VM_WAIT() asm volatile("s_waitcnt vmcnt(0)" ::: "memory")
__device__ __forceinline__ unsigned long long rt() { return __builtin_amdgcn_s_memrealtime(); }
__device__ __forceinline__ unsigned f2bf(float f) { unsigned u = __builtin_bit_cast(unsigned, f); return (u + 0x7fffu + ((u >> 16) & 1u)) >> 16; }
__device__ __forceinline__ unsigned pk2(float lo, float hi) { return f2bf(lo) | (f2bf(hi) << 16); }

#define XB_TMO      128
#define XB_XCNT(j)  (256  + 64 * (j))
#define XB_XSUB(j)  (1280 + 64 * (j))
#define XB_XGEN(j)  (2304 + 64 * (j))
#define XB_TOP      3328
#define XB_TOPGEN   3392
#define XCD_BAR_WORDS 3456
#define XB_SPIN_CAP (1u << 18)

__device__ __forceinline__ unsigned xb_ld(unsigned* p)              { return __hip_atomic_load(p, __ATOMIC_RELAXED, __HIP_MEMORY_SCOPE_AGENT); }
__device__ __forceinline__ unsigned xb_add(unsigned* p, unsigned v) { return __hip_atomic_fetch_add(p, v, __ATOMIC_RELAXED, __HIP_MEMORY_SCOPE_AGENT); }
__device__ __forceinline__ unsigned xb_xcc_id() { return (unsigned)__builtin_amdgcn_s_getreg((3 << 11) | 20) & 0xFu; }
#define XB_SPIN(cond, bar) do { unsigned _sp = 0; while (cond) { __builtin_amdgcn_s_sleep(1); \
    if ((++_sp & 255u) == 0u) { if (xb_ld(&(bar)[XB_TMO])) break; if (_sp > XB_SPIN_CAP) { atomicAdd(&(bar)[XB_TMO], 1u); break; } } } } while (0)

struct XcdBarrier {
    unsigned* bar; unsigned x;
    volatile LAS unsigned* st;
};

__device__ __forceinline__ XcdBarrier xcd_barrier_post(unsigned* bar, volatile LAS unsigned* st) {
    XcdBarrier b; b.bar = bar; b.x = xb_xcc_id(); b.st = st;
    if (threadIdx.x == 0) (void)xb_add(&bar[XB_XCNT(b.x)], 1u);
    return b;
}
__device__ __forceinline__ void xcd_barrier_complete(unsigned* bar, unsigned x, unsigned& nloc, unsigned& nx) {
    const unsigned G = gridDim.x * gridDim.y * gridDim.z;
    unsigned sum, cnt, mine, sp = 0u;
    for (;;) {
        sum = 0u; cnt = 0u; mine = 0u;
#pragma unroll
        for (unsigned j = 0; j < 16; ++j) { const unsigned c = xb_ld(&bar[XB_XCNT(j)]); sum += c; cnt += (c > 0u) ? 1u : 0u; mine = (j == x) ? c : mine; }
        if (sum == G) break;
        __builtin_amdgcn_s_sleep(1);
        if ((++sp & 255u) == 0u) { if (xb_ld(&bar[XB_TMO])) break; if (sp > XB_SPIN_CAP) { atomicAdd(&bar[XB_TMO], 1u); break; } }
    }
    nloc = mine > 0u ? mine : 1u; nx = cnt > 0u ? cnt : 1u;
}

__device__ __forceinline__ void xcd_barrier(const XcdBarrier& b) {
    asm volatile("s_waitcnt vmcnt(0)" ::: "memory");
    __syncthreads();
    if (threadIdx.x == 0) {
        unsigned* bar = b.bar;
        __builtin_amdgcn_s_waitcnt(0);
        unsigned nloc = b.st[0], nx = b.st[1];
        if (nloc == 0u) { xcd_barrier_complete(bar, b.x, nloc, nx); b.st[0] = nloc; b.st[1] = nx; }
        const unsigned old = xb_add(&bar[XB_XSUB(b.x)], 1u);
        const unsigned gen = old / nloc;
        if (old + 1u == (gen + 1u) * nloc) {
            __builtin_amdgcn_fence(__ATOMIC_RELEASE, "agent");
            asm volatile("s_waitcnt vmcnt(0)" ::: "memory");
            const unsigned og = xb_add(&bar[XB_TOP], 1u);
            const unsigned tg = og / nx;
            if (og + 1u == (tg + 1u) * nx) xb_add(&bar[XB_TOPGEN], 1u);
            else XB_SPIN(xb_ld(&bar[XB_TOPGEN]) == tg, bar);
            __builtin_amdgcn_fence(__ATOMIC_ACQUIRE, "agent");
            xb_add(&bar[XB_XGEN(b.x)], 1u);
            asm volatile("s_waitcnt vmcnt(0)" ::: "memory");
        } else {
            XB_SPIN(xb_ld(&bar[XB_XGEN(b.x)]) == gen, bar);
            __builtin_amdgcn_fence(__ATOMIC_ACQUIRE, "agent");
            asm volatile("s_waitcnt vmcnt(0)" ::: "memory");
        }
    }
    __syncthreads();
}
__device__ __forceinline__ void xcd_barrier_arrive(const XcdBarrier& b) {
    asm volatile("s_waitcnt vmcnt(0)" ::: "memory");
    __syncthreads();
    if (threadIdx.x == 0) {
        unsigned* bar = b.bar;
        __builtin_amdgcn_s_waitcnt(0);
        unsigned nloc = b.st[0], nx = b.st[1];
        if (nloc == 0u) { xcd_barrier_complete(bar, b.x, nloc, nx); b.st[0] = nloc; b.st[1] = nx; }
        const unsigned old = xb_add(&bar[XB_XSUB(b.x)], 1u);
        const unsigned gen = old / nloc;
        if (old + 1u == (gen + 1u) * nloc) {
            __builtin_amdgcn_fence(__ATOMIC_RELEASE, "agent");
            asm volatile("s_waitcnt vmcnt(0)" ::: "memory");
            (void)xb_add(&bar[XB_TOP], 1u);
        }
        b.st[2] = (gen + 1u) * nx;
    }
}
__device__ __forceinline__ void xcd_barrier_wait(const XcdBarrier& b) {
    if (threadIdx.x == 0) {
        unsigned* bar = b.bar; const unsigned tgt = b.st[2];
        XB_SPIN(xb_ld(&bar[XB_TOP]) < tgt, bar);
        __builtin_amdgcn_fence(__ATOMIC_ACQUIRE, "agent");
        asm volatile("s_waitcnt vmcnt(0)" ::: "memory");
    }
    __syncthreads();
}
namespace pg8 {
#define PG8_LAS __attribute__((address_space(3)))
typedef unsigned short bf16_t;
typedef short bf16x8 __attribute__((ext_vector_type(8)));
typedef float f32x4 __attribute__((ext_vector_type(4)));
typedef unsigned u32x4 __attribute__((ext_vector_type(4)));
constexpr int BM = 256, BK = 64, HALF = 128, HTB = HALF * BK * 2  , STAGE_BYTES = 8 * HTB, NXCD = 8, WGM = 8;

__host__ __device__ __forceinline__ int lds_byte(int r, int c) { const int st = (r >> 4) * 2 + (c >> 5), rr = r & 15, cc = c & 31, ob = rr * 64 + cc * 2; return st * 1024 + (ob ^ (((ob >> 9) & 1) << 5)); }
__host__ __device__ __forceinline__ void stage_rc(int b, int& R, int& C) { const int st = b / 1024, sb = b % 1024, swz = sb ^ (((sb >> 9) & 1) << 5); R = (st >> 1) * 16 + swz / 64; C = (st & 1) * 32 + (swz % 64) / 2; }
__host__ __device__ __forceinline__ int perm32(int rho) { const int n = rho >> 4, i = rho & 15; return 8 * (i >> 2) + 4 * n + (i & 3); }

struct Unit { int pm, pn; };
struct Gemm { const bf16_t* A; const bf16_t* Bt; int M, N, K; };

struct StaticOrder {
    int nM, nN, nwg, G, c;
    __host__ __device__ void init(int M, int N, int G_, int c_) { nM = M / BM; nN = N / BM; nwg = nM * nN; G = G_; c = c_; }
    __host__ __device__ bool next(int i, Unit& u) const {
        const long L = (long)i * G + c; if (L >= nwg) return false;
        int wgid = (int)L; { const int q = nwg / NXCD, r = nwg % NXCD, xcd = wgid % NXCD, off = wgid / NXCD; wgid = (xcd < r ? xcd * (q + 1) : r * (q + 1) + (xcd - r) * q) + off; }
        const int nig = WGM * nN, gid = wgid / nig, fm = gid * WGM, gsz = (nM - fm) < WGM ? (nM - fm) : WGM;
        u.pm = fm + ((wgid % nig) % gsz); u.pn = (wgid % nig) / gsz; return true;
    }
    __device__ __forceinline__ void a_ready(const Unit&) const {}
    __device__ __forceinline__ void done(const Unit&) const {}
};

template <class Epi, class Sched, bool ALIGN_EPI = false, bool SP2 = false>
__device__ __forceinline__ void gemm_phase(PG8_LAS unsigned char* lds, const Gemm g, const Sched& S, const Epi& E, const int tid_in) {
    const int tid = tid_in, wid = __builtin_amdgcn_readfirstlane(tid >> 6), lane = tid & 63, wr = wid >> 2, wc = wid & 3, fr = lane & 15, fq = lane >> 4;
    const int K = g.K, nt = K / BK;
    unsigned voffA[2], voffB[2];
#pragma unroll
    for (int i = 0; i < 2; ++i) { int R, C; stage_rc(tid * 16 + i * 8192, R, C); const int Rb = Epi::PERM ? ((R & ~31) + perm32(R & 31)) : R;
        voffA[i] = (unsigned)(R * K + C) * 2u; voffB[i] = (unsigned)(Rb * K + C) * 2u; }
    const size_t kstep = (size_t)(BK * 2);
    const size_t hstep = (size_t)HALF * K * 2;
    const size_t tstep = 2 * hstep;
    const unsigned ldsw = (unsigned)wid * 1024u;
    const int aoff = lds_byte(wr * 64 + fr, fq * 8), boff = lds_byte(wc * 32 + fr, fq * 8);
#define PG8_SA(b, h) (((b) * 2 + (h)) * HTB)
#define PG8_SB(b, h) ((4 + (b) * 2 + (h)) * HTB)
#define PG8_STAGE(bufoff, gbase, voff) do { _Pragma("unroll") for (int _i = 0; _i < 2; ++_i) \
        __builtin_amdgcn_global_load_lds((const unsigned*)((const char*)(gbase) + (voff)[_i]), (PG8_LAS unsigned*)(lds + (bufoff) + ldsw + _i * 8192), 16, 0, 0); } while (0)
#define PG8_LDA(dst, b, h) do { _Pragma("unroll") for (int m = 0; m < 4; ++m) _Pragma("unroll") for (int k = 0; k < 2; ++k) dst[m][k] = *(const PG8_LAS bf16x8*)(lds + PG8_SA(b, h) + aoff + m * 2048 + k * 1024); } while (0)
#define PG8_LDB(dst, b, h) do { _Pragma("unroll") for (int n = 0; n < 2; ++n) _Pragma("unroll") for (int k = 0; k < 2; ++k) dst[n][k] = *(const PG8_LAS bf16x8*)(lds + PG8_SB(b, h) + boff + n * 2048 + k * 1024); } while (0)
#define PG8_MMA(ai, bj, At, Bt) do { __builtin_amdgcn_s_setprio(1); _Pragma("unroll") for (int m = 0; m < 4; ++m) _Pragma("unroll") for (int n = 0; n < 2; ++n) _Pragma("unroll") for (int k = 0; k < 2; ++k) \
        acc[ai][bj][m][n] = __builtin_amdgcn_mfma_f32_16x16x32_bf16(Bt[n][k], At[m][k], acc[ai][bj][m][n], 0, 0, 0); __builtin_amdgcn_s_setprio(0); } while (0)
#define PG8_WAIT_V(n) asm volatile("s_waitcnt vmcnt(" #n ")" ::: "memory")
#define PG8_WAIT_L(n) asm volatile("s_waitcnt lgkmcnt(" #n ")" ::: "memory")
#define PG8_BAR __builtin_amdgcn_s_barrier()
#define PG8_SCHED __builtin_amdgcn_sched_barrier(0)
    Unit cur, nxt; int ui = 0;
    if (!S.next(0, cur)) return;
    E.first(lds, cur, tid);
    f32x4 acc[2][2][4][2];
#pragma unroll
    for (int a = 0; a < 2; ++a)
#pragma unroll
        for (int b = 0; b < 2; ++b)
#pragma unroll
            for (int m = 0; m < 4; ++m)
#pragma unroll
                for (int n = 0; n < 2; ++n) acc[a][b][m][n] = (f32x4){0.f, 0.f, 0.f, 0.f};
    bf16x8 At[4][2], B0[2][2], B1[2][2];
    const char* cA = (const char*)g.A + (size_t)cur.pm * tstep; const char* cB = (const char*)g.Bt + (size_t)cur.pn * tstep;
    S.a_ready(cur);
    if constexpr (SP2) {
        PG8_STAGE(PG8_SB(0, 0), cB, voffB); PG8_STAGE(PG8_SB(0, 1), cB + hstep, voffB); PG8_STAGE(PG8_SA(0, 0), cA, voffA); PG8_STAGE(PG8_SA(0, 1), cA + hstep, voffA);
        if (wr == 1) PG8_BAR;
        PG8_WAIT_V(2); PG8_BAR;
        PG8_STAGE(PG8_SB(1, 0), cB + kstep, voffB); PG8_STAGE(PG8_SA(1, 0), cA + kstep, voffA); PG8_STAGE(PG8_SB(1, 1), cB + hstep + kstep, voffB);
        PG8_WAIT_V(6); PG8_BAR;
    } else {
        PG8_STAGE(PG8_SB(0, 0), cB, voffB); PG8_STAGE(PG8_SA(0, 0), cA, voffA); PG8_STAGE(PG8_SB(0, 1), cB + hstep, voffB); PG8_STAGE(PG8_SA(0, 1), cA + hstep, voffA);
        if (wr == 1) PG8_BAR;
        PG8_WAIT_V(4); PG8_BAR;
        PG8_STAGE(PG8_SB(1, 0), cB + kstep, voffB); PG8_STAGE(PG8_SA(1, 0), cA + kstep, voffA); PG8_STAGE(PG8_SB(1, 1), cB + hstep + kstep, voffB);
        PG8_WAIT_V(6); PG8_BAR;
    }
    for (;;) {
        const bool has_next = S.next(ui + 1, nxt);
        const char* nA = has_next ? (const char*)g.A + (size_t)nxt.pm * tstep : cA; const char* nB = has_next ? (const char*)g.Bt + (size_t)nxt.pn * tstep : cB;
        for (int t = 0; t < nt; t += 2) {
            const bool last = (t == nt - 2);
            const char* a1 = cA + (size_t)(t + 1) * kstep;
            const char* a2 = last ? nA : cA + (size_t)(t + 2) * kstep; const char* b2 = last ? nB : cB + (size_t)(t + 2) * kstep;
            const char* a3 = a2 + kstep; const char* b3 = b2 + kstep;
            if (last && has_next) S.a_ready(nxt);
            if constexpr (SP2) {
            PG8_LDB(B0, 0, 0); PG8_LDB(B1, 0, 1); PG8_SCHED; PG8_LDA(At, 0, 0); PG8_STAGE(PG8_SA(1, 1), a1 + hstep, voffA);
            PG8_WAIT_V(8); PG8_WAIT_L(0); PG8_BAR; PG8_MMA(0, 0, At, B0); PG8_MMA(0, 1, At, B1); PG8_BAR; PG8_SCHED;
            PG8_LDA(At, 0, 1); PG8_STAGE(PG8_SB(0, 0), b2, voffB); PG8_STAGE(PG8_SB(0, 1), b2 + hstep, voffB); PG8_STAGE(PG8_SA(0, 0), a2, voffA);
            PG8_WAIT_V(8); PG8_WAIT_L(0); PG8_BAR; PG8_MMA(1, 0, At, B0); PG8_MMA(1, 1, At, B1); PG8_BAR; PG8_SCHED;
            PG8_LDB(B0, 1, 0); PG8_LDB(B1, 1, 1); PG8_SCHED; PG8_LDA(At, 1, 0); PG8_STAGE(PG8_SA(0, 1), a2 + hstep, voffA);
            PG8_WAIT_V(8); PG8_WAIT_L(0); PG8_BAR; PG8_MMA(0, 0, At, B0); PG8_MMA(0, 1, At, B1); PG8_BAR; PG8_SCHED;
            PG8_LDA(At, 1, 1); PG8_STAGE(PG8_SB(1, 0), b3, voffB); PG8_STAGE(PG8_SB(1, 1), b3 + hstep, voffB); PG8_STAGE(PG8_SA(1, 0), a3, voffA);
            PG8_WAIT_V(8); PG8_WAIT_L(0); PG8_BAR; PG8_MMA(1, 0, At, B0); PG8_MMA(1, 1, At, B1); PG8_BAR; PG8_SCHED;
            } else {
            PG8_LDB(B0, 0, 0); PG8_SCHED; PG8_LDA(At, 0, 0); PG8_STAGE(PG8_SA(1, 1), a1 + hstep, voffA);
            PG8_WAIT_L(8); PG8_BAR; PG8_WAIT_L(0); PG8_MMA(0, 0, At, B0); PG8_BAR; PG8_SCHED;
            PG8_LDB(B1, 0, 1); PG8_STAGE(PG8_SB(0, 0), b2, voffB);
            PG8_BAR; PG8_WAIT_L(0); PG8_MMA(0, 1, At, B1); PG8_BAR;
            PG8_LDA(At, 0, 1); PG8_STAGE(PG8_SA(0, 0), a2, voffA);
            PG8_BAR; PG8_WAIT_L(0); PG8_MMA(1, 0, At, B0); PG8_BAR; PG8_SCHED;
            PG8_STAGE(PG8_SB(0, 1), b2 + hstep, voffB);
            PG8_WAIT_V(6); PG8_BAR; PG8_MMA(1, 1, At, B1); PG8_BAR;
            PG8_LDB(B0, 1, 0); PG8_SCHED; PG8_LDA(At, 1, 0); PG8_STAGE(PG8_SA(0, 1), a2 + hstep, voffA);
            PG8_WAIT_L(8); PG8_BAR; PG8_WAIT_L(0); PG8_MMA(0, 0, At, B0); PG8_BAR; PG8_SCHED;
            PG8_LDB(B1, 1, 1); PG8_STAGE(PG8_SB(1, 0), b3, voffB);
            PG8_BAR; PG8_WAIT_L(0); PG8_MMA(0, 1, At, B1); PG8_BAR;
            PG8_LDA(At, 1, 1); PG8_STAGE(PG8_SA(1, 0), a3, voffA);
            PG8_BAR; PG8_WAIT_L(0); PG8_MMA(1, 0, At, B0); PG8_BAR; PG8_SCHED;
            PG8_STAGE(PG8_SB(1, 1), b3 + hstep, voffB);
            PG8_WAIT_V(6); PG8_BAR; PG8_MMA(1, 1, At, B1); PG8_BAR;
            }
        }
        if constexpr (ALIGN_EPI) { if (wr == 0) PG8_BAR; }
        if constexpr (!Epi::AFTER_DRAIN) { E(acc, cur, wr, wc, fr, fq, lds, nxt, has_next, ui, tid); S.done(cur); }
        if (!has_next) break;
#pragma unroll
        for (int a = 0; a < 2; ++a)
#pragma unroll
            for (int b = 0; b < 2; ++b)
#pragma unroll
                for (int m = 0; m < 4; ++m)
#pragma unroll
                    for (int n = 0; n < 2; ++n) acc[a][b][m][n] = (f32x4){0.f, 0.f, 0.f, 0.f};
        cur = nxt; cA = nA; cB = nB; ++ui;
        if constexpr (ALIGN_EPI) { if (wr == 1) PG8_BAR; }
    }
    PG8_WAIT_V(0);
    if constexpr (!ALIGN_EPI) { if (wr == 0) PG8_BAR; }
    PG8_BAR;
    if constexpr (Epi::AFTER_DRAIN) { E.fused(acc, cur, wr, wc, fr, fq, lds, wid, lane); S.done(cur); }
#undef PG8_SA
#undef PG8_SB
#undef PG8_STAGE
#undef PG8_LDA
#undef PG8_LDB
#undef PG8_MMA
#undef PG8_WAIT_V
#undef PG8_WAIT_L
#undef PG8_BAR
#undef PG8_SCHED
}
}
__device__ __forceinline__ float bf2f(unsigned short h) { return __builtin_bit_cast(float, (unsigned)h << 16); }
__device__ __forceinline__ float gelu_tanh(float x) { const float u = 0.7978845608028654f * (x + 0.044715f * x * x * x); return 0.5f * x * (1.f + tanhf(u)); }
__device__ __forceinline__ float sigmoidf_(float x) { return 1.f / (1.f + expf(-x)); }
template <int CTRL> __device__ __forceinline__ float dpp0(float src) { return __builtin_bit_cast(float, __builtin_amdgcn_update_dpp(0, __builtin_bit_cast(int, src), CTRL, 0xf, 0xf, true)); }
__device__ __forceinline__ float xor16f(float v) { return __shfl_xor(v, 16); }
__device__ __forceinline__ float sum32f(float v) { return v + __shfl_xor(v, 32); }
__device__ __forceinline__ float wave_sum(float v) {
#pragma unroll
    for (int o = 1; o < 64; o <<= 1) v += __shfl_xor(v, o);
    return v;
}
__device__ __forceinline__ unsigned cvt_pk_bf16(float lo, float hi) { unsigned r; asm volatile("v_cvt_pk_bf16_f32 %0, %1, %2" : "=v"(r) : "v"(lo), "v"(hi)); return r; }
__device__ __forceinline__ void wt16(const void* base, size_t byte_off, v4u v) { __builtin_amdgcn_raw_buffer_store_b128(v, __builtin_amdgcn_make_buffer_rsrc((void*)base, 0, 0x7fffffff, 0x00020000), (int)byte_off, 0, 16); }
__device__ __forceinline__ float gelu_fast(float x) { const float u = x * (0.7978845608028654f + 0.035677408136300125f * x * x); return x * __builtin_amdgcn_rcpf(1.f + __builtin_amdgcn_exp2f(-2.8853900817779268f * u)); }
__device__ __forceinline__ float sigmoid_fast(float x) { return __builtin_amdgcn_rcpf(1.f + __builtin_amdgcn_exp2f(-1.4426950408889634f * x)); }
__device__ __forceinline__ float bflo(unsigned u) { return __builtin_bit_cast(float, u << 16); }
__device__ __forceinline__ float bfhi(unsigned u) { return __builtin_bit_cast(float, u & 0xffff0000u); }
enum { ACT_GELU = 0, ACT_SQRELU = 1 };
typedef unsigned u32x2 __attribute__((ext_vector_type(2)));
struct RowCtx { float rs, ss; };
constexpr int XS_P = 32, XS_S = 64, VS_P = 16, VS_S = 64;
template <int N4> __device__ __forceinline__ float sum_slots_n(const float* p) { f32x4 v[N4];
#pragma unroll
    for (int i = 0; i < N4; ++i) v[i] = ((const f32x4*)p)[i];
    float s = 0.f;
#pragma unroll
    for (int i = 0; i < N4; ++i) s += (v[i].x + v[i].y) + (v[i].z + v[i].w);
    return s; }
__device__ __forceinline__ float sum_slots(const float* p, int n4) { return n4 == 4 ? sum_slots_n<4>(p) : (n4 == 8 ? sum_slots_n<8>(p) : sum_slots_n<16>(p)); }
__device__ __forceinline__ float rs_x(const float* P, int nslot, int row) {
    const float s = row < MP ? sum_slots(P + (size_t)row * XS_P, nslot >> 2) : sum_slots(P + (size_t)MP * XS_P + (size_t)(row - MP) * XS_S, XS_S >> 2); return rsqrtf(s * (1.f / 1024.f) + EPS); }
__device__ __forceinline__ float rs_v(const float* P, int row) {
    const float s = row < MP ? sum_slots(P + (size_t)row * VS_P, VS_P >> 2) : sum_slots(P + (size_t)MP * VS_P + (size_t)(row - MP) * VS_S, VS_S >> 2); return rsqrtf(s * (1.f / 1024.f) + EPS); }
__device__ __forceinline__ float fq_sum(float ss) { ss += xor16f(ss); return sum32f(ss); }
__device__ __forceinline__ void xs_store(float* P, int row, int col, bool pair, float ss, int fq) {
    ss = fq_sum(ss); if (fq != 0) return;
    if (row < MP) P[(size_t)row * XS_P + (pair ? (col >> 5) : (((col >> 8) << 2) | ((col >> 5) & 3)))] = ss; else P[(size_t)MP * XS_P + (size_t)(row - MP) * XS_S + (col >> 4)] = ss; }
__device__ __forceinline__ void vs_store(float* P, int row, int col, float ss, int fq) {
    ss = fq_sum(ss); if (fq != 0) return; const int c = col - 1024;
    if (row < MP) P[(size_t)row * VS_P + (((c >> 8) << 2) | ((c >> 5) & 3))] = ss; else P[(size_t)MP * VS_P + (size_t)(row - MP) * VS_S + (c >> 4)] = ss; }
constexpr int RSTAB_OFF = 131072 + 2048;
__device__ __forceinline__ LAS float* rstab(LAS unsigned char* lds, int par) { return (LAS float*)(lds + RSTAB_OFF) + par * 256; }
template <int ACT> __device__ __forceinline__ float act_f(float x) { if (ACT == ACT_GELU) return gelu_fast(x); const float t = fmaxf(x, 0.f); return t * t; }

template <int ACT, bool VSTAT> struct FAct { bf16* O; int ldc; const float* S; int nslot; float* SV;
    __device__ __forceinline__ RowCtx begin(int row) const { return RowCtx{rs_x(S, nslot, row), 0.f}; }
    __device__ __forceinline__ float rs_row(int row) const { return rs_x(S, nslot, row); }
    __device__ __forceinline__ void apply8(RowCtx& c, int row, int col, f32x4 v0, f32x4 v1) const {
        float r[8];
#pragma unroll
        for (int i = 0; i < 4; ++i) { r[i] = act_f<ACT>(v0[i] * c.rs); r[4 + i] = act_f<ACT>(v1[i] * c.rs); }
        if (VSTAT && col >= 1024) {
#pragma unroll
            for (int i = 0; i < 8; ++i) c.ss += r[i] * r[i]; }
        v4u w; w.x = cvt_pk_bf16(r[0], r[1]); w.y = cvt_pk_bf16(r[2], r[3]); w.z = cvt_pk_bf16(r[4], r[5]); w.w = cvt_pk_bf16(r[6], r[7]); if (ACT == ACT_SQRELU) wt16(O, ((size_t)row * ldc + col) * 2, w); else *(v4u*)(O + (size_t)row * ldc + col) = w; }
    __device__ __forceinline__ void apply4(RowCtx& c, int row, int col, f32x4 v) const {
        float r[4];
#pragma unroll
        for (int i = 0; i < 4; ++i) r[i] = act_f<ACT>(v[i] * c.rs);
        if (VSTAT && col >= 1024) c.ss += (r[0] * r[0] + r[1] * r[1]) + (r[2] * r[2] + r[3] * r[3]);
        u32x2 w; w.x = cvt_pk_bf16(r[0], r[1]); w.y = cvt_pk_bf16(r[2], r[3]); *(u32x2*)(O + (size_t)row * ldc + col) = w; }
    __device__ __forceinline__ void end(RowCtx& c, int row, int col, int fq) const { if (VSTAT && col >= 1024) vs_store(SV, row, col, c.ss, fq); } };
struct FRglru { bf16* G; float* XB; const float* S;
    __device__ __forceinline__ RowCtx begin(int row) const { return RowCtx{rs_x(S, 16, row), 0.f}; }
    __device__ __forceinline__ float rs_row(int row) const { return rs_x(S, 16, row); }
    __device__ __forceinline__ void apply8(RowCtx& c, int row, int col, f32x4 v0, f32x4 v1) const {
        if (col < 1024) { v4u w; w.x = cvt_pk_bf16(gelu_fast(v0[0] * c.rs), gelu_fast(v0[1] * c.rs)); w.y = cvt_pk_bf16(gelu_fast(v0[2] * c.rs), gelu_fast(v0[3] * c.rs));
            w.z = cvt_pk_bf16(gelu_fast(v1[0] * c.rs), gelu_fast(v1[1] * c.rs)); w.w = cvt_pk_bf16(gelu_fast(v1[2] * c.rs), gelu_fast(v1[3] * c.rs)); *(v4u*)(G + (size_t)row * 1024 + col) = w; }
        else { const f32x4 a = v0 * c.rs, b = v1 * c.rs; v4u w; w.x = cvt_pk_bf16(a[0], a[1]); w.y = cvt_pk_bf16(a[2], a[3]); w.z = cvt_pk_bf16(b[0], b[1]); w.w = cvt_pk_bf16(b[2], b[3]);
            *(v4u*)((bf16*)XB + (size_t)row * 1024 + col - 1024) = w; } }
    __device__ __forceinline__ void apply4(RowCtx& c, int row, int col, f32x4 v) const {
        if (col < 1024) { u32x2 w; w.x = cvt_pk_bf16(gelu_fast(v[0] * c.rs), gelu_fast(v[1] * c.rs)); w.y = cvt_pk_bf16(gelu_fast(v[2] * c.rs), gelu_fast(v[3] * c.rs)); *(u32x2*)(G + (size_t)row * 1024 + col) = w; }
        else { const f32x4 a = v * c.rs; u32x2 w; w.x = cvt_pk_bf16(a[0], a[1]); w.y = cvt_pk_bf16(a[2], a[3]); *(u32x2*)((bf16*)XB + (size_t)row * 1024 + col - 1024) = w; } }
    __device__ __forceinline__ void end(RowCtx&, int, int, int) const {} };
struct FBf { bf16* O; int ldc; const float* S;
    __device__ __forceinline__ RowCtx begin(int row) const { return RowCtx{rs_x(S, 16, row), 0.f}; }
    __device__ __forceinline__ float rs_row(int row) const { return rs_x(S, 16, row); }
    __device__ __forceinline__ void apply8(RowCtx& c, int row, int col, f32x4 v0, f32x4 v1) const { const f32x4 a = v0 * c.rs, b = v1 * c.rs; v4u w; w.x = cvt_pk_bf16(a[0], a[1]); w.y = cvt_pk_bf16(a[2], a[3]); w.z = cvt_pk_bf16(b[0], b[1]); w.w = cvt_pk_bf16(b[2], b[3]); *(v4u*)(O + (size_t)row * ldc + col) = w; }
    __device__ __forceinline__ void apply4(RowCtx& c, int row, int col, f32x4 v) const { const f32x4 a = v * c.rs; u32x2 w; w.x = cvt_pk_bf16(a[0], a[1]); w.y = cvt_pk_bf16(a[2], a[3]); *(u32x2*)(O + (size_t)row * ldc + col) = w; }
    __device__ __forceinline__ void end(RowCtx&, int, int, int) const {} };
struct FF32 { float* O; int ldc; const float* S;
    __device__ __forceinline__ RowCtx begin(int row) const { return RowCtx{rs_x(S, 16, row), 0.f}; }
    __device__ __forceinline__ float rs_row(int row) const { return rs_x(S, 16, row); }
    __device__ __forceinline__ void apply8(RowCtx& c, int row, int col, f32x4 v0, f32x4 v1) const { float* p = O + (size_t)row * ldc + col; *(f32x4*)p = v0 * c.rs; *(f32x4*)(p + 4) = v1 * c.rs; }
    __device__ __forceinline__ void apply4(RowCtx& c, int row, int col, f32x4 v) const { *(f32x4*)(O + (size_t)row * ldc + col) = v * c.rs; }
    __device__ __forceinline__ void end(RowCtx&, int, int, int) const {} };
__device__ __forceinline__ f32x4 bf_lo4(v4u w) { return (f32x4){bflo(w.x), bfhi(w.x), bflo(w.y), bfhi(w.y)}; }
__device__ __forceinline__ f32x4 bf_hi4(v4u w) { return (f32x4){bflo(w.z), bfhi(w.z), bflo(w.w), bfhi(w.w)}; }
struct FResid { bf16* XB16; float* Sacc;
    __device__ __forceinline__ RowCtx begin(int) const { return RowCtx{0.f, 0.f}; }
    __device__ __forceinline__ void load8(int row, int col, v4u& xo) const { xo = *(const v4u*)(XB16 + (size_t)row * D + col); }
    __device__ __forceinline__ void apply8x(RowCtx& c, int row, int col, f32x4 v0, f32x4 v1, v4u xo) const {
        const f32x4 x0 = bf_lo4(xo) + v0, x1 = bf_hi4(xo) + v1;
        c.ss += (x0[0] * x0[0] + x0[1] * x0[1]) + (x0[2] * x0[2] + x0[3] * x0[3]) + (x1[0] * x1[0] + x1[1] * x1[1]) + (x1[2] * x1[2] + x1[3] * x1[3]);
        v4u w; w.x = cvt_pk_bf16(x0[0], x0[1]); w.y = cvt_pk_bf16(x0[2], x0[3]); w.z = cvt_pk_bf16(x1[0], x1[1]); w.w = cvt_pk_bf16(x1[2], x1[3]); *(v4u*)(XB16 + (size_t)row * D + col) = w; }
    __device__ __forceinline__ void apply4(RowCtx& c, int row, int col, f32x4 v) const { bf16* p = XB16 + (size_t)row * D + col; const u32x2 o = *(const u32x2*)p;
        const f32x4 x0 = (f32x4){bflo(o.x), bfhi(o.x), bflo(o.y), bfhi(o.y)} + v; c.ss += (x0[0] * x0[0] + x0[1] * x0[1]) + (x0[2] * x0[2] + x0[3] * x0[3]);
        u32x2 w; w.x = cvt_pk_bf16(x0[0], x0[1]); w.y = cvt_pk_bf16(x0[2], x0[3]); *(u32x2*)p = w; }
    __device__ __forceinline__ void end(RowCtx& c, int row, int col, int fq) const { xs_store(Sacc, row, col, false, c.ss, fq); } };
struct FGlu { bf16* XB16; float* Sacc;
    __device__ __forceinline__ RowCtx begin(int) const { return RowCtx{0.f, 0.f}; }
    __device__ __forceinline__ void load8(int row, int col, v4u& xo) const { xo = *(const v4u*)(XB16 + (size_t)row * D + col); }
    __device__ __forceinline__ void apply8x_pair(RowCtx& c, int row, int col, f32x4 a0, f32x4 a1, f32x4 b0, f32x4 b1, v4u xo) const {
        f32x4 x0 = bf_lo4(xo), x1 = bf_hi4(xo);
#pragma unroll
        for (int i = 0; i < 4; ++i) { x0[i] += a0[i] * sigmoid_fast(b0[i]); x1[i] += a1[i] * sigmoid_fast(b1[i]); }
        c.ss += (x0[0] * x0[0] + x0[1] * x0[1]) + (x0[2] * x0[2] + x0[3] * x0[3]) + (x1[0] * x1[0] + x1[1] * x1[1]) + (x1[2] * x1[2] + x1[3] * x1[3]);
        v4u w; w.x = cvt_pk_bf16(x0[0], x0[1]); w.y = cvt_pk_bf16(x0[2], x0[3]); w.z = cvt_pk_bf16(x1[0], x1[1]); w.w = cvt_pk_bf16(x1[2], x1[3]); *(v4u*)(XB16 + (size_t)row * D + col) = w; }
    __device__ __forceinline__ void apply4_pair(RowCtx& c, int row, int col, f32x4 a, f32x4 b) const { bf16* p = XB16 + (size_t)row * D + col; const u32x2 o = *(const u32x2*)p;
        f32x4 x0 = (f32x4){bflo(o.x), bfhi(o.x), bflo(o.y), bfhi(o.y)};
#pragma unroll
        for (int i = 0; i < 4; ++i) x0[i] += a[i] * sigmoid_fast(b[i]);
        c.ss += (x0[0] * x0[0] + x0[1] * x0[1]) + (x0[2] * x0[2] + x0[3] * x0[3]);
        u32x2 w; w.x = cvt_pk_bf16(x0[0], x0[1]); w.y = cvt_pk_bf16(x0[2], x0[3]); *(u32x2*)p = w; }
    __device__ __forceinline__ void end(RowCtx& c, int row, int col, int fq) const { xs_store(Sacc, row, col, true, c.ss, fq); } };

template <class F> struct EpiRow8 { static constexpr bool PERM = true, AFTER_DRAIN = false; F f;
    __device__ __forceinline__ void first(PG8_LAS unsigned char* lds, const pg8::Unit& u, int tid) const { if (tid < 256) rstab(lds, 0)[tid] = f.rs_row(u.pm * 256 + tid); }
    __device__ __forceinline__ void operator()(const pg8::f32x4 (&acc)[2][2][4][2], const pg8::Unit& u, int wr, int wc, int fr, int fq, PG8_LAS unsigned char* lds, const pg8::Unit& nxt, bool has_next, int ui, int tid) const {
        const LAS float* tab = rstab(lds, ui & 1);
        float nrs = 0.f; if (has_next && tid < 256) nrs = f.rs_row(nxt.pm * 256 + tid);
#pragma unroll
        for (int ai = 0; ai < 2; ++ai)
#pragma unroll
            for (int m = 0; m < 4; ++m) { const int rl = ai * 128 + wr * 64 + m * 16 + fr, row = u.pm * 256 + rl; RowCtx c = RowCtx{tab[rl], 0.f};
#pragma unroll
                for (int bj = 0; bj < 2; ++bj) f.apply8(c, row, u.pn * 256 + bj * 128 + wc * 32 + 8 * fq, acc[ai][bj][m][0], acc[ai][bj][m][1]);
                f.end(c, row, u.pn * 256 + wc * 32, fq); }
        if (has_next && tid < 256) rstab(lds, (ui + 1) & 1)[tid] = nrs; } };
template <class F> struct EpiResid8 { static constexpr bool PERM = true, AFTER_DRAIN = true; F f;
    __device__ __forceinline__ void first(PG8_LAS unsigned char*, const pg8::Unit&, int) const {}
    __device__ __forceinline__ void operator()(const pg8::f32x4 (&)[2][2][4][2], const pg8::Unit&, int, int, int, int, PG8_LAS unsigned char*, const pg8::Unit&, bool, int, int) const {}
    __device__ __forceinline__ void fused(pg8::f32x4 (&acc)[2][2][4][2], const pg8::Unit& u, int wr, int wc, int fr, int fq, PG8_LAS unsigned char* lds, int wid, int lane) const {
#pragma unroll
        for (int m = 0; m < 4; ++m)
#pragma unroll
            for (int bj = 0; bj < 2; ++bj) { const bf16* src = f.XB16 + (size_t)(u.pm * 256 + wr * 64 + m * 16 + fr) * D + u.pn * 256 + bj * 128 + wc * 32 + 8 * fq;
                __builtin_amdgcn_global_load_lds((const unsigned*)src, (PG8_LAS unsigned*)(lds + (m * 2 + bj) * 8192 + wid * 1024), 16, 0, 0); }
        v4u xr[4][2];
#pragma unroll
        for (int m = 0; m < 4; ++m)
#pragma unroll
            for (int bj = 0; bj < 2; ++bj) f.load8(u.pm * 256 + 128 + wr * 64 + m * 16 + fr, u.pn * 256 + bj * 128 + wc * 32 + 8 * fq, xr[m][bj]);
        asm volatile("s_waitcnt vmcnt(0)" ::: "memory");
#pragma unroll
        for (int ai = 1; ai >= 0; --ai)
#pragma unroll
            for (int m = 0; m < 4; ++m) { const int row = u.pm * 256 + ai * 128 + wr * 64 + m * 16 + fr; RowCtx c = f.begin(row);
#pragma unroll
                for (int bj = 0; bj < 2; ++bj) { const v4u xo = ai ? xr[m][bj] : *(const PG8_LAS v4u*)(lds + (m * 2 + bj) * 8192 + wid * 1024 + lane * 16);
                    f.apply8x(c, row, u.pn * 256 + bj * 128 + wc * 32 + 8 * fq, acc[ai][bj][m][0], acc[ai][bj][m][1], xo); }
                f.end(c, row, u.pn * 256 + wc * 32, fq); }
    } };
template <class F> struct EpiPair8 { static constexpr bool PERM = true, AFTER_DRAIN = false; F f;
    __device__ __forceinline__ void first(PG8_LAS unsigned char*, const pg8::Unit&, int) const {}
    __device__ __forceinline__ void operator()(const pg8::f32x4 (&acc)[2][2][4][2], const pg8::Unit& u, int wr, int wc, int fr, int fq, PG8_LAS unsigned char*, const pg8::Unit&, bool, int, int) const {
        v4u xo[2][4];
#pragma unroll
        for (int ai = 0; ai < 2; ++ai)
#pragma unroll
            for (int m = 0; m < 4; ++m) f.load8(u.pm * 256 + ai * 128 + wr * 64 + m * 16 + fr, u.pn * 128 + wc * 32 + 8 * fq, xo[ai][m]);
#pragma unroll
        for (int ai = 0; ai < 2; ++ai)
#pragma unroll
            for (int m = 0; m < 4; ++m) { const int row = u.pm * 256 + ai * 128 + wr * 64 + m * 16 + fr; RowCtx c = f.begin(row);
                f.apply8x_pair(c, row, u.pn * 128 + wc * 32 + 8 * fq, acc[ai][0][m][0], acc[ai][0][m][1], acc[ai][1][m][0], acc[ai][1][m][1], xo[ai][m]);
                f.end(c, row, u.pn * 128 + wc * 32, fq); } } };

constexpr int NWAVES = 8;
constexpr int RING_BYTES = 131072, LDSCTL_OFF = RING_BYTES, MISC_OFF = LDSCTL_OFF + 320, LDS_BYTES = 147456;
constexpr int PTAB_OFF = LDSCTL_OFF + 1024;
struct Frame { LAS unsigned char* lds; int tid, lane, wave, vcu, G, bx; };
__device__ __forceinline__ const float* inp(const Frame& F, int i) {
    const volatile LAS unsigned* t = (const volatile LAS unsigned*)(F.lds + PTAB_OFF) + 2 * i;
    const unsigned lo = __builtin_amdgcn_readfirstlane(t[0]), hi = __builtin_amdgcn_readfirstlane(t[1]);
    return (const float*)(((unsigned long long)hi << 32) | lo);
}

template <int NCT, int KS, bool GLU, int UNR, class F>
__device__ __forceinline__ void small_gemm(const Frame& Fr, const bf16* A, const bf16* WT, int K, const F& f) {
    constexpr int CS = 8 / KS, CT = NCT / CS, NT = 4 * CT;
    const int rb = Fr.vcu & 7, cb = Fr.vcu >> 3, kq = Fr.wave % KS, cs = Fr.wave / KS, fr = Fr.lane & 15, fq = Fr.lane >> 4;
    const int m0 = MP + rb * 64, ksl = K / KS;
    const bf16* ap = A + (size_t)(m0 + fr) * K + kq * ksl + 8 * fq;
    const bf16* bp[CT];
#pragma unroll
    for (int j = 0; j < CT; ++j) { const int ct = cs * CT + j; int wrow;
        if (GLU) { const int c = cb * 32 + (ct & 1) * 16; wrow = 256 * (c >> 7) + 128 * (ct >> 1) + (c & 127); } else wrow = (cb * NCT + ct) * 16;
        bp[j] = WT + (size_t)(wrow + fr) * K + kq * ksl + 8 * fq; }
    f32x4 acc[4][CT];
#pragma unroll
    for (int r = 0; r < 4; ++r)
#pragma unroll
        for (int j = 0; j < CT; ++j) acc[r][j] = (f32x4){0.f, 0.f, 0.f, 0.f};
    (void)UNR;
    bf16x8 a0[2][4], b0[2][CT], a1[2][4], b1[2][CT];
    auto ldb = [&](bf16x8 (&a)[2][4], bf16x8 (&b)[2][CT], int kb) {
#pragma unroll
        for (int s_ = 0; s_ < 2; ++s_) {
#pragma unroll
            for (int r = 0; r < 4; ++r) a[s_][r] = *(const bf16x8*)(ap + (size_t)r * 16 * K + kb + 32 * s_);
#pragma unroll
            for (int j = 0; j < CT; ++j) b[s_][j] = *(const bf16x8*)(bp[j] + kb + 32 * s_); } };
    auto mmb = [&](const bf16x8 (&a)[2][4], const bf16x8 (&b)[2][CT]) {
#pragma unroll
        for (int s_ = 0; s_ < 2; ++s_)
#pragma unroll
            for (int r = 0; r < 4; ++r)
#pragma unroll
                for (int j = 0; j < CT; ++j) acc[r][j] = __builtin_amdgcn_mfma_f32_16x16x32_bf16(b[s_][j], a[s_][r], acc[r][j], 0, 0, 0); };
    ldb(a0, b0, 0);
    for (int kb = 0; kb < ksl; kb += 128) {
        if (kb + 64 < ksl) ldb(a1, b1, kb + 64);
        mmb(a0, b0);
        if (kb + 128 < ksl) ldb(a0, b0, kb + 128);
        if (kb + 64 < ksl) mmb(a1, b1);
    }
    LAS f32x4* RED = (LAS f32x4*)Fr.lds;
    __syncthreads();
#pragma unroll
    for (int r = 0; r < 4; ++r)
#pragma unroll
        for (int j = 0; j < CT; ++j) RED[(Fr.wave * NT + r * CT + j) * 64 + Fr.lane] = acc[r][j];
    __syncthreads();
    const int rt = Fr.wave & 3, hf = Fr.wave >> 2, row = m0 + rt * 16 + fr;
    RowCtx c = f.begin(row);
    if constexpr (GLU) {
        f32x4 va = (f32x4){0.f, 0.f, 0.f, 0.f}, vb = va;
#pragma unroll
        for (int q = 0; q < KS; ++q) { va = va + RED[(q * NT + rt * CT + hf) * 64 + Fr.lane]; vb = vb + RED[(q * NT + rt * CT + 2 + hf) * 64 + Fr.lane]; }
        const int col = cb * 32 + hf * 16; c.ss = 0.f; f.apply4_pair(c, row, col + 4 * fq, va, vb); f.end(c, row, col, fq);
    } else {
#pragma unroll
        for (int jj = 0; jj < NCT / 2; ++jj) { const int ct = hf * (NCT / 2) + jj, g = ct / CT, j = ct % CT; f32x4 v = (f32x4){0.f, 0.f, 0.f, 0.f};
#pragma unroll
            for (int q = 0; q < KS; ++q) v = v + RED[((g * KS + q) * NT + rt * CT + j) * 64 + Fr.lane];
            const int col = (cb * NCT + ct) * 16; c.ss = 0.f; f.apply4(c, row, col + 4 * fq, v); f.end(c, row, col, fq); }
    }
    __syncthreads();
}

__device__ __forceinline__ void transpose_item(const float* W, int K, int N, bf16* WT, int drow0, LAS float* scr, int k0, int n0, int lane, const float* gain) {
    const int rq = lane >> 3, cq = lane & 7;
    f32x4 v[8]; float gn[8];
#pragma unroll
    for (int i = 0; i < 8; ++i) { const int kk = 8 * i + rq; v[i] = *(const GAS f32x4*)((const GAS float*)W + (size_t)(k0 + kk) * N + n0 + 4 * cq); gn[i] = gain ? gain[k0 + kk] : 1.f; }
#pragma unroll
    for (int i = 0; i < 8; ++i) { LAS float* d = scr + (8 * i + rq) * 33 + 4 * cq; d[0] = v[i].x * gn[i]; d[1] = v[i].y * gn[i]; d[2] = v[i].z * gn[i]; d[3] = v[i].w * gn[i]; }
    LDS_WAIT(); asm volatile("" ::: "memory");
    const int c = lane & 7;
#pragma unroll
    for (int j = 0; j < 4; ++j) { const int n = (lane >> 3) + 8 * j; const LAS float* s = scr + (8 * c) * 33 + n;
        v4u o; o.x = cvt_pk_bf16(s[0 * 33], s[1 * 33]); o.y = cvt_pk_bf16(s[2 * 33], s[3 * 33]); o.z = cvt_pk_bf16(s[4 * 33], s[5 * 33]); o.w = cvt_pk_bf16(s[6 * 33], s[7 * 33]);
        *(GAS v4u*)(WT + (size_t)(drow0 + n) * K + k0 + 8 * c) = o; }
    LDS_WAIT(); asm volatile("" ::: "memory");
}
__device__ __forceinline__ bool conv_job(const Frame& F, int& it, const float* W, int K, int N, bf16* WT, bool glu, const float* gain) {
    const int nblk = N / 32, nit = (K / 64) * nblk;
    if (it >= nit) { it -= nit; return false; }
    const int kb = it / nblk, nb = it % nblk, n0 = 32 * nb; int drow0 = n0;
    if (glu) { const int bj = n0 >> 10, r = n0 & 1023; drow0 = 256 * (r >> 7) + 128 * bj + (r & 127); }
    transpose_item(W, K, N, WT, drow0, (LAS float*)(F.lds + F.wave * 16384), 64 * kb, n0, F.lane, gain);
    return true;
}
__device__ __forceinline__ void ffn_conv(const Frame& F, int l, const float* w1, const float* w2, const float* gffn, unsigned char* ws, int half) {
    const int gw = F.vcu * NWAVES + F.wave, NGW = F.G * NWAVES;
    for (int it0 = 2048 * half + gw; it0 < 2048 * half + 2048; it0 += NGW) { int it = it0;
        if (conv_job(F, it, w1 + (size_t)l * D * FF, D, FF, (bf16*)(ws + WS_W_FF1), false, gffn + l * D)) continue;
        conv_job(F, it, w2 + (size_t)l * FF * D, FF, D, (bf16*)(ws + WS_W_FF2), false, nullptr);
    }
}

__device__ __forceinline__ void proj_conv(const Frame& F, unsigned char* ws, int grp) {
    const int gw = F.vcu * NWAVES + F.wave, NGW = F.G * NWAVES; const float* gm = inp(F, 6);
    if (grp == 0) {
        for (int it0 = gw; it0 < 2048; it0 += NGW) { int it = it0;
            if (conv_job(F, it, inp(F, 15), D, D, (bf16*)(ws + WS_W_OUTA), false, nullptr)) continue;
            if (conv_job(F, it, inp(F, 16), D, 2048, (bf16*)(ws + WS_W_INB), false, gm + D)) continue;
            conv_job(F, it, inp(F, 24), D, D, (bf16*)(ws + WS_W_OUTB), false, nullptr); }
    } else if (grp == 1) {
        for (int it0 = gw; it0 < 2048; it0 += NGW) { int it = it0;
            if (conv_job(F, it, inp(F, 25), D, D, (bf16*)(ws + WS_W_INC), false, gm + 2 * D)) continue;
            if (conv_job(F, it, inp(F, 34), D, 2048, (bf16*)(ws + WS_W_GLU), true, nullptr)) continue;
            conv_job(F, it, inp(F, 15) + (size_t)D * D, D, D, (bf16*)(ws + WS_W_OUTA + 2 * MiB), false, nullptr); }
    } else {
        for (int it0 = gw; it0 < 1024; it0 += NGW) { int it = it0; conv_job(F, it, inp(F, 11) + (size_t)D * 2048, D, 2048, (bf16*)(ws + WS_W_INA + 4 * MiB), false, gm + 3 * D); }
    }
}

struct Args { const float* in[35]; float* out; unsigned char* ws; int ph_lo, ph_hi; };

__device__ __forceinline__ void prologue_rows(const Frame& F, const float* xp, const float* xs, bf16* XB16, float* SX0) {
    const int gw = F.vcu * NWAVES + F.wave, NGW = F.G * NWAVES;
    for (int row0 = gw; row0 < M; row0 += 3 * NGW) {
        f32x4 v[3][4];
#pragma unroll
        for (int q = 0; q < 3; ++q) { const int row = row0 + q * NGW; if (row < M) {
            const GAS f32x4* xr = (const GAS f32x4*)(row < MP ? xp + (size_t)row * D : xs + (size_t)(row - MP) * D) + F.lane;
#pragma unroll
            for (int j = 0; j < 4; ++j) v[q][j] = xr[64 * j]; } }
#pragma unroll
        for (int q = 0; q < 3; ++q) { const int row = row0 + q * NGW; if (row < M) { float s = 0.f;
#pragma unroll
            for (int j = 0; j < 4; ++j) s += (v[q][j].x * v[q][j].x + v[q][j].y * v[q][j].y) + (v[q][j].z * v[q][j].z + v[q][j].w * v[q][j].w);
            s = wave_sum(s);
            if (row < MP) { if (F.lane < 16) SX0[(size_t)row * XS_P + F.lane] = F.lane == 0 ? s : 0.f; } else SX0[(size_t)MP * XS_P + (size_t)(row - MP) * XS_S + F.lane] = F.lane == 0 ? s : 0.f;
            u32x2* o = (u32x2*)(XB16 + (size_t)row * D) + F.lane;
#pragma unroll
            for (int j = 0; j < 4; ++j) { u32x2 w; w.x = cvt_pk_bf16(v[q][j].x, v[q][j].y); w.y = cvt_pk_bf16(v[q][j].z, v[q][j].w); o[64 * j] = w; } } }
    }
}
__device__ __forceinline__ void norm_final(const Frame& F, const bf16* XB16, float* out, const float* g) {
    const int gw = F.vcu * NWAVES + F.wave, NGW = F.G * NWAVES;
    f32x4 gv[4];
#pragma unroll
    for (int j = 0; j < 4; ++j) gv[j] = ((const f32x4*)g)[F.lane + 64 * j];
    for (int row = gw; row < M; row += NGW) {
        const u32x2* xr = (const u32x2*)(XB16 + (size_t)row * D) + F.lane; f32x4 v[4]; float s = 0.f;
#pragma unroll
        for (int j = 0; j < 4; ++j) { const u32x2 o = xr[64 * j]; v[j] = (f32x4){bflo(o.x), bfhi(o.x), bflo(o.y), bfhi(o.y)}; s += (v[j].x * v[j].x + v[j].y * v[j].y) + (v[j].z * v[j].z + v[j].w * v[j].w); }
        const float rs = rsqrtf(wave_sum(s) * (1.f / D) + EPS);
        f32x4* yo = (f32x4*)(out + (size_t)row * D) + F.lane;
#pragma unroll
        for (int j = 0; j < 4; ++j) yo[64 * j] = v[j] * rs * gv[j];
    }
}

template <class Epi> __device__ __forceinline__ void big_gemm(const Frame& F, const bf16* A, const bf16* WT, int N, int K, const Epi& E) {
    pg8::Gemm g{A, WT, MP, N, K}; pg8::StaticOrder S; S.init(MP, N, F.G, F.bx);
    pg8::gemm_phase<Epi, pg8::StaticOrder, true, true>(F.lds, g, S, E, F.tid);
}

constexpr int VS_STRIDE = 264;
constexpr int SGU_RS_OFF = 128 * VS_STRIDE;
constexpr int SGU_ST_OFF = 40960, SGU_ST_STRIDE = 272;
__device__ __forceinline__ void sgu_mix_phase(const Frame& F, const bf16* UV, const float* SV, const float* sg, const bf16* Wm, const float* bs, const float* wsf, bf16* Y, float* vs_out) {
    LAS unsigned char* Vs = F.lds; LAS float* RS = (LAS float*)(F.lds + SGU_RS_OFF); const int fr = F.lane & 15, fq = F.lane >> 4;
    { const int i = F.tid >> 7, u = F.vcu + 256 * i; if (u < 1024) RS[F.tid] = rs_v(SV, (u >> 3) * 128 + (F.tid & 127)); }
    const int g = F.vcu & 7; const bf16* wg = Wm + (size_t)g * 128 * 128;
    bf16x8 bfr[20]; { int q = 0;
#pragma unroll
        for (int n = 0; n < 8; ++n)
#pragma unroll
            for (int kk = 0; kk <= n / 2; ++kk) bfr[q++] = *(const GAS bf16x8*)((const GAS bf16*)wg + (size_t)(16 * n + fr) * 128 + 32 * kk + 8 * fq); }
    float bb[8];
#pragma unroll
    for (int n = 0; n < 8; ++n) bb[n] = bs[g * 128 + 16 * n + fr];
    const f32x4 g4 = *(const f32x4*)(sg + g * 128 + 16 * F.wave + 4 * fq);
    v4u raw[4]; u32x2 uu[8];
    auto load_unit = [&](int u) { const int r0 = (u >> 3) * 128;
#pragma unroll
        for (int i = 0; i < 4; ++i) { const int id = F.tid + 512 * i, row = id >> 4, ch = id & 15; raw[i] = *(const GAS v4u*)((const GAS bf16*)UV + (size_t)(r0 + row) * 2048 + 1024 + g * 128 + ch * 8); }
#pragma unroll
        for (int n = 0; n < 8; ++n) uu[n] = *(const GAS u32x2*)((const GAS bf16*)UV + (size_t)(r0 + 16 * n + fr) * 2048 + g * 128 + 16 * F.wave + 4 * fq); };
    load_unit(F.vcu);
    __syncthreads();
    for (int ui = 0, u = F.vcu; u < 1024; u += F.G, ++ui) {
        const int r0 = (u >> 3) * 128;
#pragma unroll
        for (int i = 0; i < 4; ++i) { const int id = F.tid + 512 * i, row = id >> 4, ch = id & 15;
            *(LAS u32x2*)(Vs + row * VS_STRIDE + ch * 16) = (u32x2){raw[i].x, raw[i].y}; *(LAS u32x2*)(Vs + row * VS_STRIDE + ch * 16 + 8) = (u32x2){raw[i].z, raw[i].w}; }
        u32x2 uc[8];
#pragma unroll
        for (int n = 0; n < 8; ++n) uc[n] = uu[n];
        if (u + F.G < 1024) load_unit(u + F.G);
        __syncthreads();
        bf16x8 af[4];
#pragma unroll
        for (int kk = 0; kk < 4; ++kk) { float e[8];
#pragma unroll
            for (int j = 0; j < 8; ++j) { const int sr = 32 * kk + 8 * fq + j; e[j] = bf2f(*(const LAS unsigned short*)(Vs + sr * VS_STRIDE + (16 * F.wave + fr) * 2)) * RS[ui * 128 + sr]; }
            v4u p; p.x = cvt_pk_bf16(e[0], e[1]); p.y = cvt_pk_bf16(e[2], e[3]); p.z = cvt_pk_bf16(e[4], e[5]); p.w = cvt_pk_bf16(e[6], e[7]); af[kk] = __builtin_bit_cast(bf16x8, p); }
        f32x4 acc[8]; { int q = 0;
#pragma unroll
            for (int n = 0; n < 8; ++n) { acc[n] = (f32x4){0.f, 0.f, 0.f, 0.f};
#pragma unroll
                for (int kk = 0; kk <= n / 2; ++kk) acc[n] = __builtin_amdgcn_mfma_f32_16x16x32_bf16(af[kk], bfr[q++], acc[n], 0, 0, 0); } }
#pragma unroll
        for (int n = 0; n < 8; ++n) { const int t = 16 * n + fr, row = r0 + t, col = g * 128 + 16 * F.wave + 4 * fq;
            u32x2 w; w.x = cvt_pk_bf16(bflo(uc[n].x) * (acc[n][0] * g4.x + bb[n]), bfhi(uc[n].x) * (acc[n][1] * g4.y + bb[n])); w.y = cvt_pk_bf16(bflo(uc[n].y) * (acc[n][2] * g4.z + bb[n]), bfhi(uc[n].y) * (acc[n][3] * g4.w + bb[n]));
            (void)row; (void)col; *(LAS u32x2*)(F.lds + SGU_ST_OFF + t * SGU_ST_STRIDE + (16 * F.wave + 4 * fq) * 2) = w; }
        __syncthreads();
#pragma unroll
        for (int i = 0; i < 4; ++i) { const int id = F.tid + 512 * i, row = id >> 4, ch = id & 15;
            *(GAS v4u*)((GAS bf16*)Y + (size_t)(r0 + row) * 1024 + g * 128 + ch * 8) = *(const LAS v4u*)(F.lds + SGU_ST_OFF + row * SGU_ST_STRIDE + ch * 16); }
        __syncthreads();
    }
    for (int it = F.vcu * 512 + F.tid; it < 128 * 256; it += F.G * 512) {
        const int b = it >> 8, d = (it & 255) * 4, gh = d >> 7, rowb = MP + b * 4; const f32x4 gg = *(const f32x4*)(sg + d);
        float v[4][4], uu[4][4];
#pragma unroll
        for (int s = 0; s < 4; ++s) { const u32x2 rv = *(const u32x2*)(UV + (size_t)(rowb + s) * 2048 + 1024 + d), ru = *(const u32x2*)(UV + (size_t)(rowb + s) * 2048 + d); const float rs = rs_v(SV, rowb + s);
            v[s][0] = bflo(rv.x) * rs; v[s][1] = bfhi(rv.x) * rs; v[s][2] = bflo(rv.y) * rs; v[s][3] = bfhi(rv.y) * rs;
            uu[s][0] = bflo(ru.x); uu[s][1] = bfhi(ru.x); uu[s][2] = bflo(ru.y); uu[s][3] = bfhi(ru.y);
            *(f32x4*)(vs_out + (size_t)(b * 4 + s) * 1024 + d) = (f32x4){v[s][0] * gg.x, v[s][1] * gg.y, v[s][2] * gg.z, v[s][3] * gg.w}; }
#pragma unroll
        for (int t = 0; t < 4; ++t) { float m[4] = {0.f, 0.f, 0.f, 0.f};
#pragma unroll
            for (int s = 0; s <= t; ++s) { const float w = wsf[((size_t)gh * 128 + t) * 128 + s];
#pragma unroll
                for (int e = 0; e < 4; ++e) m[e] += w * v[s][e]; }
            const float bb = bs[gh * 128 + t];
            u32x2 w; w.x = cvt_pk_bf16(uu[t][0] * (m[0] * gg.x + bb), uu[t][1] * (m[1] * gg.y + bb)); w.y = cvt_pk_bf16(uu[t][2] * (m[2] * gg.z + bb), uu[t][3] * (m[3] * gg.w + bb));
            *(u32x2*)(Y + (size_t)(rowb + t) * 1024 + d) = w; }
    }
}
constexpr size_t RGT_W = 0, RGT_BA = 512 * 1024, RGT_BX = RGT_BA + 4096, RGT_NSP = RGT_BX + 4096;
__device__ __forceinline__ int rg_jch(int m, int r) { return 8 * (r >> 2) + 4 * (m & 1) + (r & 3) + 32 * (m >> 1); }
__device__ __forceinline__ void rglru_tables(const Frame& F, const float* wa, const float* wx, const float* ba, const float* bx, const float* lam, unsigned char* tab) {
    bf16* W = (bf16*)(tab + RGT_W);
    for (int i = F.vcu * 512 + F.tid; i < 16 * 2 * 4 * 2 * 64 * 8; i += F.G * 512) {
        const int e = i & 7, lane = (i >> 3) & 63, ks = (i >> 9) & 1, m = (i >> 10) & 3, type = (i >> 12) & 1, h = i >> 13, fr = lane & 15, fq = lane >> 4;
        const float* w = type ? wx : wa; const float v = w[((size_t)h * 64 + 32 * ks + 8 * fq + e) * 64 + rg_jch(m, fr)];
        W[i] = (bf16)(cvt_pk_bf16(v, 0.f) & 0xffffu);
    }
    for (int c = F.vcu * 512 + F.tid; c < 1024; c += F.G * 512) {
        ((float*)(tab + RGT_BA))[c] = ba[c]; ((float*)(tab + RGT_BX))[c] = bx[c]; ((float*)(tab + RGT_NSP))[c] = -8.0f * log1pf(expf(-lam[c]));
    }
}
template <int CTRL> __device__ __forceinline__ float dpp_f(float old, float src) {
    return __builtin_bit_cast(float, __builtin_amdgcn_update_dpp(__builtin_bit_cast(int, old), __builtin_bit_cast(int, src), CTRL, 0xf, 0xf, false)); }
template <int CTRL> __device__ __forceinline__ float dpp_z(float src) {
    return __builtin_bit_cast(float, __builtin_amdgcn_update_dpp(0, __builtin_bit_cast(int, src), CTRL, 0xf, 0xf, true)); }
constexpr int RG_XC_STRIDE = 68, RG_XC_BYTES = 128 * RG_XC_STRIDE * 4, RG_TOT_OFF = 2 * RG_XC_BYTES, RG_CARRY_OFF = RG_TOT_OFF + 2 * 2 * 8 * 64 * 4, RG_AF_OFF = RG_CARRY_OFF + 512, RG_CT_OFF = RG_AF_OFF + 16384;
template <int D_, bool SAMPLE, int NCH> __device__ __forceinline__ void ks_step(float (&a)[NCH], float (&b)[NCH], int tt) {
#pragma unroll
    for (int i = 0; i < NCH; ++i) {
        float as = dpp_f<0x110 + D_>(1.0f, a[i]), bs = dpp_z<0x110 + D_>(b[i]);
        if (SAMPLE) { const bool ok = tt >= D_; as = ok ? as : 1.0f; bs = ok ? bs : 0.0f; }
        b[i] = a[i] * bs + b[i]; a[i] = a[i] * as;
    }
}
template <bool SAMPLE>
__device__ __forceinline__ void rglru_unit(const Frame& F, int unit, const float* XB, const bf16* G, bf16* Y, const float* cw, const float* cb, const unsigned char* tab,
                                           const float* cstate, const float* hstate, float* conv_out, float* h_out) {
    constexpr int NCH = SAMPLE ? 16 : 8, NM = NCH / 4, CW = SAMPLE ? 64 : 32;
    const int fr = F.lane & 15, fq = F.lane >> 4, w = F.wave;
    int h, b0, rowbase, nchunk, mh;
    if (SAMPLE) { h = unit >> 2; b0 = (unit & 3) * 32; rowbase = MP + b0 * 4; nchunk = 1; mh = 0; }
    else { b0 = unit >> 5; h = (unit >> 1) & 15; mh = unit & 1; rowbase = b0 * 2048; nchunk = 16; }
    LAS float* XC = (LAS float*)F.lds; LAS float* TOT = (LAS float*)(F.lds + RG_TOT_OFF); LAS float* CARRY = (LAS float*)(F.lds + RG_CARRY_OFF);
    const int chq = F.tid & 15, rg = F.tid >> 4, cA = h * 64 + 4 * chq;
    f32x4 nx[7]; u32x2 nq[7];
    auto loadA = [&](int c) {
#pragma unroll
        for (int i = 0; i < 7; ++i) {
            if (SAMPLE) { if (i < 3) nx[i] = *(const GAS f32x4*)((const GAS float*)cstate + ((size_t)(b0 + rg) * 3 + i) * 1024 + cA);
                else { const u32x2 q = *(const GAS u32x2*)((const GAS bf16*)XB + (size_t)(rowbase + rg * 4 + i - 3) * 1024 + cA); nx[i] = (f32x4){bflo(q.x), bfhi(q.x), bflo(q.y), bfhi(q.y)}; } }
            else { const int tau = c * 128 + 4 * rg + i - 3, tc = tau < 0 ? 0 : tau;
                nq[i] = *(const GAS u32x2*)((const GAS bf16*)XB + (size_t)(rowbase + tc) * 1024 + cA); } } };
    loadA(0);
    { const v4u* src = (const v4u*)((const bf16*)(tab + RGT_W) + (size_t)h * 16 * 64 * 8); LAS v4u* dst = (LAS v4u*)(F.lds + RG_AF_OFF);
      dst[F.tid] = src[F.tid]; dst[F.tid + 512] = src[F.tid + 512]; }
    { LAS float* CT = (LAS float*)(F.lds + RG_CT_OFF);
      if (F.tid < 64) { CT[F.tid] = ((const float*)(tab + RGT_BA))[h * 64 + F.tid]; CT[64 + F.tid] = ((const float*)(tab + RGT_BX))[h * 64 + F.tid]; CT[128 + F.tid] = ((const float*)(tab + RGT_NSP))[h * 64 + F.tid];
                        CT[448 + F.tid] = cb[h * 64 + F.tid]; }
      if (F.tid < 256) CT[192 + F.tid] = cw[(F.tid >> 6) * 1024 + h * 64 + (F.tid & 63)]; }
    __syncthreads();
    const LAS float* CTL = (const LAS float*)(F.lds + RG_CT_OFF);
    const LAS bf16x8* AfL = (const LAS bf16x8*)(F.lds + RG_AF_OFF) + F.lane;
    const int chl = h * 64 + 32 * mh + 8 * fq;
    for (int c = 0; c < nchunk; ++c) {
        const int buf = c & 1, c0 = c * 128;
        if (!SAMPLE) {
#pragma unroll
            for (int i = 0; i < 7; ++i) { const bool z = c == 0 && 4 * rg + i - 3 < 0; const u32x2 q = nq[i]; nx[i] = z ? (f32x4){0.f, 0.f, 0.f, 0.f} : (f32x4){bflo(q.x), bfhi(q.x), bflo(q.y), bfhi(q.y)}; } }
        { f32x4 cwv[4];
#pragma unroll
          for (int k = 0; k < 4; ++k) cwv[k] = *(const LAS f32x4*)(CTL + 192 + k * 64 + 4 * chq);
          const f32x4 cbv = *(const LAS f32x4*)(CTL + 448 + 4 * chq);
#pragma unroll
          for (int i = 0; i < 4; ++i) { f32x4 acc = cbv;
#pragma unroll
              for (int k = 0; k < 4; ++k) acc = acc + cwv[k] * nx[i + k];
              *(LAS f32x4*)(XC + (size_t)buf * (128 * RG_XC_STRIDE) + (4 * rg + i) * RG_XC_STRIDE + 4 * chq) = acc; } }
        if (c + 1 < nchunk) loadA(c + 1);
        const int trow = 16 * w + fr;
        const size_t o0 = ((size_t)rowbase + c0 + trow) * 1024 + (SAMPLE ? h * 64 + 8 * fq : chl);
        const v4u g0 = *(const GAS v4u*)((const GAS bf16*)G + o0); v4u g1 = g0; if (SAMPLE) g1 = *(const GAS v4u*)((const GAS bf16*)G + o0 + 32);
        __syncthreads();
        float xc[16];
        { const LAS float* xp = XC + (size_t)buf * (128 * RG_XC_STRIDE) + trow * RG_XC_STRIDE + 8 * fq;
          const f32x4 x0 = *(const LAS f32x4*)(xp), x1 = *(const LAS f32x4*)(xp + 4), x2 = *(const LAS f32x4*)(xp + 32), x3 = *(const LAS f32x4*)(xp + 36);
          xc[0] = x0.x; xc[1] = x0.y; xc[2] = x0.z; xc[3] = x0.w; xc[4] = x1.x; xc[5] = x1.y; xc[6] = x1.z; xc[7] = x1.w;
          xc[8] = x2.x; xc[9] = x2.y; xc[10] = x2.z; xc[11] = x2.w; xc[12] = x3.x; xc[13] = x3.y; xc[14] = x3.z; xc[15] = x3.w; }
        bf16x8 bf0, bf1;
        { v4u p0, p1; p0.x = cvt_pk_bf16(xc[0], xc[1]); p0.y = cvt_pk_bf16(xc[2], xc[3]); p0.z = cvt_pk_bf16(xc[4], xc[5]); p0.w = cvt_pk_bf16(xc[6], xc[7]);
          p1.x = cvt_pk_bf16(xc[8], xc[9]); p1.y = cvt_pk_bf16(xc[10], xc[11]); p1.z = cvt_pk_bf16(xc[12], xc[13]); p1.w = cvt_pk_bf16(xc[14], xc[15]);
          bf0 = __builtin_bit_cast(bf16x8, p0); bf1 = __builtin_bit_cast(bf16x8, p1); }
        float av[NCH], bv[NCH];
#pragma unroll
        for (int mm = 0; mm < NM; ++mm) { const int m = SAMPLE ? mm : 2 * mh + mm;
            f32x4 ra = (f32x4){0.f, 0.f, 0.f, 0.f}, rx = ra;
            ra = __builtin_amdgcn_mfma_f32_16x16x32_bf16(AfL[((0 * 4 + m) * 2 + 0) * 64], bf0, ra, 0, 0, 0); ra = __builtin_amdgcn_mfma_f32_16x16x32_bf16(AfL[((0 * 4 + m) * 2 + 1) * 64], bf1, ra, 0, 0, 0);
            rx = __builtin_amdgcn_mfma_f32_16x16x32_bf16(AfL[((1 * 4 + m) * 2 + 0) * 64], bf0, rx, 0, 0, 0); rx = __builtin_amdgcn_mfma_f32_16x16x32_bf16(AfL[((1 * 4 + m) * 2 + 1) * 64], bf1, rx, 0, 0, 0);
            const int cg = h * 64 + 8 * fq + 4 * (m & 1) + 32 * (m >> 1);
            const int cgl = cg - h * 64; const f32x4 ba4 = *(const LAS f32x4*)(CTL + cgl), bx4 = *(const LAS f32x4*)(CTL + 64 + cgl), ns4 = *(const LAS f32x4*)(CTL + 128 + cgl);
#pragma unroll
            for (int r = 0; r < 4; ++r) { const float rg_ = sigmoid_fast(ra[r] + ba4[r]), ig = sigmoid_fast(rx[r] + bx4[r]);
                const float la = ns4[r] * rg_, a = __builtin_amdgcn_exp2f(1.4426950408889634f * la), mult = __builtin_amdgcn_sqrtf(fmaxf(1.f - a * a, 0.f));
                const float xcv = SAMPLE ? xc[4 * mm + r] : (mh ? xc[8 + 4 * mm + r] : xc[4 * mm + r]);
                av[4 * mm + r] = a; bv[4 * mm + r] = mult * ig * xcv; }
        }
        const int tt = fr & 3;
        if (SAMPLE) {
            const int bi = (16 * w + fr) >> 2;
#pragma unroll
            for (int m = 0; m < 4; ++m) { const int cg = h * 64 + 8 * fq + 4 * (m & 1) + 32 * (m >> 1); const f32x4 h0 = *(const f32x4*)(hstate + (size_t)(b0 + bi) * 1024 + cg);
#pragma unroll
                for (int r = 0; r < 4; ++r) if (tt == 0) bv[4 * m + r] += av[4 * m + r] * h0[r]; }
            ks_step<1, true, NCH>(av, bv, tt); ks_step<2, true, NCH>(av, bv, tt);
        } else {
            ks_step<1, false, NCH>(av, bv, tt); ks_step<2, false, NCH>(av, bv, tt); ks_step<4, false, NCH>(av, bv, tt); ks_step<8, false, NCH>(av, bv, tt);
            if (fr == 15) { LAS float* ta = TOT + ((size_t)(buf * 2 + 0) * 8 + w) * 64 + fq * NCH; LAS float* th = TOT + ((size_t)(buf * 2 + 1) * 8 + w) * 64 + fq * NCH;
#pragma unroll
                for (int i = 0; i < NCH; i += 4) { *(LAS f32x4*)(ta + i) = (f32x4){av[i], av[i + 1], av[i + 2], av[i + 3]}; *(LAS f32x4*)(th + i) = (f32x4){bv[i], bv[i + 1], bv[i + 2], bv[i + 3]}; } }
            __syncthreads();
            float ch[NCH];
            if (c == 0) {
#pragma unroll
                for (int i = 0; i < NCH; ++i) ch[i] = 0.f;
            } else {
#pragma unroll
                for (int i = 0; i < NCH; i += 4) { const f32x4 t = *(const LAS f32x4*)(CARRY + buf * 64 + fq * NCH + i); ch[i] = t.x; ch[i + 1] = t.y; ch[i + 2] = t.z; ch[i + 3] = t.w; }
            }
            for (int v = 0; v < w; ++v) { const LAS float* ta = TOT + ((size_t)(buf * 2 + 0) * 8 + v) * 64 + fq * NCH; const LAS float* th = TOT + ((size_t)(buf * 2 + 1) * 8 + v) * 64 + fq * NCH;
#pragma unroll
                for (int i = 0; i < NCH; i += 4) { const f32x4 A4 = *(const LAS f32x4*)(ta + i), H4 = *(const LAS f32x4*)(th + i);
                    ch[i] = A4.x * ch[i] + H4.x; ch[i + 1] = A4.y * ch[i + 1] + H4.y; ch[i + 2] = A4.z * ch[i + 2] + H4.z; ch[i + 3] = A4.w * ch[i + 3] + H4.w; } }
#pragma unroll
            for (int i = 0; i < NCH; ++i) bv[i] = bv[i] + av[i] * ch[i];
            if (w == 7 && fr == 15) {
#pragma unroll
                for (int i = 0; i < NCH; i += 4) *(LAS f32x4*)(CARRY + (buf ^ 1) * 64 + fq * NCH + i) = (f32x4){bv[i], bv[i + 1], bv[i + 2], bv[i + 3]}; }
        }
        { v4u y0;
          y0.x = cvt_pk_bf16(bv[0] * bflo(g0.x), bv[1] * bfhi(g0.x)); y0.y = cvt_pk_bf16(bv[2] * bflo(g0.y), bv[3] * bfhi(g0.y)); y0.z = cvt_pk_bf16(bv[4] * bflo(g0.z), bv[5] * bfhi(g0.z)); y0.w = cvt_pk_bf16(bv[6] * bflo(g0.w), bv[7] * bfhi(g0.w));
          *(v4u*)(Y + o0) = y0;
          if constexpr (SAMPLE) { v4u y1;
            y1.x = cvt_pk_bf16(bv[8] * bflo(g1.x), bv[9] * bfhi(g1.x)); y1.y = cvt_pk_bf16(bv[10] * bflo(g1.y), bv[11] * bfhi(g1.y)); y1.z = cvt_pk_bf16(bv[12] * bflo(g1.z), bv[13] * bfhi(g1.z)); y1.w = cvt_pk_bf16(bv[14] * bflo(g1.w), bv[15] * bfhi(g1.w));
            *(v4u*)(Y + o0 + 32) = y1; } }
        if constexpr (SAMPLE) {
            if (tt == 3) { const int bi = (16 * w + fr) >> 2; float* ho = h_out + (size_t)(b0 + bi) * 1024 + h * 64 + 8 * fq;
                *(f32x4*)(ho) = (f32x4){bv[0], bv[1], bv[2], bv[3]}; *(f32x4*)(ho + 4) = (f32x4){bv[4], bv[5], bv[6], bv[7]};
                *(f32x4*)(ho + 32) = (f32x4){bv[8], bv[9], bv[10], bv[11]}; *(f32x4*)(ho + 36) = (f32x4){bv[12], bv[13], bv[14], bv[15]}; }
        } else if (c == nchunk - 1 && w == 7 && fr == 15) { float* ho = h_out + (size_t)b0 * 1024 + chl;
            *(f32x4*)(ho) = (f32x4){bv[0], bv[1], bv[2], bv[3]}; *(f32x4*)(ho + 4) = (f32x4){bv[4], bv[5], bv[6], bv[7]}; }
    }
    if (SAMPLE) { for (int i = F.tid; i < 32 * 3 * 64; i += 512) { const int cc = i & 63, r = (i >> 6) % 3, bi = i / 192;
            conv_out[((size_t)(b0 + bi) * 3 + r) * 1024 + h * 64 + cc] = bf2f(((const bf16*)XB)[(size_t)(rowbase + bi * 4 + 1 + r) * 1024 + h * 64 + cc]); } }
    else if (mh == 0 && F.tid < 192) { const int cc = F.tid & 63, r = F.tid >> 6; conv_out[((size_t)b0 * 3 + r) * 1024 + h * 64 + cc] = bf2f(((const bf16*)XB)[(size_t)(rowbase + 2045 + r) * 1024 + h * 64 + cc]); }
    __syncthreads();
}
__device__ __forceinline__ void rglru_phase(const Frame& F, const float* XB, const bf16* G, bf16* Y, const float* cw, const float* cb, const unsigned char* tab, const float* cstate, const float* hstate, float* out) {
    for (int unit = F.vcu; unit < 320; unit += F.G) {
        if (unit < 256) rglru_unit<false>(F, unit, XB, G, Y, cw, cb, tab, nullptr, nullptr, out + O_CONVP, out + O_HP);
        else rglru_unit<true>(F, unit - 256, XB, G, Y, cw, cb, tab, cstate, hstate, out + O_CONVS, out + O_HS);
    }
}
typedef float f32x16 __attribute__((ext_vector_type(16)));
typedef float f32x2 __attribute__((ext_vector_type(2)));
constexpr size_t S5T_AP = 0, S5T_BF = 128 * 1024, S5T_CF = S5T_BF + 256 * 1024;
__device__ __forceinline__ void s5_disc(const float* lre, const float* lim, const float* ldt, int g, int p, float& ar, float& ai, float& qr, float& qi) {
    const float dt = expf(ldt[g]), lr = lre[g * 64 + p], li = lim[g * 64 + p], mag = expf(lr * dt); ar = mag * cosf(li * dt); ai = mag * sinf(li * dt);
    const float zr = ar - 1.f, zi = ai, den = lr * lr + li * li; qr = (zr * lr + zi * li) / den; qi = (zi * lr - zr * li) / den;
}
__device__ __forceinline__ void s5_tables(const Frame& F, const float* lre, const float* lim, const float* ldt, const float* bre, const float* bim, const float* cre, const float* cim, unsigned char* tab) {
    for (int i = F.vcu * 512 + F.tid; i < 4096; i += F.G * 512) { float ar, ai, qr, qi; s5_disc(lre, lim, ldt, i >> 6, i & 63, ar, ai, qr, qi);
        float* o = (float*)(tab + S5T_AP) + (size_t)i * 8; o[0] = ar; o[1] = ai;
        const float r2 = ar * ar - ai * ai, i2 = 2.f * ar * ai; o[2] = r2; o[3] = i2; const float r3 = r2 * ar - i2 * ai, i3 = r2 * ai + i2 * ar; o[4] = r3; o[5] = i3; o[6] = r2 * r2 - i2 * i2; o[7] = 2.f * r2 * i2; }
    for (int i = F.vcu * 512 + F.tid; i < 64 * 2 * 2 * 64 * 8; i += F.G * 512) {
        const int j = i & 7, lane = (i >> 3) & 63, c = (i >> 9) & 1, ws = (i >> 10) & 1, g = i >> 11, p = 32 * ws + (lane & 31), h = 8 * (lane >> 5) + j;
        float ar, ai, qr, qi; s5_disc(lre, lim, ldt, g, p, ar, ai, qr, qi);
        const float br = bre[((size_t)g * 64 + p) * 16 + h], bi = bim[((size_t)g * 64 + p) * 16 + h]; const float v = c ? (qr * bi + qi * br) : (qr * br - qi * bi);
        ((bf16*)(tab + S5T_BF))[i] = (bf16)(cvt_pk_bf16(v, 0.f) & 0xffffu);
    }
    for (int i = F.vcu * 512 + F.tid; i < 64 * 4 * 64 * 8; i += F.G * 512) {
        const int j = i & 7, lane = (i >> 3) & 63, kk = (i >> 9) & 3, g = i >> 11, h = lane & 15, k = 32 * kk + 8 * (lane >> 4) + j, p = k >> 1;
        const float v = (k & 1) ? -cim[((size_t)g * 16 + h) * 64 + p] : cre[((size_t)g * 16 + h) * 64 + p];
        ((bf16*)(tab + S5T_CF))[i] = (bf16)(cvt_pk_bf16(v, 0.f) & 0xffffu);
    }
}
constexpr int S5_XT_STRIDE = 272;
constexpr int S5_XT_UNIT = 128 * S5_XT_STRIDE;
__device__ __forceinline__ f32x2 cmadd(f32x2 a, f32x2 x, f32x2 c) {
    c = (f32x2){a.x, a.x} * x + c; return (f32x2){-a.y, a.y} * __builtin_shufflevector(x, x, 1, 0) + c; }
template <bool SAMPLE>
__device__ __forceinline__ void s5_pass(const Frame& F, int upair, const float* U, bf16* Gs, const float* dsk, const unsigned char* tab, const float* sre, const float* sim, float* ore, float* oim) {
    const int w = F.wave, l31 = F.lane & 31, hh = F.lane >> 5, fr = F.lane & 15, fq = F.lane >> 4;
    constexpr int NTILE = SAMPLE ? 1 : 4, NCHUNK = SAMPLE ? 1 : 16, CROWS = SAMPLE ? 32 : 128;
    LAS unsigned char* XT = F.lds;
    const int su = (w >> 1) & 1, ws = w & 1, sunit = upair * 2 + su;
    int sg, srow, sb0; if (SAMPLE) { sg = sunit >> 4; sb0 = (sunit & 15) * 8; srow = MP + sb0 * 4; } else { sb0 = sunit >> 6; sg = sunit & 63; srow = sb0 * 2048; }
    const int pw = SAMPLE ? ((w >> 1) & 1) : (w >> 2), punit = upair * 2 + pw;
    int pg, prow; if (SAMPLE) { pg = punit >> 4; prow = MP + (punit & 15) * 32; } else { pg = punit & 63; prow = (punit >> 6) * 2048; }
    bf16x8 Cf[4];
#pragma unroll
    for (int kk = 0; kk < 4; ++kk) Cf[kk] = *(const bf16x8*)((const bf16*)(tab + S5T_CF) + (((size_t)pg * 4 + kk) * 64 + F.lane) * 8);
    const f32x4 d4 = *(const f32x4*)(dsk + pg * 16 + 4 * fq);
    f32x2 A1, A2, A3, A4, X = (f32x2){0.f, 0.f}; bf16x8 Bf0, Bf1; v4u ua[NTILE];
    if (w < 4) {
        const f32x4* a4 = (const f32x4*)((const float*)(tab + S5T_AP) + ((size_t)sg * 64 + 32 * ws + l31) * 8); const f32x4 lo = a4[0], hi = a4[1];
        A1 = (f32x2){lo.x, lo.y}; A2 = (f32x2){lo.z, lo.w}; A3 = (f32x2){hi.x, hi.y}; A4 = (f32x2){hi.z, hi.w};
        Bf0 = *(const bf16x8*)((const bf16*)(tab + S5T_BF) + ((((size_t)sg * 2 + ws) * 2 + 0) * 64 + F.lane) * 8);
        Bf1 = *(const bf16x8*)((const bf16*)(tab + S5T_BF) + ((((size_t)sg * 2 + ws) * 2 + 1) * 64 + F.lane) * 8);
#pragma unroll
        for (int tl = 0; tl < NTILE; ++tl) if (SAMPLE) ua[tl] = *(const GAS v4u*)((const GAS bf16*)U + ((size_t)srow + tl * 32 + l31) * 1024 + sg * 16 + 8 * hh);
    }
    constexpr int S5_YS_OFF = 2 * S5_XT_UNIT, S5_YS_STRIDE = 80, S5_YS_BUF = 128 * S5_YS_STRIDE;
    const int ys_row = 16 * F.wave + (F.lane >> 2), ys_pc = F.lane & 3;
    bf16* ys_dst = Gs + ((size_t)((upair * 2) >> 6) * 2048 + ys_row) * 1024 + ((upair * 2) & 63) * 16 + ys_pc * 8;
    constexpr int S5_UL_OFF = S5_YS_OFF + 2 * S5_YS_BUF, S5_UL_STRIDE = 80, S5_UL_BUF = 128 * S5_UL_STRIDE;
    const GAS bf16* ul_src = (const GAS bf16*)U + ((size_t)((upair * 2) >> 6) * 2048 + ys_row) * 1024 + ((upair * 2) & 63) * 16 + ys_pc * 8;
    v4u un = (v4u){0u, 0u, 0u, 0u};
    if (!SAMPLE) { un = *(const GAS v4u*)ul_src; *(LAS v4u*)(F.lds + S5_UL_OFF + ys_row * S5_UL_STRIDE + ys_pc * 16) = un; __syncthreads(); }
    for (int c = 0; c < NCHUNK; ++c) {
        if (!SAMPLE && c + 1 < NCHUNK) un = *(const GAS v4u*)(ul_src + (size_t)(c + 1) * 128 * 1024);
        if (!SAMPLE && c > 0) *(GAS v4u*)((GAS bf16*)ys_dst + (size_t)(c - 1) * 128 * 1024) = *(const LAS v4u*)(F.lds + S5_YS_OFF + ((c - 1) & 1) * S5_YS_BUF + ys_row * S5_YS_STRIDE + ys_pc * 16);
        u32x2 up4[2];
#pragma unroll
        for (int q2 = 0; q2 < (SAMPLE ? 1 : 2); ++q2) { const int st = SAMPLE ? (w & 1) : ((w & 3) * 2 + q2);
            if (SAMPLE) up4[q2] = *(const GAS u32x2*)((const GAS bf16*)U + ((size_t)prow + c * 128 + st * 16 + fr) * 1024 + pg * 16 + 4 * fq);
            else up4[q2] = (u32x2){0u, 0u}; }
        if (w < 4) {
#pragma unroll
            for (int tl = 0; tl < NTILE; ++tl) {
                const v4u aw = SAMPLE ? ua[tl] : *(const LAS v4u*)(F.lds + S5_UL_OFF + (c & 1) * S5_UL_BUF + (tl * 32 + l31) * S5_UL_STRIDE + su * 32 + hh * 16);
                const bf16x8 Au = __builtin_bit_cast(bf16x8, aw); f32x16 z16;
#pragma unroll
                for (int i = 0; i < 16; ++i) z16[i] = 0.f;
                const f32x16 bur = __builtin_amdgcn_mfma_f32_32x32x16_bf16(Au, Bf0, z16, 0, 0, 0), bui = __builtin_amdgcn_mfma_f32_32x32x16_bf16(Au, Bf1, z16, 0, 0, 0);
                f32x2 x[16];
#pragma unroll
                for (int k = 0; k < 4; ++k) { f32x2 s = (f32x2){0.f, 0.f};
                    if (SAMPLE) { const size_t so = ((size_t)(sb0 + 2 * k + hh) * 64 + sg) * 64 + 32 * ws + l31; s = (f32x2){sre[so], sim[so]}; }
#pragma unroll
                    for (int i = 0; i < 4; ++i) { const f32x2 bu = (f32x2){bur[4 * k + i], bui[4 * k + i]}; s = (!SAMPLE && i == 0) ? bu : cmadd(A1, s, bu); x[4 * k + i] = s; } }
                if (!SAMPLE) {
                    f32x2 xin[4];
#pragma unroll
                    for (int k = 0; k < 4; ++k) {
                        const f32x2 own = x[4 * k + 3]; float ax = own.x, bx = own.x, ay = own.y, by = own.y;
                        asm volatile("v_nop\n\tv_nop\n\tv_permlane32_swap_b32 %0, %1" : "+v"(ax), "+v"(bx)); asm volatile("v_nop\n\tv_nop\n\tv_permlane32_swap_b32 %0, %1" : "+v"(ay), "+v"(by));
                        const f32x2 L0 = (f32x2){ax, ay}, L1 = (f32x2){bx, by};
                        const f32x2 X0 = X; const f32x2 X1 = cmadd(A4, X0, L0); X = cmadd(A4, X1, L1);
                        xin[k] = hh ? X1 : X0; }
#pragma unroll
                    for (int k = 0; k < 4; ++k) { x[4 * k + 0] = cmadd(A1, xin[k], x[4 * k + 0]); x[4 * k + 1] = cmadd(A2, xin[k], x[4 * k + 1]); x[4 * k + 2] = cmadd(A3, xin[k], x[4 * k + 2]); x[4 * k + 3] = cmadd(A4, xin[k], x[4 * k + 3]); }
                }
                LAS unsigned char* xt = XT + su * S5_XT_UNIT + (32 * ws + l31) * 4;
#pragma unroll
                for (int r = 0; r < 16; ++r) *(LAS unsigned*)(xt + (tl * 32 + 8 * (r >> 2) + 4 * hh + (r & 3)) * S5_XT_STRIDE) = cvt_pk_bf16(x[r].x, x[r].y);
                if (SAMPLE) {
#pragma unroll
                    for (int k = 0; k < 4; ++k) { const size_t so = ((size_t)(sb0 + 2 * k + hh) * 64 + sg) * 64 + 32 * ws + l31; ore[so] = x[4 * k + 3].x; oim[so] = x[4 * k + 3].y; } }
            }
        }
        __syncthreads();
        if (!SAMPLE || w < 4) {
#pragma unroll
            for (int q2 = 0; q2 < (SAMPLE ? 1 : 2); ++q2) { const int st = SAMPLE ? (w & 1) : ((w & 3) * 2 + q2);
                const size_t row = (size_t)prow + c * 128 + st * 16 + fr; const int ch = pg * 16 + 4 * fq;
                const u32x2 uq = SAMPLE ? up4[q2] : *(const LAS u32x2*)(F.lds + S5_UL_OFF + (c & 1) * S5_UL_BUF + (st * 16 + fr) * S5_UL_STRIDE + pw * 32 + fq * 8);
                const f32x4 u4 = (f32x4){bflo(uq.x), bfhi(uq.x), bflo(uq.y), bfhi(uq.y)};
                const LAS unsigned char* xr = XT + pw * S5_XT_UNIT + (st * 16 + fr) * S5_XT_STRIDE + 16 * fq; f32x4 y = (f32x4){0.f, 0.f, 0.f, 0.f};
#pragma unroll
                for (int kk = 0; kk < 4; ++kk) y = __builtin_amdgcn_mfma_f32_16x16x32_bf16(Cf[kk], *(const LAS bf16x8*)(xr + 64 * kk), y, 0, 0, 0);
                y = y + d4 * u4;
                u32x2 o; o.x = cvt_pk_bf16(gelu_fast(y.x), gelu_fast(y.y)); o.y = cvt_pk_bf16(gelu_fast(y.z), gelu_fast(y.w));
                if (SAMPLE) *(u32x2*)(Gs + row * 1024 + ch) = o; else *(LAS u32x2*)(F.lds + S5_YS_OFF + (c & 1) * S5_YS_BUF + (st * 16 + fr) * S5_YS_STRIDE + pw * 32 + fq * 8) = o; }
        }
        if (!SAMPLE && c + 1 < NCHUNK) *(LAS v4u*)(F.lds + S5_UL_OFF + ((c + 1) & 1) * S5_UL_BUF + ys_row * S5_UL_STRIDE + ys_pc * 16) = un;
        __syncthreads();
    }
    if (!SAMPLE) *(GAS v4u*)((GAS bf16*)ys_dst + (size_t)(NCHUNK - 1) * 128 * 1024) = *(const LAS v4u*)(F.lds + S5_YS_OFF + ((NCHUNK - 1) & 1) * S5_YS_BUF + ys_row * S5_YS_STRIDE + ys_pc * 16);
    if (!SAMPLE && w < 4 && hh == 0) { const size_t so = ((size_t)sb0 * 64 + sg) * 64 + 32 * ws + l31; ore[so] = X.x; oim[so] = X.y; }
    if (!SAMPLE) __syncthreads();
}
__device__ __forceinline__ void s5_phase(const Frame& F, const float* U, bf16* Gs, const float* dsk, const unsigned char* tab, const float* sre, const float* sim, float* out) {
    for (int u0 = F.vcu; u0 < 256; u0 += F.G) s5_pass<false>(F, u0, U, Gs, dsk, tab, nullptr, nullptr, out + O_SREP, out + O_SIMP);
    for (int u0 = F.vcu; u0 < 512; u0 += F.G) s5_pass<true>(F, u0, U, Gs, dsk, tab, sre, sim, out + O_SRES, out + O_SIMS);
}
constexpr int PH_FINAL = 21, PH_END = 22;
enum { ST_GIN = 0, ST_MIX = 1, ST_GOUT = 2, ST_FF1 = 3, ST_FF2 = 4 };
constexpr size_t WS_SX0 = 172 * MiB, WS_SX1 = 175 * MiB, WS_SV = 178 * MiB;
constexpr size_t T_Y = 99 * MiB;

__global__ void __launch_bounds__(NWAVES * 64, 2) mk(Args a) {
    extern __shared__ __attribute__((aligned(16))) unsigned char lds_raw[];
    Frame F; F.lds = (LAS unsigned char*)lds_raw; F.tid = threadIdx.x; F.lane = F.tid & 63; F.wave = __builtin_amdgcn_readfirstlane(F.tid >> 6);
    F.G = gridDim.x; F.bx = blockIdx.x; F.vcu = (F.bx % 8) * (F.G / 8) + F.bx / 8;
    volatile LAS unsigned* MISC = (volatile LAS unsigned*)(F.lds + MISC_OFF);
    for (int u = F.tid; u < (LDS_BYTES - LDSCTL_OFF) / 4; u += NWAVES * 64) ((LAS unsigned*)(F.lds + LDSCTL_OFF))[u] = 0u;
    __syncthreads();
    if (F.tid == 0) { LAS unsigned long long* pt = (LAS unsigned long long*)(F.lds + PTAB_OFF);
#pragma unroll
        for (int i = 0; i < 35; ++i) pt[i] = (unsigned long long)a.in[i]; }
    __syncthreads();
    const bool multi = (a.ph_hi - a.ph_lo) > 1;
    XcdBarrier bar; bar.bar = (unsigned*)(a.ws + WS_CTL) + CW_BAR; bar.x = 0; bar.st = nullptr;
    if (multi) bar = xcd_barrier_post((unsigned*)(a.ws + WS_CTL) + CW_BAR, MISC + 8);

    for (int ph = a.ph_lo; ph < a.ph_hi; ++ph) {
        { int t_ = threadIdx.x, b_ = blockIdx.x; asm volatile("" : "+v"(t_)); asm volatile("" : "+s"(b_));
          F.tid = t_; F.lane = t_ & 63; F.wave = __builtin_amdgcn_readfirstlane(t_ >> 6); F.bx = b_; F.vcu = (b_ % 8) * (F.G / 8) + b_ / 8; }
        unsigned char* ws = a.ws; float* X = a.out; asm volatile("" : "+s"(ws)); asm volatile("" : "+s"(X));
        bf16* XB16 = (bf16*)(ws + WS_XN); unsigned char* T = ws + WS_T; bf16* Y = (bf16*)(T + T_Y);
        float* SX0 = (float*)(ws + WS_SX0); float* SX1 = (float*)(ws + WS_SX1); float* SV = (float*)(ws + WS_SV);
        if (ph == 0) {
            prologue_rows(F, inp(F, 0), inp(F, 1), XB16, SX0);
            { const float* wsf = inp(F, 13); bf16* wm = (bf16*)(ws + WS_WM);
              for (int i = F.vcu * 512 + F.tid; i < 2 * 8 * 128 * 128; i += F.G * 512) { const int s_ = i & 127, t_ = (i >> 7) & 127; wm[i] = s_ <= t_ ? (bf16)(cvt_pk_bf16(wsf[i], 0.f) & 0xffffu) : (bf16)0; } }
            s5_tables(F, inp(F, 26), inp(F, 27), inp(F, 28), inp(F, 29), inp(F, 30), inp(F, 31), inp(F, 32), ws + WS_S5T);
            rglru_tables(F, inp(F, 19), inp(F, 21), inp(F, 20), inp(F, 22), inp(F, 23), ws + WS_RGT);
            const int gw = F.vcu * NWAVES + F.wave, NGW = F.G * NWAVES; const float* gm = inp(F, 6);
            for (int it0 = gw; it0 < 1024; it0 += NGW) { int it = it0; conv_job(F, it, inp(F, 11), D, 2048, (bf16*)(ws + WS_W_INA), false, gm); }
        } else if (ph == PH_FINAL) {
            norm_final(F, XB16, X, inp(F, 8));
        } else {
            const int l = (ph - 1) / 5, st = (ph - 1) % 5, kind = l % 3, j = l / 3;
            if (st == ST_GIN) {
                if (kind == 0) { const bf16* W = (const bf16*)(ws + WS_W_INA + (size_t)j * 4 * MiB); EpiRow8<FAct<ACT_GELU, true>> E{{(bf16*)T, 2048, SX0, 16, SV}};
                    if (F.vcu & 1) { small_gemm<4, 8, false, 4>(F, XB16, W, D, E.f); big_gemm(F, XB16, W, 2048, D, E); } else { big_gemm(F, XB16, W, 2048, D, E); small_gemm<4, 8, false, 4>(F, XB16, W, D, E.f); } }
                else if (kind == 1) { const bf16* W = (const bf16*)(ws + WS_W_INB); EpiRow8<FRglru> E{{(bf16*)T, (float*)(T + 33 * MiB), SX0}};
                    if (F.vcu & 1) { small_gemm<4, 8, false, 4>(F, XB16, W, D, E.f); big_gemm(F, XB16, W, 2048, D, E); } else { big_gemm(F, XB16, W, 2048, D, E); small_gemm<4, 8, false, 4>(F, XB16, W, D, E.f); } }
                else { const bf16* W = (const bf16*)(ws + WS_W_INC); EpiRow8<FBf> E{{(bf16*)T, D, SX0}};
                    if (F.vcu & 1) { small_gemm<2, 8, false, 4>(F, XB16, W, D, E.f); big_gemm(F, XB16, W, D, D, E); } else { big_gemm(F, XB16, W, D, D, E); small_gemm<2, 8, false, 4>(F, XB16, W, D, E.f); } }
            } else if (st == ST_MIX) {
                if (kind == 0) sgu_mix_phase(F, (const bf16*)T, SV, inp(F, 12) + j * 1024, (const bf16*)(ws + WS_WM) + (size_t)j * 8 * 128 * 128, inp(F, 14) + j * 8 * 128, inp(F, 13) + (size_t)j * 8 * 128 * 128, Y, X + O_VS + (size_t)j * MS * 1024);
                else if (kind == 1) rglru_phase(F, (const float*)(T + 33 * MiB), (const bf16*)T, Y, inp(F, 17), inp(F, 18), ws + WS_RGT, inp(F, 2), inp(F, 3), X);
                else s5_phase(F, (const float*)T, Y, inp(F, 33), ws + WS_S5T, inp(F, 4), inp(F, 5), X);
            } else if (st == ST_GOUT) {
                if (kind == 2) { const bf16* W = (const bf16*)(ws + WS_W_GLU); EpiPair8<FGlu> E{{XB16, SX1}};
                    if (F.vcu & 1) { small_gemm<4, 8, true, 4>(F, Y, W, D, E.f); big_gemm(F, Y, W, 2048, D, E); } else { big_gemm(F, Y, W, 2048, D, E); small_gemm<4, 8, true, 4>(F, Y, W, D, E.f); } }
                else { const bf16* W = kind == 0 ? (const bf16*)(ws + WS_W_OUTA + (size_t)j * 2 * MiB) : (const bf16*)(ws + WS_W_OUTB); EpiResid8<FResid> E{{XB16, SX1}};
                    if (F.vcu & 1) { small_gemm<2, 8, false, 4>(F, Y, W, D, E.f); big_gemm(F, Y, W, D, D, E); } else { big_gemm(F, Y, W, D, D, E); small_gemm<2, 8, false, 4>(F, Y, W, D, E.f); } }
            } else if (st == ST_FF1) {
                const bf16* W = (const bf16*)(ws + WS_W_FF1); EpiRow8<FAct<ACT_SQRELU, false>> E{{(bf16*)T, FF, SX1, kind == 2 ? 32 : 16, nullptr}};
                if (F.vcu & 1) { small_gemm<8, 4, false, 4>(F, XB16, W, D, E.f); big_gemm(F, XB16, W, FF, D, E); } else { big_gemm(F, XB16, W, FF, D, E); small_gemm<8, 4, false, 4>(F, XB16, W, D, E.f); }
            } else {
                const bf16* W = (const bf16*)(ws + WS_W_FF2); EpiResid8<FResid> E{{XB16, SX0}};
                if (F.vcu & 1) { small_gemm<2, 8, false, 4>(F, (const bf16*)T, W, FF, E.f); big_gemm(F, (const bf16*)T, W, D, FF, E); } else { big_gemm(F, (const bf16*)T, W, D, FF, E); small_gemm<2, 8, false, 4>(F, (const bf16*)T, W, FF, E.f); }
            }
        }
        if (ph + 1 < a.ph_hi) {
            xcd_barrier_arrive(bar);
            if (ph >= 1 && ph < PH_FINAL) { const int st = (ph - 1) % 5;
                if (st == ST_GIN || st == ST_MIX) ffn_conv(F, (ph - 1) / 5, inp(F, 9), inp(F, 10), inp(F, 7), ws, st == ST_MIX ? 1 : 0);
                else if (ph == 1 + ST_GOUT) proj_conv(F, ws, 1);
                else if (ph == 1 + ST_FF1) proj_conv(F, ws, 2); }
            else if (ph == 0) proj_conv(F, ws, 0);
            xcd_barrier_wait(bar);
        }
    }
}

static void launch_mk(const Args& base, int lo, int hi, hipStream_t stream) {
    Args a = base; a.ph_lo = lo; a.ph_hi = hi;
    hipLaunchKernelGGL(mk, dim3(256), dim3(NWAVES * 64), LDS_BYTES, stream, a);
}

extern "C" void kernel_launch(void* const* d_in, const int* in_sizes, int n_in, void* d_out, int out_size, void* d_ws, size_t ws_size, hipStream_t stream) {
    static int inited = 0;
    if (!inited) {
        if (n_in != 35 || out_size != (int)O_END || ws_size < WS_END) { fprintf(stderr, "kernel_launch: unexpected sizes n_in %d out %d ws %zu\n", n_in, out_size, ws_size); }
        if (hipFuncSetAttribute((const void*)mk, hipFuncAttributeMaxDynamicSharedMemorySize, LDS_BYTES) != hipSuccess) fprintf(stderr, "kernel_launch: hipFuncSetAttribute failed\n");
        (void)hipGetLastError(); inited = 1;
    }
    (void)hipMemsetAsync((unsigned char*)d_ws + WS_CTL, 0, CTL_ZERO_BYTES, stream);
    Args base{}; for (int i = 0; i < 35; ++i) base.in[i] = (const float*)d_in[i]; base.out = (float*)d_out; base.ws = (unsigned char*)d_ws;
    launch_mk(base, 0, PH_END, stream);
}
```

```cpp
#include <hip/hip_runtime.h>
#include <cstdio>
#include <cstdint>

constexpr int MP = 16384, MS = 512, M = MP + MS, D = 1024, FF = 4096;
constexpr float EPS = 1e-6f;

constexpr size_t O_YP = 0, O_YS = (size_t)MP * D, O_VS = O_YS + (size_t)MS * D, O_CONVP = O_VS + 2 * (size_t)MS * D, O_HP = O_CONVP + 8 * 3 * 1024,
                 O_CONVS = O_HP + 8 * 1024, O_HS = O_CONVS + 128 * 3 * 1024, O_SREP = O_HS + 128 * 1024, O_SIMP = O_SREP + 8 * 4096, O_SRES = O_SIMP + 8 * 4096,
                 O_SIMS = O_SRES + 128 * 4096, O_END = O_SIMS + 128 * 4096;

constexpr size_t MiB = 1u << 20;
constexpr size_t WS_CTL = 0, CTL_ZERO_BYTES = 64 * 1024;
constexpr size_t WS_XN = 1 * MiB;
constexpr size_t WS_T = 34 * MiB;
constexpr size_t WS_RSV = 128 * 1024;
constexpr size_t WS_WM = 166 * MiB;
constexpr size_t WS_RGT = 167 * MiB;
constexpr size_t WS_S5T = 168 * MiB;
constexpr size_t WS_S5AB = 170 * MiB;
constexpr size_t WS_S5BB = 170 * MiB + 512 * 1024;
constexpr size_t WS_HST = 171 * MiB;
constexpr size_t WS_S5ST = 172 * MiB;
constexpr size_t WS_CHA = 176 * MiB;
constexpr size_t WS_CHB = 180 * MiB;
constexpr size_t WS_XSR = 184 * MiB;
constexpr size_t WS_XSI = 200 * MiB;
constexpr size_t WS_W_INA = 216 * MiB, WS_W_OUTA = 224 * MiB, WS_W_INB = 228 * MiB, WS_W_OUTB = 232 * MiB, WS_W_INC = 234 * MiB, WS_W_GLU = 236 * MiB,
                 WS_W_FF1 = 240 * MiB, WS_W_FF2 = 248 * MiB, WS_END = 256 * MiB;
constexpr int CW_BAR = 4096;

#define GAS __attribute__((address_space(1)))
#define LAS __attribute__((address_space(3)))
typedef unsigned short bf16;
typedef unsigned v4u __attribute__((ext_vector_type(4)));
typedef float f32x4 __attribute__((ext_vector_type(4)));
typedef short bf16x8 __attribute__((ext_vector_type(8)));
typedef GAS unsigned gu32;
typedef GAS unsigned long long gu64;
#define RLX_AGENT __ATOMIC_RELAXED, __HIP_MEMORY_SCOPE_AGENT
#define LDS_WAIT() asm volatile("s_waitcnt lgkmcnt(0)" ::: "memory")
#define VM_WAIT() asm volatile("s_waitcnt vmcnt(0)" ::: "memory")
__device__ __forceinline__ unsigned long long rt() { return __builtin_amdgcn_s_memrealtime(); }
__device__ __forceinline__ unsigned f2bf(float f) { unsigned u = __builtin_bit_cast(unsigned, f); return (u + 0x7fffu + ((u >> 16) & 1u)) >> 16; }
__device__ __forceinline__ unsigned pk2(float lo, float hi) { return f2bf(lo) | (f2bf(hi) << 16); }

#define XB_TMO      128
#define XB_XCNT(j)  (256  + 64 * (j))
#define XB_XSUB(j)  (1280 + 64 * (j))
#define XB_XGEN(j)  (2304 + 64 * (j))
#define XB_TOP      3328
#define XB_TOPGEN   3392
#define XCD_BAR_WORDS 3456
#define XB_SPIN_CAP (1u << 18)

__device__ __forceinline__ unsigned xb_ld(unsigned* p)              { return __hip_atomic_load(p, __ATOMIC_RELAXED, __HIP_MEMORY_SCOPE_AGENT); }
__device__ __forceinline__ unsigned xb_add(unsigned* p, unsigned v) { return __hip_atomic_fetch_add(p, v, __ATOMIC_RELAXED, __HIP_MEMORY_SCOPE_AGENT); }
__device__ __forceinline__ unsigned xb_xcc_id() { return (unsigned)__builtin_amdgcn_s_getreg((3 << 11) | 20) & 0xFu; }
#define XB_SPIN(cond, bar) do { unsigned _sp = 0; while (cond) { __builtin_amdgcn_s_sleep(1); \
    if ((++_sp & 255u) == 0u) { if (xb_ld(&(bar)[XB_TMO])) break; if (_sp > XB_SPIN_CAP) { atomicAdd(&(bar)[XB_TMO], 1u); break; } } } } while (0)

struct XcdBarrier {
    unsigned* bar; unsigned x;
    volatile LAS unsigned* st;
};

__device__ __forceinline__ XcdBarrier xcd_barrier_post(unsigned* bar, volatile LAS unsigned* st) {
    XcdBarrier b; b.bar = bar; b.x = xb_xcc_id(); b.st = st;
    if (threadIdx.x == 0) (void)xb_add(&bar[XB_XCNT(b.x)], 1u);
    return b;
}
__device__ __forceinline__ void xcd_barrier_complete(unsigned* bar, unsigned x, unsigned& nloc, unsigned& nx) {
    const unsigned G = gridDim.x * gridDim.y * gridDim.z;
    unsigned sum, cnt, mine, sp = 0u;
    for (;;) {
        sum = 0u; cnt = 0u; mine = 0u;
#pragma unroll
        for (unsigned j = 0; j < 16; ++j) { const unsigned c = xb_ld(&bar[XB_XCNT(j)]); sum += c; cnt += (c > 0u) ? 1u : 0u; mine = (j == x) ? c : mine; }
        if (sum == G) break;
        __builtin_amdgcn_s_sleep(1);
        if ((++sp & 255u) == 0u) { if (xb_ld(&bar[XB_TMO])) break; if (sp > XB_SPIN_CAP) { atomicAdd(&bar[XB_TMO], 1u); break; } }
    }
    nloc = mine > 0u ? mine : 1u; nx = cnt > 0u ? cnt : 1u;
}

__device__ __forceinline__ void xcd_barrier(const XcdBarrier& b) {
    asm volatile("s_waitcnt vmcnt(0)" ::: "memory");
    __syncthreads();
    if (threadIdx.x == 0) {
        unsigned* bar = b.bar;
        __builtin_amdgcn_s_waitcnt(0);
        unsigned nloc = b.st[0], nx = b.st[1];
        if (nloc == 0u) { xcd_barrier_complete(bar, b.x, nloc, nx); b.st[0] = nloc; b.st[1] = nx; }
        const unsigned old = xb_add(&bar[XB_XSUB(b.x)], 1u);
        const unsigned gen = old / nloc;
        if (old + 1u == (gen + 1u) * nloc) {
            __builtin_amdgcn_fence(__ATOMIC_RELEASE, "agent");
            asm volatile("s_waitcnt vmcnt(0)" ::: "memory");
            const unsigned og = xb_add(&bar[XB_TOP], 1u);
            const unsigned tg = og / nx;
            if (og + 1u == (tg + 1u) * nx) xb_add(&bar[XB_TOPGEN], 1u);
            else XB_SPIN(xb_ld(&bar[XB_TOPGEN]) == tg, bar);
            __builtin_amdgcn_fence(__ATOMIC_ACQUIRE, "agent");
            xb_add(&bar[XB_XGEN(b.x)], 1u);
            asm volatile("s_waitcnt vmcnt(0)" ::: "memory");
        } else {
            XB_SPIN(xb_ld(&bar[XB_XGEN(b.x)]) == gen, bar);
            __builtin_amdgcn_fence(__ATOMIC_ACQUIRE, "agent");
            asm volatile("s_waitcnt vmcnt(0)" ::: "memory");
        }
    }
    __syncthreads();
}
__device__ __forceinline__ void xcd_barrier_arrive(const XcdBarrier& b) {
    asm volatile("s_waitcnt vmcnt(0)" ::: "memory");
    __syncthreads();
    if (threadIdx.x == 0) {
        unsigned* bar = b.bar;
        __builtin_amdgcn_s_waitcnt(0);
        unsigned nloc = b.st[0], nx = b.st[1];
        if (nloc == 0u) { xcd_barrier_complete(bar, b.x, nloc, nx); b.st[0] = nloc; b.st[1] = nx; }
        const unsigned old = xb_add(&bar[XB_XSUB(b.x)], 1u);
        const unsigned gen = old / nloc;
        if (old + 1u == (gen + 1u) * nloc) {
            __builtin_amdgcn_fence(__ATOMIC_RELEASE, "agent");
            asm volatile("s_waitcnt vmcnt(0)" ::: "memory");
            const unsigned og = xb_add(&bar[XB_TOP], 1u);
            const unsigned tg = og / nx;
            if (og + 1u == (tg + 1u) * nx) xb_add(&bar[XB_TOPGEN], 1u);
        }
        b.st[2] = gen;
    }
}
__device__ __forceinline__ void xcd_barrier_wait(const XcdBarrier& b) {
    if (threadIdx.x == 0) {
        unsigned* bar = b.bar; const unsigned gen = b.st[2];
        XB_SPIN(xb_ld(&bar[XB_TOPGEN]) == gen, bar);
        __builtin_amdgcn_fence(__ATOMIC_ACQUIRE, "agent");
        asm volatile("s_waitcnt vmcnt(0)" ::: "memory");
    }
    __syncthreads();
}
namespace pg8 {
#define PG8_LAS __attribute__((address_space(3)))
typedef unsigned short bf16_t;
typedef short bf16x8 __attribute__((ext_vector_type(8)));
typedef float f32x4 __attribute__((ext_vector_type(4)));
typedef unsigned u32x4 __attribute__((ext_vector_type(4)));
constexpr int BM = 256, BK = 64, HALF = 128, HTB = HALF * BK * 2  , STAGE_BYTES = 8 * HTB, NXCD = 8, WGM = 8;

__host__ __device__ __forceinline__ int lds_byte(int r, int c) { const int st = (r >> 4) * 2 + (c >> 5), rr = r & 15, cc = c & 31, ob = rr * 64 + cc * 2; return st * 1024 + (ob ^ (((ob >> 9) & 1) << 5)); }
__host__ __device__ __forceinline__ void stage_rc(int b, int& R, int& C) { const int st = b / 1024, sb = b % 1024, swz = sb ^ (((sb >> 9) & 1) << 5); R = (st >> 1) * 16 + swz / 64; C = (st & 1) * 32 + (swz % 64) / 2; }
__host__ __device__ __forceinline__ int perm32(int rho) { const int n = rho >> 4, i = rho & 15; return 8 * (i >> 2) + 4 * n + (i & 3); }

struct Unit { int pm, pn; };
struct Gemm { const bf16_t* A; const bf16_t* Bt; int M, N, K; };

struct StaticOrder {
    int nM, nN, nwg, G, c;
    __host__ __device__ void init(int M, int N, int G_, int c_) { nM = M / BM; nN = N / BM; nwg = nM * nN; G = G_; c = c_; }
    __host__ __device__ bool next(int i, Unit& u) const {
        const long L = (long)i * G + c; if (L >= nwg) return false;
        int wgid = (int)L; { const int q = nwg / NXCD, r = nwg % NXCD, xcd = wgid % NXCD, off = wgid / NXCD; wgid = (xcd < r ? xcd * (q + 1) : r * (q + 1) + (xcd - r) * q) + off; }
        const int nig = WGM * nN, gid = wgid / nig, fm = gid * WGM, gsz = (nM - fm) < WGM ? (nM - fm) : WGM;
        u.pm = fm + ((wgid % nig) % gsz); u.pn = (wgid % nig) / gsz; return true;
    }
    __device__ __forceinline__ void a_ready(const Unit&) const {}
    __device__ __forceinline__ void done(const Unit&) const {}
};

template <class Epi, class Sched, bool ALIGN_EPI = false, bool SP2 = false>
__device__ __forceinline__ void gemm_phase(PG8_LAS unsigned char* lds, const Gemm g, const Sched& S, const Epi& E, const int tid_in) {
    const int tid = tid_in, wid = __builtin_amdgcn_readfirstlane(tid >> 6), lane = tid & 63, wr = wid >> 2, wc = wid & 3, fr = lane & 15, fq = lane >> 4;
    const int K = g.K, nt = K / BK;
    unsigned voffA[2], voffB[2];
#pragma unroll
    for (int i = 0; i < 2; ++i) { int R, C; stage_rc(tid * 16 + i * 8192, R, C);
        const int Rb = Epi::PERM ? (Epi::BADJ ? (64 * (R >> 5) + perm32(R & 31)) : ((R & ~31) + perm32(R & 31))) : R;
        voffA[i] = (unsigned)(R * K + C) * 2u; voffB[i] = (unsigned)(Rb * K + C) * 2u; }
    const size_t kstep = (size_t)(BK * 2);
    const size_t hstep = (size_t)HALF * K * 2;
    const size_t tstep = 2 * hstep;
    const size_t hstepB = Epi::BADJ ? (size_t)32 * K * 2 : hstep;
    const unsigned ldsw = (unsigned)wid * 1024u;
    const int aoff = lds_byte(wr * 64 + fr, fq * 8), boff = lds_byte(wc * 32 + fr, fq * 8);
#define PG8_SA(b, h) (((b) * 2 + (h)) * HTB)
#define PG8_SB(b, h) ((4 + (b) * 2 + (h)) * HTB)
#define PG8_STAGE(bufoff, gbase, voff) do { _Pragma("unroll") for (int _i = 0; _i < 2; ++_i) \
        __builtin_amdgcn_global_load_lds((const unsigned*)((const char*)(gbase) + (voff)[_i]), (PG8_LAS unsigned*)(lds + (bufoff) + ldsw + _i * 8192), 16, 0, 0); } while (0)
#define PG8_LDA(dst, b, h) do { _Pragma("unroll") for (int m = 0; m < 4; ++m) _Pragma("unroll") for (int k = 0; k < 2; ++k) dst[m][k] = *(const PG8_LAS bf16x8*)(lds + PG8_SA(b, h) + aoff + m * 2048 + k * 1024); } while (0)
#define PG8_LDB(dst, b, h) do { _Pragma("unroll") for (int n = 0; n < 2; ++n) _Pragma("unroll") for (int k = 0; k < 2; ++k) dst[n][k] = *(const PG8_LAS bf16x8*)(lds + PG8_SB(b, h) + boff + n * 2048 + k * 1024); } while (0)
#define PG8_MMA(ai, bj, At, Bt) do { __builtin_amdgcn_s_setprio(1); _Pragma("unroll") for (int m = 0; m < 4; ++m) _Pragma("unroll") for (int n = 0; n < 2; ++n) _Pragma("unroll") for (int k = 0; k < 2; ++k) \
        acc[ai][bj][m][n] = __builtin_amdgcn_mfma_f32_16x16x32_bf16(Bt[n][k], At[m][k], acc[ai][bj][m][n], 0, 0, 0); __builtin_amdgcn_s_setprio(0); } while (0)
#define PG8_WAIT_V(n) asm volatile("s_waitcnt vmcnt(" #n ")" ::: "memory")
#define PG8_WAIT_L(n) asm volatile("s_waitcnt lgkmcnt(" #n ")" ::: "memory")
#define PG8_BAR __builtin_amdgcn_s_barrier()
#define PG8_SCHED __builtin_amdgcn_sched_barrier(0)
    Unit cur, nxt; int ui = 0;
    if (!S.next(0, cur)) return;
    E.first(lds, cur, tid);
    f32x4 acc[2][2][4][2];
#pragma unroll
    for (int a = 0; a < 2; ++a)
#pragma unroll
        for (int b = 0; b < 2; ++b)
#pragma unroll
            for (int m = 0; m < 4; ++m)
#pragma unroll
                for (int n = 0; n < 2; ++n) acc[a][b][m][n] = (f32x4){0.f, 0.f, 0.f, 0.f};
    bf16x8 At[4][2], B0[2][2], B1[2][2];
    const char* cA = (const char*)g.A + (size_t)cur.pm * tstep; const char* cB = (const char*)g.Bt + (size_t)cur.pn * tstep;
    S.a_ready(cur);
    if constexpr (SP2) {
        PG8_STAGE(PG8_SB(0, 0), cB, voffB); PG8_STAGE(PG8_SB(0, 1), cB + hstepB, voffB); PG8_STAGE(PG8_SA(0, 0), cA, voffA); PG8_STAGE(PG8_SA(0, 1), cA + hstep, voffA);
        if (wr == 1) PG8_BAR;
        PG8_WAIT_V(2); PG8_BAR;
        PG8_STAGE(PG8_SB(1, 0), cB + kstep, voffB); PG8_STAGE(PG8_SA(1, 0), cA + kstep, voffA); PG8_STAGE(PG8_SB(1, 1), cB + hstepB + kstep, voffB);
        PG8_WAIT_V(6); PG8_BAR;
    } else {
        PG8_STAGE(PG8_SB(0, 0), cB, voffB); PG8_STAGE(PG8_SA(0, 0), cA, voffA); PG8_STAGE(PG8_SB(0, 1), cB + hstepB, voffB); PG8_STAGE(PG8_SA(0, 1), cA + hstep, voffA);
        if (wr == 1) PG8_BAR;
        PG8_WAIT_V(4); PG8_BAR;
        PG8_STAGE(PG8_SB(1, 0), cB + kstep, voffB); PG8_STAGE(PG8_SA(1, 0), cA + kstep, voffA); PG8_STAGE(PG8_SB(1, 1), cB + hstepB + kstep, voffB);
        PG8_WAIT_V(6); PG8_BAR;
    }
    for (;;) {
        const bool has_next = S.next(ui + 1, nxt);
        const char* nA = has_next ? (const char*)g.A + (size_t)nxt.pm * tstep : cA; const char* nB = has_next ? (const char*)g.Bt + (size_t)nxt.pn * tstep : cB;
        for (int t = 0; t < nt; t += 2) {
            const bool last = (t == nt - 2);
            const char* a1 = cA + (size_t)(t + 1) * kstep;
            const char* a2 = last ? nA : cA + (size_t)(t + 2) * kstep; const char* b2 = last ? nB : cB + (size_t)(t + 2) * kstep;
            const char* a3 = a2 + kstep; const char* b3 = b2 + kstep;
            if (last && has_next) S.a_ready(nxt);
            if constexpr (SP2) {
            PG8_LDB(B0, 0, 0); PG8_LDB(B1, 0, 1); PG8_SCHED; PG8_LDA(At, 0, 0); PG8_STAGE(PG8_SA(1, 1), a1 + hstep, voffA);
            PG8_WAIT_V(8); PG8_WAIT_L(0); PG8_BAR; PG8_MMA(0, 0, At, B0); PG8_MMA(0, 1, At, B1); PG8_BAR; PG8_SCHED;
            PG8_LDA(At, 0, 1); PG8_STAGE(PG8_SB(0, 0), b2, voffB); PG8_STAGE(PG8_SB(0, 1), b2 + hstepB, voffB); PG8_STAGE(PG8_SA(0, 0), a2, voffA);
            PG8_WAIT_V(8); PG8_WAIT_L(0); PG8_BAR; PG8_MMA(1, 0, At, B0); PG8_MMA(1, 1, At, B1); PG8_BAR; PG8_SCHED;
            PG8_LDB(B0, 1, 0); PG8_LDB(B1, 1, 1); PG8_SCHED; PG8_LDA(At, 1, 0); PG8_STAGE(PG8_SA(0, 1), a2 + hstep, voffA);
            PG8_WAIT_V(8); PG8_WAIT_L(0); PG8_BAR; PG8_MMA(0, 0, At, B0); PG8_MMA(0, 1, At, B1); PG8_BAR; PG8_SCHED;
            PG8_LDA(At, 1, 1); PG8_STAGE(PG8_SB(1, 0), b3, voffB); PG8_STAGE(PG8_SB(1, 1), b3 + hstepB, voffB); PG8_STAGE(PG8_SA(1, 0), a3, voffA);
            PG8_WAIT_V(8); PG8_WAIT_L(0); PG8_BAR; PG8_MMA(1, 0, At, B0); PG8_MMA(1, 1, At, B1); PG8_BAR; PG8_SCHED;
            } else {
            PG8_LDB(B0, 0, 0); PG8_SCHED; PG8_LDA(At, 0, 0); PG8_STAGE(PG8_SA(1, 1), a1 + hstep, voffA);
            PG8_WAIT_L(8); PG8_BAR; PG8_WAIT_L(0); PG8_MMA(0, 0, At, B0); PG8_BAR; PG8_SCHED;
            PG8_LDB(B1, 0, 1); PG8_STAGE(PG8_SB(0, 0), b2, voffB);
            PG8_BAR; PG8_WAIT_L(0); PG8_MMA(0, 1, At, B1); PG8_BAR;
            PG8_LDA(At, 0, 1); PG8_STAGE(PG8_SA(0, 0), a2, voffA);
            PG8_BAR; PG8_WAIT_L(0); PG8_MMA(1, 0, At, B0); PG8_BAR; PG8_SCHED;
            PG8_STAGE(PG8_SB(0, 1), b2 + hstepB, voffB);
            PG8_WAIT_V(6); PG8_BAR; PG8_MMA(1, 1, At, B1); PG8_BAR;
            PG8_LDB(B0, 1, 0); PG8_SCHED; PG8_LDA(At, 1, 0); PG8_STAGE(PG8_SA(0, 1), a2 + hstep, voffA);
            PG8_WAIT_L(8); PG8_BAR; PG8_WAIT_L(0); PG8_MMA(0, 0, At, B0); PG8_BAR; PG8_SCHED;
            PG8_LDB(B1, 1, 1); PG8_STAGE(PG8_SB(1, 0), b3, voffB);
            PG8_BAR; PG8_WAIT_L(0); PG8_MMA(0, 1, At, B1); PG8_BAR;
            PG8_LDA(At, 1, 1); PG8_STAGE(PG8_SA(1, 0), a3, voffA);
            PG8_BAR; PG8_WAIT_L(0); PG8_MMA(1, 0, At, B0); PG8_BAR; PG8_SCHED;
            PG8_STAGE(PG8_SB(1, 1), b3 + hstepB, voffB);
            PG8_WAIT_V(6); PG8_BAR; PG8_MMA(1, 1, At, B1); PG8_BAR;
            }
        }
        if constexpr (ALIGN_EPI) { if (wr == 0) PG8_BAR; }
        if constexpr (!Epi::AFTER_DRAIN) { E(acc, cur, wr, wc, fr, fq, lds, nxt, has_next, ui, tid); S.done(cur); }
        if (!has_next) break;
#pragma unroll
        for (int a = 0; a < 2; ++a)
#pragma unroll
            for (int b = 0; b < 2; ++b)
#pragma unroll
                for (int m = 0; m < 4; ++m)
#pragma unroll
                    for (int n = 0; n < 2; ++n) acc[a][b][m][n] = (f32x4){0.f, 0.f, 0.f, 0.f};
        cur = nxt; cA = nA; cB = nB; ++ui;
        if constexpr (ALIGN_EPI) { if (wr == 1) PG8_BAR; }
    }
    PG8_WAIT_V(0);
    if constexpr (!ALIGN_EPI) { if (wr == 0) PG8_BAR; }
    PG8_BAR;
    if constexpr (Epi::AFTER_DRAIN) { E.fused(acc, cur, wr, wc, fr, fq, lds, wid, lane); S.done(cur); }
#undef PG8_SA
#undef PG8_SB
#undef PG8_STAGE
#undef PG8_LDA
#undef PG8_LDB
#undef PG8_MMA
#undef PG8_WAIT_V
#undef PG8_WAIT_L
#undef PG8_BAR
#undef PG8_SCHED
}
}
__device__ __forceinline__ float bf2f(unsigned short h) { return __builtin_bit_cast(float, (unsigned)h << 16); }
__device__ __forceinline__ float gelu_tanh(float x) { const float u = 0.7978845608028654f * (x + 0.044715f * x * x * x); return 0.5f * x * (1.f + tanhf(u)); }
__device__ __forceinline__ float sigmoidf_(float x) { return 1.f / (1.f + expf(-x)); }
template <int CTRL> __device__ __forceinline__ float dpp0(float src) { return __builtin_bit_cast(float, __builtin_amdgcn_update_dpp(0, __builtin_bit_cast(int, src), CTRL, 0xf, 0xf, true)); }
__device__ __forceinline__ float xor16f(float v) { return __shfl_xor(v, 16); }
__device__ __forceinline__ float sum32f(float v) { return v + __shfl_xor(v, 32); }
__device__ __forceinline__ float wave_sum(float v) {
#pragma unroll
    for (int o = 1; o < 64; o <<= 1) v += __shfl_xor(v, o);
    return v;
}
__device__ __forceinline__ unsigned cvt_pk_bf16(float lo, float hi) { unsigned r; asm volatile("v_cvt_pk_bf16_f32 %0, %1, %2" : "=v"(r) : "v"(lo), "v"(hi)); return r; }
typedef unsigned u32x2w __attribute__((ext_vector_type(2)));
__device__ __forceinline__ void wt16(const void* base, size_t byte_off, v4u v) { __builtin_amdgcn_raw_buffer_store_b128(v, __builtin_amdgcn_make_buffer_rsrc((void*)base, 0, 0x7fffffff, 0x00020000), (int)byte_off, 0, 16); }
__device__ __forceinline__ void wt8(const void* base, size_t byte_off, u32x2w v) { __builtin_amdgcn_raw_buffer_store_b64(v, __builtin_amdgcn_make_buffer_rsrc((void*)base, 0, 0x7fffffff, 0x00020000), (int)byte_off, 0, 16); }
__device__ __forceinline__ void wt4(const void* base, size_t byte_off, float v) { __builtin_amdgcn_raw_buffer_store_b32(__builtin_bit_cast(unsigned, v), __builtin_amdgcn_make_buffer_rsrc((void*)base, 0, 0x7fffffff, 0x00020000), (int)byte_off, 0, 16); }
__device__ __forceinline__ float gelu_fast(float x) { const float u = x * (0.7978845608028654f + 0.035677408136300125f * x * x); return x * __builtin_amdgcn_rcpf(1.f + __builtin_amdgcn_exp2f(-2.8853900817779268f * u)); }
typedef float f32x2g __attribute__((ext_vector_type(2)));
__device__ __forceinline__ f32x2g gelu_fast2(f32x2g x) { const f32x2g p = x * x * 0.035677408136300125f + 0.7978845608028654f; const f32x2g e = x * p * -2.8853900817779268f;
    const f32x2g d = (f32x2g){__builtin_amdgcn_exp2f(e.x), __builtin_amdgcn_exp2f(e.y)} + 1.f; return x * (f32x2g){__builtin_amdgcn_rcpf(d.x), __builtin_amdgcn_rcpf(d.y)}; }
__device__ __forceinline__ float sigmoid_fast(float x) { return __builtin_amdgcn_rcpf(1.f + __builtin_amdgcn_exp2f(-1.4426950408889634f * x)); }
__device__ __forceinline__ float bflo(unsigned u) { return __builtin_bit_cast(float, u << 16); }
__device__ __forceinline__ float bfhi(unsigned u) { return __builtin_bit_cast(float, u & 0xffff0000u); }
enum { ACT_GELU = 0, ACT_SQRELU = 1 };
typedef unsigned u32x2 __attribute__((ext_vector_type(2)));
struct RowCtx { float rs, ss; };
constexpr int XS_P = 32, XS_S = 64, VS_P = 16, VS_S = 64;
template <int N4> __device__ __forceinline__ float sum_slots_n(const float* p) { f32x4 v[N4];
#pragma unroll
    for (int i = 0; i < N4; ++i) v[i] = ((const f32x4*)p)[i];
    float s = 0.f;
#pragma unroll
    for (int i = 0; i < N4; ++i) s += (v[i].x + v[i].y) + (v[i].z + v[i].w);
    return s; }
__device__ __forceinline__ float sum_slots(const float* p, int n4) { return n4 == 4 ? sum_slots_n<4>(p) : (n4 == 8 ? sum_slots_n<8>(p) : sum_slots_n<16>(p)); }
__device__ __forceinline__ float sum_col16(const float* p) { float v[16];
#pragma unroll
    for (int i = 0; i < 16; ++i) v[i] = p[(size_t)i * MP];
    return (((v[0] + v[1]) + (v[2] + v[3])) + ((v[4] + v[5]) + (v[6] + v[7]))) + (((v[8] + v[9]) + (v[10] + v[11])) + ((v[12] + v[13]) + (v[14] + v[15]))); }
__device__ __forceinline__ float sum_col(const float* P, int nslot, int row) {
    if (nslot == 1) return P[row];
    float s = sum_col16(P + row); if (nslot == 32) s += sum_col16(P + (size_t)16 * MP + row); return s; }
__device__ __forceinline__ float rs_x(const float* P, int nslot, int row) {
    const float s = row < MP ? sum_col(P, nslot, row) : sum_slots(P + (size_t)MP * XS_P + (size_t)(row - MP) * XS_S, XS_S >> 2); return rsqrtf(s * (1.f / 1024.f) + EPS); }
__device__ __forceinline__ float rs_v(const float* P, int row) {
    const float s = row < MP ? sum_col(P, VS_P, row) : sum_slots(P + (size_t)MP * VS_P + (size_t)(row - MP) * VS_S, VS_S >> 2); return rsqrtf(s * (1.f / 1024.f) + EPS); }
__device__ __forceinline__ float fq_sum(float ss) { ss += xor16f(ss); return sum32f(ss); }
__device__ __forceinline__ void xs_store(float* P, int row, int col, bool pair, float ss, int fq) {
    ss = fq_sum(ss); if (fq != 0) return;
    if (row < MP) wt4(P, ((size_t)(pair ? (col >> 5) : (((col >> 8) << 2) | ((col >> 5) & 3))) * MP + row) * 4, ss); else wt4(P, ((size_t)MP * XS_P + (size_t)(row - MP) * XS_S + (col >> 4)) * 4, ss); }
__device__ __forceinline__ void vs_store(float* P, int row, int col, float ss, int fq) {
    ss = fq_sum(ss); if (fq != 0) return; const int c = col - 1024;
    if (row < MP) P[(size_t)(((c >> 8) << 2) | ((c >> 5) & 3)) * MP + row] = ss; else P[(size_t)MP * VS_P + (size_t)(row - MP) * VS_S + (c >> 4)] = ss; }
constexpr int RSTAB_OFF = 131072 + 2048;
__device__ __forceinline__ LAS float* rstab(LAS unsigned char* lds, int par) { return (LAS float*)(lds + RSTAB_OFF) + par * 256; }
template <int ACT> __device__ __forceinline__ float act_f(float x) { if (ACT == ACT_GELU) return gelu_fast(x); const float t = fmaxf(x, 0.f); return t * t; }

template <int ACT, bool VSTAT> struct FAct { bf16* O; int ldc; const float* S; int nslot; float* SV;
    __device__ __forceinline__ RowCtx begin(int row) const { return RowCtx{rs_x(S, nslot, row), 0.f}; }
    __device__ __forceinline__ float rs_row(int row) const { return rs_x(S, nslot, row); }
    __device__ __forceinline__ void apply8(RowCtx& c, int row, int col, f32x4 v0, f32x4 v1) const {
        float r[8];
        if (ACT == ACT_GELU) {
#pragma unroll
            for (int i = 0; i < 4; i += 2) { const f32x2g a = gelu_fast2((f32x2g){v0[i], v0[i + 1]} * c.rs), b = gelu_fast2((f32x2g){v1[i], v1[i + 1]} * c.rs); r[i] = a.x; r[i + 1] = a.y; r[4 + i] = b.x; r[5 + i] = b.y; }
        } else {
#pragma unroll
        for (int i = 0; i < 4; ++i) { r[i] = act_f<ACT>(v0[i] * c.rs); r[4 + i] = act_f<ACT>(v1[i] * c.rs); } }
        if (VSTAT && col >= 1024) {
#pragma unroll
            for (int i = 0; i < 8; ++i) c.ss += r[i] * r[i]; }
        v4u w; w.x = cvt_pk_bf16(r[0], r[1]); w.y = cvt_pk_bf16(r[2], r[3]); w.z = cvt_pk_bf16(r[4], r[5]); w.w = cvt_pk_bf16(r[6], r[7]); wt16(O, ((size_t)row * ldc + col) * 2, w); }
    __device__ __forceinline__ void apply4(RowCtx& c, int row, int col, f32x4 v) const {
        float r[4];
#pragma unroll
        for (int i = 0; i < 4; ++i) r[i] = act_f<ACT>(v[i] * c.rs);
        if (VSTAT && col >= 1024) c.ss += (r[0] * r[0] + r[1] * r[1]) + (r[2] * r[2] + r[3] * r[3]);
        u32x2 w; w.x = cvt_pk_bf16(r[0], r[1]); w.y = cvt_pk_bf16(r[2], r[3]); *(u32x2*)(O + (size_t)row * ldc + col) = w; }
    __device__ __forceinline__ void end(RowCtx& c, int row, int col, int fq) const { if (VSTAT && col >= 1024) vs_store(SV, row, col, c.ss, fq); } };
struct FRglru { bf16* G; float* XB; const float* S;
    __device__ __forceinline__ RowCtx begin(int row) const { return RowCtx{rs_x(S, 16, row), 0.f}; }
    __device__ __forceinline__ float rs_row(int row) const { return rs_x(S, 16, row); }
    __device__ __forceinline__ void apply8(RowCtx& c, int row, int col, f32x4 v0, f32x4 v1) const {
        if (col < 1024) { const f32x2g g0 = gelu_fast2((f32x2g){v0[0], v0[1]} * c.rs), g1 = gelu_fast2((f32x2g){v0[2], v0[3]} * c.rs), g2 = gelu_fast2((f32x2g){v1[0], v1[1]} * c.rs), g3 = gelu_fast2((f32x2g){v1[2], v1[3]} * c.rs);
            v4u w; w.x = cvt_pk_bf16(g0.x, g0.y); w.y = cvt_pk_bf16(g1.x, g1.y); w.z = cvt_pk_bf16(g2.x, g2.y); w.w = cvt_pk_bf16(g3.x, g3.y); wt16(G, ((size_t)row * 1024 + col) * 2, w); }
        else { const f32x4 a = v0 * c.rs, b = v1 * c.rs; v4u w; w.x = cvt_pk_bf16(a[0], a[1]); w.y = cvt_pk_bf16(a[2], a[3]); w.z = cvt_pk_bf16(b[0], b[1]); w.w = cvt_pk_bf16(b[2], b[3]);
            wt16(XB, ((size_t)row * 1024 + col - 1024) * 2, w); } }
    __device__ __forceinline__ void apply4(RowCtx& c, int row, int col, f32x4 v) const {
        if (col < 1024) { u32x2 w; w.x = cvt_pk_bf16(gelu_fast(v[0] * c.rs), gelu_fast(v[1] * c.rs)); w.y = cvt_pk_bf16(gelu_fast(v[2] * c.rs), gelu_fast(v[3] * c.rs)); *(u32x2*)(G + (size_t)row * 1024 + col) = w; }
        else { const f32x4 a = v * c.rs; u32x2 w; w.x = cvt_pk_bf16(a[0], a[1]); w.y = cvt_pk_bf16(a[2], a[3]); *(u32x2*)((bf16*)XB + (size_t)row * 1024 + col - 1024) = w; } }
    __device__ __forceinline__ void end(RowCtx&, int, int, int) const {} };
struct FBf { bf16* O; int ldc; const float* S;
    __device__ __forceinline__ RowCtx begin(int row) const { return RowCtx{rs_x(S, 16, row), 0.f}; }
    __device__ __forceinline__ float rs_row(int row) const { return rs_x(S, 16, row); }
    __device__ __forceinline__ void apply8(RowCtx& c, int row, int col, f32x4 v0, f32x4 v1) const { const f32x4 a = v0 * c.rs, b = v1 * c.rs; v4u w; w.x = cvt_pk_bf16(a[0], a[1]); w.y = cvt_pk_bf16(a[2], a[3]); w.z = cvt_pk_bf16(b[0], b[1]); w.w = cvt_pk_bf16(b[2], b[3]); wt16(O, ((size_t)row * ldc + col) * 2, w); }
    __device__ __forceinline__ void apply4(RowCtx& c, int row, int col, f32x4 v) const { const f32x4 a = v * c.rs; u32x2 w; w.x = cvt_pk_bf16(a[0], a[1]); w.y = cvt_pk_bf16(a[2], a[3]); *(u32x2*)(O + (size_t)row * ldc + col) = w; }
    __device__ __forceinline__ void end(RowCtx&, int, int, int) const {} };
struct FF32 { float* O; int ldc; const float* S;
    __device__ __forceinline__ RowCtx begin(int row) const { return RowCtx{rs_x(S, 16, row), 0.f}; }
    __device__ __forceinline__ float rs_row(int row) const { return rs_x(S, 16, row); }
    __device__ __forceinline__ void apply8(RowCtx& c, int row, int col, f32x4 v0, f32x4 v1) const { float* p = O + (size_t)row * ldc + col; *(f32x4*)p = v0 * c.rs; *(f32x4*)(p + 4) = v1 * c.rs; }
    __device__ __forceinline__ void apply4(RowCtx& c, int row, int col, f32x4 v) const { *(f32x4*)(O + (size_t)row * ldc + col) = v * c.rs; }
    __device__ __forceinline__ void end(RowCtx&, int, int, int) const {} };
__device__ __forceinline__ f32x4 bf_lo4(v4u w) { return (f32x4){bflo(w.x), bfhi(w.x), bflo(w.y), bfhi(w.y)}; }
__device__ __forceinline__ f32x4 bf_hi4(v4u w) { return (f32x4){bflo(w.z), bfhi(w.z), bflo(w.w), bfhi(w.w)}; }
struct FResid { bf16* XB16; float* Sacc;
    __device__ __forceinline__ RowCtx begin(int) const { return RowCtx{0.f, 0.f}; }
    __device__ __forceinline__ void load8(int row, int col, v4u& xo) const { xo = *(const v4u*)(XB16 + (size_t)row * D + col); }
    __device__ __forceinline__ void apply8x(RowCtx& c, int row, int col, f32x4 v0, f32x4 v1, v4u xo) const {
        const f32x4 x0 = bf_lo4(xo) + v0, x1 = bf_hi4(xo) + v1;
        c.ss += (x0[0] * x0[0] + x0[1] * x0[1]) + (x0[2] * x0[2] + x0[3] * x0[3]) + (x1[0] * x1[0] + x1[1] * x1[1]) + (x1[2] * x1[2] + x1[3] * x1[3]);
        v4u w; w.x = cvt_pk_bf16(x0[0], x0[1]); w.y = cvt_pk_bf16(x0[2], x0[3]); w.z = cvt_pk_bf16(x1[0], x1[1]); w.w = cvt_pk_bf16(x1[2], x1[3]); wt16(XB16, ((size_t)row * D + col) * 2, w); }
    __device__ __forceinline__ void apply4(RowCtx& c, int row, int col, f32x4 v) const { bf16* p = XB16 + (size_t)row * D + col; const u32x2 o = *(const u32x2*)p;
        const f32x4 x0 = (f32x4){bflo(o.x), bfhi(o.x), bflo(o.y), bfhi(o.y)} + v; c.ss += (x0[0] * x0[0] + x0[1] * x0[1]) + (x0[2] * x0[2] + x0[3] * x0[3]);
        u32x2 w; w.x = cvt_pk_bf16(x0[0], x0[1]); w.y = cvt_pk_bf16(x0[2], x0[3]); wt8(XB16, ((size_t)row * D + col) * 2, w); }
    __device__ __forceinline__ void end(RowCtx& c, int row, int col, int fq) const { xs_store(Sacc, row, col, false, c.ss, fq); } };
struct FGlu { bf16* XB16; float* Sacc;
    __device__ __forceinline__ RowCtx begin(int) const { return RowCtx{0.f, 0.f}; }
    __device__ __forceinline__ void load8(int row, int col, v4u& xo) const { xo = *(const v4u*)(XB16 + (size_t)row * D + col); }
    __device__ __forceinline__ void apply8x_pair(RowCtx& c, int row, int col, f32x4 a0, f32x4 a1, f32x4 b0, f32x4 b1, v4u xo) const {
        f32x4 x0 = bf_lo4(xo), x1 = bf_hi4(xo);
#pragma unroll
        for (int i = 0; i < 4; ++i) { x0[i] += a0[i] * sigmoid_fast(b0[i]); x1[i] += a1[i] * sigmoid_fast(b1[i]); }
        c.ss += (x0[0] * x0[0] + x0[1] * x0[1]) + (x0[2] * x0[2] + x0[3] * x0[3]) + (x1[0] * x1[0] + x1[1] * x1[1]) + (x1[2] * x1[2] + x1[3] * x1[3]);
        v4u w; w.x = cvt_pk_bf16(x0[0], x0[1]); w.y = cvt_pk_bf16(x0[2], x0[3]); w.z = cvt_pk_bf16(x1[0], x1[1]); w.w = cvt_pk_bf16(x1[2], x1[3]); wt16(XB16, ((size_t)row * D + col) * 2, w); }
    __device__ __forceinline__ void apply4_pair(RowCtx& c, int row, int col, f32x4 a, f32x4 b) const { bf16* p = XB16 + (size_t)row * D + col; const u32x2 o = *(const u32x2*)p;
        f32x4 x0 = (f32x4){bflo(o.x), bfhi(o.x), bflo(o.y), bfhi(o.y)};
#pragma unroll
        for (int i = 0; i < 4; ++i) x0[i] += a[i] * sigmoid_fast(b[i]);
        c.ss += (x0[0] * x0[0] + x0[1] * x0[1]) + (x0[2] * x0[2] + x0[3] * x0[3]);
        u32x2 w; w.x = cvt_pk_bf16(x0[0], x0[1]); w.y = cvt_pk_bf16(x0[2], x0[3]); wt8(XB16, ((size_t)row * D + col) * 2, w); }
    __device__ __forceinline__ void end(RowCtx& c, int row, int col, int fq) const { xs_store(Sacc, row, col, true, c.ss, fq); } };

template <class F> struct EpiRow8 { static constexpr bool PERM = true, AFTER_DRAIN = false, BADJ = true; F f;
    __device__ __forceinline__ void first(PG8_LAS unsigned char* lds, const pg8::Unit& u, int tid) const { if (tid < 256) rstab(lds, 0)[tid] = f.rs_row(u.pm * 256 + tid); }
    __device__ __forceinline__ void operator()(const pg8::f32x4 (&acc)[2][2][4][2], const pg8::Unit& u, int wr, int wc, int fr, int fq, PG8_LAS unsigned char* lds, const pg8::Unit& nxt, bool has_next, int ui, int tid) const {
        const LAS float* tab = rstab(lds, ui & 1);
        float nrs = 0.f; if (has_next && tid < 256) nrs = f.rs_row(nxt.pm * 256 + tid);
#pragma unroll
        for (int ai = 0; ai < 2; ++ai)
#pragma unroll
            for (int m = 0; m < 4; ++m) { const int rl = ai * 128 + wr * 64 + m * 16 + fr, row = u.pm * 256 + rl; RowCtx c = RowCtx{tab[rl], 0.f};
#pragma unroll
                for (int bj = 0; bj < 2; ++bj) f.apply8(c, row, u.pn * 256 + wc * 64 + bj * 32 + 8 * fq, acc[ai][bj][m][0], acc[ai][bj][m][1]);
                f.end(c, row, u.pn * 256 + wc * 32, fq); }
        if (has_next && tid < 256) rstab(lds, (ui + 1) & 1)[tid] = nrs; } };
template <class F> struct EpiResid8 { static constexpr bool PERM = true, AFTER_DRAIN = true, BADJ = true; F f;
    __device__ __forceinline__ void first(PG8_LAS unsigned char*, const pg8::Unit&, int) const {}
    __device__ __forceinline__ void operator()(const pg8::f32x4 (&)[2][2][4][2], const pg8::Unit&, int, int, int, int, PG8_LAS unsigned char*, const pg8::Unit&, bool, int, int) const {}
    __device__ __forceinline__ void fused(pg8::f32x4 (&acc)[2][2][4][2], const pg8::Unit& u, int wr, int wc, int fr, int fq, PG8_LAS unsigned char* lds, int wid, int lane) const {
        PG8_LAS unsigned char* stg = lds + wid * 16384;
        { const int lrow = lane >> 3, lsl = lane & 7;
          const bf16* src = f.XB16 + (size_t)(u.pm * 256 + wr * 64 + lrow) * D + u.pn * 256 + wc * 64 + ((lsl ^ lrow) * 8);
#pragma unroll
          for (int ai = 0; ai < 2; ++ai)
#pragma unroll
              for (int i = 0; i < 8; ++i) __builtin_amdgcn_global_load_lds((const unsigned*)(src + (size_t)(ai * 128 + i * 8) * D), (PG8_LAS unsigned*)(stg + ai * 8192 + i * 1024), 16, 0, 0); }
        asm volatile("s_waitcnt vmcnt(0)" ::: "memory");
#pragma unroll
        for (int ai = 1; ai >= 0; --ai)
#pragma unroll
            for (int m = 0; m < 4; ++m) { const int row = u.pm * 256 + ai * 128 + wr * 64 + m * 16 + fr; RowCtx c = f.begin(row);
#pragma unroll
                for (int bj = 0; bj < 2; ++bj) { const v4u xo = *(const PG8_LAS v4u*)(stg + ai * 8192 + (16 * m + fr) * 128 + (((bj * 4 + fq) ^ (fr & 7)) * 16));
                    f.apply8x(c, row, u.pn * 256 + wc * 64 + bj * 32 + 8 * fq, acc[ai][bj][m][0], acc[ai][bj][m][1], xo); }
                f.end(c, row, u.pn * 256 + wc * 32, fq); }
    } };
template <class F> struct EpiPair8 { static constexpr bool PERM = true, AFTER_DRAIN = false, BADJ = false; F f;
    __device__ __forceinline__ void first(PG8_LAS unsigned char*, const pg8::Unit&, int) const {}
    __device__ __forceinline__ void operator()(const pg8::f32x4 (&acc)[2][2][4][2], const pg8::Unit& u, int wr, int wc, int fr, int fq, PG8_LAS unsigned char*, const pg8::Unit&, bool, int, int) const {
        v4u xo[2][4];
#pragma unroll
        for (int ai = 0; ai < 2; ++ai)
#pragma unroll
            for (int m = 0; m < 4; ++m) f.load8(u.pm * 256 + ai * 128 + wr * 64 + m * 16 + fr, u.pn * 128 + wc * 32 + 8 * fq, xo[ai][m]);
#pragma unroll
        for (int ai = 0; ai < 2; ++ai)
#pragma unroll
            for (int m = 0; m < 4; ++m) { const int row = u.pm * 256 + ai * 128 + wr * 64 + m * 16 + fr; RowCtx c = f.begin(row);
                f.apply8x_pair(c, row, u.pn * 128 + wc * 32 + 8 * fq, acc[ai][0][m][0], acc[ai][0][m][1], acc[ai][1][m][0], acc[ai][1][m][1], xo[ai][m]);
                f.end(c, row, u.pn * 128 + wc * 32, fq); } } };

constexpr int NWAVES = 8;
constexpr int RING_BYTES = 131072, LDSCTL_OFF = RING_BYTES, MISC_OFF = LDSCTL_OFF + 320, LDS_BYTES = 147456;
constexpr int PTAB_OFF = LDSCTL_OFF + 1024;
struct Frame { LAS unsigned char* lds; int tid, lane, wave, vcu, G, bx; };
__device__ __forceinline__ const float* inp(const Frame& F, int i) {
    const volatile LAS unsigned* t = (const volatile LAS unsigned*)(F.lds + PTAB_OFF) + 2 * i;
    const unsigned lo = __builtin_amdgcn_readfirstlane(t[0]), hi = __builtin_amdgcn_readfirstlane(t[1]);
    return (const float*)(((unsigned long long)hi << 32) | lo);
}

template <int NCT, int KS, bool GLU, int UNR, class F>
__device__ __forceinline__ void small_gemm(const Frame& Fr_in, const bf16* A, const bf16* WT, int K, const F& f) {
    constexpr int CS = 8 / KS, CT = NCT / CS, NT = 4 * CT;
    int t_ = threadIdx.x; asm volatile("" : "+v"(t_));
    Frame Fr = Fr_in; Fr.tid = t_; Fr.lane = t_ & 63; Fr.wave = __builtin_amdgcn_readfirstlane(t_ >> 6);
    const int rb = Fr.vcu & 7, cb = Fr.vcu >> 3, kq = Fr.wave % KS, cs = Fr.wave / KS, fr = Fr.lane & 15, fq = Fr.lane >> 4;
    const int m0 = MP + rb * 64, ksl = K / KS;
    f32x4 acc[4][CT];
#pragma unroll
    for (int r = 0; r < 4; ++r)
#pragma unroll
        for (int j = 0; j < CT; ++j) acc[r][j] = (f32x4){0.f, 0.f, 0.f, 0.f};
    (void)UNR;
    PG8_LAS unsigned char* stg = Fr.lds + Fr.wave * 16384;
    const int lrow = Fr.lane >> 3, lsl = Fr.lane & 7;
    const GAS bf16* asrc = (const GAS bf16*)A + (size_t)(m0 + lrow) * K + kq * ksl + ((lsl ^ lrow) * 8);
    const GAS bf16* bsrc[CT];
#pragma unroll
    for (int j = 0; j < CT; ++j) { const int ct = cs * CT + j; int wrow;
        if (GLU) { const int c = cb * 32 + (ct & 1) * 16; wrow = 256 * (c >> 7) + 128 * (ct >> 1) + (c & 127); } else wrow = (cb * NCT + ct) * 16;
        bsrc[j] = (const GAS bf16*)WT + (size_t)(wrow + lrow) * K + kq * ksl + ((lsl ^ lrow) * 8); }
    for (int kc = 0; kc < ksl; kc += 64) {
#pragma unroll
        for (int i = 0; i < 8; ++i) __builtin_amdgcn_global_load_lds((const unsigned*)(asrc + (size_t)i * 8 * K + kc), (PG8_LAS unsigned*)(stg + i * 1024), 16, 0, 0);
#pragma unroll
        for (int j = 0; j < CT; ++j)
#pragma unroll
            for (int i = 0; i < 2; ++i) __builtin_amdgcn_global_load_lds((const unsigned*)(bsrc[j] + (size_t)i * 8 * K + kc), (PG8_LAS unsigned*)(stg + 8192 + (j * 2 + i) * 1024), 16, 0, 0);
        asm volatile("s_waitcnt vmcnt(0)" ::: "memory");
#pragma unroll
        for (int s_ = 0; s_ < 2; ++s_) {
            bf16x8 a[4], b[CT];
            const int so = ((4 * s_ + fq) ^ (fr & 7)) * 16;
#pragma unroll
            for (int r = 0; r < 4; ++r) a[r] = *(const PG8_LAS bf16x8*)(stg + (16 * r + fr) * 128 + so);
#pragma unroll
            for (int j = 0; j < CT; ++j) b[j] = *(const PG8_LAS bf16x8*)(stg + 8192 + (16 * j + fr) * 128 + so);
#pragma unroll
            for (int r = 0; r < 4; ++r)
#pragma unroll
                for (int j = 0; j < CT; ++j) acc[r][j] = __builtin_amdgcn_mfma_f32_16x16x32_bf16(b[j], a[r], acc[r][j], 0, 0, 0);
        }
        asm volatile("s_waitcnt lgkmcnt(0)" ::: "memory");
    }
    LAS f32x4* RED = (LAS f32x4*)Fr.lds;
    asm volatile("s_waitcnt lgkmcnt(0)" ::: "memory");
#pragma unroll
    for (int r = 0; r < 4; ++r)
#pragma unroll
        for (int j = 0; j < CT; ++j) RED[(Fr.wave * 16 + r * CT + j) * 64 + Fr.lane] = acc[r][j];
    __syncthreads();
    const int rt = Fr.wave & 3, hf = Fr.wave >> 2, row = m0 + rt * 16 + fr;
    RowCtx c = f.begin(row);
    if constexpr (GLU) {
        f32x4 va = (f32x4){0.f, 0.f, 0.f, 0.f}, vb = va;
#pragma unroll
        for (int q = 0; q < KS; ++q) { va = va + RED[(q * 16 + rt * CT + hf) * 64 + Fr.lane]; vb = vb + RED[(q * 16 + rt * CT + 2 + hf) * 64 + Fr.lane]; }
        const int col = cb * 32 + hf * 16; c.ss = 0.f; f.apply4_pair(c, row, col + 4 * fq, va, vb); f.end(c, row, col, fq);
    } else {
#pragma unroll
        for (int jj = 0; jj < NCT / 2; ++jj) { const int ct = hf * (NCT / 2) + jj, g = ct / CT, j = ct % CT; f32x4 v = (f32x4){0.f, 0.f, 0.f, 0.f};
#pragma unroll
            for (int q = 0; q < KS; ++q) v = v + RED[((g * KS + q) * 16 + rt * CT + j) * 64 + Fr.lane];
            const int col = (cb * NCT + ct) * 16; c.ss = 0.f; f.apply4(c, row, col + 4 * fq, v); f.end(c, row, col, fq); }
    }
    __syncthreads();
}

__device__ __forceinline__ void transpose_item(const float* W, int K, int N, bf16* WT, int drow0, LAS float* scr, int k0, int n0, int lane, const float* gain) {
    const int rq = lane >> 3, cq = lane & 7;
    f32x4 v[8]; float gn[8];
#pragma unroll
    for (int i = 0; i < 8; ++i) { const int kk = 8 * i + rq; v[i] = *(const GAS f32x4*)((const GAS float*)W + (size_t)(k0 + kk) * N + n0 + 4 * cq); gn[i] = gain ? gain[k0 + kk] : 1.f; }
#pragma unroll
    for (int i = 0; i < 8; ++i) { LAS float* d = scr + (8 * i + rq) * 33 + 4 * cq; d[0] = v[i].x * gn[i]; d[1] = v[i].y * gn[i]; d[2] = v[i].z * gn[i]; d[3] = v[i].w * gn[i]; }
    LDS_WAIT(); asm volatile("" ::: "memory");
    const int c = lane & 7;
#pragma unroll
    for (int j = 0; j < 4; ++j) { const int n = (lane >> 3) + 8 * j; const LAS float* s = scr + (8 * c) * 33 + n;
        v4u o; o.x = cvt_pk_bf16(s[0 * 33], s[1 * 33]); o.y = cvt_pk_bf16(s[2 * 33], s[3 * 33]); o.z = cvt_pk_bf16(s[4 * 33], s[5 * 33]); o.w = cvt_pk_bf16(s[6 * 33], s[7 * 33]);
        *(GAS v4u*)(WT + (size_t)(drow0 + n) * K + k0 + 8 * c) = o; }
    LDS_WAIT(); asm volatile("" ::: "memory");
}
__device__ __forceinline__ bool conv_job(const Frame& F, int& it, const float* W, int K, int N, bf16* WT, bool glu, const float* gain) {
    const int nblk = N / 32, nit = (K / 64) * nblk;
    if (it >= nit) { it -= nit; return false; }
    const int kb = it / nblk, nb = it % nblk, n0 = 32 * nb; int drow0 = n0;
    if (glu) { const int bj = n0 >> 10, r = n0 & 1023; drow0 = 256 * (r >> 7) + 128 * bj + (r & 127); }
    transpose_item(W, K, N, WT, drow0, (LAS float*)(F.lds + F.wave * 16384), 64 * kb, n0, F.lane, gain);
    return true;
}
__device__ __forceinline__ void ffn_conv(const Frame& F, int l, const float* w1, const float* w2, const float* gffn, unsigned char* ws, int half) {
    const int gw = F.vcu * NWAVES + F.wave, NGW = F.G * NWAVES;
    for (int it0 = 2048 * half + gw; it0 < 2048 * half + 2048; it0 += NGW) { int it = it0;
        if (conv_job(F, it, w1 + (size_t)l * D * FF, D, FF, (bf16*)(ws + WS_W_FF1), false, gffn + l * D)) continue;
        conv_job(F, it, w2 + (size_t)l * FF * D, FF, D, (bf16*)(ws + WS_W_FF2), false, nullptr);
    }
}

__device__ __forceinline__ void proj_conv(const Frame& F, unsigned char* ws, int grp) {
    const int gw = F.vcu * NWAVES + F.wave, NGW = F.G * NWAVES; const float* gm = inp(F, 6);
    if (grp == 0) {
        for (int it0 = gw; it0 < 2048; it0 += NGW) { int it = it0;
            if (conv_job(F, it, inp(F, 15), D, D, (bf16*)(ws + WS_W_OUTA), false, nullptr)) continue;
            if (conv_job(F, it, inp(F, 16), D, 2048, (bf16*)(ws + WS_W_INB), false, gm + D)) continue;
            conv_job(F, it, inp(F, 24), D, D, (bf16*)(ws + WS_W_OUTB), false, nullptr); }
    } else if (grp == 1) {
        for (int it0 = gw; it0 < 2048; it0 += NGW) { int it = it0;
            if (conv_job(F, it, inp(F, 25), D, D, (bf16*)(ws + WS_W_INC), false, gm + 2 * D)) continue;
            if (conv_job(F, it, inp(F, 34), D, 2048, (bf16*)(ws + WS_W_GLU), true, nullptr)) continue;
            conv_job(F, it, inp(F, 15) + (size_t)D * D, D, D, (bf16*)(ws + WS_W_OUTA + 2 * MiB), false, nullptr); }
    } else {
        for (int it0 = gw; it0 < 1024; it0 += NGW) { int it = it0; conv_job(F, it, inp(F, 11) + (size_t)D * 2048, D, 2048, (bf16*)(ws + WS_W_INA + 4 * MiB), false, gm + 3 * D); }
    }
}

struct Args { const float* in[35]; float* out; unsigned char* ws; int ph_lo, ph_hi; };

__device__ __forceinline__ void prologue_rows(const Frame& F, const float* xp, const float* xs, bf16* XB16, float* SX0) {
    const int gw = F.vcu * NWAVES + F.wave, NGW = F.G * NWAVES;
    for (int row0 = gw; row0 < M; row0 += 3 * NGW) {
        f32x4 v[3][4];
#pragma unroll
        for (int q = 0; q < 3; ++q) { const int row = row0 + q * NGW; if (row < M) {
            const GAS f32x4* xr = (const GAS f32x4*)(row < MP ? xp + (size_t)row * D : xs + (size_t)(row - MP) * D) + F.lane;
#pragma unroll
            for (int j = 0; j < 4; ++j) v[q][j] = xr[64 * j]; } }
#pragma unroll
        for (int q = 0; q < 3; ++q) { const int row = row0 + q * NGW; if (row < M) { float s = 0.f;
#pragma unroll
            for (int j = 0; j < 4; ++j) s += (v[q][j].x * v[q][j].x + v[q][j].y * v[q][j].y) + (v[q][j].z * v[q][j].z + v[q][j].w * v[q][j].w);
            s = wave_sum(s);
            if (row < MP) { if (F.lane == 0) SX0[row] = s; } else SX0[(size_t)MP * XS_P + (size_t)(row - MP) * XS_S + F.lane] = F.lane == 0 ? s : 0.f;
            u32x2* o = (u32x2*)(XB16 + (size_t)row * D) + F.lane;
#pragma unroll
            for (int j = 0; j < 4; ++j) { u32x2 w; w.x = cvt_pk_bf16(v[q][j].x, v[q][j].y); w.y = cvt_pk_bf16(v[q][j].z, v[q][j].w); o[64 * j] = w; } } }
    }
}
__device__ __forceinline__ void norm_final(const Frame& F, const bf16* XB16, float* out, const float* g) {
    const int gw = F.vcu * NWAVES + F.wave, NGW = F.G * NWAVES;
    f32x4 gv[4];
#pragma unroll
    for (int j = 0; j < 4; ++j) gv[j] = ((const f32x4*)g)[F.lane + 64 * j];
    for (int row = gw; row < M; row += NGW) {
        const u32x2* xr = (const u32x2*)(XB16 + (size_t)row * D) + F.lane; f32x4 v[4]; float s = 0.f;
#pragma unroll
        for (int j = 0; j < 4; ++j) { const u32x2 o = xr[64 * j]; v[j] = (f32x4){bflo(o.x), bfhi(o.x), bflo(o.y), bfhi(o.y)}; s += (v[j].x * v[j].x + v[j].y * v[j].y) + (v[j].z * v[j].z + v[j].w * v[j].w); }
        const float rs = rsqrtf(wave_sum(s) * (1.f / D) + EPS);
        f32x4* yo = (f32x4*)(out + (size_t)row * D) + F.lane;
#pragma unroll
        for (int j = 0; j < 4; ++j) yo[64 * j] = v[j] * rs * gv[j];
    }
}

template <class Epi> __device__ __forceinline__ void big_gemm(const Frame& F, const bf16* A, const bf16* WT, int N, int K, const Epi& E) {
    pg8::Gemm g{A, WT, MP, N, K}; pg8::StaticOrder S; S.init(MP, N, F.G, F.bx);
    pg8::gemm_phase<Epi, pg8::StaticOrder, true, true>(F.lds, g, S, E, F.tid);
}

constexpr int VS_STRIDE = 264;
constexpr int SGU_RS_OFF = 128 * VS_STRIDE;
constexpr int SGU_ST_OFF = 40960, SGU_ST_STRIDE = 272;
__device__ __forceinline__ void sgu_mix_phase(const Frame& F, const bf16* UV, const float* SV, const float* sg, const bf16* Wm, const float* bs, const float* wsf, bf16* Y, float* vs_out) {
    LAS unsigned char* Vs = F.lds; LAS float* RS = (LAS float*)(F.lds + SGU_RS_OFF); const int fr = F.lane & 15, fq = F.lane >> 4;
    { const int i = F.tid >> 7, u = F.vcu + 256 * i; if (u < 1024) RS[F.tid] = rs_v(SV, (u >> 3) * 128 + (F.tid & 127)); }
    const int g = F.vcu & 7; const bf16* wg = Wm + (size_t)g * 128 * 128;
    bf16x8 bfr[20]; { int q = 0;
#pragma unroll
        for (int n = 0; n < 8; ++n)
#pragma unroll
            for (int kk = 0; kk <= n / 2; ++kk) bfr[q++] = *(const GAS bf16x8*)((const GAS bf16*)wg + (size_t)(16 * n + fr) * 128 + 32 * kk + 8 * fq); }
    float bb[8];
#pragma unroll
    for (int n = 0; n < 8; ++n) bb[n] = bs[g * 128 + 16 * n + fr];
    const f32x4 g4 = *(const f32x4*)(sg + g * 128 + 16 * F.wave + 4 * fq);
    v4u raw[4]; u32x2 uu[8];
    auto load_unit = [&](int u) { const int r0 = (u >> 3) * 128;
#pragma unroll
        for (int i = 0; i < 4; ++i) { const int id = F.tid + 512 * i, row = id >> 4, ch = id & 15; raw[i] = *(const GAS v4u*)((const GAS bf16*)UV + (size_t)(r0 + row) * 2048 + 1024 + g * 128 + ch * 8); }
#pragma unroll
        for (int n = 0; n < 8; ++n) uu[n] = *(const GAS u32x2*)((const GAS bf16*)UV + (size_t)(r0 + 16 * n + fr) * 2048 + g * 128 + 16 * F.wave + 4 * fq); };
    load_unit(F.vcu);
    __syncthreads();
    for (int ui = 0, u = F.vcu; u < 1024; u += F.G, ++ui) {
        const int r0 = (u >> 3) * 128;
#pragma unroll
        for (int i = 0; i < 4; ++i) { const int id = F.tid + 512 * i, row = id >> 4, ch = id & 15;
            *(LAS u32x2*)(Vs + row * VS_STRIDE + ch * 16) = (u32x2){raw[i].x, raw[i].y}; *(LAS u32x2*)(Vs + row * VS_STRIDE + ch * 16 + 8) = (u32x2){raw[i].z, raw[i].w}; }
        u32x2 uc[8];
#pragma unroll
        for (int n = 0; n < 8; ++n) uc[n] = uu[n];
        if (u + F.G < 1024) load_unit(u + F.G);
        __syncthreads();
        bf16x8 af[4];
#pragma unroll
        for (int kk = 0; kk < 4; ++kk) { float e[8];
#pragma unroll
            for (int j = 0; j < 8; ++j) { const int sr = 32 * kk + 8 * fq + j; e[j] = bf2f(*(const LAS unsigned short*)(Vs + sr * VS_STRIDE + (16 * F.wave + fr) * 2)) * RS[ui * 128 + sr]; }
            v4u p; p.x = cvt_pk_bf16(e[0], e[1]); p.y = cvt_pk_bf16(e[2], e[3]); p.z = cvt_pk_bf16(e[4], e[5]); p.w = cvt_pk_bf16(e[6], e[7]); af[kk] = __builtin_bit_cast(bf16x8, p); }
        f32x4 acc[8]; { int q = 0;
#pragma unroll
            for (int n = 0; n < 8; ++n) { acc[n] = (f32x4){0.f, 0.f, 0.f, 0.f};
#pragma unroll
                for (int kk = 0; kk <= n / 2; ++kk) acc[n] = __builtin_amdgcn_mfma_f32_16x16x32_bf16(af[kk], bfr[q++], acc[n], 0, 0, 0); } }
#pragma unroll
        for (int n = 0; n < 8; ++n) { const int t = 16 * n + fr, row = r0 + t, col = g * 128 + 16 * F.wave + 4 * fq;
            u32x2 w; w.x = cvt_pk_bf16(bflo(uc[n].x) * (acc[n][0] * g4.x + bb[n]), bfhi(uc[n].x) * (acc[n][1] * g4.y + bb[n])); w.y = cvt_pk_bf16(bflo(uc[n].y) * (acc[n][2] * g4.z + bb[n]), bfhi(uc[n].y) * (acc[n][3] * g4.w + bb[n]));
            (void)row; (void)col; *(LAS u32x2*)(F.lds + SGU_ST_OFF + t * SGU_ST_STRIDE + (16 * F.wave + 4 * fq) * 2) = w; }
        __syncthreads();
#pragma unroll
        for (int i = 0; i < 4; ++i) { const int id = F.tid + 512 * i, row = id >> 4, ch = id & 15;
            *(GAS v4u*)((GAS bf16*)Y + (size_t)(r0 + row) * 1024 + g * 128 + ch * 8) = *(const LAS v4u*)(F.lds + SGU_ST_OFF + row * SGU_ST_STRIDE + ch * 16); }
        __syncthreads();
    }
    for (int it = F.vcu * 128 + F.tid; F.tid < 128 && it < 128 * 256; it += F.G * 128) {
        const int b = it >> 8, d = (it & 255) * 4, gh = d >> 7, rowb = MP + b * 4; const f32x4 gg = *(const f32x4*)(sg + d);
        float v[4][4], uu[4][4];
#pragma unroll
        for (int s = 0; s < 4; ++s) { const u32x2 rv = *(const u32x2*)(UV + (size_t)(rowb + s) * 2048 + 1024 + d), ru = *(const u32x2*)(UV + (size_t)(rowb + s) * 2048 + d); const float rs = rs_v(SV, rowb + s);
            v[s][0] = bflo(rv.x) * rs; v[s][1] = bfhi(rv.x) * rs; v[s][2] = bflo(rv.y) * rs; v[s][3] = bfhi(rv.y) * rs;
            uu[s][0] = bflo(ru.x); uu[s][1] = bfhi(ru.x); uu[s][2] = bflo(ru.y); uu[s][3] = bfhi(ru.y);
            *(f32x4*)(vs_out + (size_t)(b * 4 + s) * 1024 + d) = (f32x4){v[s][0] * gg.x, v[s][1] * gg.y, v[s][2] * gg.z, v[s][3] * gg.w}; }
#pragma unroll
        for (int t = 0; t < 4; ++t) { float m[4] = {0.f, 0.f, 0.f, 0.f};
#pragma unroll
            for (int s = 0; s <= t; ++s) { const float w = wsf[((size_t)gh * 128 + t) * 128 + s];
#pragma unroll
                for (int e = 0; e < 4; ++e) m[e] += w * v[s][e]; }
            const float bb = bs[gh * 128 + t];
            u32x2 w; w.x = cvt_pk_bf16(uu[t][0] * (m[0] * gg.x + bb), uu[t][1] * (m[1] * gg.y + bb)); w.y = cvt_pk_bf16(uu[t][2] * (m[2] * gg.z + bb), uu[t][3] * (m[3] * gg.w + bb));
            *(u32x2*)(Y + (size_t)(rowb + t) * 1024 + d) = w; }
    }
}
constexpr size_t RGT_W = 0, RGT_BA = 512 * 1024, RGT_BX = RGT_BA + 4096, RGT_NSP = RGT_BX + 4096;
__device__ __forceinline__ int rg_jch(int m, int r) { return 8 * (r >> 2) + 4 * (m & 1) + (r & 3) + 32 * (m >> 1); }
__device__ __forceinline__ void rglru_tables(const Frame& F, const float* wa, const float* wx, const float* ba, const float* bx, const float* lam, unsigned char* tab) {
    bf16* W = (bf16*)(tab + RGT_W);
    for (int i = F.vcu * 512 + F.tid; i < 16 * 2 * 4 * 2 * 64 * 8; i += F.G * 512) {
        const int e = i & 7, lane = (i >> 3) & 63, ks = (i >> 9) & 1, m = (i >> 10) & 3, type = (i >> 12) & 1, h = i >> 13, fr = lane & 15, fq = lane >> 4;
        const float* w = type ? wx : wa; const float v = w[((size_t)h * 64 + 32 * ks + 8 * fq + e) * 64 + rg_jch(m, fr)];
        W[i] = (bf16)(cvt_pk_bf16(v, 0.f) & 0xffffu);
    }
    for (int c = F.vcu * 512 + F.tid; c < 1024; c += F.G * 512) {
        ((float*)(tab + RGT_BA))[c] = ba[c]; ((float*)(tab + RGT_BX))[c] = bx[c]; ((float*)(tab + RGT_NSP))[c] = -8.0f * log1pf(expf(-lam[c]));
    }
}
template <int CTRL> __device__ __forceinline__ float dpp_f(float old, float src) {
    return __builtin_bit_cast(float, __builtin_amdgcn_update_dpp(__builtin_bit_cast(int, old), __builtin_bit_cast(int, src), CTRL, 0xf, 0xf, false)); }
template <int CTRL> __device__ __forceinline__ float dpp_z(float src) {
    return __builtin_bit_cast(float, __builtin_amdgcn_update_dpp(0, __builtin_bit_cast(int, src), CTRL, 0xf, 0xf, true)); }
constexpr int RG_XC_STRIDE = 68, RG_XC_BYTES = 128 * RG_XC_STRIDE * 4, RG_TOT_OFF = 2 * RG_XC_BYTES, RG_CARRY_OFF = RG_TOT_OFF + 2 * 2 * 8 * 64 * 4, RG_AF_OFF = RG_CARRY_OFF + 512, RG_CT_OFF = RG_AF_OFF + 16384;
template <int D_, bool SAMPLE, int NCH> __device__ __forceinline__ void ks_step(float (&a)[NCH], float (&b)[NCH], int tt) {
#pragma unroll
    for (int i = 0; i < NCH; ++i) {
        float as = dpp_f<0x110 + D_>(1.0f, a[i]), bs = dpp_z<0x110 + D_>(b[i]);
        if (SAMPLE) { const bool ok = tt >= D_; as = ok ? as : 1.0f; bs = ok ? bs : 0.0f; }
        b[i] = a[i] * bs + b[i]; a[i] = a[i] * as;
    }
}
template <bool SAMPLE>
__device__ __forceinline__ void rglru_unit(const Frame& F, int unit, const float* XB, const bf16* G, bf16* Y, const float* cw, const float* cb, const unsigned char* tab,
                                           const float* cstate, const float* hstate, float* conv_out, float* h_out) {
    constexpr int NCH = SAMPLE ? 16 : 8, NM = NCH / 4, CW = SAMPLE ? 64 : 32;
    const int fr = F.lane & 15, fq = F.lane >> 4, w = F.wave;
    int h, b0, rowbase, nchunk, mh;
    if (SAMPLE) { h = unit >> 2; b0 = (unit & 3) * 32; rowbase = MP + b0 * 4; nchunk = 1; mh = 0; }
    else { b0 = unit >> 5; h = (unit >> 1) & 15; mh = unit & 1; rowbase = b0 * 2048; nchunk = 16; }
    LAS float* XC = (LAS float*)F.lds; LAS float* TOT = (LAS float*)(F.lds + RG_TOT_OFF); LAS float* CARRY = (LAS float*)(F.lds + RG_CARRY_OFF);
    const int chq = F.tid & 15, rg = F.tid >> 4, cA = h * 64 + 4 * chq;
    f32x4 nx[7]; u32x2 nq[7];
    auto loadA = [&](int c) {
#pragma unroll
        for (int i = 0; i < 7; ++i) {
            if (SAMPLE) { if (i < 3) nx[i] = *(const GAS f32x4*)((const GAS float*)cstate + ((size_t)(b0 + rg) * 3 + i) * 1024 + cA);
                else { const u32x2 q = *(const GAS u32x2*)((const GAS bf16*)XB + (size_t)(rowbase + rg * 4 + i - 3) * 1024 + cA); nx[i] = (f32x4){bflo(q.x), bfhi(q.x), bflo(q.y), bfhi(q.y)}; } }
            else { const int tau = c * 128 + 4 * rg + i - 3, tc = tau < 0 ? 0 : tau;
                nq[i] = *(const GAS u32x2*)((const GAS bf16*)XB + (size_t)(rowbase + tc) * 1024 + cA); } } };
    loadA(0);
    { const v4u* src = (const v4u*)((const bf16*)(tab + RGT_W) + (size_t)h * 16 * 64 * 8); LAS v4u* dst = (LAS v4u*)(F.lds + RG_AF_OFF);
      dst[F.tid] = src[F.tid]; dst[F.tid + 512] = src[F.tid + 512]; }
    { LAS float* CT = (LAS float*)(F.lds + RG_CT_OFF);
      if (F.tid < 64) { CT[F.tid] = ((const float*)(tab + RGT_BA))[h * 64 + F.tid]; CT[64 + F.tid] = ((const float*)(tab + RGT_BX))[h * 64 + F.tid]; CT[128 + F.tid] = ((const float*)(tab + RGT_NSP))[h * 64 + F.tid];
                        CT[448 + F.tid] = cb[h * 64 + F.tid]; }
      if (F.tid < 256) CT[192 + F.tid] = cw[(F.tid >> 6) * 1024 + h * 64 + (F.tid & 63)]; }
    __syncthreads();
    const LAS float* CTL = (const LAS float*)(F.lds + RG_CT_OFF);
    const LAS bf16x8* AfL = (const LAS bf16x8*)(F.lds + RG_AF_OFF) + F.lane;
    const int chl = h * 64 + 32 * mh + 8 * fq;
    for (int c = 0; c < nchunk; ++c) {
        const int buf = c & 1, c0 = c * 128;
        if (!SAMPLE) {
#pragma unroll
            for (int i = 0; i < 7; ++i) { const bool z = c == 0 && 4 * rg + i - 3 < 0; const u32x2 q = nq[i]; nx[i] = z ? (f32x4){0.f, 0.f, 0.f, 0.f} : (f32x4){bflo(q.x), bfhi(q.x), bflo(q.y), bfhi(q.y)}; } }
        { f32x4 cwv[4];
#pragma unroll
          for (int k = 0; k < 4; ++k) cwv[k] = *(const LAS f32x4*)(CTL + 192 + k * 64 + 4 * chq);
          const f32x4 cbv = *(const LAS f32x4*)(CTL + 448 + 4 * chq);
#pragma unroll
          for (int i = 0; i < 4; ++i) { f32x4 acc = cbv;
#pragma unroll
              for (int k = 0; k < 4; ++k) acc = acc + cwv[k] * nx[i + k];
              *(LAS f32x4*)(XC + (size_t)buf * (128 * RG_XC_STRIDE) + (4 * rg + i) * RG_XC_STRIDE + 4 * chq) = acc; } }
        if (SAMPLE) {
#pragma unroll
            for (int r = 0; r < 3; ++r) *(f32x4*)(conv_out + ((size_t)(b0 + rg) * 3 + r) * 1024 + cA) = nx[4 + r]; }
        if (c + 1 < nchunk) loadA(c + 1);
        const int trow = 16 * w + fr;
        const size_t o0 = ((size_t)rowbase + c0 + trow) * 1024 + (SAMPLE ? h * 64 + 8 * fq : chl);
        const v4u g0 = *(const GAS v4u*)((const GAS bf16*)G + o0); v4u g1 = g0; if (SAMPLE) g1 = *(const GAS v4u*)((const GAS bf16*)G + o0 + 32);
        __syncthreads();
        float xc[16];
        { const LAS float* xp = XC + (size_t)buf * (128 * RG_XC_STRIDE) + trow * RG_XC_STRIDE + 8 * fq;
          const f32x4 x0 = *(const LAS f32x4*)(xp), x1 = *(const LAS f32x4*)(xp + 4), x2 = *(const LAS f32x4*)(xp + 32), x3 = *(const LAS f32x4*)(xp + 36);
          xc[0] = x0.x; xc[1] = x0.y; xc[2] = x0.z; xc[3] = x0.w; xc[4] = x1.x; xc[5] = x1.y; xc[6] = x1.z; xc[7] = x1.w;
          xc[8] = x2.x; xc[9] = x2.y; xc[10] = x2.z; xc[11] = x2.w; xc[12] = x3.x; xc[13] = x3.y; xc[14] = x3.z; xc[15] = x3.w; }
        bf16x8 bf0, bf1;
        { v4u p0, p1; p0.x = cvt_pk_bf16(xc[0], xc[1]); p0.y = cvt_pk_bf16(xc[2], xc[3]); p0.z = cvt_pk_bf16(xc[4], xc[5]); p0.w = cvt_pk_bf16(xc[6], xc[7]);
          p1.x = cvt_pk_bf16(xc[8], xc[9]); p1.y = cvt_pk_bf16(xc[10], xc[11]); p1.z = cvt_pk_bf16(xc[12], xc[13]); p1.w = cvt_pk_bf16(xc[14], xc[15]);
          bf0 = __builtin_bit_cast(bf16x8, p0); bf1 = __builtin_bit_cast(bf16x8, p1); }
        float av[NCH], bv[NCH];
#pragma unroll
        for (int mm = 0; mm < NM; ++mm) { const int m = SAMPLE ? mm : 2 * mh + mm;
            f32x4 ra = (f32x4){0.f, 0.f, 0.f, 0.f}, rx = ra;
            ra = __builtin_amdgcn_mfma_f32_16x16x32_bf16(AfL[((0 * 4 + m) * 2 + 0) * 64], bf0, ra, 0, 0, 0); ra = __builtin_amdgcn_mfma_f32_16x16x32_bf16(AfL[((0 * 4 + m) * 2 + 1) * 64], bf1, ra, 0, 0, 0);
            rx = __builtin_amdgcn_mfma_f32_16x16x32_bf16(AfL[((1 * 4 + m) * 2 + 0) * 64], bf0, rx, 0, 0, 0); rx = __builtin_amdgcn_mfma_f32_16x16x32_bf16(AfL[((1 * 4 + m) * 2 + 1) * 64], bf1, rx, 0, 0, 0);
            const int cg = h * 64 + 8 * fq + 4 * (m & 1) + 32 * (m >> 1);
            const int cgl = cg - h * 64; const f32x4 ba4 = *(const LAS f32x4*)(CTL + cgl), bx4 = *(const LAS f32x4*)(CTL + 64 + cgl), ns4 = *(const LAS f32x4*)(CTL + 128 + cgl);
#pragma unroll
            for (int r = 0; r < 4; ++r) { const float rg_ = sigmoid_fast(ra[r] + ba4[r]), ig = sigmoid_fast(rx[r] + bx4[r]);
                const float la = ns4[r] * rg_, a = __builtin_amdgcn_exp2f(1.4426950408889634f * la), mult = __builtin_amdgcn_sqrtf(fmaxf(1.f - a * a, 0.f));
                const float xcv = SAMPLE ? xc[4 * mm + r] : (mh ? xc[8 + 4 * mm + r] : xc[4 * mm + r]);
                av[4 * mm + r] = a; bv[4 * mm + r] = mult * ig * xcv; }
        }
        const int tt = fr & 3;
        if (SAMPLE) {
            const int bi = (16 * w + fr) >> 2;
#pragma unroll
            for (int m = 0; m < 4; ++m) { const int cg = h * 64 + 8 * fq + 4 * (m & 1) + 32 * (m >> 1); const f32x4 h0 = *(const f32x4*)(hstate + (size_t)(b0 + bi) * 1024 + cg);
#pragma unroll
                for (int r = 0; r < 4; ++r) if (tt == 0) bv[4 * m + r] += av[4 * m + r] * h0[r]; }
            ks_step<1, true, NCH>(av, bv, tt); ks_step<2, true, NCH>(av, bv, tt);
        } else {
            ks_step<1, false, NCH>(av, bv, tt); ks_step<2, false, NCH>(av, bv, tt); ks_step<4, false, NCH>(av, bv, tt); ks_step<8, false, NCH>(av, bv, tt);
            if (fr == 15) { LAS float* ta = TOT + ((size_t)(buf * 2 + 0) * 8 + w) * 64 + fq * NCH; LAS float* th = TOT + ((size_t)(buf * 2 + 1) * 8 + w) * 64 + fq * NCH;
#pragma unroll
                for (int i = 0; i < NCH; i += 4) { *(LAS f32x4*)(ta + i) = (f32x4){av[i], av[i + 1], av[i + 2], av[i + 3]}; *(LAS f32x4*)(th + i) = (f32x4){bv[i], bv[i + 1], bv[i + 2], bv[i + 3]}; } }
            __syncthreads();
            float ch[NCH];
            if (c == 0) {
#pragma unroll
                for (int i = 0; i < NCH; ++i) ch[i] = 0.f;
            } else {
#pragma unroll
                for (int i = 0; i < NCH; i += 4) { const f32x4 t = *(const LAS f32x4*)(CARRY + buf * 64 + fq * NCH + i); ch[i] = t.x; ch[i + 1] = t.y; ch[i + 2] = t.z; ch[i + 3] = t.w; }
            }
            for (int v = 0; v < w; ++v) { const LAS float* ta = TOT + ((size_t)(buf * 2 + 0) * 8 + v) * 64 + fq * NCH; const LAS float* th = TOT + ((size_t)(buf * 2 + 1) * 8 + v) * 64 + fq * NCH;
#pragma unroll
                for (int i = 0; i < NCH; i += 4) { const f32x4 A4 = *(const LAS f32x4*)(ta + i), H4 = *(const LAS f32x4*)(th + i);
                    ch[i] = A4.x * ch[i] + H4.x; ch[i + 1] = A4.y * ch[i + 1] + H4.y; ch[i + 2] = A4.z * ch[i + 2] + H4.z; ch[i + 3] = A4.w * ch[i + 3] + H4.w; } }
#pragma unroll
            for (int i = 0; i < NCH; ++i) bv[i] = bv[i] + av[i] * ch[i];
            if (w == 7 && fr == 15) {
#pragma unroll
                for (int i = 0; i < NCH; i += 4) *(LAS f32x4*)(CARRY + (buf ^ 1) * 64 + fq * NCH + i) = (f32x4){bv[i], bv[i + 1], bv[i + 2], bv[i + 3]}; }
        }
        { v4u y0;
          y0.x = cvt_pk_bf16(bv[0] * bflo(g0.x), bv[1] * bfhi(g0.x)); y0.y = cvt_pk_bf16(bv[2] * bflo(g0.y), bv[3] * bfhi(g0.y)); y0.z = cvt_pk_bf16(bv[4] * bflo(g0.z), bv[5] * bfhi(g0.z)); y0.w = cvt_pk_bf16(bv[6] * bflo(g0.w), bv[7] * bfhi(g0.w));
          *(v4u*)(Y + o0) = y0;
          if constexpr (SAMPLE) { v4u y1;
            y1.x = cvt_pk_bf16(bv[8] * bflo(g1.x), bv[9] * bfhi(g1.x)); y1.y = cvt_pk_bf16(bv[10] * bflo(g1.y), bv[11] * bfhi(g1.y)); y1.z = cvt_pk_bf16(bv[12] * bflo(g1.z), bv[13] * bfhi(g1.z)); y1.w = cvt_pk_bf16(bv[14] * bflo(g1.w), bv[15] * bfhi(g1.w));
            *(v4u*)(Y + o0 + 32) = y1; } }
        if constexpr (SAMPLE) {
            if (tt == 3) { const int bi = (16 * w + fr) >> 2; float* ho = h_out + (size_t)(b0 + bi) * 1024 + h * 64 + 8 * fq;
                *(f32x4*)(ho) = (f32x4){bv[0], bv[1], bv[2], bv[3]}; *(f32x4*)(ho + 4) = (f32x4){bv[4], bv[5], bv[6], bv[7]};
                *(f32x4*)(ho + 32) = (f32x4){bv[8], bv[9], bv[10], bv[11]}; *(f32x4*)(ho + 36) = (f32x4){bv[12], bv[13], bv[14], bv[15]}; }
        } else if (c == nchunk - 1 && w == 7 && fr == 15) { float* ho = h_out + (size_t)b0 * 1024 + chl;
            *(f32x4*)(ho) = (f32x4){bv[0], bv[1], bv[2], bv[3]}; *(f32x4*)(ho + 4) = (f32x4){bv[4], bv[5], bv[6], bv[7]}; }
    }
    if (!SAMPLE && mh == 0 && F.tid < 192) { const int cc = F.tid & 63, r = F.tid >> 6; conv_out[((size_t)b0 * 3 + r) * 1024 + h * 64 + cc] = bf2f(((const bf16*)XB)[(size_t)(rowbase + 2045 + r) * 1024 + h * 64 + cc]); }
    __syncthreads();
}
__device__ __forceinline__ void rglru_phase(const Frame& F, const float* XB, const bf16* G, bf16* Y, const float* cw, const float* cb, const unsigned char* tab, const float* cstate, const float* hstate, float* out) {
    for (int unit = F.vcu; unit < 320; unit += F.G) {
        if (unit < 256) rglru_unit<false>(F, unit, XB, G, Y, cw, cb, tab, nullptr, nullptr, out + O_CONVP, out + O_HP);
        else rglru_unit<true>(F, unit - 256, XB, G, Y, cw, cb, tab, cstate, hstate, out + O_CONVS, out + O_HS);
    }
}
typedef float f32x16 __attribute__((ext_vector_type(16)));
typedef float f32x2 __attribute__((ext_vector_type(2)));
constexpr size_t S5T_AP = 0, S5T_BF = 128 * 1024, S5T_CF = S5T_BF + 256 * 1024;
__device__ __forceinline__ void s5_disc(const float* lre, const float* lim, const float* ldt, int g, int p, float& ar, float& ai, float& qr, float& qi) {
    const float dt = expf(ldt[g]), lr = lre[g * 64 + p], li = lim[g * 64 + p], mag = expf(lr * dt); ar = mag * cosf(li * dt); ai = mag * sinf(li * dt);
    const float zr = ar - 1.f, zi = ai, den = lr * lr + li * li; qr = (zr * lr + zi * li) / den; qi = (zi * lr - zr * li) / den;
}
__device__ __forceinline__ void s5_tables(const Frame& F, const float* lre, const float* lim, const float* ldt, const float* bre, const float* bim, const float* cre, const float* cim, unsigned char* tab) {
    for (int i = F.vcu * 512 + F.tid; i < 4096; i += F.G * 512) { float ar, ai, qr, qi; s5_disc(lre, lim, ldt, i >> 6, i & 63, ar, ai, qr, qi);
        float* o = (float*)(tab + S5T_AP) + (size_t)i * 8; o[0] = ar; o[1] = ai;
        const float r2 = ar * ar - ai * ai, i2 = 2.f * ar * ai; o[2] = r2; o[3] = i2; const float r3 = r2 * ar - i2 * ai, i3 = r2 * ai + i2 * ar; o[4] = r3; o[5] = i3; o[6] = r2 * r2 - i2 * i2; o[7] = 2.f * r2 * i2; }
    for (int i = F.vcu * 512 + F.tid; i < 64 * 2 * 2 * 64 * 8; i += F.G * 512) {
        const int j = i & 7, lane = (i >> 3) & 63, c = (i >> 9) & 1, ws = (i >> 10) & 1, g = i >> 11, p = 32 * ws + (lane & 31), h = 8 * (lane >> 5) + j;
        float ar, ai, qr, qi; s5_disc(lre, lim, ldt, g, p, ar, ai, qr, qi);
        const float br = bre[((size_t)g * 64 + p) * 16 + h], bi = bim[((size_t)g * 64 + p) * 16 + h]; const float v = c ? (qr * bi + qi * br) : (qr * br - qi * bi);
        ((bf16*)(tab + S5T_BF))[i] = (bf16)(cvt_pk_bf16(v, 0.f) & 0xffffu);
    }
    for (int i = F.vcu * 512 + F.tid; i < 64 * 4 * 64 * 8; i += F.G * 512) {
        const int j = i & 7, lane = (i >> 3) & 63, kk = (i >> 9) & 3, g = i >> 11, h = lane & 15, k = 32 * kk + 8 * (lane >> 4) + j, p = k >> 1;
        const float v = (k & 1) ? -cim[((size_t)g * 16 + h) * 64 + p] : cre[((size_t)g * 16 + h) * 64 + p];
        ((bf16*)(tab + S5T_CF))[i] = (bf16)(cvt_pk_bf16(v, 0.f) & 0xffffu);
    }
}
constexpr int S5_XT_STRIDE = 272;
constexpr int S5_XT_UNIT = 128 * S5_XT_STRIDE;
__device__ __forceinline__ f32x2 cmadd(f32x2 a, f32x2 x, f32x2 c) {
    c = (f32x2){a.x, a.x} * x + c; return (f32x2){-a.y, a.y} * __builtin_shufflevector(x, x, 1, 0) + c; }
template <bool SAMPLE>
__device__ __forceinline__ void s5_pass(const Frame& F, int upair_in, const float* U, bf16* Gs, const float* dsk, const unsigned char* tab, const float* sre, const float* sim, float* ore, float* oim) {
    const int upair = SAMPLE ? upair_in + 256 * (F.wave >> 2) : upair_in;
    const int w = SAMPLE ? (F.wave & 3) : F.wave, l31 = F.lane & 31, hh = F.lane >> 5, fr = F.lane & 15, fq = F.lane >> 4;
    constexpr int NTILE = SAMPLE ? 1 : 4, NCHUNK = SAMPLE ? 1 : 16, CROWS = SAMPLE ? 32 : 128;
    constexpr int XTU = SAMPLE ? 32 * S5_XT_STRIDE : S5_XT_UNIT;
    LAS unsigned char* XT = F.lds + (SAMPLE ? (F.wave >> 2) * 2 * XTU : 0);
    const int su = (w >> 1) & 1, ws = w & 1, sunit = upair * 2 + su;
    int sg, srow, sb0; if (SAMPLE) { sg = sunit >> 4; sb0 = (sunit & 15) * 8; srow = MP + sb0 * 4; } else { sb0 = sunit >> 6; sg = sunit & 63; srow = sb0 * 2048; }
    const int pw = SAMPLE ? ((w >> 1) & 1) : (w >> 2), punit = upair * 2 + pw;
    int pg, prow; if (SAMPLE) { pg = punit >> 4; prow = MP + (punit & 15) * 32; } else { pg = punit & 63; prow = (punit >> 6) * 2048; }
    bf16x8 Cf[4];
#pragma unroll
    for (int kk = 0; kk < 4; ++kk) Cf[kk] = *(const bf16x8*)((const bf16*)(tab + S5T_CF) + (((size_t)pg * 4 + kk) * 64 + F.lane) * 8);
    const f32x4 d4 = *(const f32x4*)(dsk + pg * 16 + 4 * fq);
    f32x2 A1, A2, A3, A4, X = (f32x2){0.f, 0.f}; bf16x8 Bf0, Bf1; v4u ua[NTILE];
    if (w < 4) {
        const f32x4* a4 = (const f32x4*)((const float*)(tab + S5T_AP) + ((size_t)sg * 64 + 32 * ws + l31) * 8); const f32x4 lo = a4[0], hi = a4[1];
        A1 = (f32x2){lo.x, lo.y}; A2 = (f32x2){lo.z, lo.w}; A3 = (f32x2){hi.x, hi.y}; A4 = (f32x2){hi.z, hi.w};
        Bf0 = *(const bf16x8*)((const bf16*)(tab + S5T_BF) + ((((size_t)sg * 2 + ws) * 2 + 0) * 64 + F.lane) * 8);
        Bf1 = *(const bf16x8*)((const bf16*)(tab + S5T_BF) + ((((size_t)sg * 2 + ws) * 2 + 1) * 64 + F.lane) * 8);
#pragma unroll
        for (int tl = 0; tl < NTILE; ++tl) if (SAMPLE) ua[tl] = *(const GAS v4u*)((const GAS bf16*)U + ((size_t)srow + tl * 32 + l31) * 1024 + sg * 16 + 8 * hh);
    }
    constexpr int S5_YS_OFF = 2 * S5_XT_UNIT, S5_YS_STRIDE = 80, S5_YS_BUF = 128 * S5_YS_STRIDE;
    const int ys_row = 16 * F.wave + (F.lane >> 2), ys_pc = F.lane & 3;
    bf16* ys_dst = Gs + ((size_t)((upair * 2) >> 6) * 2048 + ys_row) * 1024 + ((upair * 2) & 63) * 16 + ys_pc * 8;
    constexpr int S5_UL_OFF = S5_YS_OFF + 2 * S5_YS_BUF, S5_UL_STRIDE = 80, S5_UL_BUF = 128 * S5_UL_STRIDE;
    const GAS bf16* ul_src = (const GAS bf16*)U + ((size_t)((upair * 2) >> 6) * 2048 + ys_row) * 1024 + ((upair * 2) & 63) * 16 + ys_pc * 8;
    v4u un = (v4u){0u, 0u, 0u, 0u};
    if (!SAMPLE) { un = *(const GAS v4u*)ul_src; *(LAS v4u*)(F.lds + S5_UL_OFF + ys_row * S5_UL_STRIDE + ys_pc * 16) = un; __syncthreads(); }
    for (int c = 0; c < NCHUNK; ++c) {
        if (!SAMPLE && c + 1 < NCHUNK) un = *(const GAS v4u*)(ul_src + (size_t)(c + 1) * 128 * 1024);
        if (!SAMPLE && c > 0) *(GAS v4u*)((GAS bf16*)ys_dst + (size_t)(c - 1) * 128 * 1024) = *(const LAS v4u*)(F.lds + S5_YS_OFF + ((c - 1) & 1) * S5_YS_BUF + ys_row * S5_YS_STRIDE + ys_pc * 16);
        u32x2 up4[2];
#pragma unroll
        for (int q2 = 0; q2 < (SAMPLE ? 1 : 2); ++q2) { const int st = SAMPLE ? (w & 1) : ((w & 3) * 2 + q2);
            if (SAMPLE) up4[q2] = *(const GAS u32x2*)((const GAS bf16*)U + ((size_t)prow + c * 128 + st * 16 + fr) * 1024 + pg * 16 + 4 * fq);
            else up4[q2] = (u32x2){0u, 0u}; }
        if (w < 4) {
#pragma unroll
            for (int tl = 0; tl < NTILE; ++tl) {
                const v4u aw = SAMPLE ? ua[tl] : *(const LAS v4u*)(F.lds + S5_UL_OFF + (c & 1) * S5_UL_BUF + (tl * 32 + l31) * S5_UL_STRIDE + su * 32 + hh * 16);
                const bf16x8 Au = __builtin_bit_cast(bf16x8, aw); f32x16 z16;
#pragma unroll
                for (int i = 0; i < 16; ++i) z16[i] = 0.f;
                const f32x16 bur = __builtin_amdgcn_mfma_f32_32x32x16_bf16(Au, Bf0, z16, 0, 0, 0), bui = __builtin_amdgcn_mfma_f32_32x32x16_bf16(Au, Bf1, z16, 0, 0, 0);
                f32x2 x[16];
#pragma unroll
                for (int k = 0; k < 4; ++k) { f32x2 s = (f32x2){0.f, 0.f};
                    if (SAMPLE) { const size_t so = ((size_t)(sb0 + 2 * k + hh) * 64 + sg) * 64 + 32 * ws + l31; s = (f32x2){sre[so], sim[so]}; }
#pragma unroll
                    for (int i = 0; i < 4; ++i) { const f32x2 bu = (f32x2){bur[4 * k + i], bui[4 * k + i]}; s = (!SAMPLE && i == 0) ? bu : cmadd(A1, s, bu); x[4 * k + i] = s; } }
                if (!SAMPLE) {
                    f32x2 xin[4];
#pragma unroll
                    for (int k = 0; k < 4; ++k) {
                        const f32x2 own = x[4 * k + 3]; float ax = own.x, bx = own.x, ay = own.y, by = own.y;
                        asm volatile("v_nop\n\tv_nop\n\tv_permlane32_swap_b32 %0, %1" : "+v"(ax), "+v"(bx)); asm volatile("v_nop\n\tv_nop\n\tv_permlane32_swap_b32 %0, %1" : "+v"(ay), "+v"(by));
                        const f32x2 L0 = (f32x2){ax, ay}, L1 = (f32x2){bx, by};
                        const f32x2 X0 = X; const f32x2 X1 = cmadd(A4, X0, L0); X = cmadd(A4, X1, L1);
                        xin[k] = hh ? X1 : X0; }
#pragma unroll
                    for (int k = 0; k < 4; ++k) { x[4 * k + 0] = cmadd(A1, xin[k], x[4 * k + 0]); x[4 * k + 1] = cmadd(A2, xin[k], x[4 * k + 1]); x[4 * k + 2] = cmadd(A3, xin[k], x[4 * k + 2]); x[4 * k + 3] = cmadd(A4, xin[k], x[4 * k + 3]); }
                }
                LAS unsigned char* xt = XT + su * XTU + (32 * ws + l31) * 4;
#pragma unroll
                for (int r = 0; r < 16; ++r) *(LAS unsigned*)(xt + (tl * 32 + 8 * (r >> 2) + 4 * hh + (r & 3)) * S5_XT_STRIDE) = cvt_pk_bf16(x[r].x, x[r].y);
                if (SAMPLE) {
#pragma unroll
                    for (int k = 0; k < 4; ++k) { const size_t so = ((size_t)(sb0 + 2 * k + hh) * 64 + sg) * 64 + 32 * ws + l31; ore[so] = x[4 * k + 3].x; oim[so] = x[4 * k + 3].y; } }
            }
        }
        __syncthreads();
        if (!SAMPLE || w < 4) {
#pragma unroll
            for (int q2 = 0; q2 < (SAMPLE ? 1 : 2); ++q2) { const int st = SAMPLE ? (w & 1) : ((w & 3) * 2 + q2);
                const size_t row = (size_t)prow + c * 128 + st * 16 + fr; const int ch = pg * 16 + 4 * fq;
                const u32x2 uq = SAMPLE ? up4[q2] : *(const LAS u32x2*)(F.lds + S5_UL_OFF + (c & 1) * S5_UL_BUF + (st * 16 + fr) * S5_UL_STRIDE + pw * 32 + fq * 8);
                const f32x4 u4 = (f32x4){bflo(uq.x), bfhi(uq.x), bflo(uq.y), bfhi(uq.y)};
                const LAS unsigned char* xr = XT + pw * XTU + (st * 16 + fr) * S5_XT_STRIDE + 16 * fq; f32x4 y = (f32x4){0.f, 0.f, 0.f, 0.f};
#pragma unroll
                for (int kk = 0; kk < 4; ++kk) y = __builtin_amdgcn_mfma_f32_16x16x32_bf16(Cf[kk], *(const LAS bf16x8*)(xr + 64 * kk), y, 0, 0, 0);
                y = y + d4 * u4;
                u32x2 o; o.x = cvt_pk_bf16(gelu_fast(y.x), gelu_fast(y.y)); o.y = cvt_pk_bf16(gelu_fast(y.z), gelu_fast(y.w));
                if (SAMPLE) *(u32x2*)(Gs + row * 1024 + ch) = o; else *(LAS u32x2*)(F.lds + S5_YS_OFF + (c & 1) * S5_YS_BUF + (st * 16 + fr) * S5_YS_STRIDE + pw * 32 + fq * 8) = o; }
        }
        if (!SAMPLE && c + 1 < NCHUNK) *(LAS v4u*)(F.lds + S5_UL_OFF + ((c + 1) & 1) * S5_UL_BUF + ys_row * S5_UL_STRIDE + ys_pc * 16) = un;
        __syncthreads();
    }
    if (!SAMPLE) *(GAS v4u*)((GAS bf16*)ys_dst + (size_t)(NCHUNK - 1) * 128 * 1024) = *(const LAS v4u*)(F.lds + S5_YS_OFF + ((NCHUNK - 1) & 1) * S5_YS_BUF + ys_row * S5_YS_STRIDE + ys_pc * 16);
    if (!SAMPLE && w < 4 && hh == 0) { const size_t so = ((size_t)sb0 * 64 + sg) * 64 + 32 * ws + l31; ore[so] = X.x; oim[so] = X.y; }
    if (!SAMPLE) __syncthreads();
}
__device__ __forceinline__ void s5_phase(const Frame& F, const float* U, bf16* Gs, const float* dsk, const unsigned char* tab, const float* sre, const float* sim, float* out) {
    for (int u0 = F.vcu; u0 < 256; u0 += F.G) s5_pass<false>(F, u0, U, Gs, dsk, tab, nullptr, nullptr, out + O_SREP, out + O_SIMP);
    for (int u0 = F.vcu; u0 < 256; u0 += F.G) s5_pass<true>(F, u0, U, Gs, dsk, tab, sre, sim, out + O_SRES, out + O_SIMS);
}
constexpr int PH_FINAL = 21, PH_END = 22;
enum { ST_GIN = 0, ST_MIX = 1, ST_GOUT = 2, ST_FF1 = 3, ST_FF2 = 4 };
constexpr size_t WS_SX0 = 172 * MiB, WS_SX1 = 175 * MiB, WS_SV = 178 * MiB;
constexpr size_t T_Y = 99 * MiB;

__global__ void __launch_bounds__(NWAVES * 64, 2) mk(Args a) {
    extern __shared__ __attribute__((aligned(16))) unsigned char lds_raw[];
    Frame F; F.lds = (LAS unsigned char*)lds_raw; F.tid = threadIdx.x; F.lane = F.tid & 63; F.wave = __builtin_amdgcn_readfirstlane(F.tid >> 6);
    F.G = gridDim.x; F.bx = blockIdx.x; F.vcu = (F.bx % 8) * (F.G / 8) + F.bx / 8;
    volatile LAS unsigned* MISC = (volatile LAS unsigned*)(F.lds + MISC_OFF);
    for (int u = F.tid; u < (LDS_BYTES - LDSCTL_OFF) / 4; u += NWAVES * 64) ((LAS unsigned*)(F.lds + LDSCTL_OFF))[u] = 0u;
    __syncthreads();
    if (F.tid == 0) { LAS unsigned long long* pt = (LAS unsigned long long*)(F.lds + PTAB_OFF);
#pragma unroll
        for (int i = 0; i < 35; ++i) pt[i] = (unsigned long long)a.in[i]; }
    __syncthreads();
    const bool multi = (a.ph_hi - a.ph_lo) > 1;
    XcdBarrier bar; bar.bar = (unsigned*)(a.ws + WS_CTL) + CW_BAR; bar.x = 0; bar.st = nullptr;
    if (multi) bar = xcd_barrier_post((unsigned*)(a.ws + WS_CTL) + CW_BAR, MISC + 8);

    for (int ph = a.ph_lo; ph < a.ph_hi; ++ph) {
        { int t_ = threadIdx.x, b_ = blockIdx.x; asm volatile("" : "+v"(t_)); asm volatile("" : "+s"(b_));
          F.tid = t_; F.lane = t_ & 63; F.wave = __builtin_amdgcn_readfirstlane(t_ >> 6); F.bx = b_; F.vcu = (b_ % 8) * (F.G / 8) + b_ / 8; }
        unsigned char* ws = a.ws; float* X = a.out; asm volatile("" : "+s"(ws)); asm volatile("" : "+s"(X));
        bf16* XB16 = (bf16*)(ws + WS_XN); unsigned char* T = ws + WS_T; bf16* Y = (bf16*)(T + T_Y);
        float* SX0 = (float*)(ws + WS_SX0); float* SX1 = (float*)(ws + WS_SX1); float* SV = (float*)(ws + WS_SV);
        if (ph == 0) {
            prologue_rows(F, inp(F, 0), inp(F, 1), XB16, SX0);
            { const float* wsf = inp(F, 13); bf16* wm = (bf16*)(ws + WS_WM);
              for (int i = F.vcu * 512 + F.tid; i < 2 * 8 * 128 * 128; i += F.G * 512) { const int s_ = i & 127, t_ = (i >> 7) & 127; wm[i] = s_ <= t_ ? (bf16)(cvt_pk_bf16(wsf[i], 0.f) & 0xffffu) : (bf16)0; } }
            s5_tables(F, inp(F, 26), inp(F, 27), inp(F, 28), inp(F, 29), inp(F, 30), inp(F, 31), inp(F, 32), ws + WS_S5T);
            rglru_tables(F, inp(F, 19), inp(F, 21), inp(F, 20), inp(F, 22), inp(F, 23), ws + WS_RGT);
            const int gw = F.vcu * NWAVES + F.wave, NGW = F.G * NWAVES; const float* gm = inp(F, 6);
            for (int it0 = gw; it0 < 1024; it0 += NGW) { int it = it0; conv_job(F, it, inp(F, 11), D, 2048, (bf16*)(ws + WS_W_INA), false, gm); }
        } else if (ph == PH_FINAL) {
            norm_final(F, XB16, X, inp(F, 8));
        } else {
            const int l = (ph - 1) / 5, st = (ph - 1) % 5, kind = l % 3, j = l / 3;
            if (st == ST_GIN) {
                if (kind == 0) { const bf16* W = (const bf16*)(ws + WS_W_INA + (size_t)j * 4 * MiB); EpiRow8<FAct<ACT_GELU, true>> E{{(bf16*)T, 2048, SX0, l == 0 ? 1 : 16, SV}};
                    if (F.vcu & 1) { small_gemm<4, 8, false, 4>(F, XB16, W, D, E.f); big_gemm(F, XB16, W, 2048, D, E); } else { big_gemm(F, XB16, W, 2048, D, E); small_gemm<4, 8, false, 4>(F, XB16, W, D, E.f); } }
                else if (kind == 1) { const bf16* W = (const bf16*)(ws + WS_W_INB); EpiRow8<FRglru> E{{(bf16*)T, (float*)(T + 33 * MiB), SX0}};
                    if (F.vcu & 1) { small_gemm<4, 8, false, 4>(F, XB16, W, D, E.f); big_gemm(F, XB16, W, 2048, D, E); } else { big_gemm(F, XB16, W, 2048, D, E); small_gemm<4, 8, false, 4>(F, XB16, W, D, E.f); } }
                else { const bf16* W = (const bf16*)(ws + WS_W_INC); EpiRow8<FBf> E{{(bf16*)T, D, SX0}};
                    if (F.vcu & 1) { small_gemm<2, 8, false, 4>(F, XB16, W, D, E.f); big_gemm(F, XB16, W, D, D, E); } else { big_gemm(F, XB16, W, D, D, E); small_gemm<2, 8, false, 4>(F, XB16, W, D, E.f); } }
            } else if (st == ST_MIX) {
                if (kind == 0) sgu_mix_phase(F, (const bf16*)T, SV, inp(F, 12) + j * 1024, (const bf16*)(ws + WS_WM) + (size_t)j * 8 * 128 * 128, inp(F, 14) + j * 8 * 128, inp(F, 13) + (size_t)j * 8 * 128 * 128, Y, X + O_VS + (size_t)j * MS * 1024);
                else if (kind == 1) rglru_phase(F, (const float*)(T + 33 * MiB), (const bf16*)T, Y, inp(F, 17), inp(F, 18), ws + WS_RGT, inp(F, 2), inp(F, 3), X);
                else s5_phase(F, (const float*)T, Y, inp(F, 33), ws + WS_S5T, inp(F, 4), inp(F, 5), X);
            } else if (st == ST_GOUT) {
                if (kind == 2) { const bf16* W = (const bf16*)(ws + WS_W_GLU); EpiPair8<FGlu> E{{XB16, SX1}};
                    if (F.vcu & 1) { small_gemm<4, 8, true, 4>(F, Y, W, D, E.f); big_gemm(F, Y, W, 2048, D, E); } else { big_gemm(F, Y, W, 2048, D, E); small_gemm<4, 8, true, 4>(F, Y, W, D, E.f); } }
                else { const bf16* W = kind == 0 ? (const bf16*)(ws + WS_W_OUTA + (size_t)j * 2 * MiB) : (const bf16*)(ws + WS_W_OUTB); EpiResid8<FResid> E{{XB16, SX1}};
                    if (F.vcu & 1) { small_gemm<2, 8, false, 4>(F, Y, W, D, E.f); big_gemm(F, Y, W, D, D, E); } else { big_gemm(F, Y, W, D, D, E); small_gemm<2, 8, false, 4>(F, Y, W, D, E.f); } }
            } else if (st == ST_FF1) {
                const bf16* W = (const bf16*)(ws + WS_W_FF1); EpiRow8<FAct<ACT_SQRELU, false>> E{{(bf16*)T, FF, SX1, kind == 2 ? 32 : 16, nullptr}};
                if (F.vcu & 1) { small_gemm<8, 4, false, 4>(F, XB16, W, D, E.f); big_gemm(F, XB16, W, FF, D, E); } else { big_gemm(F, XB16, W, FF, D, E); small_gemm<8, 4, false, 4>(F, XB16, W, D, E.f); }
            } else {
                const bf16* W = (const bf16*)(ws + WS_W_FF2); EpiResid8<FResid> E{{XB16, SX0}};
                if (F.vcu & 1) { small_gemm<2, 8, false, 4>(F, (const bf16*)T, W, FF, E.f); big_gemm(F, (const bf16*)T, W, D, FF, E); } else { big_gemm(F, (const bf16*)T, W, D, FF, E); small_gemm<2, 8, false, 4>(F, (const bf16*)T, W, FF, E.f); }
            }
        }
        if (ph + 1 < a.ph_hi) {
            xcd_barrier_arrive(bar);
            if (ph >= 1 && ph < PH_FINAL) { const int st = (ph - 1) % 5;
                if (st == ST_GIN || st == ST_MIX) ffn_conv(F, (ph - 1) / 5, inp(F, 9), inp(F, 10), inp(F, 7), ws, st == ST_MIX ? 1 : 0);
                else if (ph == 1 + ST_GOUT) proj_conv(F, ws, 1);
                else if (ph == 1 + ST_FF1) proj_conv(F, ws, 2); }
            else if (ph == 0) proj_conv(F, ws, 0);
            xcd_barrier_wait(bar);
        }
    }
}

static void launch_mk(const Args& base, int lo, int hi, hipStream_t stream) {
    Args a = base; a.ph_lo = lo; a.ph_hi = hi;
    hipLaunchKernelGGL(mk, dim3(256), dim3(NWAVES * 64), LDS_BYTES, stream, a);
}

extern "C" void kernel_launch(void* const* d_in, const int* in_sizes, int n_in, void* d_out, int out_size, void* d_ws, size_t ws_size, hipStream_t stream) {
    static int inited = 0;
    if (!inited) {
        if (n_in != 35 || out_size != (int)O_END || ws_size < WS_END) { fprintf(stderr, "kernel_launch: unexpected sizes n_in %d out %d ws %zu\n", n_in, out_size, ws_size); }
        if (hipFuncSetAttribute((const void*)mk, hipFuncAttributeMaxDynamicSharedMemorySize, LDS_BYTES) != hipSuccess) fprintf(stderr, "kernel_launch: hipFuncSetAttribute failed\n");
        (void)hipGetLastError(); inited = 1;
    }
    (void)hipMemsetAsync((unsigned char*)d_ws + WS_CTL, 0, CTL_ZERO_BYTES, stream);
    Args base{}; for (int i = 0; i < 35; ++i) base.in[i] = (const float*)d_in[i]; base.out = (float*)d_out; base.ws = (unsigned char*)d_ws;
    launch_mk(base, 0, PH_END, stream);
}
```
